# Optimizing an MI355X kernel written in HIP

```python
import jax
import jax.numpy as jnp
from jax import lax

D_MODEL = 1024
BATCH = 2
SEQ = 16384
DEPTH = 2

GRID_W = 64
CTX_LEN = 256
Q_BLOCK = 128
WINDOW = 128
ROPE_BASE = 10000.0
EPS = 1e-6
NEG_INF = -1e30

MLA_HEADS = 8
MLA_NOPE = 64
MLA_ROPE = 32
MLA_V = 64
MLA_Q_RANK = 256
MLA_KV_RANK = 256

GQA_HEADS = 8
GQA_KV_HEADS = 2
GQA_DIM = 64

WIN_HEADS = 8
WIN_KV_HEADS = 2
WIN_DIM = 64

CONV_CH = 512
CONV_K = 3

AB_MIX = MLA_HEADS * MLA_V + GQA_HEADS * GQA_DIM
AB_SPLIT = (MLA_Q_RANK, MLA_KV_RANK, MLA_ROPE,
            GQA_HEADS * GQA_DIM, GQA_KV_HEADS * GQA_DIM, GQA_KV_HEADS * GQA_DIM,
            AB_MIX)
AB_IN = sum(AB_SPLIT)
CD_MIX = WIN_HEADS * WIN_DIM + CONV_CH
CD_SPLIT = (WIN_HEADS * WIN_DIM, WIN_KV_HEADS * WIN_DIM, WIN_KV_HEADS * WIN_DIM,
            CONV_CH, CONV_CH, CONV_CH, CD_MIX)
CD_IN = sum(CD_SPLIT)

kernel_name = 'hybrid_mla_gqa_window_conv_dit'


def rmsnorm(x, gain=None):
    xf = x.astype(jnp.float32)
    y = xf * lax.rsqrt(jnp.mean(xf * xf, axis=-1, keepdims=True) + EPS)
    if gain is not None:
        y = y * gain.astype(jnp.float32)
    return y.astype(x.dtype)


def adaln(x, mod):
    shift, scale, gate = jnp.split(mod, 3, axis=-1)
    return rmsnorm(x) * (1.0 + scale) + shift, gate


def split_cols(t, sizes):
    out, off = [], 0
    for n in sizes:
        out.append(t[..., off:off + n])
        off += n
    return out


def grid_positions(n):
    rows = n // GRID_W
    row = jnp.repeat(jnp.arange(rows, dtype=jnp.float32), GRID_W)
    col = jnp.tile(jnp.arange(GRID_W, dtype=jnp.float32), rows)
    return row, col


def rope_1d(x, pos):
    half = x.shape[-1] // 2
    inv = ROPE_BASE ** (-jnp.arange(half, dtype=jnp.float32) / half)
    ang = pos[:, None] * inv[None, :]
    cos = jnp.cos(ang)[:, None, :].astype(x.dtype)
    sin = jnp.sin(ang)[:, None, :].astype(x.dtype)
    x1, x2 = x[..., :half], x[..., half:]
    return jnp.concatenate([x1 * cos - x2 * sin, x2 * cos + x1 * sin], axis=-1)


def axial_rope(x, row, col):
    half = x.shape[-1] // 2
    return jnp.concatenate([rope_1d(x[..., :half], row), rope_1d(x[..., half:], col)], axis=-1)


def rope_tail(x, rot_dim, row, col):
    return jnp.concatenate([x[..., :-rot_dim], axial_rope(x[..., -rot_dim:], row, col)], axis=-1)


def ctx_attention(q, k, v, sink=None):
    b, l, h, d = q.shape
    hk = k.shape[2]
    g = h // hk
    qg = q.reshape(b, l, hk, g, d)
    s = jnp.einsum('bqkgd,bnkd->bkgqn', qg, k, preferred_element_type=jnp.float32) * (d ** -0.5)
    if sink is not None:
        sk = jnp.broadcast_to(sink.reshape(hk, g).astype(jnp.float32)[None, :, :, None, None], (b, hk, g, l, 1))
        p = jax.nn.softmax(jnp.concatenate([s, sk], axis=-1), axis=-1)[..., :l]
    else:
        p = jax.nn.softmax(s, axis=-1)
    o = jnp.einsum('bkgqn,bnkd->bqkgd', p.astype(v.dtype), v)
    return o.reshape(b, l, h, v.shape[-1])


def joint_dense_attention(q, k, v, kc, vc):
    b, s, h, d = q.shape
    hk = k.shape[2]
    g = h // hk
    nb = s // Q_BLOCK
    kk = jnp.concatenate([kc, k], axis=1)
    vv = jnp.concatenate([vc, v], axis=1)
    qb = jnp.moveaxis(q.reshape(b, nb, Q_BLOCK, hk, g, d), 1, 0)

    def block(qi):
        sc = jnp.einsum('bqkgd,bnkd->bkgqn', qi, kk, preferred_element_type=jnp.float32) * (d ** -0.5)
        p = jax.nn.softmax(sc, axis=-1)
        return jnp.einsum('bkgqn,bnkd->bqkgd', p.astype(vv.dtype), vv)

    o = lax.map(block, qb)
    return jnp.moveaxis(o, 0, 1).reshape(b, s, h, v.shape[-1])


def joint_window_attention(q, k, v, kc, vc, sink):
    b, s, h, d = q.shape
    hk = k.shape[2]
    g = h // hk
    nb = s // Q_BLOCK
    l = kc.shape[1]
    pad = ((0, 0), (Q_BLOCK, Q_BLOCK), (0, 0), (0, 0))
    kp, vp = jnp.pad(k, pad), jnp.pad(v, pad)

    def bands(t):
        return jnp.concatenate(
            [t[:, j * Q_BLOCK: j * Q_BLOCK + s].reshape(b, nb, Q_BLOCK, hk, t.shape[-1]) for j in range(3)], axis=2)

    kb = jnp.moveaxis(bands(kp), 1, 0)
    vb = jnp.moveaxis(bands(vp), 1, 0)
    qb = jnp.moveaxis(q.reshape(b, nb, Q_BLOCK, hk, g, d), 1, 0)
    blk = jnp.arange(nb)[:, None, None] * Q_BLOCK
    qpos = blk + jnp.arange(Q_BLOCK)[None, :, None]
    kpos = blk - Q_BLOCK + jnp.arange(3 * Q_BLOCK)[None, None, :]
    mask = (jnp.abs(qpos - kpos) <= WINDOW) & (kpos >= 0) & (kpos < s)
    sink_l = sink.reshape(hk, g).astype(jnp.float32)
    scale = d ** -0.5

    def block(args):
        qi, ki, vi, mi = args
        s_loc = jnp.einsum('bqkgd,bmkd->bkgqm', qi, ki, preferred_element_type=jnp.float32) * scale
        s_loc = jnp.where(mi[None, None, None], s_loc, NEG_INF)
        s_ctx = jnp.einsum('bqkgd,blkd->bkgql', qi, kc, preferred_element_type=jnp.float32) * scale
        s_snk = jnp.broadcast_to(sink_l[None, :, :, None, None], (b, hk, g, Q_BLOCK, 1))
        p = jax.nn.softmax(jnp.concatenate([s_ctx, s_loc, s_snk], axis=-1), axis=-1)
        return (jnp.einsum('bkgql,blkd->bqkgd', p[..., :l].astype(vc.dtype), vc)
                + jnp.einsum('bkgqm,bmkd->bqkgd', p[..., l:l + 3 * Q_BLOCK].astype(vi.dtype), vi))

    o = lax.map(block, (qb, kb, vb, mask))
    return jnp.moveaxis(o, 0, 1).reshape(b, s, h, v.shape[-1])


def short_conv(u, w):
    ch = u.shape[-1]
    return lax.conv_general_dilated(u, w[:, None, :].astype(u.dtype), window_strides=(1,),
                                    padding=((CONV_K // 2, CONV_K // 2),),
                                    dimension_numbers=('NWC', 'WIO', 'NWC'), feature_group_count=ch)


def heads_ab(pp, cq_gain, ckv_gain, w_uq, w_ukv, q_gain, k_gain, qg_gain, kg_gain):
    cq, ckv, kr, gq, gk, gv, gate = split_cols(pp, AB_SPLIT)
    lead = pp.shape[:-1]
    qa = (rmsnorm(cq, cq_gain) @ w_uq).reshape(lead + (MLA_HEADS, MLA_NOPE + MLA_ROPE))
    kv = (rmsnorm(ckv, ckv_gain) @ w_ukv).reshape(lead + (MLA_HEADS, MLA_NOPE + MLA_V))
    kr_h = jnp.broadcast_to(kr[..., None, :], lead + (MLA_HEADS, MLA_ROPE))
    ka = jnp.concatenate([kv[..., :MLA_NOPE], kr_h], axis=-1)
    va = kv[..., MLA_NOPE:]
    qb = rmsnorm(gq.reshape(lead + (GQA_HEADS, GQA_DIM)), qg_gain)
    kb = rmsnorm(gk.reshape(lead + (GQA_KV_HEADS, GQA_DIM)), kg_gain)
    vb = gv.reshape(lead + (GQA_KV_HEADS, GQA_DIM))
    return rmsnorm(qa, q_gain), rmsnorm(ka, k_gain), va, qb, kb, vb, gate


def ab_layer(x, xc, mod, mod_c, w_in, w_out, cq_gain, ckv_gain, w_uq, w_ukv, q_gain, k_gain,
             qg_gain, kg_gain, row, col, update_ctx):
    b, s, _ = x.shape
    h, gate = adaln(x, mod)
    hc, gate_c = adaln(xc, mod_c)
    wts = (cq_gain, ckv_gain, w_uq, w_ukv, q_gain, k_gain, qg_gain, kg_gain)
    qa, ka, va, qb, kb, vb, g = heads_ab(h @ w_in, *wts)
    qac, kac, vac, qbc, kbc, vbc, gc = heads_ab(hc @ w_in, *wts)
    qa, ka = rope_tail(qa, MLA_ROPE, row, col), rope_tail(ka, MLA_ROPE, row, col)
    qb, kb = axial_rope(qb, row, col), axial_rope(kb, row, col)
    oa = joint_dense_attention(qa, ka, va, kac, vac).reshape(b, s, -1)
    ob = joint_dense_attention(qb, kb, vb, kbc, vbc).reshape(b, s, -1)
    mix = jnp.concatenate([oa, ob], axis=-1) * jax.nn.silu(g)
    x = x + gate * (mix @ w_out)
    if update_ctx:
        l = xc.shape[1]
        oac = ctx_attention(qac, kac, vac).reshape(b, l, -1)
        obc = ctx_attention(qbc, kbc, vbc).reshape(b, l, -1)
        mixc = jnp.concatenate([oac, obc], axis=-1) * jax.nn.silu(gc)
        xc = xc + gate_c * (mixc @ w_out)
    return x, xc


def heads_cd(pp, q_gain, k_gain):
    pq, pk, pv, gb, gcc, gh, gate = split_cols(pp, CD_SPLIT)
    lead = pp.shape[:-1]
    q = rmsnorm(pq.reshape(lead + (WIN_HEADS, WIN_DIM)), q_gain)
    k = rmsnorm(pk.reshape(lead + (WIN_KV_HEADS, WIN_DIM)), k_gain)
    v = pv.reshape(lead + (WIN_KV_HEADS, WIN_DIM))
    return q, k, v, gb, gcc, gh, gate


def cd_layer(x, xc, mod, mod_c, w_in, w_out, q_gain, k_gain, sink, conv_w, row, col, update_ctx):
    b, s, _ = x.shape
    h, gate = adaln(x, mod)
    hc, gate_c = adaln(xc, mod_c)
    q, k, v, gb, gcv, gh, g = heads_cd(h @ w_in, q_gain, k_gain)
    qc, kc, vc, gbc, gcvc, ghc, gc = heads_cd(hc @ w_in, q_gain, k_gain)
    q, k = axial_rope(q, row, col), axial_rope(k, row, col)
    oc = joint_window_attention(q, k, v, kc, vc, sink).reshape(b, s, -1)
    od = gb * short_conv(gcv * gh, conv_w)
    mix = jnp.concatenate([oc, od], axis=-1) * jax.nn.silu(g)
    x = x + gate * (mix @ w_out)
    if update_ctx:
        l = xc.shape[1]
        occ = ctx_attention(qc, kc, vc, sink).reshape(b, l, -1)
        odc = gbc * short_conv(gcvc * ghc, conv_w)
        mixc = jnp.concatenate([occ, odc], axis=-1) * jax.nn.silu(gc)
        xc = xc + gate_c * (mixc @ w_out)
    return x, xc


def setup_inputs(seed: int = 0) -> dict:
    key = jax.random.key(seed)
    ks = iter(jax.random.split(key, 32))
    f32 = jnp.float32
    n_ab = (DEPTH + 1) // 2
    n_cd = DEPTH // 2

    def nrm(shape, scale):
        return jax.random.normal(next(ks), shape, f32) * scale

    def gain(shape):
        return 1.0 + 0.1 * jax.random.normal(next(ks), shape, f32)

    return {
        'x': nrm((BATCH, SEQ, D_MODEL), 1.0),
        'c': nrm((BATCH, D_MODEL), 1.0),
        'ctx': nrm((BATCH, CTX_LEN, D_MODEL), 1.0),
        'c_ctx': nrm((D_MODEL,), 1.0),
        'mod_w': nrm((DEPTH, D_MODEL, 3 * D_MODEL), D_MODEL ** -0.5),
        'mod_b': nrm((DEPTH, 3 * D_MODEL), 0.02),
        'ab_w_in': nrm((n_ab, D_MODEL, AB_IN), D_MODEL ** -0.5),
        'ab_w_out': nrm((n_ab, AB_MIX, D_MODEL), AB_MIX ** -0.5),
        'mla_cq_gain': gain((n_ab, MLA_Q_RANK)),
        'mla_ckv_gain': gain((n_ab, MLA_KV_RANK)),
        'mla_w_uq': nrm((n_ab, MLA_Q_RANK, MLA_HEADS * (MLA_NOPE + MLA_ROPE)), MLA_Q_RANK ** -0.5),
        'mla_w_ukv': nrm((n_ab, MLA_KV_RANK, MLA_HEADS * (MLA_NOPE + MLA_V)), MLA_KV_RANK ** -0.5),
        'mla_q_gain': gain((n_ab, MLA_NOPE + MLA_ROPE)),
        'mla_k_gain': gain((n_ab, MLA_NOPE + MLA_ROPE)),
        'gqa_q_gain': gain((n_ab, GQA_DIM)),
        'gqa_k_gain': gain((n_ab, GQA_DIM)),
        'cd_w_in': nrm((n_cd, D_MODEL, CD_IN), D_MODEL ** -0.5),
        'cd_w_out': nrm((n_cd, CD_MIX, D_MODEL), CD_MIX ** -0.5),
        'win_q_gain': gain((n_cd, WIN_DIM)),
        'win_k_gain': gain((n_cd, WIN_DIM)),
        'win_sink': nrm((n_cd, WIN_HEADS), 0.5),
        'conv_w': nrm((n_cd, CONV_K, CONV_CH), CONV_K ** -0.5),
    }


def reference(x, c, ctx, c_ctx, mod_w, mod_b, ab_w_in, ab_w_out, mla_cq_gain, mla_ckv_gain,
              mla_w_uq, mla_w_ukv, mla_q_gain, mla_k_gain, gqa_q_gain, gqa_k_gain,
              cd_w_in, cd_w_out, win_q_gain, win_k_gain, win_sink, conv_w):
    n = x.shape[1]
    row, col = grid_positions(n)
    sc = jax.nn.silu(c)
    scc = jax.nn.silu(c_ctx)
    xc = ctx
    for i in range(DEPTH):
        mod = (sc @ mod_w[i] + mod_b[i])[:, None, :]
        mod_c = scc @ mod_w[i] + mod_b[i]
        j = i // 2
        update = i < DEPTH - 1
        if i % 2 == 0:
            x, xc = ab_layer(x, xc, mod, mod_c, ab_w_in[j], ab_w_out[j], mla_cq_gain[j], mla_ckv_gain[j],
                             mla_w_uq[j], mla_w_ukv[j], mla_q_gain[j], mla_k_gain[j],
                             gqa_q_gain[j], gqa_k_gain[j], row, col, update)
        else:
            x, xc = cd_layer(x, xc, mod, mod_c, cd_w_in[j], cd_w_out[j], win_q_gain[j], win_k_gain[j],
                             win_sink[j], conv_w[j], row, col, update)
    return x
```

```cpp
#include <hip/hip_runtime.h>
#include <hip/hip_cooperative_groups.h>
#include <cstdio>
#include <cstdint>
namespace cg = cooperative_groups;

typedef unsigned short u16;
using bf16x8 = __attribute__((ext_vector_type(8))) short;
using s16x4  = __attribute__((ext_vector_type(4))) short;
using f32x16 = __attribute__((ext_vector_type(16))) float;
using u32x4  = __attribute__((ext_vector_type(4))) unsigned;
using u32x2  = __attribute__((ext_vector_type(2))) unsigned;

constexpr int NB = 2, SEQ = 16384, DM = 1024, CL = 256;
constexpr int NLAT = NB * SEQ;
constexpr int NROW = NLAT + NB * CL;
constexpr int KVLEN = CL + SEQ;
constexpr int KV2LEN = KVLEN + 128;
constexpr int LD_AB = 2432, LD_CD = 3328;
constexpr float EPS = 1e-6f;
constexpr float QS_A = 0.14724461f;
constexpr float QS_B = 0.18033688f;
constexpr float LOG2E = 1.4426950408889634f;

constexpr size_t OFF_MODV      = 0;
constexpr size_t OFF_WT_IN_AB  = 73728;
constexpr size_t OFF_WT_OUT_AB = OFF_WT_IN_AB + (size_t)LD_AB * 1024 * 2;
constexpr size_t OFF_WT_UQ     = OFF_WT_OUT_AB + (size_t)1024 * 1024 * 2;
constexpr size_t OFF_WT_UKV    = OFF_WT_UQ + (size_t)768 * 256 * 2;
constexpr size_t OFF_WT_IN_CD  = OFF_WT_UKV + (size_t)1024 * 256 * 2;
constexpr size_t OFF_WT_OUT_CD = OFF_WT_IN_CD + (size_t)3328 * 1024 * 2;
constexpr size_t OFF_XC1       = OFF_WT_OUT_CD + (size_t)1024 * 1024 * 2;
constexpr size_t OFF_H         = OFF_XC1 + (size_t)512 * 1024 * 4;
constexpr size_t OFF_PP        = OFF_H + (size_t)NROW * 1024 * 2;
constexpr size_t OFF_QA        = OFF_PP + (size_t)NROW * 3328 * 2;
constexpr size_t OFF_QCA       = OFF_QA + (size_t)NB * 8 * SEQ * 96 * 2;
constexpr size_t OFF_KA        = OFF_QCA + (size_t)NB * 8 * CL * 96 * 2;
constexpr size_t OFF_VA        = OFF_KA + (size_t)NB * 8 * KVLEN * 96 * 2;
constexpr size_t OFF_QB        = OFF_VA + (size_t)NB * 8 * KVLEN * 64 * 2;
constexpr size_t OFF_QCB       = OFF_QB + (size_t)NB * 8 * SEQ * 64 * 2;
constexpr size_t OFF_KB        = OFF_QCB + (size_t)NB * 8 * CL * 64 * 2;
constexpr size_t OFF_VB        = OFF_KB + (size_t)NB * 2 * KVLEN * 64 * 2;
constexpr size_t OFF_END       = OFF_VB + (size_t)NB * 2 * KVLEN * 64 * 2;
constexpr size_t OFF_Q2        = OFF_QA;
constexpr size_t OFF_K2        = OFF_Q2 + (size_t)NB * 8 * SEQ * 64 * 2;
constexpr size_t OFF_V2        = OFF_K2 + (size_t)NB * 2 * KV2LEN * 64 * 2;
constexpr size_t OFF_X1B       = OFF_QA + ((size_t)64 << 20);
static_assert(OFF_V2 + (size_t)NB * 2 * KV2LEN * 64 * 2 <= OFF_X1B && OFF_X1B + (size_t)NLAT * 1024 * 2 <= OFF_END, "x1 alias");
static_assert(OFF_V2 + (size_t)NB * 2 * KV2LEN * 64 * 2 <= OFF_END, "alias overflow");

constexpr int LDS_BYTES = 98304;
#ifndef MULTI_LAUNCH
#define MULTI_LAUNCH 0
#endif

struct Params {
  const float *x, *c, *ctx, *c_ctx, *mod_w, *mod_b, *ab_w_in, *ab_w_out, *cq_gain, *ckv_gain, *w_uq, *w_ukv,
      *q_gain, *k_gain, *gq_gain, *gk_gain, *cd_w_in, *cd_w_out, *win_q_gain, *win_k_gain, *win_sink, *conv_w;
  float* out;
  char* ws;
  int ph_lo, ph_hi;
};

#define SBAR() __builtin_amdgcn_sched_barrier(0)
__device__ __forceinline__ int crow(int r, int hi) { return (r & 3) + 8 * (r >> 2) + 4 * hi; }
typedef float f32x2_t __attribute__((ext_vector_type(2)));
typedef __bf16 bf16x2_t __attribute__((ext_vector_type(2)));
__device__ __forceinline__ unsigned cvtpk(float lo, float hi) { f32x2_t v = {lo, hi}; bf16x2_t b = __builtin_convertvector(v, bf16x2_t); return __builtin_bit_cast(unsigned, b); }
__device__ __forceinline__ u16 f2bf(float x) { return (u16)(cvtpk(x, 0.f) & 0xffffu); }
__device__ __forceinline__ float bf2f(u16 x) { return __uint_as_float(((unsigned)x) << 16); }
__device__ __forceinline__ float bflo(unsigned w) { return __uint_as_float(w << 16); }
__device__ __forceinline__ float bfhi(unsigned w) { return __uint_as_float(w & 0xffff0000u); }
__device__ __forceinline__ float wave_sum(float v) {
#pragma unroll
  for (int o = 32; o >= 1; o >>= 1) v += __shfl_xor(v, o);
  return v;
}
__device__ __forceinline__ int opaque_tid() { int t = threadIdx.x; asm volatile("" : "+v"(t)); return t; }
__device__ __forceinline__ float vmaxabs(const float* g, int n) { float m = 0.f; for (int i = 0; i < n; ++i) m = fmaxf(m, fabsf(g[i])); return m; }
__device__ __forceinline__ float silu_f(float g) { return g / (1.f + __expf(-g)); }


__device__ __forceinline__ void gbar(unsigned* cnt, unsigned target) {
  asm volatile("s_waitcnt vmcnt(0)" ::: "memory");
  __syncthreads();
  if (threadIdx.x == 0) {
    __builtin_amdgcn_fence(__ATOMIC_RELEASE, "agent");
    asm volatile("s_waitcnt vmcnt(0)" ::: "memory");
    __hip_atomic_fetch_add(cnt, 1u, __ATOMIC_RELAXED, __HIP_MEMORY_SCOPE_AGENT);
    unsigned sp = 0;
    while (__hip_atomic_load(cnt, __ATOMIC_RELAXED, __HIP_MEMORY_SCOPE_AGENT) < target) { __builtin_amdgcn_s_sleep(1); if (++sp > (1u << 24)) break; }
    __builtin_amdgcn_fence(__ATOMIC_ACQUIRE, "agent");
    asm volatile("s_waitcnt vmcnt(0)" ::: "memory");
  }
  __syncthreads();
}

__device__ void mod_unit(const Params& p, int u, char* lds) {
  const int tid = opaque_tid();
  const int layer = u / 96, n0 = (u % 96) * 32, col = tid & 31, ks = tid >> 5;
  const float* W = p.mod_w + (size_t)layer * 1024 * 3072 + n0 + col;
  float a0 = 0, a1 = 0, a2 = 0;
  for (int k = ks * 64; k < ks * 64 + 64; ++k) {
    float w = W[(size_t)k * 3072];
    a0 += silu_f(p.c[k]) * w; a1 += silu_f(p.c[1024 + k]) * w; a2 += silu_f(p.c_ctx[k]) * w;
  }
  float* red = (float*)lds;
  red[(0 * 16 + ks) * 32 + col] = a0; red[(1 * 16 + ks) * 32 + col] = a1; red[(2 * 16 + ks) * 32 + col] = a2;
  __syncthreads();
  if (tid < 96) {
    int w = tid >> 5, cc = tid & 31; float s = 0;
    for (int i = 0; i < 16; ++i) s += red[(w * 16 + i) * 32 + cc];
    float* modv = (float*)(p.ws + OFF_MODV);
    modv[(layer * 3 + w) * 3072 + n0 + cc] = s + p.mod_b[layer * 3072 + n0 + cc];
  }
  __syncthreads();
}

__device__ void transpose_unit(const Params& p, int u, char* lds) {
  const float* src; const float* gain = nullptr; int K, N; u16* dst; int ul;
  if (u < 608)       { ul = u;        src = p.ab_w_in;  K = 1024; N = 2336; dst = (u16*)(p.ws + OFF_WT_IN_AB); }
  else if (u < 864)  { ul = u - 608;  src = p.ab_w_out; K = 1024; N = 1024; dst = (u16*)(p.ws + OFF_WT_OUT_AB); }
  else if (u < 912)  { ul = u - 864;  src = p.w_uq;     K = 256;  N = 768;  dst = (u16*)(p.ws + OFF_WT_UQ); gain = p.cq_gain; }
  else if (u < 976)  { ul = u - 912;  src = p.w_ukv;    K = 256;  N = 1024; dst = (u16*)(p.ws + OFF_WT_UKV); gain = p.ckv_gain; }
  else if (u < 1808) { ul = u - 976;  src = p.cd_w_in;  K = 1024; N = 3328; dst = (u16*)(p.ws + OFF_WT_IN_CD); }
  else               { ul = u - 1808; src = p.cd_w_out; K = 1024; N = 1024; dst = (u16*)(p.ws + OFF_WT_OUT_CD); }
  const int nkt = K / 64, kt = ul % nkt, nt = ul / nkt, k0 = kt * 64, n0 = nt * 64, tid = opaque_tid();
  float* tile = (float*)lds;
#pragma unroll
  for (int e = 0; e < 8; ++e) {
    int i = (tid >> 6) + 8 * e, j = tid & 63, n = n0 + j;
    float v = (n < N) ? src[(size_t)(k0 + i) * N + n] : 0.f;
    if (gain) v *= gain[k0 + i];
    tile[i * 65 + j] = v;
  }
  __syncthreads();
#pragma unroll
  for (int e = 0; e < 8; ++e) {
    int i2 = (tid >> 6) + 8 * e, j2 = tid & 63;
    dst[(size_t)(n0 + i2) * K + k0 + j2] = f2bf(tile[j2 * 65 + i2]);
  }
  __syncthreads();
}

__device__ void adaln_phase(const float* xlat, const u16* xlat_bf, const float* xctx, const float* modl, u16* H) {
  const int tid = opaque_tid(), lane = tid & 63, gw = blockIdx.x * 8 + (tid >> 6), nw = gridDim.x * 8;
  for (int r = gw; r < NROW; r += nw) {
    if (xlat_bf != nullptr && r < NLAT) {
      const float* m = modl + (r >> 14) * 3072;
      u32x4 w[2]; float f[16]; float ss = 0;
#pragma unroll
      for (int i = 0; i < 2; ++i) w[i] = *(const u32x4*)(xlat_bf + (size_t)r * 1024 + 8 * (lane + 64 * i));
#pragma unroll
      for (int i = 0; i < 2; ++i)
#pragma unroll
        for (int e = 0; e < 4; ++e) { f[i * 8 + 2 * e] = bflo(w[i][e]); f[i * 8 + 2 * e + 1] = bfhi(w[i][e]); }
#pragma unroll
      for (int e = 0; e < 16; ++e) ss += f[e] * f[e];
      ss = wave_sum(ss);
      const float rstd = rsqrtf(ss * (1.f / 1024) + EPS);
#pragma unroll
      for (int i = 0; i < 2; ++i) {
        const int c = 8 * (lane + 64 * i);
        const float4 sh0 = *(const float4*)(m + c), sh1 = *(const float4*)(m + c + 4), sc0 = *(const float4*)(m + 1024 + c), sc1 = *(const float4*)(m + 1024 + c + 4);
        const float shv[8] = {sh0.x, sh0.y, sh0.z, sh0.w, sh1.x, sh1.y, sh1.z, sh1.w}, scv[8] = {sc0.x, sc0.y, sc0.z, sc0.w, sc1.x, sc1.y, sc1.z, sc1.w};
        float y[8];
#pragma unroll
        for (int e = 0; e < 8; ++e) y[e] = f[i * 8 + e] * rstd * (1.f + scv[e]) + shv[e];
        const u32x4 o = {cvtpk(y[0], y[1]), cvtpk(y[2], y[3]), cvtpk(y[4], y[5]), cvtpk(y[6], y[7])};
        *(u32x4*)(H + (size_t)r * 1024 + c) = o;
      }
      continue;
    }
    const float* src = r < NLAT ? xlat + (size_t)r * 1024 : xctx + (size_t)(r - NLAT) * 1024;
    const float* m = modl + (r < NLAT ? (r >> 14) : 2) * 3072;
    float4 v[4]; float ss = 0;
#pragma unroll
    for (int i = 0; i < 4; ++i) { v[i] = ((const float4*)src)[lane + 64 * i]; ss += v[i].x * v[i].x + v[i].y * v[i].y + v[i].z * v[i].z + v[i].w * v[i].w; }
    ss = wave_sum(ss);
    const float rstd = rsqrtf(ss * (1.f / 1024) + EPS);
#pragma unroll
    for (int i = 0; i < 4; ++i) {
      int c = 4 * (lane + 64 * i);
      float4 sh = *(const float4*)(m + c), sc = *(const float4*)(m + 1024 + c);
      float y0 = v[i].x * rstd * (1.f + sc.x) + sh.x, y1 = v[i].y * rstd * (1.f + sc.y) + sh.y;
      float y2 = v[i].z * rstd * (1.f + sc.z) + sh.z, y3 = v[i].w * rstd * (1.f + sc.w) + sh.w;
      u32x2 o = {cvtpk(y0, y1), cvtpk(y2, y3)};
      *(u32x2*)(H + (size_t)r * 1024 + c) = o;
    }
  }
}

#define GSWZ(row, colB) ((row) * 128 + ((colB) ^ ((((row) >> 1) & 7) << 4)))
struct ResPre { float4 v[16]; u32x2 w[16]; };
struct GPre { bf16x8 ra[4], rb[2]; };
__device__ __forceinline__ void gemm_preload(const u16* __restrict__ A, int lda, const u16* __restrict__ Bt, int ldb, int m0, int n0, GPre& g) {
  const int tid = opaque_tid(), srow = tid >> 3, sch = tid & 7;
  const u16* ap = A + (size_t)(m0 + srow) * lda + sch * 8;
  const u16* bp = Bt + (size_t)(n0 + srow) * ldb + sch * 8;
#pragma unroll
  for (int i = 0; i < 4; ++i) g.ra[i] = *(const bf16x8*)(ap + (size_t)(64 * i) * lda);
#pragma unroll
  for (int i = 0; i < 2; ++i) g.rb[i] = *(const bf16x8*)(bp + (size_t)(64 * i) * ldb);
}
template <int PRE>
__device__ __forceinline__ void gemm_tile(const u16* __restrict__ A, int lda, const u16* __restrict__ Bt, int ldb, int K,
                                          int m0, int n0, f32x16 (&acc)[2][2], char* lds, GPre& g, const void* resp = nullptr, ResPre* rp = nullptr) {
  const int tid = opaque_tid(), wid = tid >> 6, lane = tid & 63, r32 = lane & 31, hi = lane >> 5;
  const int wm = wid & 3, wn = wid >> 2;
  char* As = lds;
  char* Bs = lds + 65536;
  const int srow = tid >> 3, sch = tid & 7;
  const u16* ap = A + (size_t)(m0 + srow) * lda + sch * 8;
  const u16* bp = Bt + (size_t)(n0 + srow) * ldb + sch * 8;
  const int sw = GSWZ(srow, sch * 16);
  bf16x8 (&ra)[4] = g.ra; bf16x8 (&rb)[2] = g.rb;
#pragma unroll
  for (int i = 0; i < 2; ++i) for (int j = 0; j < 2; ++j) acc[i][j] = f32x16{};
  __syncthreads();
#pragma unroll
  for (int i = 0; i < 4; ++i) *(bf16x8*)(As + sw + i * 8192) = ra[i];
#pragma unroll
  for (int i = 0; i < 2; ++i) *(bf16x8*)(Bs + sw + i * 8192) = rb[i];
  __syncthreads();
  const int nk = K / 64;
  const int arow0 = wm * 64 + r32, brow0 = wn * 64 + r32;
  for (int kt = 0; kt < nk; ++kt) {
    const int cur = kt & 1;
    if (kt + 1 < nk) {
#pragma unroll
      for (int i = 0; i < 4; ++i) ra[i] = *(const bf16x8*)(ap + (size_t)(64 * i) * lda + (kt + 1) * 64);
#pragma unroll
      for (int i = 0; i < 2; ++i) rb[i] = *(const bf16x8*)(bp + (size_t)(64 * i) * ldb + (kt + 1) * 64);
    }
    if (PRE == 1 && kt == 0) {
#pragma unroll
      for (int q = 0; q < 16; ++q) rp->v[q] = *(const float4*)((const float*)resp + (size_t)((q >> 3) * 32 + 4 * (q & 7)) * 1024);
    }
    if (PRE == 2 && kt == 0) {
#pragma unroll
      for (int q = 0; q < 16; ++q) rp->w[q] = *(const u32x2*)((const u16*)resp + (size_t)((q >> 3) * 32 + 4 * (q & 7)) * 1024);
    }
    SBAR();
    const char* Ac = As + cur * 32768; const char* Bc = Bs + cur * 16384;
#pragma unroll
    for (int kk = 0; kk < 4; ++kk) {
      const int cb = kk * 32 + hi * 16;
      bf16x8 a0 = *(const bf16x8*)(Ac + GSWZ(arow0, cb));
      bf16x8 a1 = *(const bf16x8*)(Ac + GSWZ(arow0 + 32, cb));
      bf16x8 b0 = *(const bf16x8*)(Bc + GSWZ(brow0, cb));
      bf16x8 b1 = *(const bf16x8*)(Bc + GSWZ(brow0 + 32, cb));
      acc[0][0] = __builtin_amdgcn_mfma_f32_32x32x16_bf16(a0, b0, acc[0][0], 0, 0, 0);
      acc[0][1] = __builtin_amdgcn_mfma_f32_32x32x16_bf16(a0, b1, acc[0][1], 0, 0, 0);
      acc[1][0] = __builtin_amdgcn_mfma_f32_32x32x16_bf16(a1, b0, acc[1][0], 0, 0, 0);
      acc[1][1] = __builtin_amdgcn_mfma_f32_32x32x16_bf16(a1, b1, acc[1][1], 0, 0, 0);
    }
    if (kt + 1 < nk) {
      char* An = As + (cur ^ 1) * 32768; char* Bn = Bs + (cur ^ 1) * 16384;
#pragma unroll
      for (int i = 0; i < 4; ++i) *(bf16x8*)(An + sw + i * 8192) = ra[i];
#pragma unroll
      for (int i = 0; i < 2; ++i) *(bf16x8*)(Bn + sw + i * 8192) = rb[i];
    }
    __syncthreads();
  }
}


struct TileIter {
  int f, fend, step, MT, NT;
  __device__ __forceinline__ TileIter(int MT_, int NT_) : MT(MT_), NT(NT_) {
    const int T = MT_ * NT_, bid = blockIdx.x, nblk = gridDim.x;
    if (nblk == 256) { const int x = bid & 7, cl = bid >> 3; f = (int)(((long)T * x) >> 3) + cl; fend = (int)(((long)T * (x + 1)) >> 3); step = 32; }
    else { f = bid; fend = T; step = nblk; }
  }
  __device__ __forceinline__ bool valid() const { return f < fend; }
  __device__ __forceinline__ void next() { f += step; }
  __device__ __forceinline__ void get(int& mt, int& nt) const {
    const int full = (MT >> 2) * 4 * NT;
    if (f < full) { const int g = f / (4 * NT), rem = f - g * 4 * NT; nt = rem >> 2; mt = g * 4 + (rem & 3); }
    else { const int rem = f - full, gs = MT - (MT >> 2) * 4; nt = rem / gs; mt = (MT >> 2) * 4 + (rem - nt * gs); }
  }
};

__device__ __forceinline__ void epi_bf16(f32x16 (&acc)[2][2], u16* C, int ldc, int m0, int n0, char* lds) {
  const int tid = opaque_tid(), wid = tid >> 6, lane = tid & 63, r32 = lane & 31, hi = lane >> 5;
  const int wm = wid & 3, wn = wid >> 2;
  char* wl = lds + wid * 9216;
#pragma unroll
  for (int i = 0; i < 2; ++i)
#pragma unroll
    for (int j = 0; j < 2; ++j)
#pragma unroll
      for (int r = 0; r < 16; ++r) *(u16*)(wl + (i * 32 + crow(r, hi)) * 144 + (j * 32 + r32) * 2) = f2bf(acc[i][j][r]);
  asm volatile("s_waitcnt lgkmcnt(0)" ::: "memory");
  const int rr = lane >> 3, ch = lane & 7;
  u16* cbase = C + (size_t)(m0 + wm * 64 + rr) * ldc + n0 + wn * 64 + ch * 8;
#pragma unroll
  for (int k = 0; k < 8; ++k) {
    const u32x4 v = *(const u32x4*)(wl + (rr + 8 * k) * 144 + ch * 16);
    *(u32x4*)(cbase + (size_t)(8 * k) * ldc) = v;
  }
}
template <bool IN_BF, bool OUT_BF>
__device__ __forceinline__ void epi_res(f32x16 (&acc)[2][2], const ResPre& rp, void* outp, const float* gsrc, int n0, char* lds) {
  const int tid = opaque_tid(), wid = tid >> 6, lane = tid & 63, r32 = lane & 31, hi = lane >> 5;
  const int wn = wid >> 2;
  char* wl = lds + wid * 8704;
  const int rl = lane >> 4, c4 = lane & 15;
  const float4 g = *(const float4*)(gsrc + n0 + wn * 64 + 4 * c4);
#pragma unroll
  for (int i = 0; i < 2; ++i) {
#pragma unroll
    for (int j = 0; j < 2; ++j)
#pragma unroll
      for (int r = 0; r < 16; ++r) *(float*)(wl + crow(r, hi) * 272 + (j * 32 + r32) * 4) = acc[i][j][r];
    asm volatile("s_waitcnt lgkmcnt(0)" ::: "memory");
#pragma unroll
    for (int k = 0; k < 8; ++k) {
      const float4 a = *(const float4*)(wl + (rl + 4 * k) * 272 + c4 * 16);
      float4 x;
      if (IN_BF) { const u32x2 xw = rp.w[i * 8 + k]; x.x = bflo(xw[0]); x.y = bfhi(xw[0]); x.z = bflo(xw[1]); x.w = bfhi(xw[1]); } else x = rp.v[i * 8 + k];
      float4 o; o.x = x.x + g.x * a.x; o.y = x.y + g.y * a.y; o.z = x.z + g.z * a.z; o.w = x.w + g.w * a.w;
      if (OUT_BF) { const u32x2 ow = {cvtpk(o.x, o.y), cvtpk(o.z, o.w)}; *(u32x2*)((u16*)outp + (size_t)(i * 32 + 4 * k) * 1024) = ow; }
      else *(float4*)((float*)outp + (size_t)(i * 32 + 4 * k) * 1024) = o;
    }
    asm volatile("s_waitcnt lgkmcnt(0)" ::: "memory");
  }
}

__device__ __forceinline__ float red8(float v) { v += __shfl_xor(v, 1); v += __shfl_xor(v, 2); v += __shfl_xor(v, 4); return v; }
__device__ __forceinline__ void rope_cs(float pos, float inv, bool on, float& c, float& s) {
  if (on) { float a = pos * inv * 0.15915494309189535f; a -= floorf(a); c = __builtin_amdgcn_cosf(a); s = __builtin_amdgcn_sinf(a); } else { c = 1.f; s = 0.f; }
}
__device__ __forceinline__ void head64(const u16* src, u16* dst, int gb, const float* g, const float* cG, const float* sG, float qs) {
  const u32x2 lo = *(const u32x2*)(src + gb), hi2 = *(const u32x2*)(src + gb + 16);
  float x[8] = {bflo(lo[0]), bfhi(lo[0]), bflo(lo[1]), bfhi(lo[1]), bflo(hi2[0]), bfhi(hi2[0]), bflo(hi2[1]), bfhi(hi2[1])};
  float ss = 0;
#pragma unroll
  for (int e = 0; e < 8; ++e) ss += x[e] * x[e];
  const float rn = rsqrtf(red8(ss) * (1.f / 64) + EPS) ;
#pragma unroll
  for (int e = 0; e < 8; ++e) x[e] *= rn * g[e];
  float y[8];
#pragma unroll
  for (int e = 0; e < 4; ++e) { y[e] = (x[e] * cG[e] - x[e + 4] * sG[e]) * qs; y[e + 4] = (x[e + 4] * cG[e] + x[e] * sG[e]) * qs; }
  const u32x2 o0 = {cvtpk(y[0], y[1]), cvtpk(y[2], y[3])}, o1 = {cvtpk(y[4], y[5]), cvtpk(y[6], y[7])};
  *(u32x2*)(dst + gb) = o0; *(u32x2*)(dst + gb + 16) = o1;
}
__device__ __forceinline__ void head96(float* n, float r1a, float r1b, float r2a, float r2b, u16* dst, int t, int rb,
                                       const float* gn, const float* gr, const float* cM, const float* sM, float qs) {
  float ss = r1a * r1a + r1b * r1b + r2a * r2a + r2b * r2b;
#pragma unroll
  for (int e = 0; e < 8; ++e) ss += n[e] * n[e];
  const float rn = rsqrtf(red8(ss) * (1.f / 96) + EPS);
#pragma unroll
  for (int e = 0; e < 8; ++e) n[e] *= rn * gn[e] * qs;
  r1a *= rn * gr[0]; r1b *= rn * gr[1]; r2a *= rn * gr[2]; r2b *= rn * gr[3];
  const float y1a = (r1a * cM[0] - r2a * sM[0]) * qs, y2a = (r2a * cM[0] + r1a * sM[0]) * qs;
  const float y1b = (r1b * cM[1] - r2b * sM[1]) * qs, y2b = (r2b * cM[1] + r1b * sM[1]) * qs;
  const u32x4 o = {cvtpk(n[0], n[1]), cvtpk(n[2], n[3]), cvtpk(n[4], n[5]), cvtpk(n[6], n[7])};
  *(u32x4*)(dst + 8 * t) = o;
  *(unsigned*)(dst + 64 + rb) = cvtpk(y1a, y1b); *(unsigned*)(dst + 64 + rb + 8) = cvtpk(y2a, y2b);
}
__device__ void finalize0(const Params& p) {
  const int tid = opaque_tid(), lane = tid & 63, gw = blockIdx.x * 8 + (tid >> 6), nw = gridDim.x * 8;
  const int h = lane >> 3, t = lane & 7;
  char* ws = p.ws;
  const u16* PP = (const u16*)(ws + OFF_PP);
  const u16* QAR = (const u16*)(ws + OFF_H);
  const u16* KVR = (const u16*)p.out;
  u16* QA = (u16*)(ws + OFF_QA); u16* QCA = (u16*)(ws + OFF_QCA); u16* KA = (u16*)(ws + OFF_KA); u16* VA = (u16*)(ws + OFF_VA);
  u16* QB = (u16*)(ws + OFF_QB); u16* QCB = (u16*)(ws + OFF_QCB); u16* KB = (u16*)(ws + OFF_KB); u16* VB = (u16*)(ws + OFF_VB);
  const int gb = t < 4 ? 4 * t : 32 + 4 * (t - 4), rb = t < 4 ? 2 * t : 16 + 2 * (t - 4);
  float qgn[8], kgn[8], qgr[4], kgr[4], gqg[8], gkg[8], invG[4], invM[2];
#pragma unroll
  for (int e = 0; e < 8; ++e) { qgn[e] = p.q_gain[8 * t + e]; kgn[e] = p.k_gain[8 * t + e];
    const int d = gb + (e & 3) + (e >> 2) * 16; gqg[e] = p.gq_gain[d]; gkg[e] = p.gk_gain[d]; }
#pragma unroll
  for (int k = 0; k < 4; ++k) { const int d = 64 + rb + (k & 1) + (k >> 1) * 8; qgr[k] = p.q_gain[d]; kgr[k] = p.k_gain[d]; }
#pragma unroll
  for (int e = 0; e < 4; ++e) invG[e] = exp2f(-(float)(4 * (t & 3) + e) * (13.287712379549449f / 16.f));
#pragma unroll
  for (int k = 0; k < 2; ++k) invM[k] = exp2f(-(float)(2 * (t & 3) + k) * (13.287712379549449f / 8.f));
  for (int r = gw; r < NROW; r += nw) {
    const bool isctx = r >= NLAT;
    int b, s, kpos; float pos = 0.f;
    if (!isctx) { b = r >> 14; s = r & 16383; kpos = CL + s; pos = t < 4 ? (float)(s >> 6) : (float)(s & 63); }
    else { int rc = r - NLAT; b = rc >> 8; s = rc & 255; kpos = s; }
    float cG[4], sG[4], cM[2], sM[2];
#pragma unroll
    for (int e = 0; e < 4; ++e) rope_cs(pos, invG[e], !isctx, cG[e], sG[e]);
#pragma unroll
    for (int k = 0; k < 2; ++k) rope_cs(pos, invM[k], !isctx, cM[k], sM[k]);
    const u16* pp = PP + (size_t)r * LD_AB;
    const u32x2 wq = *(const u32x2*)(pp + lane * 4), wk = *(const u32x2*)(pp + 256 + lane * 4);
    float s1 = bflo(wq[0]) * bflo(wq[0]) + bfhi(wq[0]) * bfhi(wq[0]) + bflo(wq[1]) * bflo(wq[1]) + bfhi(wq[1]) * bfhi(wq[1]);
    float s2 = bflo(wk[0]) * bflo(wk[0]) + bfhi(wk[0]) * bfhi(wk[0]) + bflo(wk[1]) * bflo(wk[1]) + bfhi(wk[1]) * bfhi(wk[1]);
    s1 = wave_sum(s1); s2 = wave_sum(s2);
    const float rstd_cq = rsqrtf(s1 * (1.f / 256) + EPS), rstd_ckv = rsqrtf(s2 * (1.f / 256) + EPS);
    { const u16* qa = QAR + (size_t)r * 768 + h * 96;
      const u32x4 nv = *(const u32x4*)(qa + 8 * t); const unsigned w1 = *(const unsigned*)(qa + 64 + rb), w2 = *(const unsigned*)(qa + 64 + rb + 8);
      float n[8] = {bflo(nv[0]) * rstd_cq, bfhi(nv[0]) * rstd_cq, bflo(nv[1]) * rstd_cq, bfhi(nv[1]) * rstd_cq, bflo(nv[2]) * rstd_cq, bfhi(nv[2]) * rstd_cq, bflo(nv[3]) * rstd_cq, bfhi(nv[3]) * rstd_cq};
      u16* dq = isctx ? QCA + ((size_t)(b * 8 + h) * CL + s) * 96 : QA + ((size_t)(b * 8 + h) * SEQ + s) * 96;
      head96(n, bflo(w1) * rstd_cq, bfhi(w1) * rstd_cq, bflo(w2) * rstd_cq, bfhi(w2) * rstd_cq, dq, t, rb, qgn, qgr, cM, sM, QS_A); }
    { const u16* kv = KVR + (size_t)r * 1024 + h * 128;
      const u32x4 nv = *(const u32x4*)(kv + 8 * t), vv = *(const u32x4*)(kv + 64 + 8 * t);
      const unsigned w1 = *(const unsigned*)(pp + 512 + rb), w2 = *(const unsigned*)(pp + 512 + rb + 8);
      float n[8] = {bflo(nv[0]) * rstd_ckv, bfhi(nv[0]) * rstd_ckv, bflo(nv[1]) * rstd_ckv, bfhi(nv[1]) * rstd_ckv, bflo(nv[2]) * rstd_ckv, bfhi(nv[2]) * rstd_ckv, bflo(nv[3]) * rstd_ckv, bfhi(nv[3]) * rstd_ckv};
      const size_t kr = (size_t)(b * 8 + h) * KVLEN + kpos;
      head96(n, bflo(w1), bfhi(w1), bflo(w2), bfhi(w2), KA + kr * 96, t, rb, kgn, kgr, cM, sM, 1.f);
      const u32x4 vo = {cvtpk(bflo(vv[0]) * rstd_ckv, bfhi(vv[0]) * rstd_ckv), cvtpk(bflo(vv[1]) * rstd_ckv, bfhi(vv[1]) * rstd_ckv),
                        cvtpk(bflo(vv[2]) * rstd_ckv, bfhi(vv[2]) * rstd_ckv), cvtpk(bflo(vv[3]) * rstd_ckv, bfhi(vv[3]) * rstd_ckv)};
      *(u32x4*)(VA + kr * 64 + 8 * t) = vo; }
    { u16* dg = isctx ? QCB + ((size_t)(b * 8 + h) * CL + s) * 64 : QB + ((size_t)(b * 8 + h) * SEQ + s) * 64;
      head64(pp + 544 + h * 64, dg, gb, gqg, cG, sG, QS_B); }
    if (h < 2) {
      const size_t kr = (size_t)(b * 2 + h) * KVLEN + kpos;
      head64(pp + 1056 + h * 64, KB + kr * 64, gb, gkg, cG, sG, 1.f);
      *(u32x4*)(VB + kr * 64 + 8 * t) = *(const u32x4*)(pp + 1184 + h * 64 + 8 * t);
    }
  }
}

__device__ void finalize1(const Params& p) {
  const int tid = opaque_tid(), lane = tid & 63, gw = blockIdx.x * 8 + (tid >> 6), nw = gridDim.x * 8;
  const int h = lane >> 3, t = lane & 7;
  char* ws = p.ws;
  const u16* PP = (const u16*)(ws + OFF_PP);
  u16* Q2 = (u16*)(ws + OFF_Q2); u16* K2 = (u16*)(ws + OFF_K2); u16* V2 = (u16*)(ws + OFF_V2);
  u16* MIX = (u16*)(ws + OFF_H);
  const int gb = t < 4 ? 4 * t : 32 + 4 * (t - 4);
  float qg[8], kg[8], invG[4];
#pragma unroll
  for (int e = 0; e < 8; ++e) { const int d = gb + (e & 3) + (e >> 2) * 16; qg[e] = p.win_q_gain[d]; kg[e] = p.win_k_gain[d]; }
#pragma unroll
  for (int e = 0; e < 4; ++e) invG[e] = exp2f(-(float)(4 * (t & 3) + e) * (13.287712379549449f / 16.f));
  float cw[3][8];
#pragma unroll
  for (int j = 0; j < 3; ++j)
#pragma unroll
    for (int e = 0; e < 8; ++e) cw[j][e] = p.conv_w[j * 512 + lane * 8 + e];
  for (int r = gw; r < NROW + 512; r += nw) {
    if (r >= NROW) {
      int slab = (r - NROW) >> 7, pr = (r - NROW) & 127;
      size_t kr = (size_t)slab * KV2LEN + KVLEN + pr;
      K2[kr * 64 + lane] = 0; V2[kr * 64 + lane] = 0;
      continue;
    }
    const bool isctx = r >= NLAT;
    int b, s, kpos; float pos = 0.f;
    if (!isctx) { b = r >> 14; s = r & 16383; kpos = CL + s; pos = t < 4 ? (float)(s >> 6) : (float)(s & 63); }
    else { int rc = r - NLAT; b = rc >> 8; s = rc & 255; kpos = s; }
    float cG[4], sG[4];
#pragma unroll
    for (int e = 0; e < 4; ++e) rope_cs(pos, invG[e], !isctx, cG[e], sG[e]);
    const u16* pp = PP + (size_t)r * LD_CD;
    if (!isctx) head64(pp + h * 64, Q2 + ((size_t)(b * 8 + h) * SEQ + s) * 64, gb, qg, cG, sG, QS_B);
    if (h < 2) {
      const size_t kr = (size_t)(b * 2 + h) * KV2LEN + kpos;
      head64(pp + 512 + h * 64, K2 + kr * 64, gb, kg, cG, sG, 1.f);
      *(u32x4*)(V2 + kr * 64 + 8 * t) = *(const u32x4*)(pp + 640 + h * 64 + 8 * t);
    }
    if (!isctx) {
      const int c0 = lane * 8;
      float y[8];
#pragma unroll
      for (int e = 0; e < 8; ++e) y[e] = 0.f;
#pragma unroll
      for (int j = 0; j < 3; ++j) {
        const int sj = s + j - 1;
        if (sj >= 0 && sj < SEQ) {
          const u16* pj = pp + (ptrdiff_t)(j - 1) * LD_CD;
          u32x4 a = *(const u32x4*)(pj + 1280 + c0), bb = *(const u32x4*)(pj + 1792 + c0);
#pragma unroll
          for (int e = 0; e < 4; ++e) {
            y[2 * e]     += bflo(a[e]) * bflo(bb[e]) * cw[j][2 * e];
            y[2 * e + 1] += bfhi(a[e]) * bfhi(bb[e]) * cw[j][2 * e + 1];
          }
        }
      }
      u32x4 gbv = *(const u32x4*)(pp + 768 + c0), gt = *(const u32x4*)(pp + 2304 + 512 + c0);
      u32x4 o;
#pragma unroll
      for (int e = 0; e < 4; ++e) {
        float v0 = bflo(gbv[e]) * y[2 * e] * silu_f(bflo(gt[e]));
        float v1 = bfhi(gbv[e]) * y[2 * e + 1] * silu_f(bfhi(gt[e]));
        o[e] = cvtpk(v0, v1);
      }
      *(u32x4*)(MIX + (size_t)r * 1024 + 512 + c0) = o;
    }
  }
}

#define KSWZ(row, colB) ((row) * 272 + (colB))
__device__ __forceinline__ int v_st2(int k, int c) { const int kk = k; return ((kk >> 3) * 2 + (c >> 5)) * 512 + ((kk & 7) * 32 + (c & 31)) * 2; }
__device__ __forceinline__ int v_rd_base(int lane) { return ((lane & 3) << 3) | (((lane >> 2) & 3) << 6) | (((lane >> 4) & 1) << 5) | (((lane >> 5) & 1) << 8); }
constexpr int v_rd_off2(int d0, int ks, int half) { return d0 * 512 + ks * 2048 + half * 1024; }
template <int OFF> __device__ __forceinline__ s16x4 tr_read(int vb) {
  s16x4 r; asm volatile("ds_read_b64_tr_b16 %0, %1 offset:%2" : "=&v"(r) : "v"(vb), "i"(OFF) : "memory"); return r;
}
template <int D0> __device__ __forceinline__ void pv_one(f32x16& od, int vb, bf16x8 pa0, bf16x8 pa1, bf16x8 pa2, bf16x8 pa3) {
  const s16x4 l0 = tr_read<v_rd_off2(D0, 0, 0)>(vb), h0 = tr_read<v_rd_off2(D0, 0, 1)>(vb), l1 = tr_read<v_rd_off2(D0, 1, 0)>(vb), h1 = tr_read<v_rd_off2(D0, 1, 1)>(vb);
  const s16x4 l2 = tr_read<v_rd_off2(D0, 2, 0)>(vb), h2 = tr_read<v_rd_off2(D0, 2, 1)>(vb), l3 = tr_read<v_rd_off2(D0, 3, 0)>(vb), h3 = tr_read<v_rd_off2(D0, 3, 1)>(vb);
  asm volatile("s_waitcnt lgkmcnt(0)" ::: "memory"); SBAR();
#define PK(L, H) (bf16x8){L[0], L[1], L[2], L[3], H[0], H[1], H[2], H[3]}
  od = __builtin_amdgcn_mfma_f32_32x32x16_bf16(pa0, PK(l0, h0), od, 0, 0, 0);
  od = __builtin_amdgcn_mfma_f32_32x32x16_bf16(pa1, PK(l1, h1), od, 0, 0, 0);
  od = __builtin_amdgcn_mfma_f32_32x32x16_bf16(pa2, PK(l2, h2), od, 0, 0, 0);
  od = __builtin_amdgcn_mfma_f32_32x32x16_bf16(pa3, PK(l3, h3), od, 0, 0, 0);
#undef PK
}
__device__ __forceinline__ void pv_all(f32x16* o, int vb, bf16x8 pa0, bf16x8 pa1, bf16x8 pa2, bf16x8 pa3) {
  pv_one<0>(o[0], vb, pa0, pa1, pa2, pa3); pv_one<1>(o[1], vb, pa0, pa1, pa2, pa3);
}
__device__ __forceinline__ void pv_exp(f32x16* o, int vb, bf16x8 pa0, bf16x8 pa1, bf16x8 pa2, bf16x8 pa3, f32x16& n0, f32x16& n1) {
#define PK(L, H) (bf16x8){L[0], L[1], L[2], L[3], H[0], H[1], H[2], H[3]}
  { const s16x4 l0 = tr_read<v_rd_off2(0, 0, 0)>(vb), h0 = tr_read<v_rd_off2(0, 0, 1)>(vb), l1 = tr_read<v_rd_off2(0, 1, 0)>(vb), h1 = tr_read<v_rd_off2(0, 1, 1)>(vb);
    const s16x4 l2 = tr_read<v_rd_off2(0, 2, 0)>(vb), h2 = tr_read<v_rd_off2(0, 2, 1)>(vb), l3 = tr_read<v_rd_off2(0, 3, 0)>(vb), h3 = tr_read<v_rd_off2(0, 3, 1)>(vb);
#pragma unroll
    for (int r = 0; r < 8; ++r) n0[r] = __builtin_amdgcn_exp2f(n0[r]);
    asm volatile("s_waitcnt lgkmcnt(0)" ::: "memory"); SBAR();
    o[0] = __builtin_amdgcn_mfma_f32_32x32x16_bf16(pa0, PK(l0, h0), o[0], 0, 0, 0);
    o[0] = __builtin_amdgcn_mfma_f32_32x32x16_bf16(pa1, PK(l1, h1), o[0], 0, 0, 0);
    o[0] = __builtin_amdgcn_mfma_f32_32x32x16_bf16(pa2, PK(l2, h2), o[0], 0, 0, 0);
    o[0] = __builtin_amdgcn_mfma_f32_32x32x16_bf16(pa3, PK(l3, h3), o[0], 0, 0, 0); }
  { const s16x4 l0 = tr_read<v_rd_off2(1, 0, 0)>(vb), h0 = tr_read<v_rd_off2(1, 0, 1)>(vb), l1 = tr_read<v_rd_off2(1, 1, 0)>(vb), h1 = tr_read<v_rd_off2(1, 1, 1)>(vb);
    const s16x4 l2 = tr_read<v_rd_off2(1, 2, 0)>(vb), h2 = tr_read<v_rd_off2(1, 2, 1)>(vb), l3 = tr_read<v_rd_off2(1, 3, 0)>(vb), h3 = tr_read<v_rd_off2(1, 3, 1)>(vb);
#pragma unroll
    for (int r = 8; r < 16; ++r) n0[r] = __builtin_amdgcn_exp2f(n0[r]);
    asm volatile("s_waitcnt lgkmcnt(0)" ::: "memory"); SBAR();
    o[1] = __builtin_amdgcn_mfma_f32_32x32x16_bf16(pa0, PK(l0, h0), o[1], 0, 0, 0);
    o[1] = __builtin_amdgcn_mfma_f32_32x32x16_bf16(pa1, PK(l1, h1), o[1], 0, 0, 0);
    o[1] = __builtin_amdgcn_mfma_f32_32x32x16_bf16(pa2, PK(l2, h2), o[1], 0, 0, 0);
    o[1] = __builtin_amdgcn_mfma_f32_32x32x16_bf16(pa3, PK(l3, h3), o[1], 0, 0, 0); }
#undef PK
#pragma unroll
  for (int r = 0; r < 16; ++r) n1[r] = __builtin_amdgcn_exp2f(n1[r]);
}

__device__ __forceinline__ void expall(f32x16& p0, f32x16& p1) {
#pragma unroll
  for (int r = 0; r < 16; ++r) p0[r] = __builtin_amdgcn_exp2f(p0[r]);
#pragma unroll
  for (int r = 0; r < 16; ++r) p1[r] = __builtin_amdgcn_exp2f(p1[r]);
}
__device__ __forceinline__ void finishSM(f32x16& p0, f32x16& p1, float& lsum, bf16x8& pa0, bf16x8& pa1, bf16x8& pa2, bf16x8& pa3) {
  float ps = 0;
#pragma unroll
  for (int r = 0; r < 16; ++r) ps += p0[r];
#pragma unroll
  for (int r = 0; r < 16; ++r) ps += p1[r];
  lsum += ps;
#define PK4(P, BASE, OUT) do { u32x4 w = {cvtpk(P[BASE + 0], P[BASE + 1]), cvtpk(P[BASE + 2], P[BASE + 3]), cvtpk(P[BASE + 4], P[BASE + 5]), cvtpk(P[BASE + 6], P[BASE + 7])}; \
    OUT = *reinterpret_cast<bf16x8*>(&w); } while (0)
  PK4(p0, 0, pa0); PK4(p0, 8, pa1); PK4(p1, 0, pa2); PK4(p1, 8, pa3);
#undef PK4
}
template <int NQK>
__device__ __forceinline__ void qkt(f32x16& p0, f32x16& p1, const char* Ks, const bf16x8* qr, int r32, int hi, const float shift) {
  p0 = f32x16{}; p1 = f32x16{};
#pragma unroll
  for (int d0 = 0; d0 < NQK; ++d0) { int cb = (d0 * 16 + hi * 8) * 2;
    bf16x8 b0 = *reinterpret_cast<const bf16x8*>(Ks + KSWZ(r32, cb));
    bf16x8 b1 = *reinterpret_cast<const bf16x8*>(Ks + KSWZ(32 + r32, cb));
    p0 = __builtin_amdgcn_mfma_f32_32x32x16_bf16(b0, qr[d0], p0, 0, 0, 0);
    p1 = __builtin_amdgcn_mfma_f32_32x32x16_bf16(b1, qr[d0], p1, 0, 0, 0); }
  if (__builtin_expect(shift != 0.f, 0)) {
#pragma unroll
    for (int r = 0; r < 16; ++r) { p0[r] -= shift; p1[r] -= shift; }
  }
}

#define PK4X(P, BASE, OUT) do { u32x4 w_ = {cvtpk(P[BASE + 0], P[BASE + 1]), cvtpk(P[BASE + 2], P[BASE + 3]), cvtpk(P[BASE + 4], P[BASE + 5]), cvtpk(P[BASE + 6], P[BASE + 7])}; \
    OUT = *reinterpret_cast<bf16x8*>(&w_); } while (0)
template <int NQK>
__device__ __forceinline__ void qkt_fin(f32x16& n0, f32x16& n1, const char* Ks, const bf16x8* qr, int r32, int hi, const float shift,
                                        f32x16& o0, f32x16& o1, float& lsum, bf16x8& pa0, bf16x8& pa1, bf16x8& pa2, bf16x8& pa3) {
  n0 = f32x16{}; n1 = f32x16{};
  float ps = 0.f;
  bf16x8 kc0 = *reinterpret_cast<const bf16x8*>(Ks + KSWZ(r32, (hi * 8) * 2));
  bf16x8 kc1 = *reinterpret_cast<const bf16x8*>(Ks + KSWZ(32 + r32, (hi * 8) * 2));
#pragma unroll
  for (int d0 = 0; d0 < NQK; ++d0) {
    bf16x8 kn0 = kc0, kn1 = kc1;
    if (d0 + 1 < NQK) { const int cb = ((d0 + 1) * 16 + hi * 8) * 2;
      kn0 = *reinterpret_cast<const bf16x8*>(Ks + KSWZ(r32, cb)); kn1 = *reinterpret_cast<const bf16x8*>(Ks + KSWZ(32 + r32, cb)); }
    n0 = __builtin_amdgcn_mfma_f32_32x32x16_bf16(kc0, qr[d0], n0, 0, 0, 0);
    n1 = __builtin_amdgcn_mfma_f32_32x32x16_bf16(kc1, qr[d0], n1, 0, 0, 0);
#define PIN(X) asm volatile("" : "+v"(X))
    if (NQK == 6) {
      if (d0 == 0) { PK4X(o0, 0, pa0); }
      if (d0 == 1) { PIN(o0); PK4X(o0, 8, pa1); }
      if (d0 == 2) { _Pragma("unroll") for (int r = 0; r < 16; ++r) ps += o0[r]; }
      if (d0 == 3) { PIN(o1); PK4X(o1, 0, pa2); _Pragma("unroll") for (int r = 0; r < 8; ++r) ps += o1[r]; }
      if (d0 == 4) { PIN(o1); PK4X(o1, 8, pa3); _Pragma("unroll") for (int r = 8; r < 16; ++r) ps += o1[r]; }
    } else {
      if (d0 == 0) { PK4X(o0, 0, pa0); PK4X(o0, 8, pa1); }
      if (d0 == 1) { _Pragma("unroll") for (int r = 0; r < 16; ++r) ps += o0[r]; }
      if (d0 == 2) { PIN(o1); PK4X(o1, 0, pa2); _Pragma("unroll") for (int r = 0; r < 8; ++r) ps += o1[r]; }
      if (d0 == 3) { PIN(o1); PK4X(o1, 8, pa3); _Pragma("unroll") for (int r = 8; r < 16; ++r) ps += o1[r]; }
    }
#undef PIN
    asm volatile("" : "+v"(ps), "+v"(pa0), "+v"(pa1), "+v"(pa2), "+v"(pa3));
    kc0 = kn0; kc1 = kn1;
    SBAR();
  }
  lsum += ps;
  if (__builtin_expect(shift != 0.f, 0)) {
#pragma unroll
    for (int r = 0; r < 16; ++r) { n0[r] -= shift; n1[r] -= shift; }
  }
}

template <int NQK, int MODE, int LDG>
__device__ __forceinline__ void attn_body(const u16* __restrict__ Qb, const u16* __restrict__ Kh, const u16* __restrict__ Vh,
                                          const int NT, const int q0, const float sink2, const float mbound,
                                          u16* __restrict__ mix0, const u16* __restrict__ gate0, char* lds) {
  constexpr int DK = NQK * 16;
  constexpr int SHM_V = 8192, SHM_K = 17408;
  int tid_ = threadIdx.x; asm volatile("" : "+v"(tid_));
  const int tid = tid_, wid = __builtin_amdgcn_readfirstlane(tid >> 6), lane = tid & 63, r32 = lane & 31, hi = lane >> 5;
  char* V_lds = lds; char* K_lds = lds + 3 * SHM_V;
  float* wsf = (float*)(lds + 3 * SHM_V + 3 * SHM_K) + wid * 64; float* li_l = wsf;
  float lsum = 0; f32x16 o[2] = {}; bf16x8 qr[NQK];
  const float shift = mbound > 80.f ? mbound - 80.f : 0.f;
  const u16* Qw = Qb + (size_t)(wid * 32 + r32) * DK + hi * 8;
#pragma unroll
  for (int d0 = 0; d0 < NQK; ++d0) qr[d0] = *(const bf16x8*)(Qw + d0 * 16);
  const int srow = tid >> 3, sc8 = tid & 7;
  const int kst0 = KSWZ(srow, sc8 * 16), kst1 = KSWZ(srow, 128 + sc8 * 16), vst = v_st2(srow, sc8 * 8);
  const int vb0 = (int)(uintptr_t)V_lds + v_rd_base(lane);
  const bool k1on = (NQK == 6) && (sc8 < 4);
  const unsigned koff0 = srow * DK + sc8 * 8, voff0 = srow * 64 + sc8 * 8;
  struct { bf16x8 k0, k1, v0; } st[1];
#define TROW(j) (MODE == 0 ? (j) * 64 : ((j) < 4 ? (j) * 64 : q0 + 128 + ((j) - 4) * 64))
#define SLOAD(i, kr) do { const u16* kp_ = Kh + (unsigned)((kr) * DK); st[i].k0 = *(const bf16x8*)(kp_ + koff0);   \
    if (k1on) st[i].k1 = *(const bf16x8*)(kp_ + koff0 + 64);                                                           \
    const u16* vp_ = Vh + (unsigned)((kr) * 64); st[i].v0 = *(const bf16x8*)(vp_ + voff0); } while (0)
#define SWRITE(b, i) do { *(bf16x8*)(K_lds + (b) * SHM_K + kst0) = st[i].k0; if (k1on) *(bf16x8*)(K_lds + (b) * SHM_K + kst1) = st[i].k1; \
    *(bf16x8*)(V_lds + (b) * SHM_V + vst) = st[i].v0; } while (0)
#define MASKT(P0, P1, j) do { if (MODE == 1 && (j) >= 4) { const int kb_ = q0 - 128 + ((j) - 4) * 64, qp_ = q0 + wid * 32 + r32;    \
    _Pragma("unroll") for (int r = 0; r < 16; ++r) { int k0_ = kb_ + crow(r, hi), k1_ = k0_ + 32; int d0_ = qp_ - k0_, d1_ = qp_ - k1_; \
      bool ok0 = (d0_ <= 128) && (d0_ >= -128) && (k0_ >= 0) && (k0_ < SEQ); bool ok1 = (d1_ <= 128) && (d1_ >= -128) && (k1_ >= 0) && (k1_ < SEQ); \
      P0[r] = ok0 ? P0[r] : -1e30f; P1[r] = ok1 ? P1[r] : -1e30f; } } } while (0)
  f32x16 pA0, pA1, pB0, pB1; bf16x8 pa0, pa1, pa2, pa3;
  __syncthreads();
  SLOAD(0, TROW(0)); asm volatile("s_waitcnt vmcnt(0)" ::: "memory"); SWRITE(0, 0);
  SLOAD(0, TROW(1)); SWRITE(1, 0);
  if (2 < NT) SLOAD(0, TROW(2));
  __syncthreads();
  qkt<NQK>(pA0, pA1, K_lds, qr, r32, hi, shift); MASKT(pA0, pA1, 0); expall(pA0, pA1);
  int sm1 = 0, s0 = 1, sp1 = 2;
  for (int j = 1; j + 1 < NT; j += 2) {
    SBAR(); SWRITE(sp1, 0); SBAR();
    qkt_fin<NQK>(pB0, pB1, K_lds + s0 * SHM_K, qr, r32, hi, shift, pA0, pA1, lsum, pa0, pa1, pa2, pa3); MASKT(pB0, pB1, j); SBAR();
    SLOAD(0, TROW(j + 2)); SBAR();
    pv_exp(o, vb0 + sm1 * SHM_V, pa0, pa1, pa2, pa3, pB0, pB1);
    __syncthreads();
    { const int t = sm1; sm1 = s0; s0 = sp1; sp1 = t; }
    SBAR(); SWRITE(sp1, 0); SBAR();
    qkt_fin<NQK>(pA0, pA1, K_lds + s0 * SHM_K, qr, r32, hi, shift, pB0, pB1, lsum, pa0, pa1, pa2, pa3); MASKT(pA0, pA1, j + 1); SBAR();
    if (j + 3 < NT) SLOAD(0, TROW(j + 3)); SBAR();
    pv_exp(o, vb0 + sm1 * SHM_V, pa0, pa1, pa2, pa3, pA0, pA1);
    __syncthreads();
    { const int t = sm1; sm1 = s0; s0 = sp1; sp1 = t; }
  }
  SBAR(); qkt_fin<NQK>(pB0, pB1, K_lds + s0 * SHM_K, qr, r32, hi, shift, pA0, pA1, lsum, pa0, pa1, pa2, pa3); MASKT(pB0, pB1, NT - 1); SBAR();
  pv_all(o, vb0 + sm1 * SHM_V, pa0, pa1, pa2, pa3); expall(pB0, pB1);
  finishSM(pB0, pB1, lsum, pa0, pa1, pa2, pa3); SBAR();
  pv_all(o, vb0 + s0 * SHM_V, pa0, pa1, pa2, pa3);
  float l_reg;
  { auto rr = __builtin_amdgcn_permlane32_swap(__float_as_uint(lsum), __float_as_uint(lsum), false, false);
    l_reg = __uint_as_float(rr[0]) + __uint_as_float(rr[1]); }
  if (MODE == 1) l_reg += __builtin_amdgcn_exp2f(sink2 - shift);
  if (hi == 0) li_l[r32] = l_reg; asm volatile("s_waitcnt lgkmcnt(0)" ::: "memory");
  float rli[16];
#pragma unroll
  for (int r = 0; r < 16; ++r) rli[r] = __builtin_amdgcn_rcpf(li_l[crow(r, hi)]);
#pragma unroll
  for (int r = 0; r < 16; ++r) { const int orow = wid * 32 + crow(r, hi);
#pragma unroll
    for (int d0 = 0; d0 < 2; ++d0) {
      const float g = bf2f(gate0[(size_t)orow * LDG + d0 * 32 + r32]);
      mix0[(size_t)orow * 1024 + d0 * 32 + r32] = f2bf(o[d0][r] * rli[r] * silu_f(g));
    } }
#undef TROW
#undef SLOAD
#undef SWRITE
#undef MASKT
}

__global__ void __launch_bounds__(512, 1) mega(Params p) {
  extern __shared__ __attribute__((aligned(16))) char lds[];
  cg::grid_group grid = cg::this_grid();
  const int bid = blockIdx.x, nblk = gridDim.x;
  char* ws = p.ws;
  float* modv = (float*)(ws + OFF_MODV);
  u16* H = (u16*)(ws + OFF_H);
  u16* PP = (u16*)(ws + OFF_PP);
  float* XC1 = (float*)(ws + OFF_XC1);
  unsigned* gcnt = (unsigned*)(ws + OFF_END);
  if (bid == 0 && threadIdx.x == 0) __hip_atomic_store(gcnt, 0u, __ATOMIC_RELAXED, __HIP_MEMORY_SCOPE_AGENT);

  if (p.ph_lo <= 0 && 0 < p.ph_hi) {
  for (int u = bid; u < 192; u += nblk) mod_unit(p, u, lds);
  }
  if (p.ph_lo <= 0 && 0 + 1 < p.ph_hi) grid.sync();
  if (p.ph_lo <= 1 && 1 < p.ph_hi) {
  for (int u = bid; u < 2064; u += nblk) transpose_unit(p, u, lds);
  adaln_phase(p.x, nullptr, p.ctx, modv, H);
  }
  if (p.ph_lo <= 1 && 1 + 1 < p.ph_hi) gbar(gcnt, 1u * gridDim.x);
  if (p.ph_lo <= 2 && 2 < p.ph_hi) {
  { TileIter ti(130, 19); GPre g; int nt = 0, mt = 0; const u16* Wt = (const u16*)(ws + OFF_WT_IN_AB);
    if (ti.valid()) { ti.get(mt, nt); gemm_preload(H, 1024, Wt, 1024, mt * 256, nt * 128, g); }
    while (ti.valid()) {
      f32x16 acc[2][2]; const int m0 = mt * 256, n0 = nt * 128;
      gemm_tile<0>(H, 1024, Wt, 1024, 1024, m0, n0, acc, lds, g);
      ti.next(); if (ti.valid()) { ti.get(mt, nt); gemm_preload(H, 1024, Wt, 1024, mt * 256, nt * 128, g); }
      epi_bf16(acc, PP, LD_AB, m0, n0, lds);
    } }
  }
  if (p.ph_lo <= 2 && 2 + 1 < p.ph_hi) gbar(gcnt, 2u * gridDim.x);
  if (p.ph_lo <= 3 && 3 < p.ph_hi) {
  { TileIter ti(130, 14); GPre g; int nt = 0, mt = 0;
    const u16* Wq = (const u16*)(ws + OFF_WT_UQ); const u16* Wkv = (const u16*)(ws + OFF_WT_UKV);
    if (ti.valid()) { ti.get(mt, nt); gemm_preload(nt < 6 ? PP : PP + 256, LD_AB, nt < 6 ? Wq : Wkv, 256, mt * 256, (nt < 6 ? nt : nt - 6) * 128, g); }
    while (ti.valid()) {
      f32x16 acc[2][2]; const int m0 = mt * 256, cn = nt, n0 = (nt < 6 ? nt : nt - 6) * 128;
      gemm_tile<0>(cn < 6 ? PP : PP + 256, LD_AB, cn < 6 ? Wq : Wkv, 256, 256, m0, n0, acc, lds, g);
      ti.next(); if (ti.valid()) { ti.get(mt, nt); gemm_preload(nt < 6 ? PP : PP + 256, LD_AB, nt < 6 ? Wq : Wkv, 256, mt * 256, (nt < 6 ? nt : nt - 6) * 128, g); }
      if (cn < 6) epi_bf16(acc, H, 768, m0, n0, lds); else epi_bf16(acc, (u16*)p.out, 1024, m0, n0, lds);
    } }
  }
  if (p.ph_lo <= 3 && 3 + 1 < p.ph_hi) gbar(gcnt, 3u * gridDim.x);
  if (p.ph_lo <= 4 && 4 < p.ph_hi) {
  finalize0(p);
  }
  if (p.ph_lo <= 4 && 4 + 1 < p.ph_hi) gbar(gcnt, 4u * gridDim.x);
  if (p.ph_lo <= 5 && 5 < p.ph_hi) {
  const float mbA = LOG2E * 9.7979590f * 1.02f * vmaxabs(p.q_gain, 96) * vmaxabs(p.k_gain, 96);
  const float mbB = LOG2E * 8.f * 1.02f * vmaxabs(p.gq_gain, 64) * vmaxabs(p.gk_gain, 64);
  for (int it = bid; it < 2080; it += nblk) {
    int b, h, kvh, nt, qoff; bool mla, isctx;
    if (it < 2048) {
      const int round = it >> 8, blk = it & 255, xcd = blk & 7, cl = blk >> 3;
      isctx = false; nt = KVLEN / 64;
      if (round < 4) { const int pair = xcd * 2 + (round >> 1); b = pair >> 3; h = pair & 7; kvh = h; qoff = ((round & 1) * 32 + cl) * 256; mla = true; }
      else { const int g = round - 4, pi = xcd >> 1, idx = (xcd & 1) * 128 + g * 32 + cl; b = pi >> 1; kvh = pi & 1; h = kvh * 4 + (idx >> 6); qoff = (idx & 63) * 256; mla = false; }
    } else {
      const int ci = it - 2048; b = (ci >> 3) & 1; h = ci & 7; mla = ci < 16; kvh = mla ? h : (h >> 2); isctx = true; nt = CL / 64; qoff = 0;
    }
    const size_t r0 = isctx ? (size_t)NLAT + b * CL : (size_t)b * SEQ + qoff;
    const size_t qrow = isctx ? (size_t)(b * 8 + h) * CL : (size_t)(b * 8 + h) * SEQ + qoff;
    if (mla) {
      const u16* Qp = (const u16*)(ws + (isctx ? OFF_QCA : OFF_QA)) + qrow * 96;
      attn_body<6, 0, LD_AB>(Qp, (const u16*)(ws + OFF_KA) + (size_t)(b * 8 + kvh) * KVLEN * 96, (const u16*)(ws + OFF_VA) + (size_t)(b * 8 + kvh) * KVLEN * 64,
                             nt, 0, 0.f, mbA, H + r0 * 1024 + h * 64, PP + r0 * LD_AB + 1312 + h * 64, lds);
    } else {
      const u16* Qp = (const u16*)(ws + (isctx ? OFF_QCB : OFF_QB)) + qrow * 64;
      attn_body<4, 0, LD_AB>(Qp, (const u16*)(ws + OFF_KB) + (size_t)(b * 2 + kvh) * KVLEN * 64, (const u16*)(ws + OFF_VB) + (size_t)(b * 2 + kvh) * KVLEN * 64,
                             nt, 0, 0.f, mbB, H + r0 * 1024 + 512 + h * 64, PP + r0 * LD_AB + 1312 + 512 + h * 64, lds);
    }
  }
  }
  if (p.ph_lo <= 5 && 5 + 1 < p.ph_hi) gbar(gcnt, 5u * gridDim.x);
  if (p.ph_lo <= 6 && 6 < p.ph_hi) {
  { TileIter ti(130, 8); GPre g; int nt = 0, mt = 0; const u16* Wt = (const u16*)(ws + OFF_WT_OUT_AB);
    if (ti.valid()) { ti.get(mt, nt); gemm_preload(H, 1024, Wt, 1024, mt * 256, nt * 128, g); }
    while (ti.valid()) {
      f32x16 acc[2][2]; const int m0 = mt * 256, n0 = nt * 128; const bool lat = m0 < NLAT;
      const int tid_ = opaque_tid(), wid_ = tid_ >> 6, lane_ = tid_ & 63;
      const size_t eoff = (size_t)((lat ? m0 : m0 - NLAT) + (wid_ & 3) * 64 + (lane_ >> 4)) * 1024 + n0 + (wid_ >> 2) * 64 + 4 * (lane_ & 15);
      ResPre rp;
      gemm_tile<1>(H, 1024, Wt, 1024, 1024, m0, n0, acc, lds, g, (lat ? p.x : p.ctx) + eoff, &rp);
      ti.next(); if (ti.valid()) { ti.get(mt, nt); gemm_preload(H, 1024, Wt, 1024, mt * 256, nt * 128, g); }
      if (lat) epi_res<false, true>(acc, rp, (u16*)(ws + OFF_X1B) + eoff, modv + (m0 >> 14) * 3072 + 2048, n0, lds);
      else epi_res<false, false>(acc, rp, XC1 + eoff, modv + 2 * 3072 + 2048, n0, lds);
    } }
  }
  if (p.ph_lo <= 6 && 6 + 1 < p.ph_hi) gbar(gcnt, 6u * gridDim.x);
  if (p.ph_lo <= 7 && 7 < p.ph_hi) {
  adaln_phase(nullptr, (const u16*)(ws + OFF_X1B), XC1, modv + 3 * 3072, H);
  }
  if (p.ph_lo <= 7 && 7 + 1 < p.ph_hi) gbar(gcnt, 7u * gridDim.x);
  if (p.ph_lo <= 8 && 8 < p.ph_hi) {
  { TileIter ti(130, 26); GPre g; int nt = 0, mt = 0; const u16* Wt = (const u16*)(ws + OFF_WT_IN_CD);
    if (ti.valid()) { ti.get(mt, nt); gemm_preload(H, 1024, Wt, 1024, mt * 256, nt * 128, g); }
    while (ti.valid()) {
      f32x16 acc[2][2]; const int m0 = mt * 256, n0 = nt * 128;
      gemm_tile<0>(H, 1024, Wt, 1024, 1024, m0, n0, acc, lds, g);
      ti.next(); if (ti.valid()) { ti.get(mt, nt); gemm_preload(H, 1024, Wt, 1024, mt * 256, nt * 128, g); }
      epi_bf16(acc, PP, LD_CD, m0, n0, lds);
    } }
  }
  if (p.ph_lo <= 8 && 8 + 1 < p.ph_hi) gbar(gcnt, 8u * gridDim.x);
  if (p.ph_lo <= 9 && 9 < p.ph_hi) {
  finalize1(p);
  }
  if (p.ph_lo <= 9 && 9 + 1 < p.ph_hi) gbar(gcnt, 9u * gridDim.x);
  if (p.ph_lo <= 10 && 10 < p.ph_hi) {
  const float mbW = LOG2E * 8.f * 1.02f * vmaxabs(p.win_q_gain, 64) * vmaxabs(p.win_k_gain, 64);
  for (int it = bid; it < 1024; it += nblk) {
    const int g = it >> 8, blk = it & 255, xcd = blk & 7, cl = blk >> 3;
    const int pi = xcd >> 1, b = pi >> 1, kvh = pi & 1, idx = (xcd & 1) * 128 + g * 32 + cl;
    const int h = kvh * 4 + (idx >> 6), qblk = idx & 63;
    const size_t r0 = (size_t)b * SEQ + qblk * 256;
    attn_body<4, 1, LD_CD>((const u16*)(ws + OFF_Q2) + ((size_t)(b * 8 + h) * SEQ + qblk * 256) * 64,
                    (const u16*)(ws + OFF_K2) + (size_t)(b * 2 + kvh) * KV2LEN * 64, (const u16*)(ws + OFF_V2) + (size_t)(b * 2 + kvh) * KV2LEN * 64,
                    12, qblk * 256, p.win_sink[h] * LOG2E, mbW, H + r0 * 1024 + h * 64, PP + r0 * LD_CD + 2304 + h * 64, lds);
  }
  }
  if (p.ph_lo <= 10 && 10 + 1 < p.ph_hi) gbar(gcnt, 10u * gridDim.x);
  if (p.ph_lo <= 11 && 11 < p.ph_hi) {
  { TileIter ti(128, 8); GPre g; int nt = 0, mt = 0; const u16* Wt = (const u16*)(ws + OFF_WT_OUT_CD);
    if (ti.valid()) { ti.get(mt, nt); gemm_preload(H, 1024, Wt, 1024, mt * 256, nt * 128, g); }
    while (ti.valid()) {
      f32x16 acc[2][2]; const int m0 = mt * 256, n0 = nt * 128;
      const int tid_ = opaque_tid(), wid_ = tid_ >> 6, lane_ = tid_ & 63;
      const size_t eoff = (size_t)(m0 + (wid_ & 3) * 64 + (lane_ >> 4)) * 1024 + n0 + (wid_ >> 2) * 64 + 4 * (lane_ & 15);
      ResPre rp;
      gemm_tile<2>(H, 1024, Wt, 1024, 1024, m0, n0, acc, lds, g, (const u16*)(ws + OFF_X1B) + eoff, &rp);
      ti.next(); if (ti.valid()) { ti.get(mt, nt); gemm_preload(H, 1024, Wt, 1024, mt * 256, nt * 128, g); }
      epi_res<true, false>(acc, rp, p.out + eoff, modv + 3 * 3072 + (m0 >> 14) * 3072 + 2048, n0, lds);
    } }
  }
}

extern "C" void kernel_launch(void* const* d_in, const int* in_sizes, int n_in, void* d_out, int out_size, void* d_ws, size_t ws_size, hipStream_t stream) {
  static int grid_blocks = 0;
  if (!grid_blocks) {
    if (n_in != 22 || out_size != NLAT * DM || ws_size < OFF_END + 4096) {
      fprintf(stderr, "kernel_launch: shape/ws mismatch n_in %d out %d ws %zu need %zu\n", n_in, out_size, ws_size, (size_t)OFF_END);
      return;
    }
    if (hipFuncSetAttribute((const void*)mega, hipFuncAttributeMaxDynamicSharedMemorySize, LDS_BYTES) != hipSuccess) {
      fprintf(stderr, "kernel_launch: hipFuncSetAttribute failed\n"); return;
    }
    int dev = 0, cus = 0, per_cu = 0;
    (void)hipGetDevice(&dev);
    (void)hipDeviceGetAttribute(&cus, hipDeviceAttributeMultiprocessorCount, dev);
    (void)hipOccupancyMaxActiveBlocksPerMultiprocessor(&per_cu, mega, 512, LDS_BYTES);
    if (per_cu < 1) { fprintf(stderr, "kernel_launch: occupancy 0\n"); return; }
    grid_blocks = cus;
  }
  Params p{};
  p.x = (const float*)d_in[0]; p.c = (const float*)d_in[1]; p.ctx = (const float*)d_in[2]; p.c_ctx = (const float*)d_in[3];
  p.mod_w = (const float*)d_in[4]; p.mod_b = (const float*)d_in[5]; p.ab_w_in = (const float*)d_in[6]; p.ab_w_out = (const float*)d_in[7];
  p.cq_gain = (const float*)d_in[8]; p.ckv_gain = (const float*)d_in[9]; p.w_uq = (const float*)d_in[10]; p.w_ukv = (const float*)d_in[11];
  p.q_gain = (const float*)d_in[12]; p.k_gain = (const float*)d_in[13]; p.gq_gain = (const float*)d_in[14]; p.gk_gain = (const float*)d_in[15];
  p.cd_w_in = (const float*)d_in[16]; p.cd_w_out = (const float*)d_in[17]; p.win_q_gain = (const float*)d_in[18]; p.win_k_gain = (const float*)d_in[19];
  p.win_sink = (const float*)d_in[20]; p.conv_w = (const float*)d_in[21];
  p.out = (float*)d_out; p.ws = (char*)d_ws;
#if MULTI_LAUNCH
  for (int ph = 0; ph < 12; ++ph) {
    p.ph_lo = ph; p.ph_hi = ph + 1;
    hipLaunchKernelGGL(mega, dim3(grid_blocks), dim3(512), LDS_BYTES, stream, p);
  }
#else
  p.ph_lo = 0; p.ph_hi = 12;
  void* args[] = {&p};
  hipError_t e = hipLaunchCooperativeKernel((void*)mega, dim3(grid_blocks), dim3(512), args, LDS_BYTES, stream);
  if (e != hipSuccess) fprintf(stderr, "cooperative launch failed: %s (grid %d)\n", hipGetErrorString(e), grid_blocks);
#endif
}
```

```cpp
#include <hip/hip_runtime.h>
#include <hip/hip_cooperative_groups.h>
#include <cstdio>
#include <cstdint>
namespace cg = cooperative_groups;

typedef unsigned short u16;
using bf16x8 = __attribute__((ext_vector_type(8))) short;
using s16x4  = __attribute__((ext_vector_type(4))) short;
using f32x16 = __attribute__((ext_vector_type(16))) float;
using u32x4  = __attribute__((ext_vector_type(4))) unsigned;
using u32x2  = __attribute__((ext_vector_type(2))) unsigned;

constexpr int NB = 2, SEQ = 16384, DM = 1024, CL = 256;
constexpr int NLAT = NB * SEQ;
constexpr int NROW = NLAT + NB * CL;
constexpr int KVLEN = CL + SEQ;
constexpr int KV2LEN = KVLEN + 128;
constexpr int LD_AB = 2432, LD_CD = 3328;
constexpr float EPS = 1e-6f;
constexpr float QS_A = 0.14724461f;
constexpr float QS_B = 0.18033688f;
constexpr float LOG2E = 1.4426950408889634f;

constexpr size_t OFF_MODV      = 0;
constexpr size_t OFF_WT_IN_AB  = 73728;
constexpr size_t OFF_WT_OUT_AB = OFF_WT_IN_AB + (size_t)LD_AB * 1024 * 2;
constexpr size_t OFF_WT_UQ     = OFF_WT_OUT_AB + (size_t)1024 * 1024 * 2;
constexpr size_t OFF_WT_UKV    = OFF_WT_UQ + (size_t)768 * 256 * 2;
constexpr size_t OFF_WT_IN_CD  = OFF_WT_UKV + (size_t)1024 * 256 * 2;
constexpr size_t OFF_WT_OUT_CD = OFF_WT_IN_CD + (size_t)3328 * 1024 * 2;
constexpr size_t OFF_XC1       = OFF_WT_OUT_CD + (size_t)1024 * 1024 * 2;
constexpr size_t OFF_H         = OFF_XC1 + (size_t)512 * 1024 * 4;
constexpr size_t OFF_PP        = OFF_H + (size_t)NROW * 1024 * 2;
constexpr size_t OFF_QA        = OFF_PP + (size_t)NROW * 3328 * 2;
constexpr size_t OFF_QCA       = OFF_QA + (size_t)NB * 8 * SEQ * 96 * 2;
constexpr size_t OFF_KA        = OFF_QCA + (size_t)NB * 8 * CL * 96 * 2;
constexpr size_t OFF_VA        = OFF_KA + (size_t)NB * 8 * KVLEN * 96 * 2;
constexpr size_t OFF_QB        = OFF_VA + (size_t)NB * 8 * KVLEN * 64 * 2;
constexpr size_t OFF_QCB       = OFF_QB + (size_t)NB * 8 * SEQ * 64 * 2;
constexpr size_t OFF_KB        = OFF_QCB + (size_t)NB * 8 * CL * 64 * 2;
constexpr size_t OFF_VB        = OFF_KB + (size_t)NB * 2 * KVLEN * 64 * 2;
constexpr size_t OFF_END       = OFF_VB + (size_t)NB * 2 * KVLEN * 64 * 2;
constexpr size_t OFF_Q2        = OFF_QA;
constexpr size_t OFF_K2        = OFF_Q2 + (size_t)NB * 8 * SEQ * 64 * 2;
constexpr size_t OFF_V2        = OFF_K2 + (size_t)NB * 2 * KV2LEN * 64 * 2;
constexpr size_t OFF_X1B       = OFF_QA + ((size_t)64 << 20);
static_assert(OFF_V2 + (size_t)NB * 2 * KV2LEN * 64 * 2 <= OFF_X1B && OFF_X1B + (size_t)NLAT * 1024 * 2 <= OFF_END, "x1 alias");
static_assert(OFF_V2 + (size_t)NB * 2 * KV2LEN * 64 * 2 <= OFF_END, "alias overflow");

constexpr int LDS_BYTES = 131072;
#ifndef MULTI_LAUNCH
#define MULTI_LAUNCH 0
#endif

struct Params {
  const float *x, *c, *ctx, *c_ctx, *mod_w, *mod_b, *ab_w_in, *ab_w_out, *cq_gain, *ckv_gain, *w_uq, *w_ukv,
      *q_gain, *k_gain, *gq_gain, *gk_gain, *cd_w_in, *cd_w_out, *win_q_gain, *win_k_gain, *win_sink, *conv_w;
  float* out;
  char* ws;
  int ph_lo, ph_hi;
};

#define SBAR() __builtin_amdgcn_sched_barrier(0)
__device__ __forceinline__ int crow(int r, int hi) { return (r & 3) + 8 * (r >> 2) + 4 * hi; }
typedef float f32x2_t __attribute__((ext_vector_type(2)));
typedef __bf16 bf16x2_t __attribute__((ext_vector_type(2)));
__device__ __forceinline__ unsigned cvtpk(float lo, float hi) { f32x2_t v = {lo, hi}; bf16x2_t b = __builtin_convertvector(v, bf16x2_t); return __builtin_bit_cast(unsigned, b); }
__device__ __forceinline__ u16 f2bf(float x) { return (u16)(cvtpk(x, 0.f) & 0xffffu); }
__device__ __forceinline__ float bf2f(u16 x) { return __uint_as_float(((unsigned)x) << 16); }
__device__ __forceinline__ float bflo(unsigned w) { return __uint_as_float(w << 16); }
__device__ __forceinline__ float bfhi(unsigned w) { return __uint_as_float(w & 0xffff0000u); }
__device__ __forceinline__ float wave_sum(float v) {
#pragma unroll
  for (int o = 32; o >= 1; o >>= 1) v += __shfl_xor(v, o);
  return v;
}
__device__ __forceinline__ int opaque_tid() { int t = threadIdx.x; asm volatile("" : "+v"(t)); return t; }
__device__ __forceinline__ float vmaxabs(const float* g, int n) { float m = 0.f; for (int i = 0; i < n; ++i) m = fmaxf(m, fabsf(g[i])); return m; }
__device__ __forceinline__ float silu_f(float g) { return g / (1.f + __expf(-g)); }


__device__ __forceinline__ void gbar(unsigned* cnt, unsigned target) {
  asm volatile("s_waitcnt vmcnt(0)" ::: "memory");
  __syncthreads();
  if (threadIdx.x == 0) {
    __builtin_amdgcn_fence(__ATOMIC_RELEASE, "agent");
    asm volatile("s_waitcnt vmcnt(0)" ::: "memory");
    __hip_atomic_fetch_add(cnt, 1u, __ATOMIC_RELAXED, __HIP_MEMORY_SCOPE_AGENT);
    unsigned sp = 0;
    while (__hip_atomic_load(cnt, __ATOMIC_RELAXED, __HIP_MEMORY_SCOPE_AGENT) < target) { __builtin_amdgcn_s_sleep(1); if (++sp > (1u << 24)) break; }
    __builtin_amdgcn_fence(__ATOMIC_ACQUIRE, "agent");
    asm volatile("s_waitcnt vmcnt(0)" ::: "memory");
  }
  __syncthreads();
}

__device__ void mod_unit(const Params& p, int u, char* lds) {
  const int tid = opaque_tid();
  const int layer = u / 96, n0 = (u % 96) * 32, col = tid & 31, ks = tid >> 5;
  const float* W = p.mod_w + (size_t)layer * 1024 * 3072 + n0 + col;
  float a0 = 0, a1 = 0, a2 = 0;
  for (int k = ks * 64; k < ks * 64 + 64; ++k) {
    float w = W[(size_t)k * 3072];
    a0 += silu_f(p.c[k]) * w; a1 += silu_f(p.c[1024 + k]) * w; a2 += silu_f(p.c_ctx[k]) * w;
  }
  float* red = (float*)lds;
  red[(0 * 16 + ks) * 32 + col] = a0; red[(1 * 16 + ks) * 32 + col] = a1; red[(2 * 16 + ks) * 32 + col] = a2;
  __syncthreads();
  if (tid < 96) {
    int w = tid >> 5, cc = tid & 31; float s = 0;
    for (int i = 0; i < 16; ++i) s += red[(w * 16 + i) * 32 + cc];
    float* modv = (float*)(p.ws + OFF_MODV);
    modv[(layer * 3 + w) * 3072 + n0 + cc] = s + p.mod_b[layer * 3072 + n0 + cc];
  }
  __syncthreads();
}

__device__ void transpose_unit(const Params& p, int u, char* lds) {
  const float* src; const float* gain = nullptr; int K, N; u16* dst; int ul;
  if (u < 608)       { ul = u;        src = p.ab_w_in;  K = 1024; N = 2336; dst = (u16*)(p.ws + OFF_WT_IN_AB); }
  else if (u < 864)  { ul = u - 608;  src = p.ab_w_out; K = 1024; N = 1024; dst = (u16*)(p.ws + OFF_WT_OUT_AB); }
  else if (u < 912)  { ul = u - 864;  src = p.w_uq;     K = 256;  N = 768;  dst = (u16*)(p.ws + OFF_WT_UQ); gain = p.cq_gain; }
  else if (u < 976)  { ul = u - 912;  src = p.w_ukv;    K = 256;  N = 1024; dst = (u16*)(p.ws + OFF_WT_UKV); gain = p.ckv_gain; }
  else if (u < 1808) { ul = u - 976;  src = p.cd_w_in;  K = 1024; N = 3328; dst = (u16*)(p.ws + OFF_WT_IN_CD); }
  else               { ul = u - 1808; src = p.cd_w_out; K = 1024; N = 1024; dst = (u16*)(p.ws + OFF_WT_OUT_CD); }
  const int nkt = K / 64, kt = ul % nkt, nt = ul / nkt, k0 = kt * 64, n0 = nt * 64, tid = opaque_tid();
  float* tile = (float*)lds;
#pragma unroll
  for (int e = 0; e < 8; ++e) {
    int i = (tid >> 6) + 8 * e, j = tid & 63, n = n0 + j;
    float v = (n < N) ? src[(size_t)(k0 + i) * N + n] : 0.f;
    if (gain) v *= gain[k0 + i];
    tile[i * 65 + j] = v;
  }
  __syncthreads();
#pragma unroll
  for (int e = 0; e < 8; ++e) {
    int i2 = (tid >> 6) + 8 * e, j2 = tid & 63;
    dst[(size_t)(n0 + i2) * K + k0 + j2] = f2bf(tile[j2 * 65 + i2]);
  }
  __syncthreads();
}

__device__ void adaln_phase(const float* xlat, const u16* xlat_bf, const float* xctx, const float* modl, u16* H) {
  const int tid = opaque_tid(), lane = tid & 63, gw = blockIdx.x * 8 + (tid >> 6), nw = gridDim.x * 8;
  for (int r = gw; r < NROW; r += nw) {
    if (xlat_bf != nullptr && r < NLAT) {
      const float* m = modl + (r >> 14) * 3072;
      u32x4 w[2]; float f[16]; float ss = 0;
#pragma unroll
      for (int i = 0; i < 2; ++i) w[i] = *(const u32x4*)(xlat_bf + (size_t)r * 1024 + 8 * (lane + 64 * i));
#pragma unroll
      for (int i = 0; i < 2; ++i)
#pragma unroll
        for (int e = 0; e < 4; ++e) { f[i * 8 + 2 * e] = bflo(w[i][e]); f[i * 8 + 2 * e + 1] = bfhi(w[i][e]); }
#pragma unroll
      for (int e = 0; e < 16; ++e) ss += f[e] * f[e];
      ss = wave_sum(ss);
      const float rstd = rsqrtf(ss * (1.f / 1024) + EPS);
#pragma unroll
      for (int i = 0; i < 2; ++i) {
        const int c = 8 * (lane + 64 * i);
        const float4 sh0 = *(const float4*)(m + c), sh1 = *(const float4*)(m + c + 4), sc0 = *(const float4*)(m + 1024 + c), sc1 = *(const float4*)(m + 1024 + c + 4);
        const float shv[8] = {sh0.x, sh0.y, sh0.z, sh0.w, sh1.x, sh1.y, sh1.z, sh1.w}, scv[8] = {sc0.x, sc0.y, sc0.z, sc0.w, sc1.x, sc1.y, sc1.z, sc1.w};
        float y[8];
#pragma unroll
        for (int e = 0; e < 8; ++e) y[e] = f[i * 8 + e] * rstd * (1.f + scv[e]) + shv[e];
        const u32x4 o = {cvtpk(y[0], y[1]), cvtpk(y[2], y[3]), cvtpk(y[4], y[5]), cvtpk(y[6], y[7])};
        *(u32x4*)(H + (size_t)r * 1024 + c) = o;
      }
      continue;
    }
    const float* src = r < NLAT ? xlat + (size_t)r * 1024 : xctx + (size_t)(r - NLAT) * 1024;
    const float* m = modl + (r < NLAT ? (r >> 14) : 2) * 3072;
    float4 v[4]; float ss = 0;
#pragma unroll
    for (int i = 0; i < 4; ++i) { v[i] = ((const float4*)src)[lane + 64 * i]; ss += v[i].x * v[i].x + v[i].y * v[i].y + v[i].z * v[i].z + v[i].w * v[i].w; }
    ss = wave_sum(ss);
    const float rstd = rsqrtf(ss * (1.f / 1024) + EPS);
#pragma unroll
    for (int i = 0; i < 4; ++i) {
      int c = 4 * (lane + 64 * i);
      float4 sh = *(const float4*)(m + c), sc = *(const float4*)(m + 1024 + c);
      float y0 = v[i].x * rstd * (1.f + sc.x) + sh.x, y1 = v[i].y * rstd * (1.f + sc.y) + sh.y;
      float y2 = v[i].z * rstd * (1.f + sc.z) + sh.z, y3 = v[i].w * rstd * (1.f + sc.w) + sh.w;
      u32x2 o = {cvtpk(y0, y1), cvtpk(y2, y3)};
      *(u32x2*)(H + (size_t)r * 1024 + c) = o;
    }
  }
}

#define GSWZ(row, colB) ((row) * 128 + ((colB) ^ ((((row) >> 1) & 7) << 4)))
struct ResPre { float4 v[16]; u32x2 w[16]; };
struct GPre { bf16x8 ra[4], rb[2]; };
__device__ __forceinline__ void gemm_preload(const u16* __restrict__ A, int lda, const u16* __restrict__ Bt, int ldb, int m0, int n0, GPre& g) {
  const int tid = opaque_tid(), srow = tid >> 3, sch = tid & 7;
  const u16* ap = A + (size_t)(m0 + srow) * lda + sch * 8;
  const u16* bp = Bt + (size_t)(n0 + srow) * ldb + sch * 8;
#pragma unroll
  for (int i = 0; i < 4; ++i) g.ra[i] = *(const bf16x8*)(ap + (size_t)(64 * i) * lda);
#pragma unroll
  for (int i = 0; i < 2; ++i) g.rb[i] = *(const bf16x8*)(bp + (size_t)(64 * i) * ldb);
}
template <int PRE>
__device__ __forceinline__ void gemm_tile(const u16* __restrict__ A, int lda, const u16* __restrict__ Bt, int ldb, int K,
                                          int m0, int n0, f32x16 (&acc)[2][2], char* lds, GPre& g, const void* resp = nullptr, ResPre* rp = nullptr) {
  const int tid = opaque_tid(), wid = tid >> 6, lane = tid & 63, r32 = lane & 31, hi = lane >> 5;
  const int wm = wid & 3, wn = wid >> 2;
  char* As = lds;
  char* Bs = lds + 65536;
  const int srow = tid >> 3, sch = tid & 7;
  const u16* ap = A + (size_t)(m0 + srow) * lda + sch * 8;
  const u16* bp = Bt + (size_t)(n0 + srow) * ldb + sch * 8;
  const int sw = GSWZ(srow, sch * 16);
  bf16x8 (&ra)[4] = g.ra; bf16x8 (&rb)[2] = g.rb;
#pragma unroll
  for (int i = 0; i < 2; ++i) for (int j = 0; j < 2; ++j) acc[i][j] = f32x16{};
  __syncthreads();
#pragma unroll
  for (int i = 0; i < 4; ++i) *(bf16x8*)(As + sw + i * 8192) = ra[i];
#pragma unroll
  for (int i = 0; i < 2; ++i) *(bf16x8*)(Bs + sw + i * 8192) = rb[i];
  __syncthreads();
  const int nk = K / 64;
  const int arow0 = wm * 64 + r32, brow0 = wn * 64 + r32;
  for (int kt = 0; kt < nk; ++kt) {
    const int cur = kt & 1;
    if (kt + 1 < nk) {
#pragma unroll
      for (int i = 0; i < 4; ++i) ra[i] = *(const bf16x8*)(ap + (size_t)(64 * i) * lda + (kt + 1) * 64);
#pragma unroll
      for (int i = 0; i < 2; ++i) rb[i] = *(const bf16x8*)(bp + (size_t)(64 * i) * ldb + (kt + 1) * 64);
    }
    if (PRE == 1 && kt == 0) {
#pragma unroll
      for (int q = 0; q < 16; ++q) rp->v[q] = *(const float4*)((const float*)resp + (size_t)((q >> 3) * 32 + 4 * (q & 7)) * 1024);
    }
    if (PRE == 2 && kt == 0) {
#pragma unroll
      for (int q = 0; q < 16; ++q) rp->w[q] = *(const u32x2*)((const u16*)resp + (size_t)((q >> 3) * 32 + 4 * (q & 7)) * 1024);
    }
    SBAR();
    const char* Ac = As + cur * 32768; const char* Bc = Bs + cur * 16384;
#pragma unroll
    for (int kk = 0; kk < 4; ++kk) {
      const int cb = kk * 32 + hi * 16;
      bf16x8 a0 = *(const bf16x8*)(Ac + GSWZ(arow0, cb));
      bf16x8 a1 = *(const bf16x8*)(Ac + GSWZ(arow0 + 32, cb));
      bf16x8 b0 = *(const bf16x8*)(Bc + GSWZ(brow0, cb));
      bf16x8 b1 = *(const bf16x8*)(Bc + GSWZ(brow0 + 32, cb));
      acc[0][0] = __builtin_amdgcn_mfma_f32_32x32x16_bf16(a0, b0, acc[0][0], 0, 0, 0);
      acc[0][1] = __builtin_amdgcn_mfma_f32_32x32x16_bf16(a0, b1, acc[0][1], 0, 0, 0);
      acc[1][0] = __builtin_amdgcn_mfma_f32_32x32x16_bf16(a1, b0, acc[1][0], 0, 0, 0);
      acc[1][1] = __builtin_amdgcn_mfma_f32_32x32x16_bf16(a1, b1, acc[1][1], 0, 0, 0);
    }
    if (kt + 1 < nk) {
      char* An = As + (cur ^ 1) * 32768; char* Bn = Bs + (cur ^ 1) * 16384;
#pragma unroll
      for (int i = 0; i < 4; ++i) *(bf16x8*)(An + sw + i * 8192) = ra[i];
#pragma unroll
      for (int i = 0; i < 2; ++i) *(bf16x8*)(Bn + sw + i * 8192) = rb[i];
    }
    __syncthreads();
  }
}


struct TileIter {
  int f, fend, step, MT, NT;
  __device__ __forceinline__ TileIter(int MT_, int NT_) : MT(MT_), NT(NT_) {
    const int T = MT_ * NT_, bid = blockIdx.x, nblk = gridDim.x;
    if (nblk == 256) { const int x = bid & 7, cl = bid >> 3; f = (int)(((long)T * x) >> 3) + cl; fend = (int)(((long)T * (x + 1)) >> 3); step = 32; }
    else { f = bid; fend = T; step = nblk; }
  }
  __device__ __forceinline__ bool valid() const { return f < fend; }
  __device__ __forceinline__ void next() { f += step; }
  __device__ __forceinline__ void get(int& mt, int& nt) const {
    const int full = (MT >> 2) * 4 * NT;
    if (f < full) { const int g = f / (4 * NT), rem = f - g * 4 * NT; nt = rem >> 2; mt = g * 4 + (rem & 3); }
    else { const int rem = f - full, gs = MT - (MT >> 2) * 4; nt = rem / gs; mt = (MT >> 2) * 4 + (rem - nt * gs); }
  }
};

__device__ __forceinline__ void epi_bf16(f32x16 (&acc)[2][2], u16* C, int ldc, int m0, int n0, char* lds) {
  const int tid = opaque_tid(), wid = tid >> 6, lane = tid & 63, r32 = lane & 31, hi = lane >> 5;
  const int wm = wid & 3, wn = wid >> 2;
  char* wl = lds + wid * 9216;
#pragma unroll
  for (int i = 0; i < 2; ++i)
#pragma unroll
    for (int j = 0; j < 2; ++j)
#pragma unroll
      for (int r = 0; r < 16; ++r) *(u16*)(wl + (i * 32 + crow(r, hi)) * 144 + (j * 32 + r32) * 2) = f2bf(acc[i][j][r]);
  asm volatile("s_waitcnt lgkmcnt(0)" ::: "memory");
  const int rr = lane >> 3, ch = lane & 7;
  u16* cbase = C + (size_t)(m0 + wm * 64 + rr) * ldc + n0 + wn * 64 + ch * 8;
#pragma unroll
  for (int k = 0; k < 8; ++k) {
    const u32x4 v = *(const u32x4*)(wl + (rr + 8 * k) * 144 + ch * 16);
    *(u32x4*)(cbase + (size_t)(8 * k) * ldc) = v;
  }
}
template <bool IN_BF, bool OUT_BF>
__device__ __forceinline__ void epi_res(f32x16 (&acc)[2][2], const ResPre& rp, void* outp, const float* gsrc, int n0, char* lds) {
  const int tid = opaque_tid(), wid = tid >> 6, lane = tid & 63, r32 = lane & 31, hi = lane >> 5;
  const int wn = wid >> 2;
  char* wl = lds + wid * 8704;
  const int rl = lane >> 4, c4 = lane & 15;
  const float4 g = *(const float4*)(gsrc + n0 + wn * 64 + 4 * c4);
#pragma unroll
  for (int i = 0; i < 2; ++i) {
#pragma unroll
    for (int j = 0; j < 2; ++j)
#pragma unroll
      for (int r = 0; r < 16; ++r) *(float*)(wl + crow(r, hi) * 272 + (j * 32 + r32) * 4) = acc[i][j][r];
    asm volatile("s_waitcnt lgkmcnt(0)" ::: "memory");
#pragma unroll
    for (int k = 0; k < 8; ++k) {
      const float4 a = *(const float4*)(wl + (rl + 4 * k) * 272 + c4 * 16);
      float4 x;
      if (IN_BF) { const u32x2 xw = rp.w[i * 8 + k]; x.x = bflo(xw[0]); x.y = bfhi(xw[0]); x.z = bflo(xw[1]); x.w = bfhi(xw[1]); } else x = rp.v[i * 8 + k];
      float4 o; o.x = x.x + g.x * a.x; o.y = x.y + g.y * a.y; o.z = x.z + g.z * a.z; o.w = x.w + g.w * a.w;
      if (OUT_BF) { const u32x2 ow = {cvtpk(o.x, o.y), cvtpk(o.z, o.w)}; *(u32x2*)((u16*)outp + (size_t)(i * 32 + 4 * k) * 1024) = ow; }
      else *(float4*)((float*)outp + (size_t)(i * 32 + 4 * k) * 1024) = o;
    }
    asm volatile("s_waitcnt lgkmcnt(0)" ::: "memory");
  }
}

__device__ __forceinline__ float red8(float v) { v += __shfl_xor(v, 1); v += __shfl_xor(v, 2); v += __shfl_xor(v, 4); return v; }
__device__ __forceinline__ void rope_cs(float pos, float inv, bool on, float& c, float& s) {
  if (on) { float a = pos * inv * 0.15915494309189535f; a -= floorf(a); c = __builtin_amdgcn_cosf(a); s = __builtin_amdgcn_sinf(a); } else { c = 1.f; s = 0.f; }
}
__device__ __forceinline__ void head64(const u16* src, u16* dst, int gb, const float* g, const float* cG, const float* sG, float qs) {
  const u32x2 lo = *(const u32x2*)(src + gb), hi2 = *(const u32x2*)(src + gb + 16);
  float x[8] = {bflo(lo[0]), bfhi(lo[0]), bflo(lo[1]), bfhi(lo[1]), bflo(hi2[0]), bfhi(hi2[0]), bflo(hi2[1]), bfhi(hi2[1])};
  float ss = 0;
#pragma unroll
  for (int e = 0; e < 8; ++e) ss += x[e] * x[e];
  const float rn = rsqrtf(red8(ss) * (1.f / 64) + EPS) ;
#pragma unroll
  for (int e = 0; e < 8; ++e) x[e] *= rn * g[e];
  float y[8];
#pragma unroll
  for (int e = 0; e < 4; ++e) { y[e] = (x[e] * cG[e] - x[e + 4] * sG[e]) * qs; y[e + 4] = (x[e + 4] * cG[e] + x[e] * sG[e]) * qs; }
  const u32x2 o0 = {cvtpk(y[0], y[1]), cvtpk(y[2], y[3])}, o1 = {cvtpk(y[4], y[5]), cvtpk(y[6], y[7])};
  *(u32x2*)(dst + gb) = o0; *(u32x2*)(dst + gb + 16) = o1;
}
__device__ __forceinline__ void head96(float* n, float r1a, float r1b, float r2a, float r2b, u16* dst, int t, int rb,
                                       const float* gn, const float* gr, const float* cM, const float* sM, float qs) {
  float ss = r1a * r1a + r1b * r1b + r2a * r2a + r2b * r2b;
#pragma unroll
  for (int e = 0; e < 8; ++e) ss += n[e] * n[e];
  const float rn = rsqrtf(red8(ss) * (1.f / 96) + EPS);
#pragma unroll
  for (int e = 0; e < 8; ++e) n[e] *= rn * gn[e] * qs;
  r1a *= rn * gr[0]; r1b *= rn * gr[1]; r2a *= rn * gr[2]; r2b *= rn * gr[3];
  const float y1a = (r1a * cM[0] - r2a * sM[0]) * qs, y2a = (r2a * cM[0] + r1a * sM[0]) * qs;
  const float y1b = (r1b * cM[1] - r2b * sM[1]) * qs, y2b = (r2b * cM[1] + r1b * sM[1]) * qs;
  const u32x4 o = {cvtpk(n[0], n[1]), cvtpk(n[2], n[3]), cvtpk(n[4], n[5]), cvtpk(n[6], n[7])};
  *(u32x4*)(dst + 8 * t) = o;
  *(unsigned*)(dst + 64 + rb) = cvtpk(y1a, y1b); *(unsigned*)(dst + 64 + rb + 8) = cvtpk(y2a, y2b);
}
__device__ void finalize0(const Params& p) {
  const int tid = opaque_tid(), lane = tid & 63, gw = blockIdx.x * 8 + (tid >> 6), nw = gridDim.x * 8;
  const int h = lane >> 3, t = lane & 7;
  char* ws = p.ws;
  const u16* PP = (const u16*)(ws + OFF_PP);
  const u16* QAR = (const u16*)(ws + OFF_H);
  const u16* KVR = (const u16*)p.out;
  u16* QA = (u16*)(ws + OFF_QA); u16* QCA = (u16*)(ws + OFF_QCA); u16* KA = (u16*)(ws + OFF_KA); u16* VA = (u16*)(ws + OFF_VA);
  u16* QB = (u16*)(ws + OFF_QB); u16* QCB = (u16*)(ws + OFF_QCB); u16* KB = (u16*)(ws + OFF_KB); u16* VB = (u16*)(ws + OFF_VB);
  const int gb = t < 4 ? 4 * t : 32 + 4 * (t - 4), rb = t < 4 ? 2 * t : 16 + 2 * (t - 4);
  float qgn[8], kgn[8], qgr[4], kgr[4], gqg[8], gkg[8], invG[4], invM[2];
#pragma unroll
  for (int e = 0; e < 8; ++e) { qgn[e] = p.q_gain[8 * t + e]; kgn[e] = p.k_gain[8 * t + e];
    const int d = gb + (e & 3) + (e >> 2) * 16; gqg[e] = p.gq_gain[d]; gkg[e] = p.gk_gain[d]; }
#pragma unroll
  for (int k = 0; k < 4; ++k) { const int d = 64 + rb + (k & 1) + (k >> 1) * 8; qgr[k] = p.q_gain[d]; kgr[k] = p.k_gain[d]; }
#pragma unroll
  for (int e = 0; e < 4; ++e) invG[e] = exp2f(-(float)(4 * (t & 3) + e) * (13.287712379549449f / 16.f));
#pragma unroll
  for (int k = 0; k < 2; ++k) invM[k] = exp2f(-(float)(2 * (t & 3) + k) * (13.287712379549449f / 8.f));
  for (int r = gw; r < NROW; r += nw) {
    const bool isctx = r >= NLAT;
    int b, s, kpos; float pos = 0.f;
    if (!isctx) { b = r >> 14; s = r & 16383; kpos = CL + s; pos = t < 4 ? (float)(s >> 6) : (float)(s & 63); }
    else { int rc = r - NLAT; b = rc >> 8; s = rc & 255; kpos = s; }
    float cG[4], sG[4], cM[2], sM[2];
#pragma unroll
    for (int e = 0; e < 4; ++e) rope_cs(pos, invG[e], !isctx, cG[e], sG[e]);
#pragma unroll
    for (int k = 0; k < 2; ++k) rope_cs(pos, invM[k], !isctx, cM[k], sM[k]);
    const u16* pp = PP + (size_t)r * LD_AB;
    const u32x2 wq = *(const u32x2*)(pp + lane * 4), wk = *(const u32x2*)(pp + 256 + lane * 4);
    float s1 = bflo(wq[0]) * bflo(wq[0]) + bfhi(wq[0]) * bfhi(wq[0]) + bflo(wq[1]) * bflo(wq[1]) + bfhi(wq[1]) * bfhi(wq[1]);
    float s2 = bflo(wk[0]) * bflo(wk[0]) + bfhi(wk[0]) * bfhi(wk[0]) + bflo(wk[1]) * bflo(wk[1]) + bfhi(wk[1]) * bfhi(wk[1]);
    s1 = wave_sum(s1); s2 = wave_sum(s2);
    const float rstd_cq = rsqrtf(s1 * (1.f / 256) + EPS), rstd_ckv = rsqrtf(s2 * (1.f / 256) + EPS);
    { const u16* qa = QAR + (size_t)r * 768 + h * 96;
      const u32x4 nv = *(const u32x4*)(qa + 8 * t); const unsigned w1 = *(const unsigned*)(qa + 64 + rb), w2 = *(const unsigned*)(qa + 64 + rb + 8);
      float n[8] = {bflo(nv[0]) * rstd_cq, bfhi(nv[0]) * rstd_cq, bflo(nv[1]) * rstd_cq, bfhi(nv[1]) * rstd_cq, bflo(nv[2]) * rstd_cq, bfhi(nv[2]) * rstd_cq, bflo(nv[3]) * rstd_cq, bfhi(nv[3]) * rstd_cq};
      u16* dq = isctx ? QCA + ((size_t)(b * 8 + h) * CL + s) * 96 : QA + ((size_t)(b * 8 + h) * SEQ + s) * 96;
      head96(n, bflo(w1) * rstd_cq, bfhi(w1) * rstd_cq, bflo(w2) * rstd_cq, bfhi(w2) * rstd_cq, dq, t, rb, qgn, qgr, cM, sM, QS_A); }
    { const u16* kv = KVR + (size_t)r * 1024 + h * 128;
      const u32x4 nv = *(const u32x4*)(kv + 8 * t), vv = *(const u32x4*)(kv + 64 + 8 * t);
      const unsigned w1 = *(const unsigned*)(pp + 512 + rb), w2 = *(const unsigned*)(pp + 512 + rb + 8);
      float n[8] = {bflo(nv[0]) * rstd_ckv, bfhi(nv[0]) * rstd_ckv, bflo(nv[1]) * rstd_ckv, bfhi(nv[1]) * rstd_ckv, bflo(nv[2]) * rstd_ckv, bfhi(nv[2]) * rstd_ckv, bflo(nv[3]) * rstd_ckv, bfhi(nv[3]) * rstd_ckv};
      const size_t kr = (size_t)(b * 8 + h) * KVLEN + kpos;
      head96(n, bflo(w1), bfhi(w1), bflo(w2), bfhi(w2), KA + kr * 96, t, rb, kgn, kgr, cM, sM, 1.f);
      const u32x4 vo = {cvtpk(bflo(vv[0]) * rstd_ckv, bfhi(vv[0]) * rstd_ckv), cvtpk(bflo(vv[1]) * rstd_ckv, bfhi(vv[1]) * rstd_ckv),
                        cvtpk(bflo(vv[2]) * rstd_ckv, bfhi(vv[2]) * rstd_ckv), cvtpk(bflo(vv[3]) * rstd_ckv, bfhi(vv[3]) * rstd_ckv)};
      *(u32x4*)(VA + kr * 64 + 8 * t) = vo; }
    { u16* dg = isctx ? QCB + ((size_t)(b * 8 + h) * CL + s) * 64 : QB + ((size_t)(b * 8 + h) * SEQ + s) * 64;
      head64(pp + 544 + h * 64, dg, gb, gqg, cG, sG, QS_B); }
    if (h < 2) {
      const size_t kr = (size_t)(b * 2 + h) * KVLEN + kpos;
      head64(pp + 1056 + h * 64, KB + kr * 64, gb, gkg, cG, sG, 1.f);
      *(u32x4*)(VB + kr * 64 + 8 * t) = *(const u32x4*)(pp + 1184 + h * 64 + 8 * t);
    }
  }
}

__device__ void finalize1(const Params& p) {
  const int tid = opaque_tid(), lane = tid & 63, gw = blockIdx.x * 8 + (tid >> 6), nw = gridDim.x * 8;
  const int h = lane >> 3, t = lane & 7;
  char* ws = p.ws;
  const u16* PP = (const u16*)(ws + OFF_PP);
  u16* Q2 = (u16*)(ws + OFF_Q2); u16* K2 = (u16*)(ws + OFF_K2); u16* V2 = (u16*)(ws + OFF_V2);
  u16* MIX = (u16*)(ws + OFF_H);
  const int gb = t < 4 ? 4 * t : 32 + 4 * (t - 4);
  float qg[8], kg[8], invG[4];
#pragma unroll
  for (int e = 0; e < 8; ++e) { const int d = gb + (e & 3) + (e >> 2) * 16; qg[e] = p.win_q_gain[d]; kg[e] = p.win_k_gain[d]; }
#pragma unroll
  for (int e = 0; e < 4; ++e) invG[e] = exp2f(-(float)(4 * (t & 3) + e) * (13.287712379549449f / 16.f));
  float cw[3][8];
#pragma unroll
  for (int j = 0; j < 3; ++j)
#pragma unroll
    for (int e = 0; e < 8; ++e) cw[j][e] = p.conv_w[j * 512 + lane * 8 + e];
  for (int r = gw; r < NROW + 512; r += nw) {
    if (r >= NROW) {
      int slab = (r - NROW) >> 7, pr = (r - NROW) & 127;
      size_t kr = (size_t)slab * KV2LEN + KVLEN + pr;
      K2[kr * 64 + lane] = 0; V2[kr * 64 + lane] = 0;
      continue;
    }
    const bool isctx = r >= NLAT;
    int b, s, kpos; float pos = 0.f;
    if (!isctx) { b = r >> 14; s = r & 16383; kpos = CL + s; pos = t < 4 ? (float)(s >> 6) : (float)(s & 63); }
    else { int rc = r - NLAT; b = rc >> 8; s = rc & 255; kpos = s; }
    float cG[4], sG[4];
#pragma unroll
    for (int e = 0; e < 4; ++e) rope_cs(pos, invG[e], !isctx, cG[e], sG[e]);
    const u16* pp = PP + (size_t)r * LD_CD;
    if (!isctx) head64(pp + h * 64, Q2 + ((size_t)(b * 8 + h) * SEQ + s) * 64, gb, qg, cG, sG, QS_B);
    if (h < 2) {
      const size_t kr = (size_t)(b * 2 + h) * KV2LEN + kpos;
      head64(pp + 512 + h * 64, K2 + kr * 64, gb, kg, cG, sG, 1.f);
      *(u32x4*)(V2 + kr * 64 + 8 * t) = *(const u32x4*)(pp + 640 + h * 64 + 8 * t);
    }
    if (!isctx) {
      const int c0 = lane * 8;
      float y[8];
#pragma unroll
      for (int e = 0; e < 8; ++e) y[e] = 0.f;
#pragma unroll
      for (int j = 0; j < 3; ++j) {
        const int sj = s + j - 1;
        if (sj >= 0 && sj < SEQ) {
          const u16* pj = pp + (ptrdiff_t)(j - 1) * LD_CD;
          u32x4 a = *(const u32x4*)(pj + 1280 + c0), bb = *(const u32x4*)(pj + 1792 + c0);
#pragma unroll
          for (int e = 0; e < 4; ++e) {
            y[2 * e]     += bflo(a[e]) * bflo(bb[e]) * cw[j][2 * e];
            y[2 * e + 1] += bfhi(a[e]) * bfhi(bb[e]) * cw[j][2 * e + 1];
          }
        }
      }
      u32x4 gbv = *(const u32x4*)(pp + 768 + c0), gt = *(const u32x4*)(pp + 2304 + 512 + c0);
      u32x4 o;
#pragma unroll
      for (int e = 0; e < 4; ++e) {
        float v0 = bflo(gbv[e]) * y[2 * e] * silu_f(bflo(gt[e]));
        float v1 = bfhi(gbv[e]) * y[2 * e + 1] * silu_f(bfhi(gt[e]));
        o[e] = cvtpk(v0, v1);
      }
      *(u32x4*)(MIX + (size_t)r * 1024 + 512 + c0) = o;
    }
  }
}

#define KSWZ(row, colB) ((row) * 272 + (colB))
__device__ __forceinline__ int v_st2(int k, int c) { const int kk = k; return ((kk >> 3) * 2 + (c >> 5)) * 512 + ((kk & 7) * 32 + (c & 31)) * 2; }
__device__ __forceinline__ int v_rd_base(int lane) { return ((lane & 3) << 3) | (((lane >> 2) & 3) << 6) | (((lane >> 4) & 1) << 5) | (((lane >> 5) & 1) << 8); }
constexpr int v_rd_off2(int d0, int ks, int half) { return d0 * 512 + ks * 2048 + half * 1024; }
template <int OFF> __device__ __forceinline__ s16x4 tr_read(int vb) {
  s16x4 r; asm volatile("ds_read_b64_tr_b16 %0, %1 offset:%2" : "=&v"(r) : "v"(vb), "i"(OFF) : "memory"); return r;
}
template <int D0> __device__ __forceinline__ void pv_one(f32x16& od, int vb, bf16x8 pa0, bf16x8 pa1, bf16x8 pa2, bf16x8 pa3) {
  const s16x4 l0 = tr_read<v_rd_off2(D0, 0, 0)>(vb), h0 = tr_read<v_rd_off2(D0, 0, 1)>(vb), l1 = tr_read<v_rd_off2(D0, 1, 0)>(vb), h1 = tr_read<v_rd_off2(D0, 1, 1)>(vb);
  const s16x4 l2 = tr_read<v_rd_off2(D0, 2, 0)>(vb), h2 = tr_read<v_rd_off2(D0, 2, 1)>(vb), l3 = tr_read<v_rd_off2(D0, 3, 0)>(vb), h3 = tr_read<v_rd_off2(D0, 3, 1)>(vb);
  asm volatile("s_waitcnt lgkmcnt(0)" ::: "memory"); SBAR();
#define PK(L, H) (bf16x8){L[0], L[1], L[2], L[3], H[0], H[1], H[2], H[3]}
  od = __builtin_amdgcn_mfma_f32_32x32x16_bf16(pa0, PK(l0, h0), od, 0, 0, 0);
  od = __builtin_amdgcn_mfma_f32_32x32x16_bf16(pa1, PK(l1, h1), od, 0, 0, 0);
  od = __builtin_amdgcn_mfma_f32_32x32x16_bf16(pa2, PK(l2, h2), od, 0, 0, 0);
  od = __builtin_amdgcn_mfma_f32_32x32x16_bf16(pa3, PK(l3, h3), od, 0, 0, 0);
#undef PK
}
__device__ __forceinline__ void pv_all(f32x16* o, int vb, bf16x8 pa0, bf16x8 pa1, bf16x8 pa2, bf16x8 pa3) {
  pv_one<0>(o[0], vb, pa0, pa1, pa2, pa3); pv_one<1>(o[1], vb, pa0, pa1, pa2, pa3);
}
__device__ __forceinline__ void pv_exp(f32x16* o, int vb, bf16x8 pa0, bf16x8 pa1, bf16x8 pa2, bf16x8 pa3, f32x16& n0, f32x16& n1) {
#define PK(L, H) (bf16x8){L[0], L[1], L[2], L[3], H[0], H[1], H[2], H[3]}
  { const s16x4 l0 = tr_read<v_rd_off2(0, 0, 0)>(vb), h0 = tr_read<v_rd_off2(0, 0, 1)>(vb), l1 = tr_read<v_rd_off2(0, 1, 0)>(vb), h1 = tr_read<v_rd_off2(0, 1, 1)>(vb);
    const s16x4 l2 = tr_read<v_rd_off2(0, 2, 0)>(vb), h2 = tr_read<v_rd_off2(0, 2, 1)>(vb), l3 = tr_read<v_rd_off2(0, 3, 0)>(vb), h3 = tr_read<v_rd_off2(0, 3, 1)>(vb);
#pragma unroll
    for (int r = 0; r < 8; ++r) n0[r] = __builtin_amdgcn_exp2f(n0[r]);
    asm volatile("s_waitcnt lgkmcnt(0)" ::: "memory"); SBAR();
    o[0] = __builtin_amdgcn_mfma_f32_32x32x16_bf16(pa0, PK(l0, h0), o[0], 0, 0, 0);
    o[0] = __builtin_amdgcn_mfma_f32_32x32x16_bf16(pa1, PK(l1, h1), o[0], 0, 0, 0);
    o[0] = __builtin_amdgcn_mfma_f32_32x32x16_bf16(pa2, PK(l2, h2), o[0], 0, 0, 0);
    o[0] = __builtin_amdgcn_mfma_f32_32x32x16_bf16(pa3, PK(l3, h3), o[0], 0, 0, 0); }
  { const s16x4 l0 = tr_read<v_rd_off2(1, 0, 0)>(vb), h0 = tr_read<v_rd_off2(1, 0, 1)>(vb), l1 = tr_read<v_rd_off2(1, 1, 0)>(vb), h1 = tr_read<v_rd_off2(1, 1, 1)>(vb);
    const s16x4 l2 = tr_read<v_rd_off2(1, 2, 0)>(vb), h2 = tr_read<v_rd_off2(1, 2, 1)>(vb), l3 = tr_read<v_rd_off2(1, 3, 0)>(vb), h3 = tr_read<v_rd_off2(1, 3, 1)>(vb);
#pragma unroll
    for (int r = 8; r < 16; ++r) n0[r] = __builtin_amdgcn_exp2f(n0[r]);
    asm volatile("s_waitcnt lgkmcnt(0)" ::: "memory"); SBAR();
    o[1] = __builtin_amdgcn_mfma_f32_32x32x16_bf16(pa0, PK(l0, h0), o[1], 0, 0, 0);
    o[1] = __builtin_amdgcn_mfma_f32_32x32x16_bf16(pa1, PK(l1, h1), o[1], 0, 0, 0);
    o[1] = __builtin_amdgcn_mfma_f32_32x32x16_bf16(pa2, PK(l2, h2), o[1], 0, 0, 0);
    o[1] = __builtin_amdgcn_mfma_f32_32x32x16_bf16(pa3, PK(l3, h3), o[1], 0, 0, 0); }
#undef PK
#pragma unroll
  for (int r = 0; r < 16; ++r) n1[r] = __builtin_amdgcn_exp2f(n1[r]);
}

__device__ __forceinline__ void expall(f32x16& p0, f32x16& p1) {
#pragma unroll
  for (int r = 0; r < 16; ++r) p0[r] = __builtin_amdgcn_exp2f(p0[r]);
#pragma unroll
  for (int r = 0; r < 16; ++r) p1[r] = __builtin_amdgcn_exp2f(p1[r]);
}
__device__ __forceinline__ void finishSM(f32x16& p0, f32x16& p1, float& lsum, bf16x8& pa0, bf16x8& pa1, bf16x8& pa2, bf16x8& pa3) {
  float ps = 0;
#pragma unroll
  for (int r = 0; r < 16; ++r) ps += p0[r];
#pragma unroll
  for (int r = 0; r < 16; ++r) ps += p1[r];
  lsum += ps;
#define PK4(P, BASE, OUT) do { u32x4 w = {cvtpk(P[BASE + 0], P[BASE + 1]), cvtpk(P[BASE + 2], P[BASE + 3]), cvtpk(P[BASE + 4], P[BASE + 5]), cvtpk(P[BASE + 6], P[BASE + 7])}; \
    OUT = *reinterpret_cast<bf16x8*>(&w); } while (0)
  PK4(p0, 0, pa0); PK4(p0, 8, pa1); PK4(p1, 0, pa2); PK4(p1, 8, pa3);
#undef PK4
}
template <int NQK>
__device__ __forceinline__ void qkt(f32x16& p0, f32x16& p1, const char* Ks, const bf16x8* qr, int r32, int hi, const float shift) {
  p0 = f32x16{}; p1 = f32x16{};
#pragma unroll
  for (int d0 = 0; d0 < NQK; ++d0) { int cb = (d0 * 16 + hi * 8) * 2;
    bf16x8 b0 = *reinterpret_cast<const bf16x8*>(Ks + KSWZ(r32, cb));
    bf16x8 b1 = *reinterpret_cast<const bf16x8*>(Ks + KSWZ(32 + r32, cb));
    p0 = __builtin_amdgcn_mfma_f32_32x32x16_bf16(b0, qr[d0], p0, 0, 0, 0);
    p1 = __builtin_amdgcn_mfma_f32_32x32x16_bf16(b1, qr[d0], p1, 0, 0, 0); }
  if (__builtin_expect(shift != 0.f, 0)) {
#pragma unroll
    for (int r = 0; r < 16; ++r) { p0[r] -= shift; p1[r] -= shift; }
  }
}

#define PK4X(P, BASE, OUT) do { u32x4 w_ = {cvtpk(P[BASE + 0], P[BASE + 1]), cvtpk(P[BASE + 2], P[BASE + 3]), cvtpk(P[BASE + 4], P[BASE + 5]), cvtpk(P[BASE + 6], P[BASE + 7])}; \
    OUT = *reinterpret_cast<bf16x8*>(&w_); } while (0)
template <int NQK>
__device__ __forceinline__ void qkt_fin(f32x16& n0, f32x16& n1, const char* Ks, const bf16x8* qr, int r32, int hi, const float shift,
                                        f32x16& o0, f32x16& o1, float& lsum, bf16x8& pa0, bf16x8& pa1, bf16x8& pa2, bf16x8& pa3) {
  n0 = f32x16{}; n1 = f32x16{};
  float ps = 0.f;
  bf16x8 kc0 = *reinterpret_cast<const bf16x8*>(Ks + KSWZ(r32, (hi * 8) * 2));
  bf16x8 kc1 = *reinterpret_cast<const bf16x8*>(Ks + KSWZ(32 + r32, (hi * 8) * 2));
#pragma unroll
  for (int d0 = 0; d0 < NQK; ++d0) {
    bf16x8 kn0 = kc0, kn1 = kc1;
    if (d0 + 1 < NQK) { const int cb = ((d0 + 1) * 16 + hi * 8) * 2;
      kn0 = *reinterpret_cast<const bf16x8*>(Ks + KSWZ(r32, cb)); kn1 = *reinterpret_cast<const bf16x8*>(Ks + KSWZ(32 + r32, cb)); }
    n0 = __builtin_amdgcn_mfma_f32_32x32x16_bf16(kc0, qr[d0], n0, 0, 0, 0);
    n1 = __builtin_amdgcn_mfma_f32_32x32x16_bf16(kc1, qr[d0], n1, 0, 0, 0);
#define PIN(X) asm volatile("" : "+v"(X))
    if (NQK == 6) {
      if (d0 == 0) { PK4X(o0, 0, pa0); }
      if (d0 == 1) { PIN(o0); PK4X(o0, 8, pa1); }
      if (d0 == 2) { _Pragma("unroll") for (int r = 0; r < 16; ++r) ps += o0[r]; }
      if (d0 == 3) { PIN(o1); PK4X(o1, 0, pa2); _Pragma("unroll") for (int r = 0; r < 8; ++r) ps += o1[r]; }
      if (d0 == 4) { PIN(o1); PK4X(o1, 8, pa3); _Pragma("unroll") for (int r = 8; r < 16; ++r) ps += o1[r]; }
    } else {
      if (d0 == 0) { PK4X(o0, 0, pa0); PK4X(o0, 8, pa1); }
      if (d0 == 1) { _Pragma("unroll") for (int r = 0; r < 16; ++r) ps += o0[r]; }
      if (d0 == 2) { PIN(o1); PK4X(o1, 0, pa2); _Pragma("unroll") for (int r = 0; r < 8; ++r) ps += o1[r]; }
      if (d0 == 3) { PIN(o1); PK4X(o1, 8, pa3); _Pragma("unroll") for (int r = 8; r < 16; ++r) ps += o1[r]; }
    }
#undef PIN
    asm volatile("" : "+v"(ps), "+v"(pa0), "+v"(pa1), "+v"(pa2), "+v"(pa3));
    kc0 = kn0; kc1 = kn1;
    SBAR();
  }
  lsum += ps;
  if (__builtin_expect(shift != 0.f, 0)) {
#pragma unroll
    for (int r = 0; r < 16; ++r) { n0[r] -= shift; n1[r] -= shift; }
  }
}

template <int NQK, int MODE, int LDG>
__device__ __forceinline__ void attn_body(const u16* __restrict__ Qb, const u16* __restrict__ Kh, const u16* __restrict__ Vh,
                                          const int NT, const int q0, const float sink2, const float mbound,
                                          u16* __restrict__ mix0, const u16* __restrict__ gate0, char* lds) {
  constexpr int DK = NQK * 16;
  constexpr int SHM_V = 8192, SHM_K = 17408;
  int tid_ = threadIdx.x; asm volatile("" : "+v"(tid_));
  const int tid = tid_, wid = __builtin_amdgcn_readfirstlane(tid >> 6), lane = tid & 63, r32 = lane & 31, hi = lane >> 5;
  char* V_lds = lds; char* K_lds = lds + 5 * SHM_V;
  float* wsf = (float*)(lds + 5 * SHM_V + 5 * SHM_K) + wid * 64; float* li_l = wsf;
  float lsum = 0; f32x16 o[2] = {}; bf16x8 qr[NQK];
  const float shift = mbound > 80.f ? mbound - 80.f : 0.f;
  const u16* Qw = Qb + (size_t)(wid * 32 + r32) * DK + hi * 8;
#pragma unroll
  for (int d0 = 0; d0 < NQK; ++d0) qr[d0] = *(const bf16x8*)(Qw + d0 * 16);
  const int srow = tid >> 3, sc8 = tid & 7;
  const int kst0 = KSWZ(srow, sc8 * 16), kst1 = KSWZ(srow, 128 + sc8 * 16), vst = v_st2(srow, sc8 * 8);
  const int vb0 = (int)(uintptr_t)V_lds + v_rd_base(lane);
  const bool k1on = (NQK == 6) && (sc8 < 4);
  const unsigned koff0 = srow * DK + sc8 * 8, voff0 = srow * 64 + sc8 * 8;
  struct { bf16x8 k0, k1, v0; } st[2];
#define TROW(j) (MODE == 0 ? (j) * 64 : ((j) < 4 ? (j) * 64 : q0 + 128 + ((j) - 4) * 64))
#define SLOAD(i, kr) do { const u16* kp_ = Kh + (unsigned)((kr) * DK); st[i].k0 = *(const bf16x8*)(kp_ + koff0);   \
    if (k1on) st[i].k1 = *(const bf16x8*)(kp_ + koff0 + 64);                                                           \
    const u16* vp_ = Vh + (unsigned)((kr) * 64); st[i].v0 = *(const bf16x8*)(vp_ + voff0); } while (0)
#define SWRITE(b, i) do { *(bf16x8*)(K_lds + (b) * SHM_K + kst0) = st[i].k0; if (k1on) *(bf16x8*)(K_lds + (b) * SHM_K + kst1) = st[i].k1; \
    *(bf16x8*)(V_lds + (b) * SHM_V + vst) = st[i].v0; } while (0)
#define MASKT(P0, P1, j) do { if (MODE == 1 && (j) >= 4) { const int kb_ = q0 - 128 + ((j) - 4) * 64, qp_ = q0 + wid * 32 + r32;    \
    _Pragma("unroll") for (int r = 0; r < 16; ++r) { int k0_ = kb_ + crow(r, hi), k1_ = k0_ + 32; int d0_ = qp_ - k0_, d1_ = qp_ - k1_; \
      bool ok0 = (d0_ <= 128) && (d0_ >= -128) && (k0_ >= 0) && (k0_ < SEQ); bool ok1 = (d1_ <= 128) && (d1_ >= -128) && (k1_ >= 0) && (k1_ < SEQ); \
      P0[r] = ok0 ? P0[r] : -1e30f; P1[r] = ok1 ? P1[r] : -1e30f; } } } while (0)
  f32x16 pA0, pA1, pB0, pB1; bf16x8 pa0, pa1, pa2, pa3;
#define NXS(x) ((x) + 1 == 5 ? 0 : (x) + 1)
  __syncthreads();
  SLOAD(0, TROW(0)); asm volatile("s_waitcnt vmcnt(0)" ::: "memory"); SWRITE(0, 0);
  SLOAD(0, TROW(1)); SWRITE(1, 0);
  SLOAD(0, TROW(2)); SWRITE(2, 0);
  if (3 < NT) SLOAD(0, TROW(3));
  if (4 < NT) SLOAD(1, TROW(4));
  __syncthreads();
  qkt<NQK>(pA0, pA1, K_lds, qr, r32, hi, shift); MASKT(pA0, pA1, 0); expall(pA0, pA1);
  int c = 0;
  for (int j = 1; j + 1 < NT; j += 2) {
    const int sj = NXS(c), sj1 = NXS(sj), sj2 = NXS(sj1), sj3 = NXS(sj2);
    SBAR(); SWRITE(sj2, 0); if (j + 3 < NT) SWRITE(sj3, 1); SBAR();
    qkt_fin<NQK>(pB0, pB1, K_lds + sj * SHM_K, qr, r32, hi, shift, pA0, pA1, lsum, pa0, pa1, pa2, pa3); MASKT(pB0, pB1, j); SBAR();
    if (j + 4 < NT) SLOAD(0, TROW(j + 4)); SBAR();
    pv_exp(o, vb0 + c * SHM_V, pa0, pa1, pa2, pa3, pB0, pB1);
    SBAR();
    qkt_fin<NQK>(pA0, pA1, K_lds + sj1 * SHM_K, qr, r32, hi, shift, pB0, pB1, lsum, pa0, pa1, pa2, pa3); MASKT(pA0, pA1, j + 1); SBAR();
    if (j + 5 < NT) SLOAD(1, TROW(j + 5)); SBAR();
    pv_exp(o, vb0 + sj * SHM_V, pa0, pa1, pa2, pa3, pA0, pA1);
    __syncthreads();
    c = sj1;
  }
  { const int sl = NXS(c);
    SBAR(); qkt_fin<NQK>(pB0, pB1, K_lds + sl * SHM_K, qr, r32, hi, shift, pA0, pA1, lsum, pa0, pa1, pa2, pa3); MASKT(pB0, pB1, NT - 1); SBAR();
    pv_all(o, vb0 + c * SHM_V, pa0, pa1, pa2, pa3); expall(pB0, pB1);
    finishSM(pB0, pB1, lsum, pa0, pa1, pa2, pa3); SBAR();
    pv_all(o, vb0 + sl * SHM_V, pa0, pa1, pa2, pa3); }
#undef NXS
  float l_reg;
  { auto rr = __builtin_amdgcn_permlane32_swap(__float_as_uint(lsum), __float_as_uint(lsum), false, false);
    l_reg = __uint_as_float(rr[0]) + __uint_as_float(rr[1]); }
  if (MODE == 1) l_reg += __builtin_amdgcn_exp2f(sink2 - shift);
  if (hi == 0) li_l[r32] = l_reg; asm volatile("s_waitcnt lgkmcnt(0)" ::: "memory");
  float rli[16];
#pragma unroll
  for (int r = 0; r < 16; ++r) rli[r] = __builtin_amdgcn_rcpf(li_l[crow(r, hi)]);
#pragma unroll
  for (int r = 0; r < 16; ++r) { const int orow = wid * 32 + crow(r, hi);
#pragma unroll
    for (int d0 = 0; d0 < 2; ++d0) {
      const float g = bf2f(gate0[(size_t)orow * LDG + d0 * 32 + r32]);
      mix0[(size_t)orow * 1024 + d0 * 32 + r32] = f2bf(o[d0][r] * rli[r] * silu_f(g));
    } }
#undef TROW
#undef SLOAD
#undef SWRITE
#undef MASKT
}

__global__ void __launch_bounds__(512, 1) mega(Params p) {
  extern __shared__ __attribute__((aligned(16))) char lds[];
  cg::grid_group grid = cg::this_grid();
  const int bid = blockIdx.x, nblk = gridDim.x;
  char* ws = p.ws;
  float* modv = (float*)(ws + OFF_MODV);
  u16* H = (u16*)(ws + OFF_H);
  u16* PP = (u16*)(ws + OFF_PP);
  float* XC1 = (float*)(ws + OFF_XC1);
  unsigned* gcnt = (unsigned*)(ws + OFF_END);
  if (bid == 0 && threadIdx.x == 0) __hip_atomic_store(gcnt, 0u, __ATOMIC_RELAXED, __HIP_MEMORY_SCOPE_AGENT);

  if (p.ph_lo <= 0 && 0 < p.ph_hi) {
  for (int u = bid; u < 192; u += nblk) mod_unit(p, u, lds);
  }
  if (p.ph_lo <= 0 && 0 + 1 < p.ph_hi) grid.sync();
  if (p.ph_lo <= 1 && 1 < p.ph_hi) {
  for (int u = bid; u < 2064; u += nblk) transpose_unit(p, u, lds);
  adaln_phase(p.x, nullptr, p.ctx, modv, H);
  }
  if (p.ph_lo <= 1 && 1 + 1 < p.ph_hi) gbar(gcnt, 1u * gridDim.x);
  if (p.ph_lo <= 2 && 2 < p.ph_hi) {
  { TileIter ti(130, 19); GPre g; int nt = 0, mt = 0; const u16* Wt = (const u16*)(ws + OFF_WT_IN_AB);
    if (ti.valid()) { ti.get(mt, nt); gemm_preload(H, 1024, Wt, 1024, mt * 256, nt * 128, g); }
    while (ti.valid()) {
      f32x16 acc[2][2]; const int m0 = mt * 256, n0 = nt * 128;
      gemm_tile<0>(H, 1024, Wt, 1024, 1024, m0, n0, acc, lds, g);
      ti.next(); if (ti.valid()) { ti.get(mt, nt); gemm_preload(H, 1024, Wt, 1024, mt * 256, nt * 128, g); }
      epi_bf16(acc, PP, LD_AB, m0, n0, lds);
    } }
  }
  if (p.ph_lo <= 2 && 2 + 1 < p.ph_hi) gbar(gcnt, 2u * gridDim.x);
  if (p.ph_lo <= 3 && 3 < p.ph_hi) {
  { TileIter ti(130, 14); GPre g; int nt = 0, mt = 0;
    const u16* Wq = (const u16*)(ws + OFF_WT_UQ); const u16* Wkv = (const u16*)(ws + OFF_WT_UKV);
    if (ti.valid()) { ti.get(mt, nt); gemm_preload(nt < 6 ? PP : PP + 256, LD_AB, nt < 6 ? Wq : Wkv, 256, mt * 256, (nt < 6 ? nt : nt - 6) * 128, g); }
    while (ti.valid()) {
      f32x16 acc[2][2]; const int m0 = mt * 256, cn = nt, n0 = (nt < 6 ? nt : nt - 6) * 128;
      gemm_tile<0>(cn < 6 ? PP : PP + 256, LD_AB, cn < 6 ? Wq : Wkv, 256, 256, m0, n0, acc, lds, g);
      ti.next(); if (ti.valid()) { ti.get(mt, nt); gemm_preload(nt < 6 ? PP : PP + 256, LD_AB, nt < 6 ? Wq : Wkv, 256, mt * 256, (nt < 6 ? nt : nt - 6) * 128, g); }
      if (cn < 6) epi_bf16(acc, H, 768, m0, n0, lds); else epi_bf16(acc, (u16*)p.out, 1024, m0, n0, lds);
    } }
  }
  if (p.ph_lo <= 3 && 3 + 1 < p.ph_hi) gbar(gcnt, 3u * gridDim.x);
  if (p.ph_lo <= 4 && 4 < p.ph_hi) {
  finalize0(p);
  }
  if (p.ph_lo <= 4 && 4 + 1 < p.ph_hi) gbar(gcnt, 4u * gridDim.x);
  if (p.ph_lo <= 5 && 5 < p.ph_hi) {
  const float mbA = LOG2E * 9.7979590f * 1.02f * vmaxabs(p.q_gain, 96) * vmaxabs(p.k_gain, 96);
  const float mbB = LOG2E * 8.f * 1.02f * vmaxabs(p.gq_gain, 64) * vmaxabs(p.gk_gain, 64);
  for (int it = bid; it < 2080; it += nblk) {
    int b, h, kvh, nt, qoff; bool mla, isctx;
    if (it < 2048) {
      const int round = it >> 8, blk = it & 255, xcd = blk & 7, cl = blk >> 3;
      isctx = false; nt = KVLEN / 64;
      if (round < 4) { const int pair = xcd * 2 + (round >> 1); b = pair >> 3; h = pair & 7; kvh = h; qoff = ((round & 1) * 32 + cl) * 256; mla = true; }
      else { const int g = round - 4, pi = xcd >> 1, idx = (xcd & 1) * 128 + g * 32 + cl; b = pi >> 1; kvh = pi & 1; h = kvh * 4 + (idx >> 6); qoff = (idx & 63) * 256; mla = false; }
    } else {
      const int ci = it - 2048; b = (ci >> 3) & 1; h = ci & 7; mla = ci < 16; kvh = mla ? h : (h >> 2); isctx = true; nt = CL / 64; qoff = 0;
    }
    const size_t r0 = isctx ? (size_t)NLAT + b * CL : (size_t)b * SEQ + qoff;
    const size_t qrow = isctx ? (size_t)(b * 8 + h) * CL : (size_t)(b * 8 + h) * SEQ + qoff;
    if (mla) {
      const u16* Qp = (const u16*)(ws + (isctx ? OFF_QCA : OFF_QA)) + qrow * 96;
      attn_body<6, 0, LD_AB>(Qp, (const u16*)(ws + OFF_KA) + (size_t)(b * 8 + kvh) * KVLEN * 96, (const u16*)(ws + OFF_VA) + (size_t)(b * 8 + kvh) * KVLEN * 64,
                             nt, 0, 0.f, mbA, H + r0 * 1024 + h * 64, PP + r0 * LD_AB + 1312 + h * 64, lds);
    } else {
      const u16* Qp = (const u16*)(ws + (isctx ? OFF_QCB : OFF_QB)) + qrow * 64;
      attn_body<4, 0, LD_AB>(Qp, (const u16*)(ws + OFF_KB) + (size_t)(b * 2 + kvh) * KVLEN * 64, (const u16*)(ws + OFF_VB) + (size_t)(b * 2 + kvh) * KVLEN * 64,
                             nt, 0, 0.f, mbB, H + r0 * 1024 + 512 + h * 64, PP + r0 * LD_AB + 1312 + 512 + h * 64, lds);
    }
  }
  }
  if (p.ph_lo <= 5 && 5 + 1 < p.ph_hi) gbar(gcnt, 5u * gridDim.x);
  if (p.ph_lo <= 6 && 6 < p.ph_hi) {
  { TileIter ti(130, 8); GPre g; int nt = 0, mt = 0; const u16* Wt = (const u16*)(ws + OFF_WT_OUT_AB);
    if (ti.valid()) { ti.get(mt, nt); gemm_preload(H, 1024, Wt, 1024, mt * 256, nt * 128, g); }
    while (ti.valid()) {
      f32x16 acc[2][2]; const int m0 = mt * 256, n0 = nt * 128; const bool lat = m0 < NLAT;
      const int tid_ = opaque_tid(), wid_ = tid_ >> 6, lane_ = tid_ & 63;
      const size_t eoff = (size_t)((lat ? m0 : m0 - NLAT) + (wid_ & 3) * 64 + (lane_ >> 4)) * 1024 + n0 + (wid_ >> 2) * 64 + 4 * (lane_ & 15);
      ResPre rp;
      gemm_tile<1>(H, 1024, Wt, 1024, 1024, m0, n0, acc, lds, g, (lat ? p.x : p.ctx) + eoff, &rp);
      ti.next(); if (ti.valid()) { ti.get(mt, nt); gemm_preload(H, 1024, Wt, 1024, mt * 256, nt * 128, g); }
      if (lat) epi_res<false, true>(acc, rp, (u16*)(ws + OFF_X1B) + eoff, modv + (m0 >> 14) * 3072 + 2048, n0, lds);
      else epi_res<false, false>(acc, rp, XC1 + eoff, modv + 2 * 3072 + 2048, n0, lds);
    } }
  }
  if (p.ph_lo <= 6 && 6 + 1 < p.ph_hi) gbar(gcnt, 6u * gridDim.x);
  if (p.ph_lo <= 7 && 7 < p.ph_hi) {
  adaln_phase(nullptr, (const u16*)(ws + OFF_X1B), XC1, modv + 3 * 3072, H);
  }
  if (p.ph_lo <= 7 && 7 + 1 < p.ph_hi) gbar(gcnt, 7u * gridDim.x);
  if (p.ph_lo <= 8 && 8 < p.ph_hi) {
  { TileIter ti(130, 26); GPre g; int nt = 0, mt = 0; const u16* Wt = (const u16*)(ws + OFF_WT_IN_CD);
    if (ti.valid()) { ti.get(mt, nt); gemm_preload(H, 1024, Wt, 1024, mt * 256, nt * 128, g); }
    while (ti.valid()) {
      f32x16 acc[2][2]; const int m0 = mt * 256, n0 = nt * 128;
      gemm_tile<0>(H, 1024, Wt, 1024, 1024, m0, n0, acc, lds, g);
      ti.next(); if (ti.valid()) { ti.get(mt, nt); gemm_preload(H, 1024, Wt, 1024, mt * 256, nt * 128, g); }
      epi_bf16(acc, PP, LD_CD, m0, n0, lds);
    } }
  }
  if (p.ph_lo <= 8 && 8 + 1 < p.ph_hi) gbar(gcnt, 8u * gridDim.x);
  if (p.ph_lo <= 9 && 9 < p.ph_hi) {
  finalize1(p);
  }
  if (p.ph_lo <= 9 && 9 + 1 < p.ph_hi) gbar(gcnt, 9u * gridDim.x);
  if (p.ph_lo <= 10 && 10 < p.ph_hi) {
  const float mbW = LOG2E * 8.f * 1.02f * vmaxabs(p.win_q_gain, 64) * vmaxabs(p.win_k_gain, 64);
  for (int it = bid; it < 1024; it += nblk) {
    const int g = it >> 8, blk = it & 255, xcd = blk & 7, cl = blk >> 3;
    const int pi = xcd >> 1, b = pi >> 1, kvh = pi & 1, idx = (xcd & 1) * 128 + g * 32 + cl;
    const int h = kvh * 4 + (idx >> 6), qblk = idx & 63;
    const size_t r0 = (size_t)b * SEQ + qblk * 256;
    attn_body<4, 1, LD_CD>((const u16*)(ws + OFF_Q2) + ((size_t)(b * 8 + h) * SEQ + qblk * 256) * 64,
                    (const u16*)(ws + OFF_K2) + (size_t)(b * 2 + kvh) * KV2LEN * 64, (const u16*)(ws + OFF_V2) + (size_t)(b * 2 + kvh) * KV2LEN * 64,
                    12, qblk * 256, p.win_sink[h] * LOG2E, mbW, H + r0 * 1024 + h * 64, PP + r0 * LD_CD + 2304 + h * 64, lds);
  }
  }
  if (p.ph_lo <= 10 && 10 + 1 < p.ph_hi) gbar(gcnt, 10u * gridDim.x);
  if (p.ph_lo <= 11 && 11 < p.ph_hi) {
  { TileIter ti(128, 8); GPre g; int nt = 0, mt = 0; const u16* Wt = (const u16*)(ws + OFF_WT_OUT_CD);
    if (ti.valid()) { ti.get(mt, nt); gemm_preload(H, 1024, Wt, 1024, mt * 256, nt * 128, g); }
    while (ti.valid()) {
      f32x16 acc[2][2]; const int m0 = mt * 256, n0 = nt * 128;
      const int tid_ = opaque_tid(), wid_ = tid_ >> 6, lane_ = tid_ & 63;
      const size_t eoff = (size_t)(m0 + (wid_ & 3) * 64 + (lane_ >> 4)) * 1024 + n0 + (wid_ >> 2) * 64 + 4 * (lane_ & 15);
      ResPre rp;
      gemm_tile<2>(H, 1024, Wt, 1024, 1024, m0, n0, acc, lds, g, (const u16*)(ws + OFF_X1B) + eoff, &rp);
      ti.next(); if (ti.valid()) { ti.get(mt, nt); gemm_preload(H, 1024, Wt, 1024, mt * 256, nt * 128, g); }
      epi_res<true, false>(acc, rp, p.out + eoff, modv + 3 * 3072 + (m0 >> 14) * 3072 + 2048, n0, lds);
    } }
  }
}

extern "C" void kernel_launch(void* const* d_in, const int* in_sizes, int n_in, void* d_out, int out_size, void* d_ws, size_t ws_size, hipStream_t stream) {
  static int grid_blocks = 0;
  if (!grid_blocks) {
    if (n_in != 22 || out_size != NLAT * DM || ws_size < OFF_END + 4096) {
      fprintf(stderr, "kernel_launch: shape/ws mismatch n_in %d out %d ws %zu need %zu\n", n_in, out_size, ws_size, (size_t)OFF_END);
      return;
    }
    if (hipFuncSetAttribute((const void*)mega, hipFuncAttributeMaxDynamicSharedMemorySize, LDS_BYTES) != hipSuccess) {
      fprintf(stderr, "kernel_launch: hipFuncSetAttribute failed\n"); return;
    }
    int dev = 0, cus = 0, per_cu = 0;
    (void)hipGetDevice(&dev);
    (void)hipDeviceGetAttribute(&cus, hipDeviceAttributeMultiprocessorCount, dev);
    (void)hipOccupancyMaxActiveBlocksPerMultiprocessor(&per_cu, mega, 512, LDS_BYTES);
    if (per_cu < 1) { fprintf(stderr, "kernel_launch: occupancy 0\n"); return; }
    grid_blocks = cus;
  }
  Params p{};
  p.x = (const float*)d_in[0]; p.c = (const float*)d_in[1]; p.ctx = (const float*)d_in[2]; p.c_ctx = (const float*)d_in[3];
  p.mod_w = (const float*)d_in[4]; p.mod_b = (const float*)d_in[5]; p.ab_w_in = (const float*)d_in[6]; p.ab_w_out = (const float*)d_in[7];
  p.cq_gain = (const float*)d_in[8]; p.ckv_gain = (const float*)d_in[9]; p.w_uq = (const float*)d_in[10]; p.w_ukv = (const float*)d_in[11];
  p.q_gain = (const float*)d_in[12]; p.k_gain = (const float*)d_in[13]; p.gq_gain = (const float*)d_in[14]; p.gk_gain = (const float*)d_in[15];
  p.cd_w_in = (const float*)d_in[16]; p.cd_w_out = (const float*)d_in[17]; p.win_q_gain = (const float*)d_in[18]; p.win_k_gain = (const float*)d_in[19];
  p.win_sink = (const float*)d_in[20]; p.conv_w = (const float*)d_in[21];
  p.out = (float*)d_out; p.ws = (char*)d_ws;
#if MULTI_LAUNCH
  for (int ph = 0; ph < 12; ++ph) {
    p.ph_lo = ph; p.ph_hi = ph + 1;
    hipLaunchKernelGGL(mega, dim3(grid_blocks), dim3(512), LDS_BYTES, stream, p);
  }
#else
  p.ph_lo = 0; p.ph_hi = 12;
  void* args[] = {&p};
  hipError_t e = hipLaunchCooperativeKernel((void*)mega, dim3(grid_blocks), dim3(512), args, LDS_BYTES, stream);
  if (e != hipSuccess) fprintf(stderr, "cooperative launch failed: %s (grid %d)\n", hipGetErrorString(e), grid_blocks);
#endif
}
```

```cpp
#include <hip/hip_runtime.h>
#include <hip/hip_cooperative_groups.h>
#include <cstdio>
#include <cstdint>
namespace cg = cooperative_groups;

typedef unsigned short u16;
using bf16x8 = __attribute__((ext_vector_type(8))) short;
using s16x4  = __attribute__((ext_vector_type(4))) short;
using f32x16 = __attribute__((ext_vector_type(16))) float;
using u32x4  = __attribute__((ext_vector_type(4))) unsigned;
using u32x2  = __attribute__((ext_vector_type(2))) unsigned;

constexpr int NB = 2, SEQ = 16384, DM = 1024, CL = 256;
constexpr int NLAT = NB * SEQ;
constexpr int NROW = NLAT + NB * CL;
constexpr int KVLEN = CL + SEQ;
constexpr int KV2LEN = KVLEN + 128;
constexpr int LD_AB = 2432, LD_CD = 3328;
constexpr float EPS = 1e-6f;
constexpr float QS_A = 0.14724461f;
constexpr float QS_B = 0.18033688f;
constexpr float LOG2E = 1.4426950408889634f;

constexpr size_t OFF_MODV      = 0;
constexpr size_t OFF_WT_IN_AB  = 73728;
constexpr size_t OFF_WT_OUT_AB = OFF_WT_IN_AB + (size_t)LD_AB * 1024 * 2;
constexpr size_t OFF_WT_UQ     = OFF_WT_OUT_AB + (size_t)1024 * 1024 * 2;
constexpr size_t OFF_WT_UKV    = OFF_WT_UQ + (size_t)768 * 256 * 2;
constexpr size_t OFF_WT_IN_CD  = OFF_WT_UKV + (size_t)1024 * 256 * 2;
constexpr size_t OFF_WT_OUT_CD = OFF_WT_IN_CD + (size_t)3328 * 1024 * 2;
constexpr size_t OFF_XC1       = OFF_WT_OUT_CD + (size_t)1024 * 1024 * 2;
constexpr size_t OFF_H         = OFF_XC1 + (size_t)512 * 1024 * 4;
constexpr size_t OFF_PP        = OFF_H + (size_t)NROW * 1024 * 2;
constexpr size_t OFF_QA        = OFF_PP + (size_t)NROW * 3328 * 2;
constexpr size_t OFF_QCA       = OFF_QA + (size_t)NB * 8 * SEQ * 96 * 2;
constexpr size_t OFF_KA        = OFF_QCA + (size_t)NB * 8 * CL * 96 * 2;
constexpr size_t OFF_VA        = OFF_KA + (size_t)NB * 8 * KVLEN * 96 * 2;
constexpr size_t OFF_QB        = OFF_VA + (size_t)NB * 8 * KVLEN * 64 * 2;
constexpr size_t OFF_QCB       = OFF_QB + (size_t)NB * 8 * SEQ * 64 * 2;
constexpr size_t OFF_KB        = OFF_QCB + (size_t)NB * 8 * CL * 64 * 2;
constexpr size_t OFF_VB        = OFF_KB + (size_t)NB * 2 * KVLEN * 64 * 2;
constexpr size_t OFF_END       = OFF_VB + (size_t)NB * 2 * KVLEN * 64 * 2;
constexpr size_t OFF_Q2        = OFF_QA;
constexpr size_t OFF_K2        = OFF_Q2 + (size_t)NB * 8 * SEQ * 64 * 2;
constexpr size_t OFF_V2        = OFF_K2 + (size_t)NB * 2 * KV2LEN * 64 * 2;
constexpr size_t OFF_X1B       = OFF_QA + ((size_t)64 << 20);
static_assert(OFF_V2 + (size_t)NB * 2 * KV2LEN * 64 * 2 <= OFF_X1B && OFF_X1B + (size_t)NLAT * 1024 * 2 <= OFF_END, "x1 alias");
static_assert(OFF_V2 + (size_t)NB * 2 * KV2LEN * 64 * 2 <= OFF_END, "alias overflow");

constexpr int LDS_BYTES = 147456;
#ifndef MULTI_LAUNCH
#define MULTI_LAUNCH 0
#endif

struct Params {
  const float *x, *c, *ctx, *c_ctx, *mod_w, *mod_b, *ab_w_in, *ab_w_out, *cq_gain, *ckv_gain, *w_uq, *w_ukv,
      *q_gain, *k_gain, *gq_gain, *gk_gain, *cd_w_in, *cd_w_out, *win_q_gain, *win_k_gain, *win_sink, *conv_w;
  float* out;
  char* ws;
  int ph_lo, ph_hi;
};

#define SBAR() __builtin_amdgcn_sched_barrier(0)
__device__ __forceinline__ int crow(int r, int hi) { return (r & 3) + 8 * (r >> 2) + 4 * hi; }
typedef float f32x2_t __attribute__((ext_vector_type(2)));
typedef __bf16 bf16x2_t __attribute__((ext_vector_type(2)));
__device__ __forceinline__ unsigned cvtpk(float lo, float hi) { f32x2_t v = {lo, hi}; bf16x2_t b = __builtin_convertvector(v, bf16x2_t); return __builtin_bit_cast(unsigned, b); }
__device__ __forceinline__ u16 f2bf(float x) { return (u16)(cvtpk(x, 0.f) & 0xffffu); }
__device__ __forceinline__ float bf2f(u16 x) { return __uint_as_float(((unsigned)x) << 16); }
__device__ __forceinline__ float bflo(unsigned w) { return __uint_as_float(w << 16); }
__device__ __forceinline__ float bfhi(unsigned w) { return __uint_as_float(w & 0xffff0000u); }
__device__ __forceinline__ float wave_sum(float v) {
#pragma unroll
  for (int o = 32; o >= 1; o >>= 1) v += __shfl_xor(v, o);
  return v;
}
__device__ __forceinline__ int opaque_tid() { int t = threadIdx.x; asm volatile("" : "+v"(t)); return t; }
__device__ __forceinline__ float vmaxabs(const float* g, int n) { float m = 0.f; for (int i = 0; i < n; ++i) m = fmaxf(m, fabsf(g[i])); return m; }
__device__ __forceinline__ float silu_f(float g) { return g / (1.f + __expf(-g)); }


__device__ __forceinline__ void gbar(unsigned* cnt, unsigned target) {
  asm volatile("s_waitcnt vmcnt(0)" ::: "memory");
  __syncthreads();
  if (threadIdx.x == 0) {
    __builtin_amdgcn_fence(__ATOMIC_RELEASE, "agent");
    asm volatile("s_waitcnt vmcnt(0)" ::: "memory");
    __hip_atomic_fetch_add(cnt, 1u, __ATOMIC_RELAXED, __HIP_MEMORY_SCOPE_AGENT);
    unsigned sp = 0;
    while (__hip_atomic_load(cnt, __ATOMIC_RELAXED, __HIP_MEMORY_SCOPE_AGENT) < target) { __builtin_amdgcn_s_sleep(1); if (++sp > (1u << 24)) break; }
    __builtin_amdgcn_fence(__ATOMIC_ACQUIRE, "agent");
    asm volatile("s_waitcnt vmcnt(0)" ::: "memory");
  }
  __syncthreads();
}

__device__ void mod_unit(const Params& p, int u, char* lds) {
  const int tid = opaque_tid();
  const int layer = u / 96, n0 = (u % 96) * 32, col = tid & 31, ks = tid >> 5;
  const float* W = p.mod_w + (size_t)layer * 1024 * 3072 + n0 + col;
  float a0 = 0, a1 = 0, a2 = 0;
  for (int k = ks * 64; k < ks * 64 + 64; ++k) {
    float w = W[(size_t)k * 3072];
    a0 += silu_f(p.c[k]) * w; a1 += silu_f(p.c[1024 + k]) * w; a2 += silu_f(p.c_ctx[k]) * w;
  }
  float* red = (float*)lds;
  red[(0 * 16 + ks) * 32 + col] = a0; red[(1 * 16 + ks) * 32 + col] = a1; red[(2 * 16 + ks) * 32 + col] = a2;
  __syncthreads();
  if (tid < 96) {
    int w = tid >> 5, cc = tid & 31; float s = 0;
    for (int i = 0; i < 16; ++i) s += red[(w * 16 + i) * 32 + cc];
    float* modv = (float*)(p.ws + OFF_MODV);
    modv[(layer * 3 + w) * 3072 + n0 + cc] = s + p.mod_b[layer * 3072 + n0 + cc];
  }
  __syncthreads();
}

__device__ void transpose_unit(const Params& p, int u, char* lds) {
  const float* src; const float* gain = nullptr; int K, N; u16* dst; int ul;
  if (u < 608)       { ul = u;        src = p.ab_w_in;  K = 1024; N = 2336; dst = (u16*)(p.ws + OFF_WT_IN_AB); }
  else if (u < 864)  { ul = u - 608;  src = p.ab_w_out; K = 1024; N = 1024; dst = (u16*)(p.ws + OFF_WT_OUT_AB); }
  else if (u < 912)  { ul = u - 864;  src = p.w_uq;     K = 256;  N = 768;  dst = (u16*)(p.ws + OFF_WT_UQ); gain = p.cq_gain; }
  else if (u < 976)  { ul = u - 912;  src = p.w_ukv;    K = 256;  N = 1024; dst = (u16*)(p.ws + OFF_WT_UKV); gain = p.ckv_gain; }
  else if (u < 1808) { ul = u - 976;  src = p.cd_w_in;  K = 1024; N = 3328; dst = (u16*)(p.ws + OFF_WT_IN_CD); }
  else               { ul = u - 1808; src = p.cd_w_out; K = 1024; N = 1024; dst = (u16*)(p.ws + OFF_WT_OUT_CD); }
  const int nkt = K / 64, kt = ul % nkt, nt = ul / nkt, k0 = kt * 64, n0 = nt * 64, tid = opaque_tid();
  float* tile = (float*)lds;
#pragma unroll
  for (int e = 0; e < 8; ++e) {
    int i = (tid >> 6) + 8 * e, j = tid & 63, n = n0 + j;
    float v = (n < N) ? src[(size_t)(k0 + i) * N + n] : 0.f;
    if (gain) v *= gain[k0 + i];
    tile[i * 65 + j] = v;
  }
  __syncthreads();
#pragma unroll
  for (int e = 0; e < 8; ++e) {
    int i2 = (tid >> 6) + 8 * e, j2 = tid & 63;
    dst[(size_t)(n0 + i2) * K + k0 + j2] = f2bf(tile[j2 * 65 + i2]);
  }
  __syncthreads();
}

__device__ void adaln_phase(const float* xlat, const u16* xlat_bf, const float* xctx, const float* modl, u16* H) {
  const int tid = opaque_tid(), lane = tid & 63, gw = blockIdx.x * 8 + (tid >> 6), nw = gridDim.x * 8;
  for (int r = gw; r < NROW; r += nw) {
    if (xlat_bf != nullptr && r < NLAT) {
      const float* m = modl + (r >> 14) * 3072;
      u32x4 w[2]; float f[16]; float ss = 0;
#pragma unroll
      for (int i = 0; i < 2; ++i) w[i] = *(const u32x4*)(xlat_bf + (size_t)r * 1024 + 8 * (lane + 64 * i));
#pragma unroll
      for (int i = 0; i < 2; ++i)
#pragma unroll
        for (int e = 0; e < 4; ++e) { f[i * 8 + 2 * e] = bflo(w[i][e]); f[i * 8 + 2 * e + 1] = bfhi(w[i][e]); }
#pragma unroll
      for (int e = 0; e < 16; ++e) ss += f[e] * f[e];
      ss = wave_sum(ss);
      const float rstd = rsqrtf(ss * (1.f / 1024) + EPS);
#pragma unroll
      for (int i = 0; i < 2; ++i) {
        const int c = 8 * (lane + 64 * i);
        const float4 sh0 = *(const float4*)(m + c), sh1 = *(const float4*)(m + c + 4), sc0 = *(const float4*)(m + 1024 + c), sc1 = *(const float4*)(m + 1024 + c + 4);
        const float shv[8] = {sh0.x, sh0.y, sh0.z, sh0.w, sh1.x, sh1.y, sh1.z, sh1.w}, scv[8] = {sc0.x, sc0.y, sc0.z, sc0.w, sc1.x, sc1.y, sc1.z, sc1.w};
        float y[8];
#pragma unroll
        for (int e = 0; e < 8; ++e) y[e] = f[i * 8 + e] * rstd * (1.f + scv[e]) + shv[e];
        const u32x4 o = {cvtpk(y[0], y[1]), cvtpk(y[2], y[3]), cvtpk(y[4], y[5]), cvtpk(y[6], y[7])};
        *(u32x4*)(H + (size_t)r * 1024 + c) = o;
      }
      continue;
    }
    const float* src = r < NLAT ? xlat + (size_t)r * 1024 : xctx + (size_t)(r - NLAT) * 1024;
    const float* m = modl + (r < NLAT ? (r >> 14) : 2) * 3072;
    float4 v[4]; float ss = 0;
#pragma unroll
    for (int i = 0; i < 4; ++i) { v[i] = ((const float4*)src)[lane + 64 * i]; ss += v[i].x * v[i].x + v[i].y * v[i].y + v[i].z * v[i].z + v[i].w * v[i].w; }
    ss = wave_sum(ss);
    const float rstd = rsqrtf(ss * (1.f / 1024) + EPS);
#pragma unroll
    for (int i = 0; i < 4; ++i) {
      int c = 4 * (lane + 64 * i);
      float4 sh = *(const float4*)(m + c), sc = *(const float4*)(m + 1024 + c);
      float y0 = v[i].x * rstd * (1.f + sc.x) + sh.x, y1 = v[i].y * rstd * (1.f + sc.y) + sh.y;
      float y2 = v[i].z * rstd * (1.f + sc.z) + sh.z, y3 = v[i].w * rstd * (1.f + sc.w) + sh.w;
      u32x2 o = {cvtpk(y0, y1), cvtpk(y2, y3)};
      *(u32x2*)(H + (size_t)r * 1024 + c) = o;
    }
  }
}

#define GSWZ(row, colB) ((row) * 128 + ((colB) ^ ((((row) >> 1) & 7) << 4)))
struct ResPre { float4 v[16]; u32x2 w[16]; };
struct GPre { bf16x8 ra[4], rb[2]; };
__device__ __forceinline__ void gemm_preload(const u16* __restrict__ A, int lda, const u16* __restrict__ Bt, int ldb, int m0, int n0, GPre& g) {
  const int tid = opaque_tid(), srow = tid >> 3, sch = tid & 7;
  const u16* ap = A + (size_t)(m0 + srow) * lda + sch * 8;
  const u16* bp = Bt + (size_t)(n0 + srow) * ldb + sch * 8;
#pragma unroll
  for (int i = 0; i < 4; ++i) g.ra[i] = *(const bf16x8*)(ap + (size_t)(64 * i) * lda);
#pragma unroll
  for (int i = 0; i < 2; ++i) g.rb[i] = *(const bf16x8*)(bp + (size_t)(64 * i) * ldb);
}
template <int PRE>
__device__ __forceinline__ void gemm_tile(const u16* __restrict__ A, int lda, const u16* __restrict__ Bt, int ldb, int K,
                                          int m0, int n0, f32x16 (&acc)[2][2], char* lds, GPre& g, const void* resp = nullptr, ResPre* rp = nullptr) {
  const int tid = opaque_tid(), wid = tid >> 6, lane = tid & 63, r32 = lane & 31, hi = lane >> 5;
  const int wm = wid & 3, wn = wid >> 2;
  char* As = lds;
  char* Bs = lds + 98304;
  const int srow = tid >> 3, sch = tid & 7;
  const u16* ap = A + (size_t)(m0 + srow) * lda + sch * 8;
  const u16* bp = Bt + (size_t)(n0 + srow) * ldb + sch * 8;
  const int sw = GSWZ(srow, sch * 16);
  bf16x8 (&ra)[4] = g.ra; bf16x8 (&rb)[2] = g.rb;
#pragma unroll
  for (int i = 0; i < 2; ++i) for (int j = 0; j < 2; ++j) acc[i][j] = f32x16{};
  const int nk = K / 64;
  __syncthreads();
#pragma unroll
  for (int i = 0; i < 4; ++i) *(bf16x8*)(As + sw + i * 8192) = ra[i];
#pragma unroll
  for (int i = 0; i < 2; ++i) *(bf16x8*)(Bs + sw + i * 8192) = rb[i];
  if (1 < nk) {
#pragma unroll
    for (int i = 0; i < 4; ++i) ra[i] = *(const bf16x8*)(ap + (size_t)(64 * i) * lda + 64);
#pragma unroll
    for (int i = 0; i < 2; ++i) rb[i] = *(const bf16x8*)(bp + (size_t)(64 * i) * ldb + 64);
  }
  __syncthreads();
  const int arow0 = wm * 64 + r32, brow0 = wn * 64 + r32;
  int st = 0;
  for (int kt = 0; kt < nk; ++kt) {
    const int stn = (st == 2) ? 0 : st + 1;
    if (kt + 1 < nk) {
      char* An = As + stn * 32768; char* Bn = Bs + stn * 16384;
#pragma unroll
      for (int i = 0; i < 4; ++i) *(bf16x8*)(An + sw + i * 8192) = ra[i];
#pragma unroll
      for (int i = 0; i < 2; ++i) *(bf16x8*)(Bn + sw + i * 8192) = rb[i];
    }
    if (kt + 2 < nk) {
#pragma unroll
      for (int i = 0; i < 4; ++i) ra[i] = *(const bf16x8*)(ap + (size_t)(64 * i) * lda + (kt + 2) * 64);
#pragma unroll
      for (int i = 0; i < 2; ++i) rb[i] = *(const bf16x8*)(bp + (size_t)(64 * i) * ldb + (kt + 2) * 64);
    }
    if (PRE == 1 && kt == 0) {
#pragma unroll
      for (int q = 0; q < 16; ++q) rp->v[q] = *(const float4*)((const float*)resp + (size_t)((q >> 3) * 32 + 4 * (q & 7)) * 1024);
    }
    if (PRE == 2 && kt == 0) {
#pragma unroll
      for (int q = 0; q < 16; ++q) rp->w[q] = *(const u32x2*)((const u16*)resp + (size_t)((q >> 3) * 32 + 4 * (q & 7)) * 1024);
    }
    SBAR();
    const char* Ac = As + st * 32768; const char* Bc = Bs + st * 16384;
#pragma unroll
    for (int kk = 0; kk < 4; ++kk) {
      const int cb = kk * 32 + hi * 16;
      bf16x8 a0 = *(const bf16x8*)(Ac + GSWZ(arow0, cb));
      bf16x8 a1 = *(const bf16x8*)(Ac + GSWZ(arow0 + 32, cb));
      bf16x8 b0 = *(const bf16x8*)(Bc + GSWZ(brow0, cb));
      bf16x8 b1 = *(const bf16x8*)(Bc + GSWZ(brow0 + 32, cb));
      acc[0][0] = __builtin_amdgcn_mfma_f32_32x32x16_bf16(a0, b0, acc[0][0], 0, 0, 0);
      acc[0][1] = __builtin_amdgcn_mfma_f32_32x32x16_bf16(a0, b1, acc[0][1], 0, 0, 0);
      acc[1][0] = __builtin_amdgcn_mfma_f32_32x32x16_bf16(a1, b0, acc[1][0], 0, 0, 0);
      acc[1][1] = __builtin_amdgcn_mfma_f32_32x32x16_bf16(a1, b1, acc[1][1], 0, 0, 0);
    }
    __syncthreads();
    st = stn;
  }
}

struct TileIter {
  int f, fend, step, MT, NT;
  __device__ __forceinline__ TileIter(int MT_, int NT_) : MT(MT_), NT(NT_) {
    const int T = MT_ * NT_, bid = blockIdx.x, nblk = gridDim.x;
    if (nblk == 256) { const int x = bid & 7, cl = bid >> 3; f = (int)(((long)T * x) >> 3) + cl; fend = (int)(((long)T * (x + 1)) >> 3); step = 32; }
    else { f = bid; fend = T; step = nblk; }
  }
  __device__ __forceinline__ bool valid() const { return f < fend; }
  __device__ __forceinline__ void next() { f += step; }
  __device__ __forceinline__ void get(int& mt, int& nt) const {
    const int full = (MT >> 2) * 4 * NT;
    if (f < full) { const int g = f / (4 * NT), rem = f - g * 4 * NT; nt = rem >> 2; mt = g * 4 + (rem & 3); }
    else { const int rem = f - full, gs = MT - (MT >> 2) * 4; nt = rem / gs; mt = (MT >> 2) * 4 + (rem - nt * gs); }
  }
};

__device__ __forceinline__ void epi_bf16(f32x16 (&acc)[2][2], u16* C, int ldc, int m0, int n0, char* lds) {
  const int tid = opaque_tid(), wid = tid >> 6, lane = tid & 63, r32 = lane & 31, hi = lane >> 5;
  const int wm = wid & 3, wn = wid >> 2;
  char* wl = lds + wid * 9216;
#pragma unroll
  for (int i = 0; i < 2; ++i)
#pragma unroll
    for (int j = 0; j < 2; ++j)
#pragma unroll
      for (int r = 0; r < 16; ++r) *(u16*)(wl + (i * 32 + crow(r, hi)) * 144 + (j * 32 + r32) * 2) = f2bf(acc[i][j][r]);
  asm volatile("s_waitcnt lgkmcnt(0)" ::: "memory");
  const int rr = lane >> 3, ch = lane & 7;
  u16* cbase = C + (size_t)(m0 + wm * 64 + rr) * ldc + n0 + wn * 64 + ch * 8;
#pragma unroll
  for (int k = 0; k < 8; ++k) {
    const u32x4 v = *(const u32x4*)(wl + (rr + 8 * k) * 144 + ch * 16);
    *(u32x4*)(cbase + (size_t)(8 * k) * ldc) = v;
  }
}
template <bool IN_BF, bool OUT_BF>
__device__ __forceinline__ void epi_res(f32x16 (&acc)[2][2], const ResPre& rp, void* outp, const float* gsrc, int n0, char* lds) {
  const int tid = opaque_tid(), wid = tid >> 6, lane = tid & 63, r32 = lane & 31, hi = lane >> 5;
  const int wn = wid >> 2;
  char* wl = lds + wid * 8704;
  const int rl = lane >> 4, c4 = lane & 15;
  const float4 g = *(const float4*)(gsrc + n0 + wn * 64 + 4 * c4);
#pragma unroll
  for (int i = 0; i < 2; ++i) {
#pragma unroll
    for (int j = 0; j < 2; ++j)
#pragma unroll
      for (int r = 0; r < 16; ++r) *(float*)(wl + crow(r, hi) * 272 + (j * 32 + r32) * 4) = acc[i][j][r];
    asm volatile("s_waitcnt lgkmcnt(0)" ::: "memory");
#pragma unroll
    for (int k = 0; k < 8; ++k) {
      const float4 a = *(const float4*)(wl + (rl + 4 * k) * 272 + c4 * 16);
      float4 x;
      if (IN_BF) { const u32x2 xw = rp.w[i * 8 + k]; x.x = bflo(xw[0]); x.y = bfhi(xw[0]); x.z = bflo(xw[1]); x.w = bfhi(xw[1]); } else x = rp.v[i * 8 + k];
      float4 o; o.x = x.x + g.x * a.x; o.y = x.y + g.y * a.y; o.z = x.z + g.z * a.z; o.w = x.w + g.w * a.w;
      if (OUT_BF) { const u32x2 ow = {cvtpk(o.x, o.y), cvtpk(o.z, o.w)}; *(u32x2*)((u16*)outp + (size_t)(i * 32 + 4 * k) * 1024) = ow; }
      else *(float4*)((float*)outp + (size_t)(i * 32 + 4 * k) * 1024) = o;
    }
    asm volatile("s_waitcnt lgkmcnt(0)" ::: "memory");
  }
}

__device__ __forceinline__ float red8(float v) { v += __shfl_xor(v, 1); v += __shfl_xor(v, 2); v += __shfl_xor(v, 4); return v; }
__device__ __forceinline__ void rope_cs(float pos, float inv, bool on, float& c, float& s) {
  if (on) { float a = pos * inv * 0.15915494309189535f; a -= floorf(a); c = __builtin_amdgcn_cosf(a); s = __builtin_amdgcn_sinf(a); } else { c = 1.f; s = 0.f; }
}
__device__ __forceinline__ void head64(const u16* src, u16* dst, int gb, const float* g, const float* cG, const float* sG, float qs) {
  const u32x2 lo = *(const u32x2*)(src + gb), hi2 = *(const u32x2*)(src + gb + 16);
  float x[8] = {bflo(lo[0]), bfhi(lo[0]), bflo(lo[1]), bfhi(lo[1]), bflo(hi2[0]), bfhi(hi2[0]), bflo(hi2[1]), bfhi(hi2[1])};
  float ss = 0;
#pragma unroll
  for (int e = 0; e < 8; ++e) ss += x[e] * x[e];
  const float rn = rsqrtf(red8(ss) * (1.f / 64) + EPS) ;
#pragma unroll
  for (int e = 0; e < 8; ++e) x[e] *= rn * g[e];
  float y[8];
#pragma unroll
  for (int e = 0; e < 4; ++e) { y[e] = (x[e] * cG[e] - x[e + 4] * sG[e]) * qs; y[e + 4] = (x[e + 4] * cG[e] + x[e] * sG[e]) * qs; }
  const u32x2 o0 = {cvtpk(y[0], y[1]), cvtpk(y[2], y[3])}, o1 = {cvtpk(y[4], y[5]), cvtpk(y[6], y[7])};
  *(u32x2*)(dst + gb) = o0; *(u32x2*)(dst + gb + 16) = o1;
}
__device__ __forceinline__ void head96(float* n, float r1a, float r1b, float r2a, float r2b, u16* dst, int t, int rb,
                                       const float* gn, const float* gr, const float* cM, const float* sM, float qs) {
  float ss = r1a * r1a + r1b * r1b + r2a * r2a + r2b * r2b;
#pragma unroll
  for (int e = 0; e < 8; ++e) ss += n[e] * n[e];
  const float rn = rsqrtf(red8(ss) * (1.f / 96) + EPS);
#pragma unroll
  for (int e = 0; e < 8; ++e) n[e] *= rn * gn[e] * qs;
  r1a *= rn * gr[0]; r1b *= rn * gr[1]; r2a *= rn * gr[2]; r2b *= rn * gr[3];
  const float y1a = (r1a * cM[0] - r2a * sM[0]) * qs, y2a = (r2a * cM[0] + r1a * sM[0]) * qs;
  const float y1b = (r1b * cM[1] - r2b * sM[1]) * qs, y2b = (r2b * cM[1] + r1b * sM[1]) * qs;
  const u32x4 o = {cvtpk(n[0], n[1]), cvtpk(n[2], n[3]), cvtpk(n[4], n[5]), cvtpk(n[6], n[7])};
  *(u32x4*)(dst + 8 * t) = o;
  *(unsigned*)(dst + 64 + rb) = cvtpk(y1a, y1b); *(unsigned*)(dst + 64 + rb + 8) = cvtpk(y2a, y2b);
}
__device__ void finalize0(const Params& p) {
  const int tid = opaque_tid(), lane = tid & 63, gw = blockIdx.x * 8 + (tid >> 6), nw = gridDim.x * 8;
  const int h = lane >> 3, t = lane & 7;
  char* ws = p.ws;
  const u16* PP = (const u16*)(ws + OFF_PP);
  const u16* QAR = (const u16*)(ws + OFF_H);
  const u16* KVR = (const u16*)p.out;
  u16* QA = (u16*)(ws + OFF_QA); u16* QCA = (u16*)(ws + OFF_QCA); u16* KA = (u16*)(ws + OFF_KA); u16* VA = (u16*)(ws + OFF_VA);
  u16* QB = (u16*)(ws + OFF_QB); u16* QCB = (u16*)(ws + OFF_QCB); u16* KB = (u16*)(ws + OFF_KB); u16* VB = (u16*)(ws + OFF_VB);
  const int gb = t < 4 ? 4 * t : 32 + 4 * (t - 4), rb = t < 4 ? 2 * t : 16 + 2 * (t - 4);
  float qgn[8], kgn[8], qgr[4], kgr[4], gqg[8], gkg[8], invG[4], invM[2];
#pragma unroll
  for (int e = 0; e < 8; ++e) { qgn[e] = p.q_gain[8 * t + e]; kgn[e] = p.k_gain[8 * t + e];
    const int d = gb + (e & 3) + (e >> 2) * 16; gqg[e] = p.gq_gain[d]; gkg[e] = p.gk_gain[d]; }
#pragma unroll
  for (int k = 0; k < 4; ++k) { const int d = 64 + rb + (k & 1) + (k >> 1) * 8; qgr[k] = p.q_gain[d]; kgr[k] = p.k_gain[d]; }
#pragma unroll
  for (int e = 0; e < 4; ++e) invG[e] = exp2f(-(float)(4 * (t & 3) + e) * (13.287712379549449f / 16.f));
#pragma unroll
  for (int k = 0; k < 2; ++k) invM[k] = exp2f(-(float)(2 * (t & 3) + k) * (13.287712379549449f / 8.f));
  for (int r = gw; r < NROW; r += nw) {
    const bool isctx = r >= NLAT;
    int b, s, kpos; float pos = 0.f;
    if (!isctx) { b = r >> 14; s = r & 16383; kpos = CL + s; pos = t < 4 ? (float)(s >> 6) : (float)(s & 63); }
    else { int rc = r - NLAT; b = rc >> 8; s = rc & 255; kpos = s; }
    float cG[4], sG[4], cM[2], sM[2];
#pragma unroll
    for (int e = 0; e < 4; ++e) rope_cs(pos, invG[e], !isctx, cG[e], sG[e]);
#pragma unroll
    for (int k = 0; k < 2; ++k) rope_cs(pos, invM[k], !isctx, cM[k], sM[k]);
    const u16* pp = PP + (size_t)r * LD_AB;
    const u32x2 wq = *(const u32x2*)(pp + lane * 4), wk = *(const u32x2*)(pp + 256 + lane * 4);
    float s1 = bflo(wq[0]) * bflo(wq[0]) + bfhi(wq[0]) * bfhi(wq[0]) + bflo(wq[1]) * bflo(wq[1]) + bfhi(wq[1]) * bfhi(wq[1]);
    float s2 = bflo(wk[0]) * bflo(wk[0]) + bfhi(wk[0]) * bfhi(wk[0]) + bflo(wk[1]) * bflo(wk[1]) + bfhi(wk[1]) * bfhi(wk[1]);
    s1 = wave_sum(s1); s2 = wave_sum(s2);
    const float rstd_cq = rsqrtf(s1 * (1.f / 256) + EPS), rstd_ckv = rsqrtf(s2 * (1.f / 256) + EPS);
    { const u16* qa = QAR + (size_t)r * 768 + h * 96;
      const u32x4 nv = *(const u32x4*)(qa + 8 * t); const unsigned w1 = *(const unsigned*)(qa + 64 + rb), w2 = *(const unsigned*)(qa + 64 + rb + 8);
      float n[8] = {bflo(nv[0]) * rstd_cq, bfhi(nv[0]) * rstd_cq, bflo(nv[1]) * rstd_cq, bfhi(nv[1]) * rstd_cq, bflo(nv[2]) * rstd_cq, bfhi(nv[2]) * rstd_cq, bflo(nv[3]) * rstd_cq, bfhi(nv[3]) * rstd_cq};
      u16* dq = isctx ? QCA + ((size_t)(b * 8 + h) * CL + s) * 96 : QA + ((size_t)(b * 8 + h) * SEQ + s) * 96;
      head96(n, bflo(w1) * rstd_cq, bfhi(w1) * rstd_cq, bflo(w2) * rstd_cq, bfhi(w2) * rstd_cq, dq, t, rb, qgn, qgr, cM, sM, QS_A); }
    { const u16* kv = KVR + (size_t)r * 1024 + h * 128;
      const u32x4 nv = *(const u32x4*)(kv + 8 * t), vv = *(const u32x4*)(kv + 64 + 8 * t);
      const unsigned w1 = *(const unsigned*)(pp + 512 + rb), w2 = *(const unsigned*)(pp + 512 + rb + 8);
      float n[8] = {bflo(nv[0]) * rstd_ckv, bfhi(nv[0]) * rstd_ckv, bflo(nv[1]) * rstd_ckv, bfhi(nv[1]) * rstd_ckv, bflo(nv[2]) * rstd_ckv, bfhi(nv[2]) * rstd_ckv, bflo(nv[3]) * rstd_ckv, bfhi(nv[3]) * rstd_ckv};
      const size_t kr = (size_t)(b * 8 + h) * KVLEN + kpos;
      head96(n, bflo(w1), bfhi(w1), bflo(w2), bfhi(w2), KA + kr * 96, t, rb, kgn, kgr, cM, sM, 1.f);
      const u32x4 vo = {cvtpk(bflo(vv[0]) * rstd_ckv, bfhi(vv[0]) * rstd_ckv), cvtpk(bflo(vv[1]) * rstd_ckv, bfhi(vv[1]) * rstd_ckv),
                        cvtpk(bflo(vv[2]) * rstd_ckv, bfhi(vv[2]) * rstd_ckv), cvtpk(bflo(vv[3]) * rstd_ckv, bfhi(vv[3]) * rstd_ckv)};
      *(u32x4*)(VA + kr * 64 + 8 * t) = vo; }
    { u16* dg = isctx ? QCB + ((size_t)(b * 8 + h) * CL + s) * 64 : QB + ((size_t)(b * 8 + h) * SEQ + s) * 64;
      head64(pp + 544 + h * 64, dg, gb, gqg, cG, sG, QS_B); }
    if (h < 2) {
      const size_t kr = (size_t)(b * 2 + h) * KVLEN + kpos;
      head64(pp + 1056 + h * 64, KB + kr * 64, gb, gkg, cG, sG, 1.f);
      *(u32x4*)(VB + kr * 64 + 8 * t) = *(const u32x4*)(pp + 1184 + h * 64 + 8 * t);
    }
  }
}

__device__ void finalize1(const Params& p) {
  const int tid = opaque_tid(), lane = tid & 63, gw = blockIdx.x * 8 + (tid >> 6), nw = gridDim.x * 8;
  const int h = lane >> 3, t = lane & 7;
  char* ws = p.ws;
  const u16* PP = (const u16*)(ws + OFF_PP);
  u16* Q2 = (u16*)(ws + OFF_Q2); u16* K2 = (u16*)(ws + OFF_K2); u16* V2 = (u16*)(ws + OFF_V2);
  u16* MIX = (u16*)(ws + OFF_H);
  const int gb = t < 4 ? 4 * t : 32 + 4 * (t - 4);
  float qg[8], kg[8], invG[4];
#pragma unroll
  for (int e = 0; e < 8; ++e) { const int d = gb + (e & 3) + (e >> 2) * 16; qg[e] = p.win_q_gain[d]; kg[e] = p.win_k_gain[d]; }
#pragma unroll
  for (int e = 0; e < 4; ++e) invG[e] = exp2f(-(float)(4 * (t & 3) + e) * (13.287712379549449f / 16.f));
  float cw[3][8];
#pragma unroll
  for (int j = 0; j < 3; ++j)
#pragma unroll
    for (int e = 0; e < 8; ++e) cw[j][e] = p.conv_w[j * 512 + lane * 8 + e];
  for (int r = gw; r < NROW + 512; r += nw) {
    if (r >= NROW) {
      int slab = (r - NROW) >> 7, pr = (r - NROW) & 127;
      size_t kr = (size_t)slab * KV2LEN + KVLEN + pr;
      K2[kr * 64 + lane] = 0; V2[kr * 64 + lane] = 0;
      continue;
    }
    const bool isctx = r >= NLAT;
    int b, s, kpos; float pos = 0.f;
    if (!isctx) { b = r >> 14; s = r & 16383; kpos = CL + s; pos = t < 4 ? (float)(s >> 6) : (float)(s & 63); }
    else { int rc = r - NLAT; b = rc >> 8; s = rc & 255; kpos = s; }
    float cG[4], sG[4];
#pragma unroll
    for (int e = 0; e < 4; ++e) rope_cs(pos, invG[e], !isctx, cG[e], sG[e]);
    const u16* pp = PP + (size_t)r * LD_CD;
    if (!isctx) head64(pp + h * 64, Q2 + ((size_t)(b * 8 + h) * SEQ + s) * 64, gb, qg, cG, sG, QS_B);
    if (h < 2) {
      const size_t kr = (size_t)(b * 2 + h) * KV2LEN + kpos;
      head64(pp + 512 + h * 64, K2 + kr * 64, gb, kg, cG, sG, 1.f);
      *(u32x4*)(V2 + kr * 64 + 8 * t) = *(const u32x4*)(pp + 640 + h * 64 + 8 * t);
    }
    if (!isctx) {
      const int c0 = lane * 8;
      float y[8];
#pragma unroll
      for (int e = 0; e < 8; ++e) y[e] = 0.f;
#pragma unroll
      for (int j = 0; j < 3; ++j) {
        const int sj = s + j - 1;
        if (sj >= 0 && sj < SEQ) {
          const u16* pj = pp + (ptrdiff_t)(j - 1) * LD_CD;
          u32x4 a = *(const u32x4*)(pj + 1280 + c0), bb = *(const u32x4*)(pj + 1792 + c0);
#pragma unroll
          for (int e = 0; e < 4; ++e) {
            y[2 * e]     += bflo(a[e]) * bflo(bb[e]) * cw[j][2 * e];
            y[2 * e + 1] += bfhi(a[e]) * bfhi(bb[e]) * cw[j][2 * e + 1];
          }
        }
      }
      u32x4 gbv = *(const u32x4*)(pp + 768 + c0), gt = *(const u32x4*)(pp + 2304 + 512 + c0);
      u32x4 o;
#pragma unroll
      for (int e = 0; e < 4; ++e) {
        float v0 = bflo(gbv[e]) * y[2 * e] * silu_f(bflo(gt[e]));
        float v1 = bfhi(gbv[e]) * y[2 * e + 1] * silu_f(bfhi(gt[e]));
        o[e] = cvtpk(v0, v1);
      }
      *(u32x4*)(MIX + (size_t)r * 1024 + 512 + c0) = o;
    }
  }
}

#define KSWZ(row, colB) ((row) * 272 + (colB))
__device__ __forceinline__ int v_st2(int k, int c) { const int kk = k; return ((kk >> 3) * 2 + (c >> 5)) * 512 + ((kk & 7) * 32 + (c & 31)) * 2; }
__device__ __forceinline__ int v_rd_base(int lane) { return ((lane & 3) << 3) | (((lane >> 2) & 3) << 6) | (((lane >> 4) & 1) << 5) | (((lane >> 5) & 1) << 8); }
constexpr int v_rd_off2(int d0, int ks, int half) { return d0 * 512 + ks * 2048 + half * 1024; }
template <int OFF> __device__ __forceinline__ s16x4 tr_read(int vb) {
  s16x4 r; asm volatile("ds_read_b64_tr_b16 %0, %1 offset:%2" : "=&v"(r) : "v"(vb), "i"(OFF) : "memory"); return r;
}
template <int D0> __device__ __forceinline__ void pv_one(f32x16& od, int vb, bf16x8 pa0, bf16x8 pa1, bf16x8 pa2, bf16x8 pa3) {
  const s16x4 l0 = tr_read<v_rd_off2(D0, 0, 0)>(vb), h0 = tr_read<v_rd_off2(D0, 0, 1)>(vb), l1 = tr_read<v_rd_off2(D0, 1, 0)>(vb), h1 = tr_read<v_rd_off2(D0, 1, 1)>(vb);
  const s16x4 l2 = tr_read<v_rd_off2(D0, 2, 0)>(vb), h2 = tr_read<v_rd_off2(D0, 2, 1)>(vb), l3 = tr_read<v_rd_off2(D0, 3, 0)>(vb), h3 = tr_read<v_rd_off2(D0, 3, 1)>(vb);
  asm volatile("s_waitcnt lgkmcnt(0)" ::: "memory"); SBAR();
#define PK(L, H) (bf16x8){L[0], L[1], L[2], L[3], H[0], H[1], H[2], H[3]}
  od = __builtin_amdgcn_mfma_f32_32x32x16_bf16(pa0, PK(l0, h0), od, 0, 0, 0);
  od = __builtin_amdgcn_mfma_f32_32x32x16_bf16(pa1, PK(l1, h1), od, 0, 0, 0);
  od = __builtin_amdgcn_mfma_f32_32x32x16_bf16(pa2, PK(l2, h2), od, 0, 0, 0);
  od = __builtin_amdgcn_mfma_f32_32x32x16_bf16(pa3, PK(l3, h3), od, 0, 0, 0);
#undef PK
}
__device__ __forceinline__ void pv_all(f32x16* o, int vb, bf16x8 pa0, bf16x8 pa1, bf16x8 pa2, bf16x8 pa3) {
  pv_one<0>(o[0], vb, pa0, pa1, pa2, pa3); pv_one<1>(o[1], vb, pa0, pa1, pa2, pa3);
}
__device__ __forceinline__ void pv_exp(f32x16* o, int vb, bf16x8 pa0, bf16x8 pa1, bf16x8 pa2, bf16x8 pa3, f32x16& n0, f32x16& n1) {
#define PK(L, H) (bf16x8){L[0], L[1], L[2], L[3], H[0], H[1], H[2], H[3]}
  { const s16x4 l0 = tr_read<v_rd_off2(0, 0, 0)>(vb), h0 = tr_read<v_rd_off2(0, 0, 1)>(vb), l1 = tr_read<v_rd_off2(0, 1, 0)>(vb), h1 = tr_read<v_rd_off2(0, 1, 1)>(vb);
    const s16x4 l2 = tr_read<v_rd_off2(0, 2, 0)>(vb), h2 = tr_read<v_rd_off2(0, 2, 1)>(vb), l3 = tr_read<v_rd_off2(0, 3, 0)>(vb), h3 = tr_read<v_rd_off2(0, 3, 1)>(vb);
#pragma unroll
    for (int r = 0; r < 8; ++r) n0[r] = __builtin_amdgcn_exp2f(n0[r]);
    asm volatile("s_waitcnt lgkmcnt(0)" ::: "memory"); SBAR();
    o[0] = __builtin_amdgcn_mfma_f32_32x32x16_bf16(pa0, PK(l0, h0), o[0], 0, 0, 0);
    o[0] = __builtin_amdgcn_mfma_f32_32x32x16_bf16(pa1, PK(l1, h1), o[0], 0, 0, 0);
    o[0] = __builtin_amdgcn_mfma_f32_32x32x16_bf16(pa2, PK(l2, h2), o[0], 0, 0, 0);
    o[0] = __builtin_amdgcn_mfma_f32_32x32x16_bf16(pa3, PK(l3, h3), o[0], 0, 0, 0); }
  { const s16x4 l0 = tr_read<v_rd_off2(1, 0, 0)>(vb), h0 = tr_read<v_rd_off2(1, 0, 1)>(vb), l1 = tr_read<v_rd_off2(1, 1, 0)>(vb), h1 = tr_read<v_rd_off2(1, 1, 1)>(vb);
    const s16x4 l2 = tr_read<v_rd_off2(1, 2, 0)>(vb), h2 = tr_read<v_rd_off2(1, 2, 1)>(vb), l3 = tr_read<v_rd_off2(1, 3, 0)>(vb), h3 = tr_read<v_rd_off2(1, 3, 1)>(vb);
#pragma unroll
    for (int r = 8; r < 16; ++r) n0[r] = __builtin_amdgcn_exp2f(n0[r]);
    asm volatile("s_waitcnt lgkmcnt(0)" ::: "memory"); SBAR();
    o[1] = __builtin_amdgcn_mfma_f32_32x32x16_bf16(pa0, PK(l0, h0), o[1], 0, 0, 0);
    o[1] = __builtin_amdgcn_mfma_f32_32x32x16_bf16(pa1, PK(l1, h1), o[1], 0, 0, 0);
    o[1] = __builtin_amdgcn_mfma_f32_32x32x16_bf16(pa2, PK(l2, h2), o[1], 0, 0, 0);
    o[1] = __builtin_amdgcn_mfma_f32_32x32x16_bf16(pa3, PK(l3, h3), o[1], 0, 0, 0); }
#undef PK
#pragma unroll
  for (int r = 0; r < 16; ++r) n1[r] = __builtin_amdgcn_exp2f(n1[r]);
}

__device__ __forceinline__ void expall(f32x16& p0, f32x16& p1) {
#pragma unroll
  for (int r = 0; r < 16; ++r) p0[r] = __builtin_amdgcn_exp2f(p0[r]);
#pragma unroll
  for (int r = 0; r < 16; ++r) p1[r] = __builtin_amdgcn_exp2f(p1[r]);
}
__device__ __forceinline__ void finishSM(f32x16& p0, f32x16& p1, float& lsum, bf16x8& pa0, bf16x8& pa1, bf16x8& pa2, bf16x8& pa3) {
  float ps = 0;
#pragma unroll
  for (int r = 0; r < 16; ++r) ps += p0[r];
#pragma unroll
  for (int r = 0; r < 16; ++r) ps += p1[r];
  lsum += ps;
#define PK4(P, BASE, OUT) do { u32x4 w = {cvtpk(P[BASE + 0], P[BASE + 1]), cvtpk(P[BASE + 2], P[BASE + 3]), cvtpk(P[BASE + 4], P[BASE + 5]), cvtpk(P[BASE + 6], P[BASE + 7])}; \
    OUT = *reinterpret_cast<bf16x8*>(&w); } while (0)
  PK4(p0, 0, pa0); PK4(p0, 8, pa1); PK4(p1, 0, pa2); PK4(p1, 8, pa3);
#undef PK4
}
template <int NQK>
__device__ __forceinline__ void qkt(f32x16& p0, f32x16& p1, const char* Ks, const bf16x8* qr, int r32, int hi, const float shift) {
  p0 = f32x16{}; p1 = f32x16{};
#pragma unroll
  for (int d0 = 0; d0 < NQK; ++d0) { int cb = (d0 * 16 + hi * 8) * 2;
    bf16x8 b0 = *reinterpret_cast<const bf16x8*>(Ks + KSWZ(r32, cb));
    bf16x8 b1 = *reinterpret_cast<const bf16x8*>(Ks + KSWZ(32 + r32, cb));
    p0 = __builtin_amdgcn_mfma_f32_32x32x16_bf16(b0, qr[d0], p0, 0, 0, 0);
    p1 = __builtin_amdgcn_mfma_f32_32x32x16_bf16(b1, qr[d0], p1, 0, 0, 0); }
  if (__builtin_expect(shift != 0.f, 0)) {
#pragma unroll
    for (int r = 0; r < 16; ++r) { p0[r] -= shift; p1[r] -= shift; }
  }
}

#define PK4X(P, BASE, OUT) do { u32x4 w_ = {cvtpk(P[BASE + 0], P[BASE + 1]), cvtpk(P[BASE + 2], P[BASE + 3]), cvtpk(P[BASE + 4], P[BASE + 5]), cvtpk(P[BASE + 6], P[BASE + 7])}; \
    OUT = *reinterpret_cast<bf16x8*>(&w_); } while (0)
template <int NQK>
__device__ __forceinline__ void qkt_fin(f32x16& n0, f32x16& n1, const char* Ks, const bf16x8* qr, int r32, int hi, const float shift,
                                        f32x16& o0, f32x16& o1, float& lsum, bf16x8& pa0, bf16x8& pa1, bf16x8& pa2, bf16x8& pa3) {
  n0 = f32x16{}; n1 = f32x16{};
  float ps = 0.f;
  bf16x8 kc0 = *reinterpret_cast<const bf16x8*>(Ks + KSWZ(r32, (hi * 8) * 2));
  bf16x8 kc1 = *reinterpret_cast<const bf16x8*>(Ks + KSWZ(32 + r32, (hi * 8) * 2));
#pragma unroll
  for (int d0 = 0; d0 < NQK; ++d0) {
    bf16x8 kn0 = kc0, kn1 = kc1;
    if (d0 + 1 < NQK) { const int cb = ((d0 + 1) * 16 + hi * 8) * 2;
      kn0 = *reinterpret_cast<const bf16x8*>(Ks + KSWZ(r32, cb)); kn1 = *reinterpret_cast<const bf16x8*>(Ks + KSWZ(32 + r32, cb)); }
    n0 = __builtin_amdgcn_mfma_f32_32x32x16_bf16(kc0, qr[d0], n0, 0, 0, 0);
    n1 = __builtin_amdgcn_mfma_f32_32x32x16_bf16(kc1, qr[d0], n1, 0, 0, 0);
#define PIN(X) asm volatile("" : "+v"(X))
    if (NQK == 6) {
      if (d0 == 0) { PK4X(o0, 0, pa0); }
      if (d0 == 1) { PIN(o0); PK4X(o0, 8, pa1); }
      if (d0 == 2) { _Pragma("unroll") for (int r = 0; r < 16; ++r) ps += o0[r]; }
      if (d0 == 3) { PIN(o1); PK4X(o1, 0, pa2); _Pragma("unroll") for (int r = 0; r < 8; ++r) ps += o1[r]; }
      if (d0 == 4) { PIN(o1); PK4X(o1, 8, pa3); _Pragma("unroll") for (int r = 8; r < 16; ++r) ps += o1[r]; }
    } else {
      if (d0 == 0) { PK4X(o0, 0, pa0); PK4X(o0, 8, pa1); }
      if (d0 == 1) { _Pragma("unroll") for (int r = 0; r < 16; ++r) ps += o0[r]; }
      if (d0 == 2) { PIN(o1); PK4X(o1, 0, pa2); _Pragma("unroll") for (int r = 0; r < 8; ++r) ps += o1[r]; }
      if (d0 == 3) { PIN(o1); PK4X(o1, 8, pa3); _Pragma("unroll") for (int r = 8; r < 16; ++r) ps += o1[r]; }
    }
#undef PIN
    asm volatile("" : "+v"(ps), "+v"(pa0), "+v"(pa1), "+v"(pa2), "+v"(pa3));
    kc0 = kn0; kc1 = kn1;
    SBAR();
  }
  lsum += ps;
  if (__builtin_expect(shift != 0.f, 0)) {
#pragma unroll
    for (int r = 0; r < 16; ++r) { n0[r] -= shift; n1[r] -= shift; }
  }
}

template <int NQK, int MODE, int LDG>
__device__ __forceinline__ void attn_body(const u16* __restrict__ Qb, const u16* __restrict__ Kh, const u16* __restrict__ Vh,
                                          const int NT, const int q0, const float sink2, const float mbound,
                                          u16* __restrict__ mix0, const u16* __restrict__ gate0, char* lds) {
  constexpr int DK = NQK * 16;
  constexpr int SHM_V = 8192, SHM_K = 17408;
  int tid_ = threadIdx.x; asm volatile("" : "+v"(tid_));
  const int tid = tid_, wid = __builtin_amdgcn_readfirstlane(tid >> 6), lane = tid & 63, r32 = lane & 31, hi = lane >> 5;
  char* V_lds = lds; char* K_lds = lds + 5 * SHM_V;
  float* wsf = (float*)(lds + 5 * SHM_V + 5 * SHM_K) + wid * 64; float* li_l = wsf;
  float lsum = 0; f32x16 o[2] = {}; bf16x8 qr[NQK];
  const float shift = mbound > 80.f ? mbound - 80.f : 0.f;
  const u16* Qw = Qb + (size_t)(wid * 32 + r32) * DK + hi * 8;
#pragma unroll
  for (int d0 = 0; d0 < NQK; ++d0) qr[d0] = *(const bf16x8*)(Qw + d0 * 16);
  const int srow = tid >> 3, sc8 = tid & 7;
  const int kst0 = KSWZ(srow, sc8 * 16), kst1 = KSWZ(srow, 128 + sc8 * 16), vst = v_st2(srow, sc8 * 8);
  const int vb0 = (int)(uintptr_t)V_lds + v_rd_base(lane);
  const bool k1on = (NQK == 6) && (sc8 < 4);
  const unsigned koff0 = srow * DK + sc8 * 8, voff0 = srow * 64 + sc8 * 8;
  struct { bf16x8 k0, k1, v0; } st[2];
#define TROW(j) (MODE == 0 ? (j) * 64 : ((j) < 4 ? (j) * 64 : q0 + 128 + ((j) - 4) * 64))
#define SLOAD(i, kr) do { const u16* kp_ = Kh + (unsigned)((kr) * DK); st[i].k0 = *(const bf16x8*)(kp_ + koff0);   \
    if (k1on) st[i].k1 = *(const bf16x8*)(kp_ + koff0 + 64);                                                           \
    const u16* vp_ = Vh + (unsigned)((kr) * 64); st[i].v0 = *(const bf16x8*)(vp_ + voff0); } while (0)
#define SWRITE(b, i) do { *(bf16x8*)(K_lds + (b) * SHM_K + kst0) = st[i].k0; if (k1on) *(bf16x8*)(K_lds + (b) * SHM_K + kst1) = st[i].k1; \
    *(bf16x8*)(V_lds + (b) * SHM_V + vst) = st[i].v0; } while (0)
#define MASKT(P0, P1, j) do { if (MODE == 1 && (j) >= 4) { const int kb_ = q0 - 128 + ((j) - 4) * 64, qp_ = q0 + wid * 32 + r32;    \
    _Pragma("unroll") for (int r = 0; r < 16; ++r) { int k0_ = kb_ + crow(r, hi), k1_ = k0_ + 32; int d0_ = qp_ - k0_, d1_ = qp_ - k1_; \
      bool ok0 = (d0_ <= 128) && (d0_ >= -128) && (k0_ >= 0) && (k0_ < SEQ); bool ok1 = (d1_ <= 128) && (d1_ >= -128) && (k1_ >= 0) && (k1_ < SEQ); \
      P0[r] = ok0 ? P0[r] : -1e30f; P1[r] = ok1 ? P1[r] : -1e30f; } } } while (0)
  f32x16 pA0, pA1, pB0, pB1; bf16x8 pa0, pa1, pa2, pa3;
#define NXS(x) ((x) + 1 == 5 ? 0 : (x) + 1)
  __syncthreads();
  SLOAD(0, TROW(0)); asm volatile("s_waitcnt vmcnt(0)" ::: "memory"); SWRITE(0, 0);
  SLOAD(0, TROW(1)); SWRITE(1, 0);
  SLOAD(0, TROW(2)); SWRITE(2, 0);
  if (3 < NT) SLOAD(0, TROW(3));
  if (4 < NT) SLOAD(1, TROW(4));
  __syncthreads();
  qkt<NQK>(pA0, pA1, K_lds, qr, r32, hi, shift); MASKT(pA0, pA1, 0); expall(pA0, pA1);
  int c = 0;
  for (int j = 1; j + 1 < NT; j += 2) {
    const int sj = NXS(c), sj1 = NXS(sj), sj2 = NXS(sj1), sj3 = NXS(sj2);
    SBAR(); SWRITE(sj2, 0); if (j + 3 < NT) SWRITE(sj3, 1); SBAR();
    qkt_fin<NQK>(pB0, pB1, K_lds + sj * SHM_K, qr, r32, hi, shift, pA0, pA1, lsum, pa0, pa1, pa2, pa3); MASKT(pB0, pB1, j); SBAR();
    if (j + 4 < NT) SLOAD(0, TROW(j + 4)); SBAR();
    pv_exp(o, vb0 + c * SHM_V, pa0, pa1, pa2, pa3, pB0, pB1);
    SBAR();
    qkt_fin<NQK>(pA0, pA1, K_lds + sj1 * SHM_K, qr, r32, hi, shift, pB0, pB1, lsum, pa0, pa1, pa2, pa3); MASKT(pA0, pA1, j + 1); SBAR();
    if (j + 5 < NT) SLOAD(1, TROW(j + 5)); SBAR();
    pv_exp(o, vb0 + sj * SHM_V, pa0, pa1, pa2, pa3, pA0, pA1);
    __syncthreads();
    c = sj1;
  }
  { const int sl = NXS(c);
    SBAR(); qkt_fin<NQK>(pB0, pB1, K_lds + sl * SHM_K, qr, r32, hi, shift, pA0, pA1, lsum, pa0, pa1, pa2, pa3); MASKT(pB0, pB1, NT - 1); SBAR();
    pv_all(o, vb0 + c * SHM_V, pa0, pa1, pa2, pa3); expall(pB0, pB1);
    finishSM(pB0, pB1, lsum, pa0, pa1, pa2, pa3); SBAR();
    pv_all(o, vb0 + sl * SHM_V, pa0, pa1, pa2, pa3); }
#undef NXS
  float l_reg;
  { auto rr = __builtin_amdgcn_permlane32_swap(__float_as_uint(lsum), __float_as_uint(lsum), false, false);
    l_reg = __uint_as_float(rr[0]) + __uint_as_float(rr[1]); }
  if (MODE == 1) l_reg += __builtin_amdgcn_exp2f(sink2 - shift);
  if (hi == 0) li_l[r32] = l_reg; asm volatile("s_waitcnt lgkmcnt(0)" ::: "memory");
  float rli[16];
#pragma unroll
  for (int r = 0; r < 16; ++r) rli[r] = __builtin_amdgcn_rcpf(li_l[crow(r, hi)]);
#pragma unroll
  for (int r = 0; r < 16; ++r) { const int orow = wid * 32 + crow(r, hi);
#pragma unroll
    for (int d0 = 0; d0 < 2; ++d0) {
      const float g = bf2f(gate0[(size_t)orow * LDG + d0 * 32 + r32]);
      mix0[(size_t)orow * 1024 + d0 * 32 + r32] = f2bf(o[d0][r] * rli[r] * silu_f(g));
    } }
#undef TROW
#undef SLOAD
#undef SWRITE
#undef MASKT
}

__global__ void __launch_bounds__(512, 1) mega(Params p) {
  extern __shared__ __attribute__((aligned(16))) char lds[];
  cg::grid_group grid = cg::this_grid();
  const int bid = blockIdx.x, nblk = gridDim.x;
  char* ws = p.ws;
  float* modv = (float*)(ws + OFF_MODV);
  u16* H = (u16*)(ws + OFF_H);
  u16* PP = (u16*)(ws + OFF_PP);
  float* XC1 = (float*)(ws + OFF_XC1);
  unsigned* gcnt = (unsigned*)(ws + OFF_END);
  if (bid == 0 && threadIdx.x == 0) __hip_atomic_store(gcnt, 0u, __ATOMIC_RELAXED, __HIP_MEMORY_SCOPE_AGENT);

  if (p.ph_lo <= 0 && 0 < p.ph_hi) {
  for (int u = bid; u < 192; u += nblk) mod_unit(p, u, lds);
  }
  if (p.ph_lo <= 0 && 0 + 1 < p.ph_hi) grid.sync();
  if (p.ph_lo <= 1 && 1 < p.ph_hi) {
  for (int u = bid; u < 2064; u += nblk) transpose_unit(p, u, lds);
  adaln_phase(p.x, nullptr, p.ctx, modv, H);
  }
  if (p.ph_lo <= 1 && 1 + 1 < p.ph_hi) gbar(gcnt, 1u * gridDim.x);
  if (p.ph_lo <= 2 && 2 < p.ph_hi) {
  { TileIter ti(130, 19); GPre g; int nt = 0, mt = 0; const u16* Wt = (const u16*)(ws + OFF_WT_IN_AB);
    if (ti.valid()) { ti.get(mt, nt); gemm_preload(H, 1024, Wt, 1024, mt * 256, nt * 128, g); }
    while (ti.valid()) {
      f32x16 acc[2][2]; const int m0 = mt * 256, n0 = nt * 128;
      gemm_tile<0>(H, 1024, Wt, 1024, 1024, m0, n0, acc, lds, g);
      ti.next(); if (ti.valid()) { ti.get(mt, nt); gemm_preload(H, 1024, Wt, 1024, mt * 256, nt * 128, g); }
      epi_bf16(acc, PP, LD_AB, m0, n0, lds);
    } }
  }
  if (p.ph_lo <= 2 && 2 + 1 < p.ph_hi) gbar(gcnt, 2u * gridDim.x);
  if (p.ph_lo <= 3 && 3 < p.ph_hi) {
  { TileIter ti(130, 14); GPre g; int nt = 0, mt = 0;
    const u16* Wq = (const u16*)(ws + OFF_WT_UQ); const u16* Wkv = (const u16*)(ws + OFF_WT_UKV);
    if (ti.valid()) { ti.get(mt, nt); gemm_preload(nt < 6 ? PP : PP + 256, LD_AB, nt < 6 ? Wq : Wkv, 256, mt * 256, (nt < 6 ? nt : nt - 6) * 128, g); }
    while (ti.valid()) {
      f32x16 acc[2][2]; const int m0 = mt * 256, cn = nt, n0 = (nt < 6 ? nt : nt - 6) * 128;
      gemm_tile<0>(cn < 6 ? PP : PP + 256, LD_AB, cn < 6 ? Wq : Wkv, 256, 256, m0, n0, acc, lds, g);
      ti.next(); if (ti.valid()) { ti.get(mt, nt); gemm_preload(nt < 6 ? PP : PP + 256, LD_AB, nt < 6 ? Wq : Wkv, 256, mt * 256, (nt < 6 ? nt : nt - 6) * 128, g); }
      if (cn < 6) epi_bf16(acc, H, 768, m0, n0, lds); else epi_bf16(acc, (u16*)p.out, 1024, m0, n0, lds);
    } }
  }
  if (p.ph_lo <= 3 && 3 + 1 < p.ph_hi) gbar(gcnt, 3u * gridDim.x);
  if (p.ph_lo <= 4 && 4 < p.ph_hi) {
  finalize0(p);
  }
  if (p.ph_lo <= 4 && 4 + 1 < p.ph_hi) gbar(gcnt, 4u * gridDim.x);
  if (p.ph_lo <= 5 && 5 < p.ph_hi) {
  const float mbA = LOG2E * 9.7979590f * 1.02f * vmaxabs(p.q_gain, 96) * vmaxabs(p.k_gain, 96);
  const float mbB = LOG2E * 8.f * 1.02f * vmaxabs(p.gq_gain, 64) * vmaxabs(p.gk_gain, 64);
  for (int it = bid; it < 2080; it += nblk) {
    int b, h, kvh, nt, qoff; bool mla, isctx;
    if (it < 2048) {
      const int round = it >> 8, blk = it & 255, xcd = blk & 7, cl = blk >> 3;
      isctx = false; nt = KVLEN / 64;
      if (round < 4) { const int pair = xcd * 2 + (round >> 1); b = pair >> 3; h = pair & 7; kvh = h; qoff = ((round & 1) * 32 + cl) * 256; mla = true; }
      else { const int g = round - 4, pi = xcd >> 1, idx = (xcd & 1) * 128 + g * 32 + cl; b = pi >> 1; kvh = pi & 1; h = kvh * 4 + (idx >> 6); qoff = (idx & 63) * 256; mla = false; }
    } else {
      const int ci = it - 2048; b = (ci >> 3) & 1; h = ci & 7; mla = ci < 16; kvh = mla ? h : (h >> 2); isctx = true; nt = CL / 64; qoff = 0;
    }
    const size_t r0 = isctx ? (size_t)NLAT + b * CL : (size_t)b * SEQ + qoff;
    const size_t qrow = isctx ? (size_t)(b * 8 + h) * CL : (size_t)(b * 8 + h) * SEQ + qoff;
    if (mla) {
      const u16* Qp = (const u16*)(ws + (isctx ? OFF_QCA : OFF_QA)) + qrow * 96;
      attn_body<6, 0, LD_AB>(Qp, (const u16*)(ws + OFF_KA) + (size_t)(b * 8 + kvh) * KVLEN * 96, (const u16*)(ws + OFF_VA) + (size_t)(b * 8 + kvh) * KVLEN * 64,
                             nt, 0, 0.f, mbA, H + r0 * 1024 + h * 64, PP + r0 * LD_AB + 1312 + h * 64, lds);
    } else {
      const u16* Qp = (const u16*)(ws + (isctx ? OFF_QCB : OFF_QB)) + qrow * 64;
      attn_body<4, 0, LD_AB>(Qp, (const u16*)(ws + OFF_KB) + (size_t)(b * 2 + kvh) * KVLEN * 64, (const u16*)(ws + OFF_VB) + (size_t)(b * 2 + kvh) * KVLEN * 64,
                             nt, 0, 0.f, mbB, H + r0 * 1024 + 512 + h * 64, PP + r0 * LD_AB + 1312 + 512 + h * 64, lds);
    }
  }
  }
  if (p.ph_lo <= 5 && 5 + 1 < p.ph_hi) gbar(gcnt, 5u * gridDim.x);
  if (p.ph_lo <= 6 && 6 < p.ph_hi) {
  { TileIter ti(130, 8); GPre g; int nt = 0, mt = 0; const u16* Wt = (const u16*)(ws + OFF_WT_OUT_AB);
    if (ti.valid()) { ti.get(mt, nt); gemm_preload(H, 1024, Wt, 1024, mt * 256, nt * 128, g); }
    while (ti.valid()) {
      f32x16 acc[2][2]; const int m0 = mt * 256, n0 = nt * 128; const bool lat = m0 < NLAT;
      const int tid_ = opaque_tid(), wid_ = tid_ >> 6, lane_ = tid_ & 63;
      const size_t eoff = (size_t)((lat ? m0 : m0 - NLAT) + (wid_ & 3) * 64 + (lane_ >> 4)) * 1024 + n0 + (wid_ >> 2) * 64 + 4 * (lane_ & 15);
      ResPre rp;
      gemm_tile<1>(H, 1024, Wt, 1024, 1024, m0, n0, acc, lds, g, (lat ? p.x : p.ctx) + eoff, &rp);
      ti.next(); if (ti.valid()) { ti.get(mt, nt); gemm_preload(H, 1024, Wt, 1024, mt * 256, nt * 128, g); }
      if (lat) epi_res<false, true>(acc, rp, (u16*)(ws + OFF_X1B) + eoff, modv + (m0 >> 14) * 3072 + 2048, n0, lds);
      else epi_res<false, false>(acc, rp, XC1 + eoff, modv + 2 * 3072 + 2048, n0, lds);
    } }
  }
  if (p.ph_lo <= 6 && 6 + 1 < p.ph_hi) gbar(gcnt, 6u * gridDim.x);
  if (p.ph_lo <= 7 && 7 < p.ph_hi) {
  adaln_phase(nullptr, (const u16*)(ws + OFF_X1B), XC1, modv + 3 * 3072, H);
  }
  if (p.ph_lo <= 7 && 7 + 1 < p.ph_hi) gbar(gcnt, 7u * gridDim.x);
  if (p.ph_lo <= 8 && 8 < p.ph_hi) {
  { TileIter ti(130, 26); GPre g; int nt = 0, mt = 0; const u16* Wt = (const u16*)(ws + OFF_WT_IN_CD);
    if (ti.valid()) { ti.get(mt, nt); gemm_preload(H, 1024, Wt, 1024, mt * 256, nt * 128, g); }
    while (ti.valid()) {
      f32x16 acc[2][2]; const int m0 = mt * 256, n0 = nt * 128;
      gemm_tile<0>(H, 1024, Wt, 1024, 1024, m0, n0, acc, lds, g);
      ti.next(); if (ti.valid()) { ti.get(mt, nt); gemm_preload(H, 1024, Wt, 1024, mt * 256, nt * 128, g); }
      epi_bf16(acc, PP, LD_CD, m0, n0, lds);
    } }
  }
  if (p.ph_lo <= 8 && 8 + 1 < p.ph_hi) gbar(gcnt, 8u * gridDim.x);
  if (p.ph_lo <= 9 && 9 < p.ph_hi) {
  finalize1(p);
  }
  if (p.ph_lo <= 9 && 9 + 1 < p.ph_hi) gbar(gcnt, 9u * gridDim.x);
  if (p.ph_lo <= 10 && 10 < p.ph_hi) {
  const float mbW = LOG2E * 8.f * 1.02f * vmaxabs(p.win_q_gain, 64) * vmaxabs(p.win_k_gain, 64);
  for (int it = bid; it < 1024; it += nblk) {
    const int g = it >> 8, blk = it & 255, xcd = blk & 7, cl = blk >> 3;
    const int pi = xcd >> 1, b = pi >> 1, kvh = pi & 1, idx = (xcd & 1) * 128 + g * 32 + cl;
    const int h = kvh * 4 + (idx >> 6), qblk = idx & 63;
    const size_t r0 = (size_t)b * SEQ + qblk * 256;
    attn_body<4, 1, LD_CD>((const u16*)(ws + OFF_Q2) + ((size_t)(b * 8 + h) * SEQ + qblk * 256) * 64,
                    (const u16*)(ws + OFF_K2) + (size_t)(b * 2 + kvh) * KV2LEN * 64, (const u16*)(ws + OFF_V2) + (size_t)(b * 2 + kvh) * KV2LEN * 64,
                    12, qblk * 256, p.win_sink[h] * LOG2E, mbW, H + r0 * 1024 + h * 64, PP + r0 * LD_CD + 2304 + h * 64, lds);
  }
  }
  if (p.ph_lo <= 10 && 10 + 1 < p.ph_hi) gbar(gcnt, 10u * gridDim.x);
  if (p.ph_lo <= 11 && 11 < p.ph_hi) {
  { TileIter ti(128, 8); GPre g; int nt = 0, mt = 0; const u16* Wt = (const u16*)(ws + OFF_WT_OUT_CD);
    if (ti.valid()) { ti.get(mt, nt); gemm_preload(H, 1024, Wt, 1024, mt * 256, nt * 128, g); }
    while (ti.valid()) {
      f32x16 acc[2][2]; const int m0 = mt * 256, n0 = nt * 128;
      const int tid_ = opaque_tid(), wid_ = tid_ >> 6, lane_ = tid_ & 63;
      const size_t eoff = (size_t)(m0 + (wid_ & 3) * 64 + (lane_ >> 4)) * 1024 + n0 + (wid_ >> 2) * 64 + 4 * (lane_ & 15);
      ResPre rp;
      gemm_tile<2>(H, 1024, Wt, 1024, 1024, m0, n0, acc, lds, g, (const u16*)(ws + OFF_X1B) + eoff, &rp);
      ti.next(); if (ti.valid()) { ti.get(mt, nt); gemm_preload(H, 1024, Wt, 1024, mt * 256, nt * 128, g); }
      epi_res<true, false>(acc, rp, p.out + eoff, modv + 3 * 3072 + (m0 >> 14) * 3072 + 2048, n0, lds);
    } }
  }
}

extern "C" void kernel_launch(void* const* d_in, const int* in_sizes, int n_in, void* d_out, int out_size, void* d_ws, size_t ws_size, hipStream_t stream) {
  static int grid_blocks = 0;
  if (!grid_blocks) {
    if (n_in != 22 || out_size != NLAT * DM || ws_size < OFF_END + 4096) {
      fprintf(stderr, "kernel_launch: shape/ws mismatch n_in %d out %d ws %zu need %zu\n", n_in, out_size, ws_size, (size_t)OFF_END);
      return;
    }
    if (hipFuncSetAttribute((const void*)mega, hipFuncAttributeMaxDynamicSharedMemorySize, LDS_BYTES) != hipSuccess) {
      fprintf(stderr, "kernel_launch: hipFuncSetAttribute failed\n"); return;
    }
    int dev = 0, cus = 0, per_cu = 0;
    (void)hipGetDevice(&dev);
    (void)hipDeviceGetAttribute(&cus, hipDeviceAttributeMultiprocessorCount, dev);
    (void)hipOccupancyMaxActiveBlocksPerMultiprocessor(&per_cu, mega, 512, LDS_BYTES);
    if (per_cu < 1) { fprintf(stderr, "kernel_launch: occupancy 0\n"); return; }
    grid_blocks = cus;
  }
  Params p{};
  p.x = (const float*)d_in[0]; p.c = (const float*)d_in[1]; p.ctx = (const float*)d_in[2]; p.c_ctx = (const float*)d_in[3];
  p.mod_w = (const float*)d_in[4]; p.mod_b = (const float*)d_in[5]; p.ab_w_in = (const float*)d_in[6]; p.ab_w_out = (const float*)d_in[7];
  p.cq_gain = (const float*)d_in[8]; p.ckv_gain = (const float*)d_in[9]; p.w_uq = (const float*)d_in[10]; p.w_ukv = (const float*)d_in[11];
  p.q_gain = (const float*)d_in[12]; p.k_gain = (const float*)d_in[13]; p.gq_gain = (const float*)d_in[14]; p.gk_gain = (const float*)d_in[15];
  p.cd_w_in = (const float*)d_in[16]; p.cd_w_out = (const float*)d_in[17]; p.win_q_gain = (const float*)d_in[18]; p.win_k_gain = (const float*)d_in[19];
  p.win_sink = (const float*)d_in[20]; p.conv_w = (const float*)d_in[21];
  p.out = (float*)d_out; p.ws = (char*)d_ws;
#if MULTI_LAUNCH
  for (int ph = 0; ph < 12; ++ph) {
    p.ph_lo = ph; p.ph_hi = ph + 1;
    hipLaunchKernelGGL(mega, dim3(grid_blocks), dim3(512), LDS_BYTES, stream, p);
  }
#else
  p.ph_lo = 0; p.ph_hi = 12;
  void* args[] = {&p};
  hipError_t e = hipLaunchCooperativeKernel((void*)mega, dim3(grid_blocks), dim3(512), args, LDS_BYTES, stream);
  if (e != hipSuccess) fprintf(stderr, "cooperative launch failed: %s (grid %d)\n", hipGetErrorString(e), grid_blocks);
#endif
}
```

```cpp
#include <hip/hip_runtime.h>
#include <hip/hip_cooperative_groups.h>
#include <cstdio>
#include <cstdint>
namespace cg = cooperative_groups;

typedef unsigned short u16;
using bf16x8 = __attribute__((ext_vector_type(8))) short;
using s16x4  = __attribute__((ext_vector_type(4))) short;
using f32x16 = __attribute__((ext_vector_type(16))) float;
using u32x4  = __attribute__((ext_vector_type(4))) unsigned;
using u32x2  = __attribute__((ext_vector_type(2))) unsigned;

constexpr int NB = 2, SEQ = 16384, DM = 1024, CL = 256;
constexpr int NLAT = NB * SEQ;
constexpr int NROW = NLAT + NB * CL;
constexpr int KVLEN = CL + SEQ;
constexpr int KV2LEN = KVLEN + 128;
constexpr int LD_AB = 2432, LD_CD = 3328;
constexpr float EPS = 1e-6f;
constexpr float QS_A = 0.14724461f;
constexpr float QS_B = 0.18033688f;
constexpr float LOG2E = 1.4426950408889634f;

constexpr size_t OFF_MODV      = 0;
constexpr size_t OFF_WT_IN_AB  = 73728;
constexpr size_t OFF_WT_OUT_AB = OFF_WT_IN_AB + (size_t)LD_AB * 1024 * 2;
constexpr size_t OFF_WT_UQ     = OFF_WT_OUT_AB + (size_t)1024 * 1024 * 2;
constexpr size_t OFF_WT_UKV    = OFF_WT_UQ + (size_t)768 * 256 * 2;
constexpr size_t OFF_WT_IN_CD  = OFF_WT_UKV + (size_t)1024 * 256 * 2;
constexpr size_t OFF_WT_OUT_CD = OFF_WT_IN_CD + (size_t)3328 * 1024 * 2;
constexpr size_t OFF_XC1       = OFF_WT_OUT_CD + (size_t)1024 * 1024 * 2;
constexpr size_t OFF_H         = OFF_XC1 + (size_t)512 * 1024 * 4;
constexpr size_t OFF_PP        = OFF_H + (size_t)NROW * 1024 * 2;
constexpr size_t OFF_QA        = OFF_PP + (size_t)NROW * 3328 * 2;
constexpr size_t OFF_QCA       = OFF_QA + (size_t)NB * 8 * SEQ * 96 * 2;
constexpr size_t OFF_KA        = OFF_QCA + (size_t)NB * 8 * CL * 96 * 2;
constexpr size_t OFF_VA        = OFF_KA + (size_t)NB * 8 * KVLEN * 96 * 2;
constexpr size_t OFF_QB        = OFF_VA + (size_t)NB * 8 * KVLEN * 64 * 2;
constexpr size_t OFF_QCB       = OFF_QB + (size_t)NB * 8 * SEQ * 64 * 2;
constexpr size_t OFF_KB        = OFF_QCB + (size_t)NB * 8 * CL * 64 * 2;
constexpr size_t OFF_VB        = OFF_KB + (size_t)NB * 2 * KVLEN * 64 * 2;
constexpr size_t OFF_END       = OFF_VB + (size_t)NB * 2 * KVLEN * 64 * 2;
constexpr size_t OFF_Q2        = OFF_QA;
constexpr size_t OFF_K2        = OFF_Q2 + (size_t)NB * 8 * SEQ * 64 * 2;
constexpr size_t OFF_V2        = OFF_K2 + (size_t)NB * 2 * KV2LEN * 64 * 2;
constexpr size_t OFF_X1B       = OFF_QA + ((size_t)64 << 20);
static_assert(OFF_V2 + (size_t)NB * 2 * KV2LEN * 64 * 2 <= OFF_X1B && OFF_X1B + (size_t)NLAT * 1024 * 2 <= OFF_END, "x1 alias");
static_assert(OFF_V2 + (size_t)NB * 2 * KV2LEN * 64 * 2 <= OFF_END, "alias overflow");

constexpr int LDS_BYTES = 147456;
#ifndef MULTI_LAUNCH
#define MULTI_LAUNCH 0
#endif

struct Params {
  const float *x, *c, *ctx, *c_ctx, *mod_w, *mod_b, *ab_w_in, *ab_w_out, *cq_gain, *ckv_gain, *w_uq, *w_ukv,
      *q_gain, *k_gain, *gq_gain, *gk_gain, *cd_w_in, *cd_w_out, *win_q_gain, *win_k_gain, *win_sink, *conv_w;
  float* out;
  char* ws;
  int ph_lo, ph_hi;
};

#define SBAR() __builtin_amdgcn_sched_barrier(0)
__device__ __forceinline__ int crow(int r, int hi) { return (r & 3) + 8 * (r >> 2) + 4 * hi; }
typedef float f32x2_t __attribute__((ext_vector_type(2)));
typedef __bf16 bf16x2_t __attribute__((ext_vector_type(2)));
__device__ __forceinline__ unsigned cvtpk(float lo, float hi) { f32x2_t v = {lo, hi}; bf16x2_t b = __builtin_convertvector(v, bf16x2_t); return __builtin_bit_cast(unsigned, b); }
__device__ __forceinline__ u16 f2bf(float x) { return (u16)(cvtpk(x, 0.f) & 0xffffu); }
__device__ __forceinline__ float bf2f(u16 x) { return __uint_as_float(((unsigned)x) << 16); }
__device__ __forceinline__ float bflo(unsigned w) { return __uint_as_float(w << 16); }
__device__ __forceinline__ float bfhi(unsigned w) { return __uint_as_float(w & 0xffff0000u); }
__device__ __forceinline__ float wave_sum(float v) {
#pragma unroll
  for (int o = 32; o >= 1; o >>= 1) v += __shfl_xor(v, o);
  return v;
}
__device__ __forceinline__ int opaque_tid() { int t = threadIdx.x; asm volatile("" : "+v"(t)); return t; }
__device__ __forceinline__ float vmaxabs(const float* g, int n) { float m = 0.f; for (int i = 0; i < n; ++i) m = fmaxf(m, fabsf(g[i])); return m; }
__device__ __forceinline__ float silu_f(float g) { return g / (1.f + __expf(-g)); }


__device__ __forceinline__ void gbar(unsigned* cnt, unsigned target) {
  asm volatile("s_waitcnt vmcnt(0)" ::: "memory");
  __syncthreads();
  if (threadIdx.x == 0) {
    __builtin_amdgcn_fence(__ATOMIC_RELEASE, "agent");
    asm volatile("s_waitcnt vmcnt(0)" ::: "memory");
    __hip_atomic_fetch_add(cnt, 1u, __ATOMIC_RELAXED, __HIP_MEMORY_SCOPE_AGENT);
    unsigned sp = 0;
    while (__hip_atomic_load(cnt, __ATOMIC_RELAXED, __HIP_MEMORY_SCOPE_AGENT) < target) { __builtin_amdgcn_s_sleep(1); if (++sp > (1u << 24)) break; }
    __builtin_amdgcn_fence(__ATOMIC_ACQUIRE, "agent");
    asm volatile("s_waitcnt vmcnt(0)" ::: "memory");
  }
  __syncthreads();
}

__device__ void mod_unit(const Params& p, int u, char* lds) {
  const int tid = opaque_tid();
  const int layer = u / 96, n0 = (u % 96) * 32, col = tid & 31, ks = tid >> 5;
  const float* W = p.mod_w + (size_t)layer * 1024 * 3072 + n0 + col;
  float a0 = 0, a1 = 0, a2 = 0;
  for (int k = ks * 64; k < ks * 64 + 64; ++k) {
    float w = W[(size_t)k * 3072];
    a0 += silu_f(p.c[k]) * w; a1 += silu_f(p.c[1024 + k]) * w; a2 += silu_f(p.c_ctx[k]) * w;
  }
  float* red = (float*)lds;
  red[(0 * 16 + ks) * 32 + col] = a0; red[(1 * 16 + ks) * 32 + col] = a1; red[(2 * 16 + ks) * 32 + col] = a2;
  __syncthreads();
  if (tid < 96) {
    int w = tid >> 5, cc = tid & 31; float s = 0;
    for (int i = 0; i < 16; ++i) s += red[(w * 16 + i) * 32 + cc];
    float* modv = (float*)(p.ws + OFF_MODV);
    modv[(layer * 3 + w) * 3072 + n0 + cc] = s + p.mod_b[layer * 3072 + n0 + cc];
  }
  __syncthreads();
}

__device__ void transpose_unit(const Params& p, int u, char* lds) {
  const float* src; const float* gain = nullptr; int K, N; u16* dst; int ul;
  if (u < 608)       { ul = u;        src = p.ab_w_in;  K = 1024; N = 2336; dst = (u16*)(p.ws + OFF_WT_IN_AB); }
  else if (u < 864)  { ul = u - 608;  src = p.ab_w_out; K = 1024; N = 1024; dst = (u16*)(p.ws + OFF_WT_OUT_AB); }
  else if (u < 912)  { ul = u - 864;  src = p.w_uq;     K = 256;  N = 768;  dst = (u16*)(p.ws + OFF_WT_UQ); gain = p.cq_gain; }
  else if (u < 976)  { ul = u - 912;  src = p.w_ukv;    K = 256;  N = 1024; dst = (u16*)(p.ws + OFF_WT_UKV); gain = p.ckv_gain; }
  else if (u < 1808) { ul = u - 976;  src = p.cd_w_in;  K = 1024; N = 3328; dst = (u16*)(p.ws + OFF_WT_IN_CD); }
  else               { ul = u - 1808; src = p.cd_w_out; K = 1024; N = 1024; dst = (u16*)(p.ws + OFF_WT_OUT_CD); }
  const int nkt = K / 64, kt = ul % nkt, nt = ul / nkt, k0 = kt * 64, n0 = nt * 64, tid = opaque_tid();
  float* tile = (float*)lds;
#pragma unroll
  for (int e = 0; e < 8; ++e) {
    int i = (tid >> 6) + 8 * e, j = tid & 63, n = n0 + j;
    float v = (n < N) ? src[(size_t)(k0 + i) * N + n] : 0.f;
    if (gain) v *= gain[k0 + i];
    tile[i * 65 + j] = v;
  }
  __syncthreads();
#pragma unroll
  for (int e = 0; e < 8; ++e) {
    int i2 = (tid >> 6) + 8 * e, j2 = tid & 63;
    dst[(size_t)(n0 + i2) * K + k0 + j2] = f2bf(tile[j2 * 65 + i2]);
  }
  __syncthreads();
}

__device__ void adaln_phase(const float* xlat, const u16* xlat_bf, const float* xctx, const float* modl, u16* H) {
  const int tid = opaque_tid(), lane = tid & 63, gw = blockIdx.x * 8 + (tid >> 6), nw = gridDim.x * 8;
  for (int r = gw; r < NROW; r += nw) {
    if (xlat_bf != nullptr && r < NLAT) {
      const float* m = modl + (r >> 14) * 3072;
      u32x4 w[2]; float f[16]; float ss = 0;
#pragma unroll
      for (int i = 0; i < 2; ++i) w[i] = *(const u32x4*)(xlat_bf + (size_t)r * 1024 + 8 * (lane + 64 * i));
#pragma unroll
      for (int i = 0; i < 2; ++i)
#pragma unroll
        for (int e = 0; e < 4; ++e) { f[i * 8 + 2 * e] = bflo(w[i][e]); f[i * 8 + 2 * e + 1] = bfhi(w[i][e]); }
#pragma unroll
      for (int e = 0; e < 16; ++e) ss += f[e] * f[e];
      ss = wave_sum(ss);
      const float rstd = rsqrtf(ss * (1.f / 1024) + EPS);
#pragma unroll
      for (int i = 0; i < 2; ++i) {
        const int c = 8 * (lane + 64 * i);
        const float4 sh0 = *(const float4*)(m + c), sh1 = *(const float4*)(m + c + 4), sc0 = *(const float4*)(m + 1024 + c), sc1 = *(const float4*)(m + 1024 + c + 4);
        const float shv[8] = {sh0.x, sh0.y, sh0.z, sh0.w, sh1.x, sh1.y, sh1.z, sh1.w}, scv[8] = {sc0.x, sc0.y, sc0.z, sc0.w, sc1.x, sc1.y, sc1.z, sc1.w};
        float y[8];
#pragma unroll
        for (int e = 0; e < 8; ++e) y[e] = f[i * 8 + e] * rstd * (1.f + scv[e]) + shv[e];
        const u32x4 o = {cvtpk(y[0], y[1]), cvtpk(y[2], y[3]), cvtpk(y[4], y[5]), cvtpk(y[6], y[7])};
        *(u32x4*)(H + (size_t)r * 1024 + c) = o;
      }
      continue;
    }
    const float* src = r < NLAT ? xlat + (size_t)r * 1024 : xctx + (size_t)(r - NLAT) * 1024;
    const float* m = modl + (r < NLAT ? (r >> 14) : 2) * 3072;
    float4 v[4]; float ss = 0;
#pragma unroll
    for (int i = 0; i < 4; ++i) { v[i] = ((const float4*)src)[lane + 64 * i]; ss += v[i].x * v[i].x + v[i].y * v[i].y + v[i].z * v[i].z + v[i].w * v[i].w; }
    ss = wave_sum(ss);
    const float rstd = rsqrtf(ss * (1.f / 1024) + EPS);
#pragma unroll
    for (int i = 0; i < 4; ++i) {
      int c = 4 * (lane + 64 * i);
      float4 sh = *(const float4*)(m + c), sc = *(const float4*)(m + 1024 + c);
      float y0 = v[i].x * rstd * (1.f + sc.x) + sh.x, y1 = v[i].y * rstd * (1.f + sc.y) + sh.y;
      float y2 = v[i].z * rstd * (1.f + sc.z) + sh.z, y3 = v[i].w * rstd * (1.f + sc.w) + sh.w;
      u32x2 o = {cvtpk(y0, y1), cvtpk(y2, y3)};
      *(u32x2*)(H + (size_t)r * 1024 + c) = o;
    }
  }
}

#define GSWZ(row, colB) ((row) * 128 + ((colB) ^ ((((row) >> 1) & 7) << 4)))
struct ResPre { float4 v[16]; u32x2 w[16]; };
struct GPre { bf16x8 ra[4], rb[2]; };
__device__ __forceinline__ void gemm_preload(const u16* __restrict__ A, int lda, const u16* __restrict__ Bt, int ldb, int m0, int n0, GPre& g) {
  const int tid = opaque_tid(), srow = tid >> 3, sch = tid & 7;
  const u16* ap = A + (size_t)(m0 + srow) * lda + sch * 8;
  const u16* bp = Bt + (size_t)(n0 + srow) * ldb + sch * 8;
#pragma unroll
  for (int i = 0; i < 4; ++i) g.ra[i] = *(const bf16x8*)(ap + (size_t)(64 * i) * lda);
#pragma unroll
  for (int i = 0; i < 2; ++i) g.rb[i] = *(const bf16x8*)(bp + (size_t)(64 * i) * ldb);
}
template <int PRE>
__device__ __forceinline__ void gemm_tile(const u16* __restrict__ A, int lda, const u16* __restrict__ Bt, int ldb, int K,
                                          int m0, int n0, f32x16 (&acc)[2][2], char* lds, GPre& g, const void* resp = nullptr, ResPre* rp = nullptr) {
  const int tid = opaque_tid(), wid = tid >> 6, lane = tid & 63, r32 = lane & 31, hi = lane >> 5;
  const int wm = wid & 3, wn = wid >> 2;
  char* As = lds;
  char* Bs = lds + 98304;
  const int srow = tid >> 3, sch = tid & 7;
  const u16* ap = A + (size_t)(m0 + srow) * lda + sch * 8;
  const u16* bp = Bt + (size_t)(n0 + srow) * ldb + sch * 8;
  const int sw = GSWZ(srow, sch * 16);
  bf16x8 (&ra)[4] = g.ra; bf16x8 (&rb)[2] = g.rb;
#pragma unroll
  for (int i = 0; i < 2; ++i) for (int j = 0; j < 2; ++j) acc[i][j] = f32x16{};
  const int nk = K / 64;
  __syncthreads();
#pragma unroll
  for (int i = 0; i < 4; ++i) *(bf16x8*)(As + sw + i * 8192) = ra[i];
#pragma unroll
  for (int i = 0; i < 2; ++i) *(bf16x8*)(Bs + sw + i * 8192) = rb[i];
  if (1 < nk) {
#pragma unroll
    for (int i = 0; i < 4; ++i) ra[i] = *(const bf16x8*)(ap + (size_t)(64 * i) * lda + 64);
#pragma unroll
    for (int i = 0; i < 2; ++i) rb[i] = *(const bf16x8*)(bp + (size_t)(64 * i) * ldb + 64);
  }
  __syncthreads();
  const int arow0 = wm * 64 + r32, brow0 = wn * 64 + r32;
  int st = 0;
  for (int kt = 0; kt < nk; ++kt) {
    const int stn = (st == 2) ? 0 : st + 1;
    if (kt + 1 < nk) {
      char* An = As + stn * 32768; char* Bn = Bs + stn * 16384;
#pragma unroll
      for (int i = 0; i < 4; ++i) *(bf16x8*)(An + sw + i * 8192) = ra[i];
#pragma unroll
      for (int i = 0; i < 2; ++i) *(bf16x8*)(Bn + sw + i * 8192) = rb[i];
    }
    if (kt + 2 < nk) {
#pragma unroll
      for (int i = 0; i < 4; ++i) ra[i] = *(const bf16x8*)(ap + (size_t)(64 * i) * lda + (kt + 2) * 64);
#pragma unroll
      for (int i = 0; i < 2; ++i) rb[i] = *(const bf16x8*)(bp + (size_t)(64 * i) * ldb + (kt + 2) * 64);
    }
    if (PRE == 1 && kt == 0) {
#pragma unroll
      for (int q = 0; q < 16; ++q) rp->v[q] = *(const float4*)((const float*)resp + (size_t)((q >> 3) * 32 + 4 * (q & 7)) * 1024);
    }
    if (PRE == 2 && kt == 0) {
#pragma unroll
      for (int q = 0; q < 16; ++q) rp->w[q] = *(const u32x2*)((const u16*)resp + (size_t)((q >> 3) * 32 + 4 * (q & 7)) * 1024);
    }
    SBAR();
    const char* Ac = As + st * 32768; const char* Bc = Bs + st * 16384;
#pragma unroll
    for (int kk = 0; kk < 4; ++kk) {
      const int cb = kk * 32 + hi * 16;
      bf16x8 a0 = *(const bf16x8*)(Ac + GSWZ(arow0, cb));
      bf16x8 a1 = *(const bf16x8*)(Ac + GSWZ(arow0 + 32, cb));
      bf16x8 b0 = *(const bf16x8*)(Bc + GSWZ(brow0, cb));
      bf16x8 b1 = *(const bf16x8*)(Bc + GSWZ(brow0 + 32, cb));
      acc[0][0] = __builtin_amdgcn_mfma_f32_32x32x16_bf16(a0, b0, acc[0][0], 0, 0, 0);
      acc[0][1] = __builtin_amdgcn_mfma_f32_32x32x16_bf16(a0, b1, acc[0][1], 0, 0, 0);
      acc[1][0] = __builtin_amdgcn_mfma_f32_32x32x16_bf16(a1, b0, acc[1][0], 0, 0, 0);
      acc[1][1] = __builtin_amdgcn_mfma_f32_32x32x16_bf16(a1, b1, acc[1][1], 0, 0, 0);
    }
    __syncthreads();
    st = stn;
  }
}

struct TileIter {
  int f, fend, step, MT, NT;
  __device__ __forceinline__ TileIter(int MT_, int NT_) : MT(MT_), NT(NT_) {
    const int T = MT_ * NT_, bid = blockIdx.x, nblk = gridDim.x;
    if (nblk == 256) { const int x = bid & 7, cl = bid >> 3; f = (int)(((long)T * x) >> 3) + cl; fend = (int)(((long)T * (x + 1)) >> 3); step = 32; }
    else { f = bid; fend = T; step = nblk; }
  }
  __device__ __forceinline__ bool valid() const { return f < fend; }
  __device__ __forceinline__ void next() { f += step; }
  __device__ __forceinline__ void get(int& mt, int& nt) const {
    const int full = (MT >> 2) * 4 * NT;
    if (f < full) { const int g = f / (4 * NT), rem = f - g * 4 * NT; nt = rem >> 2; mt = g * 4 + (rem & 3); }
    else { const int rem = f - full, gs = MT - (MT >> 2) * 4; nt = rem / gs; mt = (MT >> 2) * 4 + (rem - nt * gs); }
  }
};

__device__ __forceinline__ void epi_bf16(f32x16 (&acc)[2][2], u16* C, int ldc, int m0, int n0, char* lds) {
  const int tid = opaque_tid(), wid = tid >> 6, lane = tid & 63, r32 = lane & 31, hi = lane >> 5;
  const int wm = wid & 3, wn = wid >> 2;
  char* wl = lds + wid * 9216;
#pragma unroll
  for (int i = 0; i < 2; ++i)
#pragma unroll
    for (int j = 0; j < 2; ++j)
#pragma unroll
      for (int r = 0; r < 16; ++r) *(u16*)(wl + (i * 32 + crow(r, hi)) * 144 + (j * 32 + r32) * 2) = f2bf(acc[i][j][r]);
  asm volatile("s_waitcnt lgkmcnt(0)" ::: "memory");
  const int rr = lane >> 3, ch = lane & 7;
  u16* cbase = C + (size_t)(m0 + wm * 64 + rr) * ldc + n0 + wn * 64 + ch * 8;
#pragma unroll
  for (int k = 0; k < 8; ++k) {
    const u32x4 v = *(const u32x4*)(wl + (rr + 8 * k) * 144 + ch * 16);
    *(u32x4*)(cbase + (size_t)(8 * k) * ldc) = v;
  }
}
template <bool IN_BF, bool OUT_BF>
__device__ __forceinline__ void epi_res(f32x16 (&acc)[2][2], const ResPre& rp, void* outp, const float* gsrc, int n0, char* lds) {
  const int tid = opaque_tid(), wid = tid >> 6, lane = tid & 63, r32 = lane & 31, hi = lane >> 5;
  const int wn = wid >> 2;
  char* wl = lds + wid * 8704;
  const int rl = lane >> 4, c4 = lane & 15;
  const float4 g = *(const float4*)(gsrc + n0 + wn * 64 + 4 * c4);
#pragma unroll
  for (int i = 0; i < 2; ++i) {
#pragma unroll
    for (int j = 0; j < 2; ++j)
#pragma unroll
      for (int r = 0; r < 16; ++r) *(float*)(wl + crow(r, hi) * 272 + (j * 32 + r32) * 4) = acc[i][j][r];
    asm volatile("s_waitcnt lgkmcnt(0)" ::: "memory");
#pragma unroll
    for (int k = 0; k < 8; ++k) {
      const float4 a = *(const float4*)(wl + (rl + 4 * k) * 272 + c4 * 16);
      float4 x;
      if (IN_BF) { const u32x2 xw = rp.w[i * 8 + k]; x.x = bflo(xw[0]); x.y = bfhi(xw[0]); x.z = bflo(xw[1]); x.w = bfhi(xw[1]); } else x = rp.v[i * 8 + k];
      float4 o; o.x = x.x + g.x * a.x; o.y = x.y + g.y * a.y; o.z = x.z + g.z * a.z; o.w = x.w + g.w * a.w;
      if (OUT_BF) { const u32x2 ow = {cvtpk(o.x, o.y), cvtpk(o.z, o.w)}; *(u32x2*)((u16*)outp + (size_t)(i * 32 + 4 * k) * 1024) = ow; }
      else *(float4*)((float*)outp + (size_t)(i * 32 + 4 * k) * 1024) = o;
    }
    asm volatile("s_waitcnt lgkmcnt(0)" ::: "memory");
  }
}

__device__ __forceinline__ float red8(float v) { v += __shfl_xor(v, 1); v += __shfl_xor(v, 2); v += __shfl_xor(v, 4); return v; }
__device__ __forceinline__ void rope_cs(float pos, float inv, bool on, float& c, float& s) {
  if (on) { float a = pos * inv * 0.15915494309189535f; a -= floorf(a); c = __builtin_amdgcn_cosf(a); s = __builtin_amdgcn_sinf(a); } else { c = 1.f; s = 0.f; }
}
__device__ __forceinline__ void head64(const u16* src, u16* dst, int gb, const float* g, const float* cG, const float* sG, float qs) {
  const u32x2 lo = *(const u32x2*)(src + gb), hi2 = *(const u32x2*)(src + gb + 16);
  float x[8] = {bflo(lo[0]), bfhi(lo[0]), bflo(lo[1]), bfhi(lo[1]), bflo(hi2[0]), bfhi(hi2[0]), bflo(hi2[1]), bfhi(hi2[1])};
  float ss = 0;
#pragma unroll
  for (int e = 0; e < 8; ++e) ss += x[e] * x[e];
  const float rn = rsqrtf(red8(ss) * (1.f / 64) + EPS) ;
#pragma unroll
  for (int e = 0; e < 8; ++e) x[e] *= rn * g[e];
  float y[8];
#pragma unroll
  for (int e = 0; e < 4; ++e) { y[e] = (x[e] * cG[e] - x[e + 4] * sG[e]) * qs; y[e + 4] = (x[e + 4] * cG[e] + x[e] * sG[e]) * qs; }
  const u32x2 o0 = {cvtpk(y[0], y[1]), cvtpk(y[2], y[3])}, o1 = {cvtpk(y[4], y[5]), cvtpk(y[6], y[7])};
  *(u32x2*)(dst + gb) = o0; *(u32x2*)(dst + gb + 16) = o1;
}
__device__ __forceinline__ void head96(float* n, float r1a, float r1b, float r2a, float r2b, u16* dst, int t, int rb,
                                       const float* gn, const float* gr, const float* cM, const float* sM, float qs) {
  float ss = r1a * r1a + r1b * r1b + r2a * r2a + r2b * r2b;
#pragma unroll
  for (int e = 0; e < 8; ++e) ss += n[e] * n[e];
  const float rn = rsqrtf(red8(ss) * (1.f / 96) + EPS);
#pragma unroll
  for (int e = 0; e < 8; ++e) n[e] *= rn * gn[e] * qs;
  r1a *= rn * gr[0]; r1b *= rn * gr[1]; r2a *= rn * gr[2]; r2b *= rn * gr[3];
  const float y1a = (r1a * cM[0] - r2a * sM[0]) * qs, y2a = (r2a * cM[0] + r1a * sM[0]) * qs;
  const float y1b = (r1b * cM[1] - r2b * sM[1]) * qs, y2b = (r2b * cM[1] + r1b * sM[1]) * qs;
  const u32x4 o = {cvtpk(n[0], n[1]), cvtpk(n[2], n[3]), cvtpk(n[4], n[5]), cvtpk(n[6], n[7])};
  *(u32x4*)(dst + 8 * t) = o;
  *(unsigned*)(dst + 64 + rb) = cvtpk(y1a, y1b); *(unsigned*)(dst + 64 + rb + 8) = cvtpk(y2a, y2b);
}
__device__ void finalize0(const Params& p) {
  const int tid = opaque_tid(), lane = tid & 63, gw = blockIdx.x * 8 + (tid >> 6), nw = gridDim.x * 8;
  const int h = lane >> 3, t = lane & 7;
  char* ws = p.ws;
  const u16* PP = (const u16*)(ws + OFF_PP);
  const u16* QAR = (const u16*)(ws + OFF_H);
  const u16* KVR = (const u16*)p.out;
  u16* QA = (u16*)(ws + OFF_QA); u16* QCA = (u16*)(ws + OFF_QCA); u16* KA = (u16*)(ws + OFF_KA); u16* VA = (u16*)(ws + OFF_VA);
  u16* QB = (u16*)(ws + OFF_QB); u16* QCB = (u16*)(ws + OFF_QCB); u16* KB = (u16*)(ws + OFF_KB); u16* VB = (u16*)(ws + OFF_VB);
  const int gb = t < 4 ? 4 * t : 32 + 4 * (t - 4), rb = t < 4 ? 2 * t : 16 + 2 * (t - 4);
  float qgn[8], kgn[8], qgr[4], kgr[4], gqg[8], gkg[8], invG[4], invM[2];
#pragma unroll
  for (int e = 0; e < 8; ++e) { qgn[e] = p.q_gain[8 * t + e]; kgn[e] = p.k_gain[8 * t + e];
    const int d = gb + (e & 3) + (e >> 2) * 16; gqg[e] = p.gq_gain[d]; gkg[e] = p.gk_gain[d]; }
#pragma unroll
  for (int k = 0; k < 4; ++k) { const int d = 64 + rb + (k & 1) + (k >> 1) * 8; qgr[k] = p.q_gain[d]; kgr[k] = p.k_gain[d]; }
#pragma unroll
  for (int e = 0; e < 4; ++e) invG[e] = exp2f(-(float)(4 * (t & 3) + e) * (13.287712379549449f / 16.f));
#pragma unroll
  for (int k = 0; k < 2; ++k) invM[k] = exp2f(-(float)(2 * (t & 3) + k) * (13.287712379549449f / 8.f));
  for (int r = gw; r < NROW; r += nw) {
    const bool isctx = r >= NLAT;
    int b, s, kpos; float pos = 0.f;
    if (!isctx) { b = r >> 14; s = r & 16383; kpos = CL + s; pos = t < 4 ? (float)(s >> 6) : (float)(s & 63); }
    else { int rc = r - NLAT; b = rc >> 8; s = rc & 255; kpos = s; }
    float cG[4], sG[4], cM[2], sM[2];
#pragma unroll
    for (int e = 0; e < 4; ++e) rope_cs(pos, invG[e], !isctx, cG[e], sG[e]);
#pragma unroll
    for (int k = 0; k < 2; ++k) rope_cs(pos, invM[k], !isctx, cM[k], sM[k]);
    const u16* pp = PP + (size_t)r * LD_AB;
    const u32x2 wq = *(const u32x2*)(pp + lane * 4), wk = *(const u32x2*)(pp + 256 + lane * 4);
    float s1 = bflo(wq[0]) * bflo(wq[0]) + bfhi(wq[0]) * bfhi(wq[0]) + bflo(wq[1]) * bflo(wq[1]) + bfhi(wq[1]) * bfhi(wq[1]);
    float s2 = bflo(wk[0]) * bflo(wk[0]) + bfhi(wk[0]) * bfhi(wk[0]) + bflo(wk[1]) * bflo(wk[1]) + bfhi(wk[1]) * bfhi(wk[1]);
    s1 = wave_sum(s1); s2 = wave_sum(s2);
    const float rstd_cq = rsqrtf(s1 * (1.f / 256) + EPS), rstd_ckv = rsqrtf(s2 * (1.f / 256) + EPS);
    { const u16* qa = QAR + (size_t)r * 768 + h * 96;
      const u32x4 nv = *(const u32x4*)(qa + 8 * t); const unsigned w1 = *(const unsigned*)(qa + 64 + rb), w2 = *(const unsigned*)(qa + 64 + rb + 8);
      float n[8] = {bflo(nv[0]) * rstd_cq, bfhi(nv[0]) * rstd_cq, bflo(nv[1]) * rstd_cq, bfhi(nv[1]) * rstd_cq, bflo(nv[2]) * rstd_cq, bfhi(nv[2]) * rstd_cq, bflo(nv[3]) * rstd_cq, bfhi(nv[3]) * rstd_cq};
      u16* dq = isctx ? QCA + ((size_t)(b * 8 + h) * CL + s) * 96 : QA + ((size_t)(b * 8 + h) * SEQ + s) * 96;
      head96(n, bflo(w1) * rstd_cq, bfhi(w1) * rstd_cq, bflo(w2) * rstd_cq, bfhi(w2) * rstd_cq, dq, t, rb, qgn, qgr, cM, sM, QS_A); }
    { const u16* kv = KVR + (size_t)r * 1024 + h * 128;
      const u32x4 nv = *(const u32x4*)(kv + 8 * t), vv = *(const u32x4*)(kv + 64 + 8 * t);
      const unsigned w1 = *(const unsigned*)(pp + 512 + rb), w2 = *(const unsigned*)(pp + 512 + rb + 8);
      float n[8] = {bflo(nv[0]) * rstd_ckv, bfhi(nv[0]) * rstd_ckv, bflo(nv[1]) * rstd_ckv, bfhi(nv[1]) * rstd_ckv, bflo(nv[2]) * rstd_ckv, bfhi(nv[2]) * rstd_ckv, bflo(nv[3]) * rstd_ckv, bfhi(nv[3]) * rstd_ckv};
      const size_t kr = (size_t)(b * 8 + h) * KVLEN + kpos;
      head96(n, bflo(w1), bfhi(w1), bflo(w2), bfhi(w2), KA + kr * 96, t, rb, kgn, kgr, cM, sM, 1.f);
      const u32x4 vo = {cvtpk(bflo(vv[0]) * rstd_ckv, bfhi(vv[0]) * rstd_ckv), cvtpk(bflo(vv[1]) * rstd_ckv, bfhi(vv[1]) * rstd_ckv),
                        cvtpk(bflo(vv[2]) * rstd_ckv, bfhi(vv[2]) * rstd_ckv), cvtpk(bflo(vv[3]) * rstd_ckv, bfhi(vv[3]) * rstd_ckv)};
      *(u32x4*)(VA + kr * 64 + 8 * t) = vo; }
    { u16* dg = isctx ? QCB + ((size_t)(b * 8 + h) * CL + s) * 64 : QB + ((size_t)(b * 8 + h) * SEQ + s) * 64;
      head64(pp + 544 + h * 64, dg, gb, gqg, cG, sG, QS_B); }
    if (h < 2) {
      const size_t kr = (size_t)(b * 2 + h) * KVLEN + kpos;
      head64(pp + 1056 + h * 64, KB + kr * 64, gb, gkg, cG, sG, 1.f);
      *(u32x4*)(VB + kr * 64 + 8 * t) = *(const u32x4*)(pp + 1184 + h * 64 + 8 * t);
    }
  }
}

__device__ void finalize1(const Params& p) {
  const int tid = opaque_tid(), lane = tid & 63, gw = blockIdx.x * 8 + (tid >> 6), nw = gridDim.x * 8;
  const int h = lane >> 3, t = lane & 7;
  char* ws = p.ws;
  const u16* PP = (const u16*)(ws + OFF_PP);
  u16* Q2 = (u16*)(ws + OFF_Q2); u16* K2 = (u16*)(ws + OFF_K2); u16* V2 = (u16*)(ws + OFF_V2);
  u16* MIX = (u16*)(ws + OFF_H);
  const int gb = t < 4 ? 4 * t : 32 + 4 * (t - 4);
  float qg[8], kg[8], invG[4];
#pragma unroll
  for (int e = 0; e < 8; ++e) { const int d = gb + (e & 3) + (e >> 2) * 16; qg[e] = p.win_q_gain[d]; kg[e] = p.win_k_gain[d]; }
#pragma unroll
  for (int e = 0; e < 4; ++e) invG[e] = exp2f(-(float)(4 * (t & 3) + e) * (13.287712379549449f / 16.f));
  float cw[3][8];
#pragma unroll
  for (int j = 0; j < 3; ++j)
#pragma unroll
    for (int e = 0; e < 8; ++e) cw[j][e] = p.conv_w[j * 512 + lane * 8 + e];
  for (int r = gw; r < NROW + 512; r += nw) {
    if (r >= NROW) {
      int slab = (r - NROW) >> 7, pr = (r - NROW) & 127;
      size_t kr = (size_t)slab * KV2LEN + KVLEN + pr;
      K2[kr * 64 + lane] = 0; V2[kr * 64 + lane] = 0;
      continue;
    }
    const bool isctx = r >= NLAT;
    int b, s, kpos; float pos = 0.f;
    if (!isctx) { b = r >> 14; s = r & 16383; kpos = CL + s; pos = t < 4 ? (float)(s >> 6) : (float)(s & 63); }
    else { int rc = r - NLAT; b = rc >> 8; s = rc & 255; kpos = s; }
    float cG[4], sG[4];
#pragma unroll
    for (int e = 0; e < 4; ++e) rope_cs(pos, invG[e], !isctx, cG[e], sG[e]);
    const u16* pp = PP + (size_t)r * LD_CD;
    if (!isctx) head64(pp + h * 64, Q2 + ((size_t)(b * 8 + h) * SEQ + s) * 64, gb, qg, cG, sG, QS_B);
    if (h < 2) {
      const size_t kr = (size_t)(b * 2 + h) * KV2LEN + kpos;
      head64(pp + 512 + h * 64, K2 + kr * 64, gb, kg, cG, sG, 1.f);
      *(u32x4*)(V2 + kr * 64 + 8 * t) = *(const u32x4*)(pp + 640 + h * 64 + 8 * t);
    }
    if (!isctx) {
      const int c0 = lane * 8;
      float y[8];
#pragma unroll
      for (int e = 0; e < 8; ++e) y[e] = 0.f;
#pragma unroll
      for (int j = 0; j < 3; ++j) {
        const int sj = s + j - 1;
        if (sj >= 0 && sj < SEQ) {
          const u16* pj = pp + (ptrdiff_t)(j - 1) * LD_CD;
          u32x4 a = *(const u32x4*)(pj + 1280 + c0), bb = *(const u32x4*)(pj + 1792 + c0);
#pragma unroll
          for (int e = 0; e < 4; ++e) {
            y[2 * e]     += bflo(a[e]) * bflo(bb[e]) * cw[j][2 * e];
            y[2 * e + 1] += bfhi(a[e]) * bfhi(bb[e]) * cw[j][2 * e + 1];
          }
        }
      }
      u32x4 gbv = *(const u32x4*)(pp + 768 + c0), gt = *(const u32x4*)(pp + 2304 + 512 + c0);
      u32x4 o;
#pragma unroll
      for (int e = 0; e < 4; ++e) {
        float v0 = bflo(gbv[e]) * y[2 * e] * silu_f(bflo(gt[e]));
        float v1 = bfhi(gbv[e]) * y[2 * e + 1] * silu_f(bfhi(gt[e]));
        o[e] = cvtpk(v0, v1);
      }
      *(u32x4*)(MIX + (size_t)r * 1024 + 512 + c0) = o;
    }
  }
}

#define KSWZ(row, colB) ((row) * 272 + (colB))
__device__ __forceinline__ int v_st2(int k, int c) { const int kk = k; return ((kk >> 3) * 2 + (c >> 5)) * 512 + ((kk & 7) * 32 + (c & 31)) * 2; }
__device__ __forceinline__ int v_rd_base(int lane) { return ((lane & 3) << 3) | (((lane >> 2) & 3) << 6) | (((lane >> 4) & 1) << 5) | (((lane >> 5) & 1) << 8); }
constexpr int v_rd_off2(int d0, int ks, int half) { return d0 * 512 + ks * 2048 + half * 1024; }
template <int OFF> __device__ __forceinline__ s16x4 tr_read(int vb) {
  s16x4 r; asm volatile("ds_read_b64_tr_b16 %0, %1 offset:%2" : "=&v"(r) : "v"(vb), "i"(OFF) : "memory"); return r;
}
template <int D0> __device__ __forceinline__ void pv_one(f32x16& od, int vb, bf16x8 pa0, bf16x8 pa1, bf16x8 pa2, bf16x8 pa3) {
  const s16x4 l0 = tr_read<v_rd_off2(D0, 0, 0)>(vb), h0 = tr_read<v_rd_off2(D0, 0, 1)>(vb), l1 = tr_read<v_rd_off2(D0, 1, 0)>(vb), h1 = tr_read<v_rd_off2(D0, 1, 1)>(vb);
  const s16x4 l2 = tr_read<v_rd_off2(D0, 2, 0)>(vb), h2 = tr_read<v_rd_off2(D0, 2, 1)>(vb), l3 = tr_read<v_rd_off2(D0, 3, 0)>(vb), h3 = tr_read<v_rd_off2(D0, 3, 1)>(vb);
  asm volatile("s_waitcnt lgkmcnt(0)" ::: "memory"); SBAR();
#define PK(L, H) (bf16x8){L[0], L[1], L[2], L[3], H[0], H[1], H[2], H[3]}
  od = __builtin_amdgcn_mfma_f32_32x32x16_bf16(pa0, PK(l0, h0), od, 0, 0, 0);
  od = __builtin_amdgcn_mfma_f32_32x32x16_bf16(pa1, PK(l1, h1), od, 0, 0, 0);
  od = __builtin_amdgcn_mfma_f32_32x32x16_bf16(pa2, PK(l2, h2), od, 0, 0, 0);
  od = __builtin_amdgcn_mfma_f32_32x32x16_bf16(pa3, PK(l3, h3), od, 0, 0, 0);
#undef PK
}
__device__ __forceinline__ void pv_all(f32x16* o, int vb, bf16x8 pa0, bf16x8 pa1, bf16x8 pa2, bf16x8 pa3) {
  pv_one<0>(o[0], vb, pa0, pa1, pa2, pa3); pv_one<1>(o[1], vb, pa0, pa1, pa2, pa3);
}
__device__ __forceinline__ void pv_exp(f32x16* o, int vb, bf16x8 pa0, bf16x8 pa1, bf16x8 pa2, bf16x8 pa3, f32x16& n0, f32x16& n1) {
#define PK(L, H) (bf16x8){L[0], L[1], L[2], L[3], H[0], H[1], H[2], H[3]}
  { const s16x4 l0 = tr_read<v_rd_off2(0, 0, 0)>(vb), h0 = tr_read<v_rd_off2(0, 0, 1)>(vb), l1 = tr_read<v_rd_off2(0, 1, 0)>(vb), h1 = tr_read<v_rd_off2(0, 1, 1)>(vb);
    const s16x4 l2 = tr_read<v_rd_off2(0, 2, 0)>(vb), h2 = tr_read<v_rd_off2(0, 2, 1)>(vb), l3 = tr_read<v_rd_off2(0, 3, 0)>(vb), h3 = tr_read<v_rd_off2(0, 3, 1)>(vb);
#pragma unroll
    for (int r = 0; r < 8; ++r) n0[r] = __builtin_amdgcn_exp2f(n0[r]);
    asm volatile("s_waitcnt lgkmcnt(0)" ::: "memory"); SBAR();
    o[0] = __builtin_amdgcn_mfma_f32_32x32x16_bf16(pa0, PK(l0, h0), o[0], 0, 0, 0);
    o[0] = __builtin_amdgcn_mfma_f32_32x32x16_bf16(pa1, PK(l1, h1), o[0], 0, 0, 0);
    o[0] = __builtin_amdgcn_mfma_f32_32x32x16_bf16(pa2, PK(l2, h2), o[0], 0, 0, 0);
    o[0] = __builtin_amdgcn_mfma_f32_32x32x16_bf16(pa3, PK(l3, h3), o[0], 0, 0, 0); }
  { const s16x4 l0 = tr_read<v_rd_off2(1, 0, 0)>(vb), h0 = tr_read<v_rd_off2(1, 0, 1)>(vb), l1 = tr_read<v_rd_off2(1, 1, 0)>(vb), h1 = tr_read<v_rd_off2(1, 1, 1)>(vb);
    const s16x4 l2 = tr_read<v_rd_off2(1, 2, 0)>(vb), h2 = tr_read<v_rd_off2(1, 2, 1)>(vb), l3 = tr_read<v_rd_off2(1, 3, 0)>(vb), h3 = tr_read<v_rd_off2(1, 3, 1)>(vb);
#pragma unroll
    for (int r = 8; r < 16; ++r) n0[r] = __builtin_amdgcn_exp2f(n0[r]);
    asm volatile("s_waitcnt lgkmcnt(0)" ::: "memory"); SBAR();
    o[1] = __builtin_amdgcn_mfma_f32_32x32x16_bf16(pa0, PK(l0, h0), o[1], 0, 0, 0);
    o[1] = __builtin_amdgcn_mfma_f32_32x32x16_bf16(pa1, PK(l1, h1), o[1], 0, 0, 0);
    o[1] = __builtin_amdgcn_mfma_f32_32x32x16_bf16(pa2, PK(l2, h2), o[1], 0, 0, 0);
    o[1] = __builtin_amdgcn_mfma_f32_32x32x16_bf16(pa3, PK(l3, h3), o[1], 0, 0, 0); }
#undef PK
#pragma unroll
  for (int r = 0; r < 16; ++r) n1[r] = __builtin_amdgcn_exp2f(n1[r]);
}

__device__ __forceinline__ void expall(f32x16& p0, f32x16& p1) {
#pragma unroll
  for (int r = 0; r < 16; ++r) p0[r] = __builtin_amdgcn_exp2f(p0[r]);
#pragma unroll
  for (int r = 0; r < 16; ++r) p1[r] = __builtin_amdgcn_exp2f(p1[r]);
}
__device__ __forceinline__ void finishSM(f32x16& p0, f32x16& p1, float& lsum, bf16x8& pa0, bf16x8& pa1, bf16x8& pa2, bf16x8& pa3) {
  float ps = 0;
#pragma unroll
  for (int r = 0; r < 16; ++r) ps += p0[r];
#pragma unroll
  for (int r = 0; r < 16; ++r) ps += p1[r];
  lsum += ps;
#define PK4(P, BASE, OUT) do { u32x4 w = {cvtpk(P[BASE + 0], P[BASE + 1]), cvtpk(P[BASE + 2], P[BASE + 3]), cvtpk(P[BASE + 4], P[BASE + 5]), cvtpk(P[BASE + 6], P[BASE + 7])}; \
    OUT = *reinterpret_cast<bf16x8*>(&w); } while (0)
  PK4(p0, 0, pa0); PK4(p0, 8, pa1); PK4(p1, 0, pa2); PK4(p1, 8, pa3);
#undef PK4
}
template <int NQK>
__device__ __forceinline__ void qkt(f32x16& p0, f32x16& p1, const char* Ks, const bf16x8* qr, int r32, int hi, const float shift) {
  p0 = f32x16{}; p1 = f32x16{};
#pragma unroll
  for (int d0 = 0; d0 < NQK; ++d0) { int cb = (d0 * 16 + hi * 8) * 2;
    bf16x8 b0 = *reinterpret_cast<const bf16x8*>(Ks + KSWZ(r32, cb));
    bf16x8 b1 = *reinterpret_cast<const bf16x8*>(Ks + KSWZ(32 + r32, cb));
    p0 = __builtin_amdgcn_mfma_f32_32x32x16_bf16(b0, qr[d0], p0, 0, 0, 0);
    p1 = __builtin_amdgcn_mfma_f32_32x32x16_bf16(b1, qr[d0], p1, 0, 0, 0); }
  if (__builtin_expect(shift != 0.f, 0)) {
#pragma unroll
    for (int r = 0; r < 16; ++r) { p0[r] -= shift; p1[r] -= shift; }
  }
}

#define PK4X(P, BASE, OUT) do { u32x4 w_ = {cvtpk(P[BASE + 0], P[BASE + 1]), cvtpk(P[BASE + 2], P[BASE + 3]), cvtpk(P[BASE + 4], P[BASE + 5]), cvtpk(P[BASE + 6], P[BASE + 7])}; \
    OUT = *reinterpret_cast<bf16x8*>(&w_); } while (0)
template <int NQK>
__device__ __forceinline__ void qkt_fin(f32x16& n0, f32x16& n1, const char* Ks, const bf16x8* qr, int r32, int hi, const float shift,
                                        f32x16& o0, f32x16& o1, float& lsum, bf16x8& pa0, bf16x8& pa1, bf16x8& pa2, bf16x8& pa3) {
  n0 = f32x16{}; n1 = f32x16{};
  float ps = 0.f;
  bf16x8 kc0 = *reinterpret_cast<const bf16x8*>(Ks + KSWZ(r32, (hi * 8) * 2));
  bf16x8 kc1 = *reinterpret_cast<const bf16x8*>(Ks + KSWZ(32 + r32, (hi * 8) * 2));
#pragma unroll
  for (int d0 = 0; d0 < NQK; ++d0) {
    bf16x8 kn0 = kc0, kn1 = kc1;
    if (d0 + 1 < NQK) { const int cb = ((d0 + 1) * 16 + hi * 8) * 2;
      kn0 = *reinterpret_cast<const bf16x8*>(Ks + KSWZ(r32, cb)); kn1 = *reinterpret_cast<const bf16x8*>(Ks + KSWZ(32 + r32, cb)); }
    n0 = __builtin_amdgcn_mfma_f32_32x32x16_bf16(kc0, qr[d0], n0, 0, 0, 0);
    n1 = __builtin_amdgcn_mfma_f32_32x32x16_bf16(kc1, qr[d0], n1, 0, 0, 0);
#define PIN(X) asm volatile("" : "+v"(X))
    if (NQK == 6) {
      if (d0 == 0) { PK4X(o0, 0, pa0); }
      if (d0 == 1) { PIN(o0); PK4X(o0, 8, pa1); }
      if (d0 == 2) { _Pragma("unroll") for (int r = 0; r < 16; ++r) ps += o0[r]; }
      if (d0 == 3) { PIN(o1); PK4X(o1, 0, pa2); _Pragma("unroll") for (int r = 0; r < 8; ++r) ps += o1[r]; }
      if (d0 == 4) { PIN(o1); PK4X(o1, 8, pa3); _Pragma("unroll") for (int r = 8; r < 16; ++r) ps += o1[r]; }
    } else {
      if (d0 == 0) { PK4X(o0, 0, pa0); PK4X(o0, 8, pa1); }
      if (d0 == 1) { _Pragma("unroll") for (int r = 0; r < 16; ++r) ps += o0[r]; }
      if (d0 == 2) { PIN(o1); PK4X(o1, 0, pa2); _Pragma("unroll") for (int r = 0; r < 8; ++r) ps += o1[r]; }
      if (d0 == 3) { PIN(o1); PK4X(o1, 8, pa3); _Pragma("unroll") for (int r = 8; r < 16; ++r) ps += o1[r]; }
    }
#undef PIN
    asm volatile("" : "+v"(ps), "+v"(pa0), "+v"(pa1), "+v"(pa2), "+v"(pa3));
    kc0 = kn0; kc1 = kn1;
    SBAR();
  }
  lsum += ps;
  if (__builtin_expect(shift != 0.f, 0)) {
#pragma unroll
    for (int r = 0; r < 16; ++r) { n0[r] -= shift; n1[r] -= shift; }
  }
}

template <int NQK, int MODE, int LDG>
__device__ __forceinline__ void attn_body(const u16* __restrict__ Qb, const u16* __restrict__ Kh, const u16* __restrict__ Vh,
                                          const int NT, const int q0, const float sink2, const float mbound,
                                          u16* __restrict__ mix0, const u16* __restrict__ gate0, char* lds) {
  constexpr int DK = NQK * 16;
  constexpr int SHM_V = 8192, SHM_K = 17408;
  int tid_ = threadIdx.x; asm volatile("" : "+v"(tid_));
  const int tid = tid_, wid = __builtin_amdgcn_readfirstlane(tid >> 6), lane = tid & 63, r32 = lane & 31, hi = lane >> 5;
  char* V_lds = lds; char* K_lds = lds + 5 * SHM_V;
  float* wsf = (float*)(lds + 5 * SHM_V + 5 * SHM_K) + wid * 64; float* li_l = wsf;
  float lsum = 0; f32x16 o[2] = {}; bf16x8 qr[NQK];
  const float shift = mbound > 80.f ? mbound - 80.f : 0.f;
  const u16* Qw = Qb + (size_t)(wid * 32 + r32) * DK + hi * 8;
#pragma unroll
  for (int d0 = 0; d0 < NQK; ++d0) qr[d0] = *(const bf16x8*)(Qw + d0 * 16);
  const int srow = tid >> 3, sc8 = tid & 7;
  const int kst0 = KSWZ(srow, sc8 * 16), kst1 = KSWZ(srow, 128 + sc8 * 16), vst = v_st2(srow, sc8 * 8);
  const int vb0 = (int)(uintptr_t)V_lds + v_rd_base(lane);
  const bool k1on = (NQK == 6) && (sc8 < 4);
  const unsigned koff0 = srow * DK + sc8 * 8, voff0 = srow * 64 + sc8 * 8;
  struct { bf16x8 k0, k1, v0; } st[2];
#define TROW(j) (MODE == 0 ? (j) * 64 : ((j) < 4 ? (j) * 64 : q0 + 128 + ((j) - 4) * 64))
#define SLOAD(i, kr) do { const u16* kp_ = Kh + (unsigned)((kr) * DK); st[i].k0 = *(const bf16x8*)(kp_ + koff0);   \
    if (k1on) st[i].k1 = *(const bf16x8*)(kp_ + koff0 + 64);                                                           \
    const u16* vp_ = Vh + (unsigned)((kr) * 64); st[i].v0 = *(const bf16x8*)(vp_ + voff0); } while (0)
#define SWRITE(b, i) do { *(bf16x8*)(K_lds + (b) * SHM_K + kst0) = st[i].k0; if (k1on) *(bf16x8*)(K_lds + (b) * SHM_K + kst1) = st[i].k1; \
    *(bf16x8*)(V_lds + (b) * SHM_V + vst) = st[i].v0; } while (0)
#define MASKT(P0, P1, j) do { if (MODE == 1 && (j) >= 4) { const int kb_ = q0 - 128 + ((j) - 4) * 64, qp_ = q0 + wid * 32 + r32;    \
    _Pragma("unroll") for (int r = 0; r < 16; ++r) { int k0_ = kb_ + crow(r, hi), k1_ = k0_ + 32; int d0_ = qp_ - k0_, d1_ = qp_ - k1_; \
      bool ok0 = (d0_ <= 128) && (d0_ >= -128) && (k0_ >= 0) && (k0_ < SEQ); bool ok1 = (d1_ <= 128) && (d1_ >= -128) && (k1_ >= 0) && (k1_ < SEQ); \
      P0[r] = ok0 ? P0[r] : -1e30f; P1[r] = ok1 ? P1[r] : -1e30f; } } } while (0)
  f32x16 pA0, pA1, pB0, pB1; bf16x8 pa0, pa1, pa2, pa3;
#define NXS(x) ((x) + 1 == 5 ? 0 : (x) + 1)
  __syncthreads();
  SLOAD(0, TROW(0)); asm volatile("s_waitcnt vmcnt(0)" ::: "memory"); SWRITE(0, 0);
  SLOAD(0, TROW(1)); SWRITE(1, 0);
  SLOAD(0, TROW(2)); SWRITE(2, 0);
  if (3 < NT) SLOAD(0, TROW(3));
  if (4 < NT) SLOAD(1, TROW(4));
  __syncthreads();
  qkt<NQK>(pA0, pA1, K_lds, qr, r32, hi, shift); MASKT(pA0, pA1, 0); expall(pA0, pA1);
  int c = 0;
  for (int j = 1; j + 1 < NT; j += 2) {
    const int sj = NXS(c), sj1 = NXS(sj), sj2 = NXS(sj1), sj3 = NXS(sj2);
    SBAR(); SWRITE(sj2, 0); if (j + 3 < NT) SWRITE(sj3, 1); SBAR();
    qkt_fin<NQK>(pB0, pB1, K_lds + sj * SHM_K, qr, r32, hi, shift, pA0, pA1, lsum, pa0, pa1, pa2, pa3); MASKT(pB0, pB1, j); SBAR();
    if (j + 4 < NT) SLOAD(0, TROW(j + 4)); SBAR();
    pv_exp(o, vb0 + c * SHM_V, pa0, pa1, pa2, pa3, pB0, pB1);
    SBAR();
    qkt_fin<NQK>(pA0, pA1, K_lds + sj1 * SHM_K, qr, r32, hi, shift, pB0, pB1, lsum, pa0, pa1, pa2, pa3); MASKT(pA0, pA1, j + 1); SBAR();
    if (j + 5 < NT) SLOAD(1, TROW(j + 5)); SBAR();
    pv_exp(o, vb0 + sj * SHM_V, pa0, pa1, pa2, pa3, pA0, pA1);
    __syncthreads();
    c = sj1;
  }
  { const int sl = NXS(c);
    SBAR(); qkt_fin<NQK>(pB0, pB1, K_lds + sl * SHM_K, qr, r32, hi, shift, pA0, pA1, lsum, pa0, pa1, pa2, pa3); MASKT(pB0, pB1, NT - 1); SBAR();
    pv_all(o, vb0 + c * SHM_V, pa0, pa1, pa2, pa3); expall(pB0, pB1);
    finishSM(pB0, pB1, lsum, pa0, pa1, pa2, pa3); SBAR();
    pv_all(o, vb0 + sl * SHM_V, pa0, pa1, pa2, pa3); }
#undef NXS
  float l_reg;
  { auto rr = __builtin_amdgcn_permlane32_swap(__float_as_uint(lsum), __float_as_uint(lsum), false, false);
    l_reg = __uint_as_float(rr[0]) + __uint_as_float(rr[1]); }
  if (MODE == 1) l_reg += __builtin_amdgcn_exp2f(sink2 - shift);
  if (hi == 0) li_l[r32] = l_reg; asm volatile("s_waitcnt lgkmcnt(0)" ::: "memory");
  float rli[16];
#pragma unroll
  for (int r = 0; r < 16; ++r) rli[r] = __builtin_amdgcn_rcpf(li_l[crow(r, hi)]);
#pragma unroll
  for (int r = 0; r < 16; ++r) { const int orow = wid * 32 + crow(r, hi);
#pragma unroll
    for (int d0 = 0; d0 < 2; ++d0) {
      const float g = bf2f(gate0[(size_t)orow * LDG + d0 * 32 + r32]);
      mix0[(size_t)orow * 1024 + d0 * 32 + r32] = f2bf(o[d0][r] * rli[r] * silu_f(g));
    } }
#undef TROW
#undef SLOAD
#undef SWRITE
#undef MASKT
}

template <int NQK, int LDG>
__device__ __forceinline__ void attn_body2(const u16* __restrict__ Qb, const u16* __restrict__ Kh, const u16* __restrict__ Vh,
                                           const int NT, const float mbound, u16* __restrict__ mix0, const u16* __restrict__ gate0, char* lds) {
  constexpr int DK = NQK * 16;
  constexpr int SHM_V = 8192, SHM_K = 17408;
  int tid_ = threadIdx.x; asm volatile("" : "+v"(tid_));
  const int tid = tid_, wid = __builtin_amdgcn_readfirstlane(tid >> 6), lane = tid & 63, r32 = lane & 31, hi = lane >> 5;
  char* V_lds = lds; char* K_lds = lds + 5 * SHM_V;
  float* wsf = (float*)(lds + 5 * SHM_V + 5 * SHM_K) + wid * 64;
  float lsA = 0, lsB = 0; f32x16 oA[2] = {}, oB[2] = {}; bf16x8 qA[NQK], qB[NQK];
  const float shift = mbound > 80.f ? mbound - 80.f : 0.f;
  const u16* Qw = Qb + (size_t)(wid * 64 + r32) * DK + hi * 8;
#pragma unroll
  for (int d0 = 0; d0 < NQK; ++d0) { qA[d0] = *(const bf16x8*)(Qw + d0 * 16); qB[d0] = *(const bf16x8*)(Qw + 32 * DK + d0 * 16); }
  const int srow = tid >> 3, sc8 = tid & 7;
  const int kst0 = KSWZ(srow, sc8 * 16), kst1 = KSWZ(srow, 128 + sc8 * 16), vst = v_st2(srow, sc8 * 8);
  const int vb0 = (int)(uintptr_t)V_lds + v_rd_base(lane);
  const bool k1on = (NQK == 6) && (sc8 < 4);
  const unsigned koff0 = srow * DK + sc8 * 8, voff0 = srow * 64 + sc8 * 8;
  struct { bf16x8 k0, k1, v0; } st[2];
#define SLOAD(i, kr) do { const u16* kp_ = Kh + (unsigned)((kr) * DK); st[i].k0 = *(const bf16x8*)(kp_ + koff0);   \
    if (k1on) st[i].k1 = *(const bf16x8*)(kp_ + koff0 + 64);                                                           \
    const u16* vp_ = Vh + (unsigned)((kr) * 64); st[i].v0 = *(const bf16x8*)(vp_ + voff0); } while (0)
#define SWRITE(b, i) do { *(bf16x8*)(K_lds + (b) * SHM_K + kst0) = st[i].k0; if (k1on) *(bf16x8*)(K_lds + (b) * SHM_K + kst1) = st[i].k1; \
    *(bf16x8*)(V_lds + (b) * SHM_V + vst) = st[i].v0; } while (0)
#define NXS(x) ((x) + 1 == 5 ? 0 : (x) + 1)
#define UNIT(PN0, PN1, QN, KS, PO0, PO1, LSO, OO, VS) do {                                                                      \
    qkt_fin<NQK>(PN0, PN1, K_lds + (KS) * SHM_K, QN, r32, hi, shift, PO0, PO1, LSO, pa0, pa1, pa2, pa3); SBAR();               \
    pv_exp(OO, vb0 + (VS) * SHM_V, pa0, pa1, pa2, pa3, PN0, PN1); SBAR(); } while (0)
  f32x16 pA0, pA1, pB0, pB1; bf16x8 pa0, pa1, pa2, pa3;
  __syncthreads();
  SLOAD(0, 0); asm volatile("s_waitcnt vmcnt(0)" ::: "memory"); SWRITE(0, 0);
  SLOAD(0, 64); SWRITE(1, 0);
  SLOAD(0, 128); SWRITE(2, 0);
  if (3 < NT) SLOAD(0, 3 * 64);
  if (4 < NT) SLOAD(1, 4 * 64);
  __syncthreads();
  qkt<NQK>(pA0, pA1, K_lds, qA, r32, hi, shift); expall(pA0, pA1);
  int c = 0;
  for (int i = 0; 2 * i + 2 < NT; ++i) {
    const int s1 = NXS(c), s2 = NXS(s1), s3 = NXS(s2), s4 = NXS(s3);
    SBAR(); if (2 * i + 3 < NT) SWRITE(s3, 0); if (2 * i + 4 < NT) SWRITE(s4, 1); SBAR();
    UNIT(pB0, pB1, qB, c, pA0, pA1, lsA, oA, c);
    if (2 * i + 5 < NT) SLOAD(0, (2 * i + 5) * 64); SBAR();
    UNIT(pA0, pA1, qA, s1, pB0, pB1, lsB, oB, c);
    if (2 * i + 6 < NT) SLOAD(1, (2 * i + 6) * 64); SBAR();
    UNIT(pB0, pB1, qB, s1, pA0, pA1, lsA, oA, s1);
    UNIT(pA0, pA1, qA, s2, pB0, pB1, lsB, oB, s1);
    __syncthreads();
    c = s2;
  }
  { const int s1 = NXS(c);
    UNIT(pB0, pB1, qB, c, pA0, pA1, lsA, oA, c);
    UNIT(pA0, pA1, qA, s1, pB0, pB1, lsB, oB, c);
    UNIT(pB0, pB1, qB, s1, pA0, pA1, lsA, oA, s1);
    finishSM(pB0, pB1, lsB, pa0, pa1, pa2, pa3); SBAR();
    pv_all(oB, vb0 + s1 * SHM_V, pa0, pa1, pa2, pa3); }
#undef UNIT
#undef NXS
#undef SLOAD
#undef SWRITE
  float lA, lB;
  { auto rr = __builtin_amdgcn_permlane32_swap(__float_as_uint(lsA), __float_as_uint(lsA), false, false); lA = __uint_as_float(rr[0]) + __uint_as_float(rr[1]); }
  { auto rr = __builtin_amdgcn_permlane32_swap(__float_as_uint(lsB), __float_as_uint(lsB), false, false); lB = __uint_as_float(rr[0]) + __uint_as_float(rr[1]); }
  if (hi == 0) { wsf[r32] = lA; wsf[32 + r32] = lB; }
  asm volatile("s_waitcnt lgkmcnt(0)" ::: "memory");
#pragma unroll
  for (int g = 0; g < 2; ++g) {
    float rli[16];
#pragma unroll
    for (int r = 0; r < 16; ++r) rli[r] = __builtin_amdgcn_rcpf(wsf[g * 32 + crow(r, hi)]);
#pragma unroll
    for (int r = 0; r < 16; ++r) { const int orow = wid * 64 + g * 32 + crow(r, hi);
#pragma unroll
      for (int d0 = 0; d0 < 2; ++d0) {
        const float gt = bf2f(gate0[(size_t)orow * LDG + d0 * 32 + r32]);
        const float ov = g == 0 ? oA[d0][r] : oB[d0][r];
        mix0[(size_t)orow * 1024 + d0 * 32 + r32] = f2bf(ov * rli[r] * silu_f(gt));
      } }
  }
}

__global__ void __launch_bounds__(512, 1) mega(Params p) {
  extern __shared__ __attribute__((aligned(16))) char lds[];
  cg::grid_group grid = cg::this_grid();
  const int bid = blockIdx.x, nblk = gridDim.x;
  char* ws = p.ws;
  float* modv = (float*)(ws + OFF_MODV);
  u16* H = (u16*)(ws + OFF_H);
  u16* PP = (u16*)(ws + OFF_PP);
  float* XC1 = (float*)(ws + OFF_XC1);
  unsigned* gcnt = (unsigned*)(ws + OFF_END);
  if (bid == 0 && threadIdx.x == 0) __hip_atomic_store(gcnt, 0u, __ATOMIC_RELAXED, __HIP_MEMORY_SCOPE_AGENT);

  if (p.ph_lo <= 0 && 0 < p.ph_hi) {
  for (int u = bid; u < 192; u += nblk) mod_unit(p, u, lds);
  }
  if (p.ph_lo <= 0 && 0 + 1 < p.ph_hi) grid.sync();
  if (p.ph_lo <= 1 && 1 < p.ph_hi) {
  for (int u = bid; u < 2064; u += nblk) transpose_unit(p, u, lds);
  adaln_phase(p.x, nullptr, p.ctx, modv, H);
  }
  if (p.ph_lo <= 1 && 1 + 1 < p.ph_hi) gbar(gcnt, 1u * gridDim.x);
  if (p.ph_lo <= 2 && 2 < p.ph_hi) {
  { TileIter ti(130, 19); GPre g; int nt = 0, mt = 0; const u16* Wt = (const u16*)(ws + OFF_WT_IN_AB);
    if (ti.valid()) { ti.get(mt, nt); gemm_preload(H, 1024, Wt, 1024, mt * 256, nt * 128, g); }
    while (ti.valid()) {
      f32x16 acc[2][2]; const int m0 = mt * 256, n0 = nt * 128;
      gemm_tile<0>(H, 1024, Wt, 1024, 1024, m0, n0, acc, lds, g);
      ti.next(); if (ti.valid()) { ti.get(mt, nt); gemm_preload(H, 1024, Wt, 1024, mt * 256, nt * 128, g); }
      epi_bf16(acc, PP, LD_AB, m0, n0, lds);
    } }
  }
  if (p.ph_lo <= 2 && 2 + 1 < p.ph_hi) gbar(gcnt, 2u * gridDim.x);
  if (p.ph_lo <= 3 && 3 < p.ph_hi) {
  { TileIter ti(130, 14); GPre g; int nt = 0, mt = 0;
    const u16* Wq = (const u16*)(ws + OFF_WT_UQ); const u16* Wkv = (const u16*)(ws + OFF_WT_UKV);
    if (ti.valid()) { ti.get(mt, nt); gemm_preload(nt < 6 ? PP : PP + 256, LD_AB, nt < 6 ? Wq : Wkv, 256, mt * 256, (nt < 6 ? nt : nt - 6) * 128, g); }
    while (ti.valid()) {
      f32x16 acc[2][2]; const int m0 = mt * 256, cn = nt, n0 = (nt < 6 ? nt : nt - 6) * 128;
      gemm_tile<0>(cn < 6 ? PP : PP + 256, LD_AB, cn < 6 ? Wq : Wkv, 256, 256, m0, n0, acc, lds, g);
      ti.next(); if (ti.valid()) { ti.get(mt, nt); gemm_preload(nt < 6 ? PP : PP + 256, LD_AB, nt < 6 ? Wq : Wkv, 256, mt * 256, (nt < 6 ? nt : nt - 6) * 128, g); }
      if (cn < 6) epi_bf16(acc, H, 768, m0, n0, lds); else epi_bf16(acc, (u16*)p.out, 1024, m0, n0, lds);
    } }
  }
  if (p.ph_lo <= 3 && 3 + 1 < p.ph_hi) gbar(gcnt, 3u * gridDim.x);
  if (p.ph_lo <= 4 && 4 < p.ph_hi) {
  finalize0(p);
  }
  if (p.ph_lo <= 4 && 4 + 1 < p.ph_hi) gbar(gcnt, 4u * gridDim.x);
  if (p.ph_lo <= 5 && 5 < p.ph_hi) {
  const float mbA = LOG2E * 9.7979590f * 1.02f * vmaxabs(p.q_gain, 96) * vmaxabs(p.k_gain, 96);
  const float mbB = LOG2E * 8.f * 1.02f * vmaxabs(p.gq_gain, 64) * vmaxabs(p.gk_gain, 64);
  for (int it = bid; it < 1568; it += nblk) {
    if (it < 1024) {
      const int round = it >> 8, blk = it & 255, xcd = blk & 7, cl = blk >> 3;
      const int pair = xcd * 2 + (round >> 1), b = pair >> 3, h = pair & 7, qoff = ((round & 1) * 32 + cl) * 256;
      const size_t r0 = (size_t)b * SEQ + qoff;
      attn_body<6, 0, LD_AB>((const u16*)(ws + OFF_QA) + ((size_t)(b * 8 + h) * SEQ + qoff) * 96,
                             (const u16*)(ws + OFF_KA) + (size_t)(b * 8 + h) * KVLEN * 96, (const u16*)(ws + OFF_VA) + (size_t)(b * 8 + h) * KVLEN * 64,
                             KVLEN / 64, 0, 0.f, mbA, H + r0 * 1024 + h * 64, PP + r0 * LD_AB + 1312 + h * 64, lds);
    } else if (it < 1536) {
      const int i2 = it - 1024, g = i2 >> 8, blk = i2 & 255, xcd = blk & 7, cl = blk >> 3;
      const int pi = xcd >> 1, b = pi >> 1, kvh = pi & 1, idx = (xcd & 1) * 64 + g * 32 + cl;
      const int h = kvh * 4 + (idx >> 5), qoff = (idx & 31) * 512;
      const size_t r0 = (size_t)b * SEQ + qoff;
      attn_body2<4, LD_AB>((const u16*)(ws + OFF_QB) + ((size_t)(b * 8 + h) * SEQ + qoff) * 64,
                           (const u16*)(ws + OFF_KB) + (size_t)(b * 2 + kvh) * KVLEN * 64, (const u16*)(ws + OFF_VB) + (size_t)(b * 2 + kvh) * KVLEN * 64,
                           KVLEN / 64, mbB, H + r0 * 1024 + 512 + h * 64, PP + r0 * LD_AB + 1312 + 512 + h * 64, lds);
    } else {
      const int ci = it - 1536, b = (ci >> 3) & 1, h = ci & 7; const bool mla = ci < 16; const int kvh = mla ? h : (h >> 2);
      const size_t r0 = (size_t)NLAT + b * CL, qrow = (size_t)(b * 8 + h) * CL;
      if (mla) attn_body<6, 0, LD_AB>((const u16*)(ws + OFF_QCA) + qrow * 96, (const u16*)(ws + OFF_KA) + (size_t)(b * 8 + kvh) * KVLEN * 96,
                                      (const u16*)(ws + OFF_VA) + (size_t)(b * 8 + kvh) * KVLEN * 64, CL / 64, 0, 0.f, mbA, H + r0 * 1024 + h * 64, PP + r0 * LD_AB + 1312 + h * 64, lds);
      else attn_body<4, 0, LD_AB>((const u16*)(ws + OFF_QCB) + qrow * 64, (const u16*)(ws + OFF_KB) + (size_t)(b * 2 + kvh) * KVLEN * 64,
                                  (const u16*)(ws + OFF_VB) + (size_t)(b * 2 + kvh) * KVLEN * 64, CL / 64, 0, 0.f, mbB, H + r0 * 1024 + 512 + h * 64, PP + r0 * LD_AB + 1312 + 512 + h * 64, lds);
    }
  }
  }
  if (p.ph_lo <= 5 && 5 + 1 < p.ph_hi) gbar(gcnt, 5u * gridDim.x);
  if (p.ph_lo <= 6 && 6 < p.ph_hi) {
  { TileIter ti(130, 8); GPre g; int nt = 0, mt = 0; const u16* Wt = (const u16*)(ws + OFF_WT_OUT_AB);
    if (ti.valid()) { ti.get(mt, nt); gemm_preload(H, 1024, Wt, 1024, mt * 256, nt * 128, g); }
    while (ti.valid()) {
      f32x16 acc[2][2]; const int m0 = mt * 256, n0 = nt * 128; const bool lat = m0 < NLAT;
      const int tid_ = opaque_tid(), wid_ = tid_ >> 6, lane_ = tid_ & 63;
      const size_t eoff = (size_t)((lat ? m0 : m0 - NLAT) + (wid_ & 3) * 64 + (lane_ >> 4)) * 1024 + n0 + (wid_ >> 2) * 64 + 4 * (lane_ & 15);
      ResPre rp;
      gemm_tile<1>(H, 1024, Wt, 1024, 1024, m0, n0, acc, lds, g, (lat ? p.x : p.ctx) + eoff, &rp);
      ti.next(); if (ti.valid()) { ti.get(mt, nt); gemm_preload(H, 1024, Wt, 1024, mt * 256, nt * 128, g); }
      if (lat) epi_res<false, true>(acc, rp, (u16*)(ws + OFF_X1B) + eoff, modv + (m0 >> 14) * 3072 + 2048, n0, lds);
      else epi_res<false, false>(acc, rp, XC1 + eoff, modv + 2 * 3072 + 2048, n0, lds);
    } }
  }
  if (p.ph_lo <= 6 && 6 + 1 < p.ph_hi) gbar(gcnt, 6u * gridDim.x);
  if (p.ph_lo <= 7 && 7 < p.ph_hi) {
  adaln_phase(nullptr, (const u16*)(ws + OFF_X1B), XC1, modv + 3 * 3072, H);
  }
  if (p.ph_lo <= 7 && 7 + 1 < p.ph_hi) gbar(gcnt, 7u * gridDim.x);
  if (p.ph_lo <= 8 && 8 < p.ph_hi) {
  { TileIter ti(130, 26); GPre g; int nt = 0, mt = 0; const u16* Wt = (const u16*)(ws + OFF_WT_IN_CD);
    if (ti.valid()) { ti.get(mt, nt); gemm_preload(H, 1024, Wt, 1024, mt * 256, nt * 128, g); }
    while (ti.valid()) {
      f32x16 acc[2][2]; const int m0 = mt * 256, n0 = nt * 128;
      gemm_tile<0>(H, 1024, Wt, 1024, 1024, m0, n0, acc, lds, g);
      ti.next(); if (ti.valid()) { ti.get(mt, nt); gemm_preload(H, 1024, Wt, 1024, mt * 256, nt * 128, g); }
      epi_bf16(acc, PP, LD_CD, m0, n0, lds);
    } }
  }
  if (p.ph_lo <= 8 && 8 + 1 < p.ph_hi) gbar(gcnt, 8u * gridDim.x);
  if (p.ph_lo <= 9 && 9 < p.ph_hi) {
  finalize1(p);
  }
  if (p.ph_lo <= 9 && 9 + 1 < p.ph_hi) gbar(gcnt, 9u * gridDim.x);
  if (p.ph_lo <= 10 && 10 < p.ph_hi) {
  const float mbW = LOG2E * 8.f * 1.02f * vmaxabs(p.win_q_gain, 64) * vmaxabs(p.win_k_gain, 64);
  for (int it = bid; it < 1024; it += nblk) {
    const int g = it >> 8, blk = it & 255, xcd = blk & 7, cl = blk >> 3;
    const int pi = xcd >> 1, b = pi >> 1, kvh = pi & 1, idx = (xcd & 1) * 128 + g * 32 + cl;
    const int h = kvh * 4 + (idx >> 6), qblk = idx & 63;
    const size_t r0 = (size_t)b * SEQ + qblk * 256;
    attn_body<4, 1, LD_CD>((const u16*)(ws + OFF_Q2) + ((size_t)(b * 8 + h) * SEQ + qblk * 256) * 64,
                    (const u16*)(ws + OFF_K2) + (size_t)(b * 2 + kvh) * KV2LEN * 64, (const u16*)(ws + OFF_V2) + (size_t)(b * 2 + kvh) * KV2LEN * 64,
                    12, qblk * 256, p.win_sink[h] * LOG2E, mbW, H + r0 * 1024 + h * 64, PP + r0 * LD_CD + 2304 + h * 64, lds);
  }
  }
  if (p.ph_lo <= 10 && 10 + 1 < p.ph_hi) gbar(gcnt, 10u * gridDim.x);
  if (p.ph_lo <= 11 && 11 < p.ph_hi) {
  { TileIter ti(128, 8); GPre g; int nt = 0, mt = 0; const u16* Wt = (const u16*)(ws + OFF_WT_OUT_CD);
    if (ti.valid()) { ti.get(mt, nt); gemm_preload(H, 1024, Wt, 1024, mt * 256, nt * 128, g); }
    while (ti.valid()) {
      f32x16 acc[2][2]; const int m0 = mt * 256, n0 = nt * 128;
      const int tid_ = opaque_tid(), wid_ = tid_ >> 6, lane_ = tid_ & 63;
      const size_t eoff = (size_t)(m0 + (wid_ & 3) * 64 + (lane_ >> 4)) * 1024 + n0 + (wid_ >> 2) * 64 + 4 * (lane_ & 15);
      ResPre rp;
      gemm_tile<2>(H, 1024, Wt, 1024, 1024, m0, n0, acc, lds, g, (const u16*)(ws + OFF_X1B) + eoff, &rp);
      ti.next(); if (ti.valid()) { ti.get(mt, nt); gemm_preload(H, 1024, Wt, 1024, mt * 256, nt * 128, g); }
      epi_res<true, false>(acc, rp, p.out + eoff, modv + 3 * 3072 + (m0 >> 14) * 3072 + 2048, n0, lds);
    } }
  }
}

extern "C" void kernel_launch(void* const* d_in, const int* in_sizes, int n_in, void* d_out, int out_size, void* d_ws, size_t ws_size, hipStream_t stream) {
  static int grid_blocks = 0;
  if (!grid_blocks) {
    if (n_in != 22 || out_size != NLAT * DM || ws_size < OFF_END + 4096) {
      fprintf(stderr, "kernel_launch: shape/ws mismatch n_in %d out %d ws %zu need %zu\n", n_in, out_size, ws_size, (size_t)OFF_END);
      return;
    }
    if (hipFuncSetAttribute((const void*)mega, hipFuncAttributeMaxDynamicSharedMemorySize, LDS_BYTES) != hipSuccess) {
      fprintf(stderr, "kernel_launch: hipFuncSetAttribute failed\n"); return;
    }
    int dev = 0, cus = 0, per_cu = 0;
    (void)hipGetDevice(&dev);
    (void)hipDeviceGetAttribute(&cus, hipDeviceAttributeMultiprocessorCount, dev);
    (void)hipOccupancyMaxActiveBlocksPerMultiprocessor(&per_cu, mega, 512, LDS_BYTES);
    if (per_cu < 1) { fprintf(stderr, "kernel_launch: occupancy 0\n"); return; }
    grid_blocks = cus;
  }
  Params p{};
  p.x = (const float*)d_in[0]; p.c = (const float*)d_in[1]; p.ctx = (const float*)d_in[2]; p.c_ctx = (const float*)d_in[3];
  p.mod_w = (const float*)d_in[4]; p.mod_b = (const float*)d_in[5]; p.ab_w_in = (const float*)d_in[6]; p.ab_w_out = (const float*)d_in[7];
  p.cq_gain = (const float*)d_in[8]; p.ckv_gain = (const float*)d_in[9]; p.w_uq = (const float*)d_in[10]; p.w_ukv = (const float*)d_in[11];
  p.q_gain = (const float*)d_in[12]; p.k_gain = (const float*)d_in[13]; p.gq_gain = (const float*)d_in[14]; p.gk_gain = (const float*)d_in[15];
  p.cd_w_in = (const float*)d_in[16]; p.cd_w_out = (const float*)d_in[17]; p.win_q_gain = (const float*)d_in[18]; p.win_k_gain = (const float*)d_in[19];
  p.win_sink = (const float*)d_in[20]; p.conv_w = (const float*)d_in[21];
  p.out = (float*)d_out; p.ws = (char*)d_ws;
#if MULTI_LAUNCH
  for (int ph = 0; ph < 12; ++ph) {
    p.ph_lo = ph; p.ph_hi = ph + 1;
    hipLaunchKernelGGL(mega, dim3(grid_blocks), dim3(512), LDS_BYTES, stream, p);
  }
#else
  p.ph_lo = 0; p.ph_hi = 12;
  void* args[] = {&p};
  hipError_t e = hipLaunchCooperativeKernel((void*)mega, dim3(grid_blocks), dim3(512), args, LDS_BYTES, stream);
  if (e != hipSuccess) fprintf(stderr, "cooperative launch failed: %s (grid %d)\n", hipGetErrorString(e), grid_blocks);
#endif
}
```

```cpp
#include <hip/hip_runtime.h>
#include <hip/hip_cooperative_groups.h>
#include <cstdio>
#include <cstdint>
namespace cg = cooperative_groups;

typedef unsigned short u16;
using bf16x8 = __attribute__((ext_vector_type(8))) short;
using s16x4  = __attribute__((ext_vector_type(4))) short;
using f32x16 = __attribute__((ext_vector_type(16))) float;
using u32x4  = __attribute__((ext_vector_type(4))) unsigned;
using u32x2  = __attribute__((ext_vector_type(2))) unsigned;

constexpr int NB = 2, SEQ = 16384, DM = 1024, CL = 256;
constexpr int NLAT = NB * SEQ;
constexpr int NROW = NLAT + NB * CL;
constexpr int KVLEN = CL + SEQ;
constexpr int KV2LEN = KVLEN + 128;
constexpr int LD_AB = 2432, LD_CD = 3328;
constexpr float EPS = 1e-6f;
constexpr float QS_A = 0.14724461f;
constexpr float QS_B = 0.18033688f;
constexpr float LOG2E = 1.4426950408889634f;

constexpr size_t OFF_MODV      = 0;
constexpr size_t OFF_WT_IN_AB  = 73728;
constexpr size_t OFF_WT_OUT_AB = OFF_WT_IN_AB + (size_t)LD_AB * 1024 * 2;
constexpr size_t OFF_WT_UQ     = OFF_WT_OUT_AB + (size_t)1024 * 1024 * 2;
constexpr size_t OFF_WT_UKV    = OFF_WT_UQ + (size_t)768 * 256 * 2;
constexpr size_t OFF_WT_IN_CD  = OFF_WT_UKV + (size_t)1024 * 256 * 2;
constexpr size_t OFF_WT_OUT_CD = OFF_WT_IN_CD + (size_t)3328 * 1024 * 2;
constexpr size_t OFF_XC1       = OFF_WT_OUT_CD + (size_t)1024 * 1024 * 2;
constexpr size_t OFF_H         = OFF_XC1 + (size_t)512 * 1024 * 4;
constexpr size_t OFF_PP        = OFF_H + (size_t)NROW * 1024 * 2;
constexpr size_t OFF_QA        = OFF_PP + (size_t)NROW * 3328 * 2;
constexpr size_t OFF_QCA       = OFF_QA + (size_t)NB * 8 * SEQ * 96 * 2;
constexpr size_t OFF_KA        = OFF_QCA + (size_t)NB * 8 * CL * 96 * 2;
constexpr size_t OFF_VA        = OFF_KA + (size_t)NB * 8 * KVLEN * 96 * 2;
constexpr size_t OFF_QB        = OFF_VA + (size_t)NB * 8 * KVLEN * 64 * 2;
constexpr size_t OFF_QCB       = OFF_QB + (size_t)NB * 8 * SEQ * 64 * 2;
constexpr size_t OFF_KB        = OFF_QCB + (size_t)NB * 8 * CL * 64 * 2;
constexpr size_t OFF_VB        = OFF_KB + (size_t)NB * 2 * KVLEN * 64 * 2;
constexpr size_t OFF_END       = OFF_VB + (size_t)NB * 2 * KVLEN * 64 * 2;
constexpr size_t OFF_Q2        = OFF_QA;
constexpr size_t OFF_K2        = OFF_Q2 + (size_t)NB * 8 * SEQ * 64 * 2;
constexpr size_t OFF_V2        = OFF_K2 + (size_t)NB * 2 * KV2LEN * 64 * 2;
constexpr size_t OFF_X1B       = OFF_QA + ((size_t)64 << 20);
static_assert(OFF_V2 + (size_t)NB * 2 * KV2LEN * 64 * 2 <= OFF_X1B && OFF_X1B + (size_t)NLAT * 1024 * 2 <= OFF_END, "x1 alias");
static_assert(OFF_V2 + (size_t)NB * 2 * KV2LEN * 64 * 2 <= OFF_END, "alias overflow");

constexpr int LDS_BYTES = 147456;
#ifndef MULTI_LAUNCH
#define MULTI_LAUNCH 0
#endif

struct Params {
  const float *x, *c, *ctx, *c_ctx, *mod_w, *mod_b, *ab_w_in, *ab_w_out, *cq_gain, *ckv_gain, *w_uq, *w_ukv,
      *q_gain, *k_gain, *gq_gain, *gk_gain, *cd_w_in, *cd_w_out, *win_q_gain, *win_k_gain, *win_sink, *conv_w;
  float* out;
  char* ws;
  int ph_lo, ph_hi;
};

#define SBAR() __builtin_amdgcn_sched_barrier(0)
__device__ __forceinline__ int crow(int r, int hi) { return (r & 3) + 8 * (r >> 2) + 4 * hi; }
typedef float f32x2_t __attribute__((ext_vector_type(2)));
typedef __bf16 bf16x2_t __attribute__((ext_vector_type(2)));
__device__ __forceinline__ unsigned cvtpk(float lo, float hi) { f32x2_t v = {lo, hi}; bf16x2_t b = __builtin_convertvector(v, bf16x2_t); return __builtin_bit_cast(unsigned, b); }
__device__ __forceinline__ u16 f2bf(float x) { return (u16)(cvtpk(x, 0.f) & 0xffffu); }
__device__ __forceinline__ float bf2f(u16 x) { return __uint_as_float(((unsigned)x) << 16); }
__device__ __forceinline__ float bflo(unsigned w) { return __uint_as_float(w << 16); }
__device__ __forceinline__ float bfhi(unsigned w) { return __uint_as_float(w & 0xffff0000u); }
__device__ __forceinline__ float wave_sum(float v) {
#pragma unroll
  for (int o = 32; o >= 1; o >>= 1) v += __shfl_xor(v, o);
  return v;
}
__device__ __forceinline__ int opaque_tid() { int t = threadIdx.x; asm volatile("" : "+v"(t)); return t; }
__device__ __forceinline__ float vmaxabs(const float* g, int n) { float m = 0.f; for (int i = 0; i < n; ++i) m = fmaxf(m, fabsf(g[i])); return m; }
__device__ __forceinline__ float silu_f(float g) { return g / (1.f + __expf(-g)); }


__device__ __forceinline__ void gbar(unsigned* cnt, unsigned target) {
  asm volatile("s_waitcnt vmcnt(0)" ::: "memory");
  __syncthreads();
  if (threadIdx.x == 0) {
    __builtin_amdgcn_fence(__ATOMIC_RELEASE, "agent");
    asm volatile("s_waitcnt vmcnt(0)" ::: "memory");
    __hip_atomic_fetch_add(cnt, 1u, __ATOMIC_RELAXED, __HIP_MEMORY_SCOPE_AGENT);
    unsigned sp = 0;
    while (__hip_atomic_load(cnt, __ATOMIC_RELAXED, __HIP_MEMORY_SCOPE_AGENT) < target) { __builtin_amdgcn_s_sleep(1); if (++sp > (1u << 24)) break; }
    __builtin_amdgcn_fence(__ATOMIC_ACQUIRE, "agent");
    asm volatile("s_waitcnt vmcnt(0)" ::: "memory");
  }
  __syncthreads();
}

__device__ void mod_unit(const Params& p, int u, char* lds) {
  const int tid = opaque_tid();
  const int layer = u / 96, n0 = (u % 96) * 32, col = tid & 31, ks = tid >> 5;
  const float* W = p.mod_w + (size_t)layer * 1024 * 3072 + n0 + col;
  float a0 = 0, a1 = 0, a2 = 0;
  for (int k = ks * 64; k < ks * 64 + 64; ++k) {
    float w = W[(size_t)k * 3072];
    a0 += silu_f(p.c[k]) * w; a1 += silu_f(p.c[1024 + k]) * w; a2 += silu_f(p.c_ctx[k]) * w;
  }
  float* red = (float*)lds;
  red[(0 * 16 + ks) * 32 + col] = a0; red[(1 * 16 + ks) * 32 + col] = a1; red[(2 * 16 + ks) * 32 + col] = a2;
  __syncthreads();
  if (tid < 96) {
    int w = tid >> 5, cc = tid & 31; float s = 0;
    for (int i = 0; i < 16; ++i) s += red[(w * 16 + i) * 32 + cc];
    float* modv = (float*)(p.ws + OFF_MODV);
    modv[(layer * 3 + w) * 3072 + n0 + cc] = s + p.mod_b[layer * 3072 + n0 + cc];
  }
  __syncthreads();
}

__device__ void transpose_unit(const Params& p, int u, char* lds) {
  const float* src; const float* gain = nullptr; int K, N; u16* dst; int ul;
  if (u < 608)       { ul = u;        src = p.ab_w_in;  K = 1024; N = 2336; dst = (u16*)(p.ws + OFF_WT_IN_AB); }
  else if (u < 864)  { ul = u - 608;  src = p.ab_w_out; K = 1024; N = 1024; dst = (u16*)(p.ws + OFF_WT_OUT_AB); }
  else if (u < 912)  { ul = u - 864;  src = p.w_uq;     K = 256;  N = 768;  dst = (u16*)(p.ws + OFF_WT_UQ); gain = p.cq_gain; }
  else if (u < 976)  { ul = u - 912;  src = p.w_ukv;    K = 256;  N = 1024; dst = (u16*)(p.ws + OFF_WT_UKV); gain = p.ckv_gain; }
  else if (u < 1808) { ul = u - 976;  src = p.cd_w_in;  K = 1024; N = 3328; dst = (u16*)(p.ws + OFF_WT_IN_CD); }
  else               { ul = u - 1808; src = p.cd_w_out; K = 1024; N = 1024; dst = (u16*)(p.ws + OFF_WT_OUT_CD); }
  const int nkt = K / 64, kt = ul % nkt, nt = ul / nkt, k0 = kt * 64, n0 = nt * 64, tid = opaque_tid();
  float* tile = (float*)lds;
#pragma unroll
  for (int e = 0; e < 8; ++e) {
    int i = (tid >> 6) + 8 * e, j = tid & 63, n = n0 + j;
    float v = (n < N) ? src[(size_t)(k0 + i) * N + n] : 0.f;
    if (gain) v *= gain[k0 + i];
    tile[i * 65 + j] = v;
  }
  __syncthreads();
#pragma unroll
  for (int e = 0; e < 8; ++e) {
    int i2 = (tid >> 6) + 8 * e, j2 = tid & 63;
    dst[(size_t)(n0 + i2) * K + k0 + j2] = f2bf(tile[j2 * 65 + i2]);
  }
  __syncthreads();
}

__device__ void adaln_phase(const float* xlat, const u16* xlat_bf, const float* xctx, const float* modl, u16* H) {
  const int tid = opaque_tid(), lane = tid & 63, gw = blockIdx.x * 8 + (tid >> 6), nw = gridDim.x * 8;
  for (int r = gw; r < NROW; r += nw) {
    if (xlat_bf != nullptr && r < NLAT) {
      const float* m = modl + (r >> 14) * 3072;
      u32x4 w[2]; float f[16]; float ss = 0;
#pragma unroll
      for (int i = 0; i < 2; ++i) w[i] = *(const u32x4*)(xlat_bf + (size_t)r * 1024 + 8 * (lane + 64 * i));
#pragma unroll
      for (int i = 0; i < 2; ++i)
#pragma unroll
        for (int e = 0; e < 4; ++e) { f[i * 8 + 2 * e] = bflo(w[i][e]); f[i * 8 + 2 * e + 1] = bfhi(w[i][e]); }
#pragma unroll
      for (int e = 0; e < 16; ++e) ss += f[e] * f[e];
      ss = wave_sum(ss);
      const float rstd = rsqrtf(ss * (1.f / 1024) + EPS);
#pragma unroll
      for (int i = 0; i < 2; ++i) {
        const int c = 8 * (lane + 64 * i);
        const float4 sh0 = *(const float4*)(m + c), sh1 = *(const float4*)(m + c + 4), sc0 = *(const float4*)(m + 1024 + c), sc1 = *(const float4*)(m + 1024 + c + 4);
        const float shv[8] = {sh0.x, sh0.y, sh0.z, sh0.w, sh1.x, sh1.y, sh1.z, sh1.w}, scv[8] = {sc0.x, sc0.y, sc0.z, sc0.w, sc1.x, sc1.y, sc1.z, sc1.w};
        float y[8];
#pragma unroll
        for (int e = 0; e < 8; ++e) y[e] = f[i * 8 + e] * rstd * (1.f + scv[e]) + shv[e];
        const u32x4 o = {cvtpk(y[0], y[1]), cvtpk(y[2], y[3]), cvtpk(y[4], y[5]), cvtpk(y[6], y[7])};
        *(u32x4*)(H + (size_t)r * 1024 + c) = o;
      }
      continue;
    }
    const float* src = r < NLAT ? xlat + (size_t)r * 1024 : xctx + (size_t)(r - NLAT) * 1024;
    const float* m = modl + (r < NLAT ? (r >> 14) : 2) * 3072;
    float4 v[4]; float ss = 0;
#pragma unroll
    for (int i = 0; i < 4; ++i) { v[i] = ((const float4*)src)[lane + 64 * i]; ss += v[i].x * v[i].x + v[i].y * v[i].y + v[i].z * v[i].z + v[i].w * v[i].w; }
    ss = wave_sum(ss);
    const float rstd = rsqrtf(ss * (1.f / 1024) + EPS);
#pragma unroll
    for (int i = 0; i < 4; ++i) {
      int c = 4 * (lane + 64 * i);
      float4 sh = *(const float4*)(m + c), sc = *(const float4*)(m + 1024 + c);
      float y0 = v[i].x * rstd * (1.f + sc.x) + sh.x, y1 = v[i].y * rstd * (1.f + sc.y) + sh.y;
      float y2 = v[i].z * rstd * (1.f + sc.z) + sh.z, y3 = v[i].w * rstd * (1.f + sc.w) + sh.w;
      u32x2 o = {cvtpk(y0, y1), cvtpk(y2, y3)};
      *(u32x2*)(H + (size_t)r * 1024 + c) = o;
    }
  }
}

#define GSWZ(row, colB) ((row) * 128 + ((colB) ^ ((((row) >> 1) & 7) << 4)))
struct ResPre { float4 v[16]; u32x2 w[16]; };
struct GPre { bf16x8 ra[4], rb[2]; };
__device__ __forceinline__ void gemm_preload(const u16* __restrict__ A, int lda, const u16* __restrict__ Bt, int ldb, int m0, int n0, GPre& g) {
  const int tid = opaque_tid(), srow = tid >> 3, sch = tid & 7;
  const u16* ap = A + (size_t)(m0 + srow) * lda + sch * 8;
  const u16* bp = Bt + (size_t)(n0 + srow) * ldb + sch * 8;
#pragma unroll
  for (int i = 0; i < 4; ++i) g.ra[i] = *(const bf16x8*)(ap + (size_t)(64 * i) * lda);
#pragma unroll
  for (int i = 0; i < 2; ++i) g.rb[i] = *(const bf16x8*)(bp + (size_t)(64 * i) * ldb);
}
template <int PRE>
__device__ __forceinline__ void gemm_tile(const u16* __restrict__ A, int lda, const u16* __restrict__ Bt, int ldb, int K,
                                          int m0, int n0, f32x16 (&acc)[2][2], char* lds, GPre& g, const void* resp = nullptr, ResPre* rp = nullptr) {
  const int tid = opaque_tid(), wid = tid >> 6, lane = tid & 63, r32 = lane & 31, hi = lane >> 5;
  const int wm = wid & 3, wn = wid >> 2;
  char* As = lds;
  char* Bs = lds + 98304;
  const int srow = tid >> 3, sch = tid & 7;
  const u16* ap = A + (size_t)(m0 + srow) * lda + sch * 8;
  const u16* bp = Bt + (size_t)(n0 + srow) * ldb + sch * 8;
  const int sw = GSWZ(srow, sch * 16);
  bf16x8 (&ra)[4] = g.ra; bf16x8 (&rb)[2] = g.rb;
#pragma unroll
  for (int i = 0; i < 2; ++i) for (int j = 0; j < 2; ++j) acc[i][j] = f32x16{};
  const int nk = K / 64;
  __syncthreads();
#pragma unroll
  for (int i = 0; i < 4; ++i) *(bf16x8*)(As + sw + i * 8192) = ra[i];
#pragma unroll
  for (int i = 0; i < 2; ++i) *(bf16x8*)(Bs + sw + i * 8192) = rb[i];
  if (1 < nk) {
#pragma unroll
    for (int i = 0; i < 4; ++i) ra[i] = *(const bf16x8*)(ap + (size_t)(64 * i) * lda + 64);
#pragma unroll
    for (int i = 0; i < 2; ++i) rb[i] = *(const bf16x8*)(bp + (size_t)(64 * i) * ldb + 64);
  }
  __syncthreads();
  const int arow0 = wm * 64 + r32, brow0 = wn * 64 + r32;
  int st = 0;
  for (int kt = 0; kt < nk; ++kt) {
    const int stn = (st == 2) ? 0 : st + 1;
    if (kt + 1 < nk) {
      char* An = As + stn * 32768; char* Bn = Bs + stn * 16384;
#pragma unroll
      for (int i = 0; i < 4; ++i) *(bf16x8*)(An + sw + i * 8192) = ra[i];
#pragma unroll
      for (int i = 0; i < 2; ++i) *(bf16x8*)(Bn + sw + i * 8192) = rb[i];
    }
    if (kt + 2 < nk) {
#pragma unroll
      for (int i = 0; i < 4; ++i) ra[i] = *(const bf16x8*)(ap + (size_t)(64 * i) * lda + (kt + 2) * 64);
#pragma unroll
      for (int i = 0; i < 2; ++i) rb[i] = *(const bf16x8*)(bp + (size_t)(64 * i) * ldb + (kt + 2) * 64);
    }
    if (PRE == 1 && kt == 0) {
#pragma unroll
      for (int q = 0; q < 16; ++q) rp->v[q] = *(const float4*)((const float*)resp + (size_t)((q >> 3) * 32 + 4 * (q & 7)) * 1024);
    }
    if (PRE == 2 && kt == 0) {
#pragma unroll
      for (int q = 0; q < 16; ++q) rp->w[q] = *(const u32x2*)((const u16*)resp + (size_t)((q >> 3) * 32 + 4 * (q & 7)) * 1024);
    }
    SBAR();
    const char* Ac = As + st * 32768; const char* Bc = Bs + st * 16384;
#pragma unroll
    for (int kk = 0; kk < 4; ++kk) {
      const int cb = kk * 32 + hi * 16;
      bf16x8 a0 = *(const bf16x8*)(Ac + GSWZ(arow0, cb));
      bf16x8 a1 = *(const bf16x8*)(Ac + GSWZ(arow0 + 32, cb));
      bf16x8 b0 = *(const bf16x8*)(Bc + GSWZ(brow0, cb));
      bf16x8 b1 = *(const bf16x8*)(Bc + GSWZ(brow0 + 32, cb));
      acc[0][0] = __builtin_amdgcn_mfma_f32_32x32x16_bf16(a0, b0, acc[0][0], 0, 0, 0);
      acc[0][1] = __builtin_amdgcn_mfma_f32_32x32x16_bf16(a0, b1, acc[0][1], 0, 0, 0);
      acc[1][0] = __builtin_amdgcn_mfma_f32_32x32x16_bf16(a1, b0, acc[1][0], 0, 0, 0);
      acc[1][1] = __builtin_amdgcn_mfma_f32_32x32x16_bf16(a1, b1, acc[1][1], 0, 0, 0);
    }
    __syncthreads();
    st = stn;
  }
}

struct TileIter {
  int f, fend, step, MT, NT;
  __device__ __forceinline__ TileIter(int MT_, int NT_) : MT(MT_), NT(NT_) {
    const int T = MT_ * NT_, bid = blockIdx.x, nblk = gridDim.x;
    if (nblk == 256) { const int x = bid & 7, cl = bid >> 3; f = (int)(((long)T * x) >> 3) + cl; fend = (int)(((long)T * (x + 1)) >> 3); step = 32; }
    else { f = bid; fend = T; step = nblk; }
  }
  __device__ __forceinline__ bool valid() const { return f < fend; }
  __device__ __forceinline__ void next() { f += step; }
  __device__ __forceinline__ void get(int& mt, int& nt) const {
    const int full = (MT >> 2) * 4 * NT;
    if (f < full) { const int g = f / (4 * NT), rem = f - g * 4 * NT; nt = rem >> 2; mt = g * 4 + (rem & 3); }
    else { const int rem = f - full, gs = MT - (MT >> 2) * 4; nt = rem / gs; mt = (MT >> 2) * 4 + (rem - nt * gs); }
  }
};

__device__ __forceinline__ void epi_bf16(f32x16 (&acc)[2][2], u16* C, int ldc, int m0, int n0, char* lds) {
  const int tid = opaque_tid(), wid = tid >> 6, lane = tid & 63, r32 = lane & 31, hi = lane >> 5;
  const int wm = wid & 3, wn = wid >> 2;
  char* wl = lds + wid * 9216;
#pragma unroll
  for (int i = 0; i < 2; ++i)
#pragma unroll
    for (int j = 0; j < 2; ++j)
#pragma unroll
      for (int r = 0; r < 16; ++r) *(u16*)(wl + (i * 32 + crow(r, hi)) * 144 + (j * 32 + r32) * 2) = f2bf(acc[i][j][r]);
  asm volatile("s_waitcnt lgkmcnt(0)" ::: "memory");
  const int rr = lane >> 3, ch = lane & 7;
  u16* cbase = C + (size_t)(m0 + wm * 64 + rr) * ldc + n0 + wn * 64 + ch * 8;
#pragma unroll
  for (int k = 0; k < 8; ++k) {
    const u32x4 v = *(const u32x4*)(wl + (rr + 8 * k) * 144 + ch * 16);
    *(u32x4*)(cbase + (size_t)(8 * k) * ldc) = v;
  }
}
template <bool IN_BF, bool OUT_BF>
__device__ __forceinline__ void epi_res(f32x16 (&acc)[2][2], const ResPre& rp, void* outp, const float* gsrc, int n0, char* lds) {
  const int tid = opaque_tid(), wid = tid >> 6, lane = tid & 63, r32 = lane & 31, hi = lane >> 5;
  const int wn = wid >> 2;
  char* wl = lds + wid * 8704;
  const int rl = lane >> 4, c4 = lane & 15;
  const float4 g = *(const float4*)(gsrc + n0 + wn * 64 + 4 * c4);
#pragma unroll
  for (int i = 0; i < 2; ++i) {
#pragma unroll
    for (int j = 0; j < 2; ++j)
#pragma unroll
      for (int r = 0; r < 16; ++r) *(float*)(wl + crow(r, hi) * 272 + (j * 32 + r32) * 4) = acc[i][j][r];
    asm volatile("s_waitcnt lgkmcnt(0)" ::: "memory");
#pragma unroll
    for (int k = 0; k < 8; ++k) {
      const float4 a = *(const float4*)(wl + (rl + 4 * k) * 272 + c4 * 16);
      float4 x;
      if (IN_BF) { const u32x2 xw = rp.w[i * 8 + k]; x.x = bflo(xw[0]); x.y = bfhi(xw[0]); x.z = bflo(xw[1]); x.w = bfhi(xw[1]); } else x = rp.v[i * 8 + k];
      float4 o; o.x = x.x + g.x * a.x; o.y = x.y + g.y * a.y; o.z = x.z + g.z * a.z; o.w = x.w + g.w * a.w;
      if (OUT_BF) { const u32x2 ow = {cvtpk(o.x, o.y), cvtpk(o.z, o.w)}; *(u32x2*)((u16*)outp + (size_t)(i * 32 + 4 * k) * 1024) = ow; }
      else *(float4*)((float*)outp + (size_t)(i * 32 + 4 * k) * 1024) = o;
    }
    asm volatile("s_waitcnt lgkmcnt(0)" ::: "memory");
  }
}

__device__ __forceinline__ float red8(float v) { v += __shfl_xor(v, 1); v += __shfl_xor(v, 2); v += __shfl_xor(v, 4); return v; }
__device__ __forceinline__ void rope_cs(float pos, float inv, bool on, float& c, float& s) {
  if (on) { float a = pos * inv * 0.15915494309189535f; a -= floorf(a); c = __builtin_amdgcn_cosf(a); s = __builtin_amdgcn_sinf(a); } else { c = 1.f; s = 0.f; }
}
__device__ __forceinline__ void head64(const u16* src, u16* dst, int gb, const float* g, const float* cG, const float* sG, float qs) {
  const u32x2 lo = *(const u32x2*)(src + gb), hi2 = *(const u32x2*)(src + gb + 16);
  float x[8] = {bflo(lo[0]), bfhi(lo[0]), bflo(lo[1]), bfhi(lo[1]), bflo(hi2[0]), bfhi(hi2[0]), bflo(hi2[1]), bfhi(hi2[1])};
  float ss = 0;
#pragma unroll
  for (int e = 0; e < 8; ++e) ss += x[e] * x[e];
  const float rn = rsqrtf(red8(ss) * (1.f / 64) + EPS) ;
#pragma unroll
  for (int e = 0; e < 8; ++e) x[e] *= rn * g[e];
  float y[8];
#pragma unroll
  for (int e = 0; e < 4; ++e) { y[e] = (x[e] * cG[e] - x[e + 4] * sG[e]) * qs; y[e + 4] = (x[e + 4] * cG[e] + x[e] * sG[e]) * qs; }
  const u32x2 o0 = {cvtpk(y[0], y[1]), cvtpk(y[2], y[3])}, o1 = {cvtpk(y[4], y[5]), cvtpk(y[6], y[7])};
  *(u32x2*)(dst + gb) = o0; *(u32x2*)(dst + gb + 16) = o1;
}
__device__ __forceinline__ void head96(float* n, float r1a, float r1b, float r2a, float r2b, u16* dst, int t, int rb,
                                       const float* gn, const float* gr, const float* cM, const float* sM, float qs) {
  float ss = r1a * r1a + r1b * r1b + r2a * r2a + r2b * r2b;
#pragma unroll
  for (int e = 0; e < 8; ++e) ss += n[e] * n[e];
  const float rn = rsqrtf(red8(ss) * (1.f / 96) + EPS);
#pragma unroll
  for (int e = 0; e < 8; ++e) n[e] *= rn * gn[e] * qs;
  r1a *= rn * gr[0]; r1b *= rn * gr[1]; r2a *= rn * gr[2]; r2b *= rn * gr[3];
  const float y1a = (r1a * cM[0] - r2a * sM[0]) * qs, y2a = (r2a * cM[0] + r1a * sM[0]) * qs;
  const float y1b = (r1b * cM[1] - r2b * sM[1]) * qs, y2b = (r2b * cM[1] + r1b * sM[1]) * qs;
  const u32x4 o = {cvtpk(n[0], n[1]), cvtpk(n[2], n[3]), cvtpk(n[4], n[5]), cvtpk(n[6], n[7])};
  *(u32x4*)(dst + 8 * t) = o;
  *(unsigned*)(dst + 64 + rb) = cvtpk(y1a, y1b); *(unsigned*)(dst + 64 + rb + 8) = cvtpk(y2a, y2b);
}
__device__ void finalize0(const Params& p) {
  const int tid = opaque_tid(), lane = tid & 63, gw = blockIdx.x * 8 + (tid >> 6), nw = gridDim.x * 8;
  const int h = lane >> 3, t = lane & 7;
  char* ws = p.ws;
  const u16* PP = (const u16*)(ws + OFF_PP);
  const u16* QAR = (const u16*)(ws + OFF_H);
  const u16* KVR = (const u16*)p.out;
  u16* QA = (u16*)(ws + OFF_QA); u16* QCA = (u16*)(ws + OFF_QCA); u16* KA = (u16*)(ws + OFF_KA); u16* VA = (u16*)(ws + OFF_VA);
  u16* QB = (u16*)(ws + OFF_QB); u16* QCB = (u16*)(ws + OFF_QCB); u16* KB = (u16*)(ws + OFF_KB); u16* VB = (u16*)(ws + OFF_VB);
  const int gb = t < 4 ? 4 * t : 32 + 4 * (t - 4), rb = t < 4 ? 2 * t : 16 + 2 * (t - 4);
  float qgn[8], kgn[8], qgr[4], kgr[4], gqg[8], gkg[8], invG[4], invM[2];
#pragma unroll
  for (int e = 0; e < 8; ++e) { qgn[e] = p.q_gain[8 * t + e]; kgn[e] = p.k_gain[8 * t + e];
    const int d = gb + (e & 3) + (e >> 2) * 16; gqg[e] = p.gq_gain[d]; gkg[e] = p.gk_gain[d]; }
#pragma unroll
  for (int k = 0; k < 4; ++k) { const int d = 64 + rb + (k & 1) + (k >> 1) * 8; qgr[k] = p.q_gain[d]; kgr[k] = p.k_gain[d]; }
#pragma unroll
  for (int e = 0; e < 4; ++e) invG[e] = exp2f(-(float)(4 * (t & 3) + e) * (13.287712379549449f / 16.f));
#pragma unroll
  for (int k = 0; k < 2; ++k) invM[k] = exp2f(-(float)(2 * (t & 3) + k) * (13.287712379549449f / 8.f));
  for (int r = gw; r < NROW; r += nw) {
    const bool isctx = r >= NLAT;
    int b, s, kpos; float pos = 0.f;
    if (!isctx) { b = r >> 14; s = r & 16383; kpos = CL + s; pos = t < 4 ? (float)(s >> 6) : (float)(s & 63); }
    else { int rc = r - NLAT; b = rc >> 8; s = rc & 255; kpos = s; }
    float cG[4], sG[4], cM[2], sM[2];
#pragma unroll
    for (int e = 0; e < 4; ++e) rope_cs(pos, invG[e], !isctx, cG[e], sG[e]);
#pragma unroll
    for (int k = 0; k < 2; ++k) rope_cs(pos, invM[k], !isctx, cM[k], sM[k]);
    const u16* pp = PP + (size_t)r * LD_AB;
    const u32x2 wq = *(const u32x2*)(pp + lane * 4), wk = *(const u32x2*)(pp + 256 + lane * 4);
    float s1 = bflo(wq[0]) * bflo(wq[0]) + bfhi(wq[0]) * bfhi(wq[0]) + bflo(wq[1]) * bflo(wq[1]) + bfhi(wq[1]) * bfhi(wq[1]);
    float s2 = bflo(wk[0]) * bflo(wk[0]) + bfhi(wk[0]) * bfhi(wk[0]) + bflo(wk[1]) * bflo(wk[1]) + bfhi(wk[1]) * bfhi(wk[1]);
    s1 = wave_sum(s1); s2 = wave_sum(s2);
    const float rstd_cq = rsqrtf(s1 * (1.f / 256) + EPS), rstd_ckv = rsqrtf(s2 * (1.f / 256) + EPS);
    { const u16* qa = QAR + (size_t)r * 768 + h * 96;
      const u32x4 nv = *(const u32x4*)(qa + 8 * t); const unsigned w1 = *(const unsigned*)(qa + 64 + rb), w2 = *(const unsigned*)(qa + 64 + rb + 8);
      float n[8] = {bflo(nv[0]) * rstd_cq, bfhi(nv[0]) * rstd_cq, bflo(nv[1]) * rstd_cq, bfhi(nv[1]) * rstd_cq, bflo(nv[2]) * rstd_cq, bfhi(nv[2]) * rstd_cq, bflo(nv[3]) * rstd_cq, bfhi(nv[3]) * rstd_cq};
      u16* dq = isctx ? QCA + ((size_t)(b * 8 + h) * CL + s) * 96 : QA + ((size_t)(b * 8 + h) * SEQ + s) * 96;
      head96(n, bflo(w1) * rstd_cq, bfhi(w1) * rstd_cq, bflo(w2) * rstd_cq, bfhi(w2) * rstd_cq, dq, t, rb, qgn, qgr, cM, sM, QS_A); }
    { const u16* kv = KVR + (size_t)r * 1024 + h * 128;
      const u32x4 nv = *(const u32x4*)(kv + 8 * t), vv = *(const u32x4*)(kv + 64 + 8 * t);
      const unsigned w1 = *(const unsigned*)(pp + 512 + rb), w2 = *(const unsigned*)(pp + 512 + rb + 8);
      float n[8] = {bflo(nv[0]) * rstd_ckv, bfhi(nv[0]) * rstd_ckv, bflo(nv[1]) * rstd_ckv, bfhi(nv[1]) * rstd_ckv, bflo(nv[2]) * rstd_ckv, bfhi(nv[2]) * rstd_ckv, bflo(nv[3]) * rstd_ckv, bfhi(nv[3]) * rstd_ckv};
      const size_t kr = (size_t)(b * 8 + h) * KVLEN + kpos;
      head96(n, bflo(w1), bfhi(w1), bflo(w2), bfhi(w2), KA + kr * 96, t, rb, kgn, kgr, cM, sM, 1.f);
      const u32x4 vo = {cvtpk(bflo(vv[0]) * rstd_ckv, bfhi(vv[0]) * rstd_ckv), cvtpk(bflo(vv[1]) * rstd_ckv, bfhi(vv[1]) * rstd_ckv),
                        cvtpk(bflo(vv[2]) * rstd_ckv, bfhi(vv[2]) * rstd_ckv), cvtpk(bflo(vv[3]) * rstd_ckv, bfhi(vv[3]) * rstd_ckv)};
      *(u32x4*)(VA + kr * 64 + 8 * t) = vo; }
    { u16* dg = isctx ? QCB + ((size_t)(b * 8 + h) * CL + s) * 64 : QB + ((size_t)(b * 8 + h) * SEQ + s) * 64;
      head64(pp + 544 + h * 64, dg, gb, gqg, cG, sG, QS_B); }
    if (h < 2) {
      const size_t kr = (size_t)(b * 2 + h) * KVLEN + kpos;
      head64(pp + 1056 + h * 64, KB + kr * 64, gb, gkg, cG, sG, 1.f);
      *(u32x4*)(VB + kr * 64 + 8 * t) = *(const u32x4*)(pp + 1184 + h * 64 + 8 * t);
    }
  }
}

__device__ void finalize1(const Params& p) {
  const int tid = opaque_tid(), lane = tid & 63, gw = blockIdx.x * 8 + (tid >> 6), nw = gridDim.x * 8;
  const int h = lane >> 3, t = lane & 7;
  char* ws = p.ws;
  const u16* PP = (const u16*)(ws + OFF_PP);
  u16* Q2 = (u16*)(ws + OFF_Q2); u16* K2 = (u16*)(ws + OFF_K2); u16* V2 = (u16*)(ws + OFF_V2);
  u16* MIX = (u16*)(ws + OFF_H);
  const int gb = t < 4 ? 4 * t : 32 + 4 * (t - 4);
  float qg[8], kg[8], invG[4];
#pragma unroll
  for (int e = 0; e < 8; ++e) { const int d = gb + (e & 3) + (e >> 2) * 16; qg[e] = p.win_q_gain[d]; kg[e] = p.win_k_gain[d]; }
#pragma unroll
  for (int e = 0; e < 4; ++e) invG[e] = exp2f(-(float)(4 * (t & 3) + e) * (13.287712379549449f / 16.f));
  float cw[3][8];
#pragma unroll
  for (int j = 0; j < 3; ++j)
#pragma unroll
    for (int e = 0; e < 8; ++e) cw[j][e] = p.conv_w[j * 512 + lane * 8 + e];
  for (int r = gw; r < NROW + 512; r += nw) {
    if (r >= NROW) {
      int slab = (r - NROW) >> 7, pr = (r - NROW) & 127;
      size_t kr = (size_t)slab * KV2LEN + KVLEN + pr;
      K2[kr * 64 + lane] = 0; V2[kr * 64 + lane] = 0;
      continue;
    }
    const bool isctx = r >= NLAT;
    int b, s, kpos; float pos = 0.f;
    if (!isctx) { b = r >> 14; s = r & 16383; kpos = CL + s; pos = t < 4 ? (float)(s >> 6) : (float)(s & 63); }
    else { int rc = r - NLAT; b = rc >> 8; s = rc & 255; kpos = s; }
    float cG[4], sG[4];
#pragma unroll
    for (int e = 0; e < 4; ++e) rope_cs(pos, invG[e], !isctx, cG[e], sG[e]);
    const u16* pp = PP + (size_t)r * LD_CD;
    if (!isctx) head64(pp + h * 64, Q2 + ((size_t)(b * 8 + h) * SEQ + s) * 64, gb, qg, cG, sG, QS_B);
    if (h < 2) {
      const size_t kr = (size_t)(b * 2 + h) * KV2LEN + kpos;
      head64(pp + 512 + h * 64, K2 + kr * 64, gb, kg, cG, sG, 1.f);
      *(u32x4*)(V2 + kr * 64 + 8 * t) = *(const u32x4*)(pp + 640 + h * 64 + 8 * t);
    }
    if (!isctx) {
      const int c0 = lane * 8;
      float y[8];
#pragma unroll
      for (int e = 0; e < 8; ++e) y[e] = 0.f;
#pragma unroll
      for (int j = 0; j < 3; ++j) {
        const int sj = s + j - 1;
        if (sj >= 0 && sj < SEQ) {
          const u16* pj = pp + (ptrdiff_t)(j - 1) * LD_CD;
          u32x4 a = *(const u32x4*)(pj + 1280 + c0), bb = *(const u32x4*)(pj + 1792 + c0);
#pragma unroll
          for (int e = 0; e < 4; ++e) {
            y[2 * e]     += bflo(a[e]) * bflo(bb[e]) * cw[j][2 * e];
            y[2 * e + 1] += bfhi(a[e]) * bfhi(bb[e]) * cw[j][2 * e + 1];
          }
        }
      }
      u32x4 gbv = *(const u32x4*)(pp + 768 + c0), gt = *(const u32x4*)(pp + 2304 + 512 + c0);
      u32x4 o;
#pragma unroll
      for (int e = 0; e < 4; ++e) {
        float v0 = bflo(gbv[e]) * y[2 * e] * silu_f(bflo(gt[e]));
        float v1 = bfhi(gbv[e]) * y[2 * e + 1] * silu_f(bfhi(gt[e]));
        o[e] = cvtpk(v0, v1);
      }
      *(u32x4*)(MIX + (size_t)r * 1024 + 512 + c0) = o;
    }
  }
}

#define KSWZ(row, colB) ((row) * 272 + (colB))
__device__ __forceinline__ int v_st2(int k, int c) { const int kk = k; return ((kk >> 3) * 2 + (c >> 5)) * 512 + ((kk & 7) * 32 + (c & 31)) * 2; }
__device__ __forceinline__ int v_rd_base(int lane) { return ((lane & 3) << 3) | (((lane >> 2) & 3) << 6) | (((lane >> 4) & 1) << 5) | (((lane >> 5) & 1) << 8); }
constexpr int v_rd_off2(int d0, int ks, int half) { return d0 * 512 + ks * 2048 + half * 1024; }
template <int OFF> __device__ __forceinline__ s16x4 tr_read(int vb) {
  s16x4 r; asm volatile("ds_read_b64_tr_b16 %0, %1 offset:%2" : "=&v"(r) : "v"(vb), "i"(OFF) : "memory"); return r;
}
template <int D0> __device__ __forceinline__ void pv_one(f32x16& od, int vb, bf16x8 pa0, bf16x8 pa1, bf16x8 pa2, bf16x8 pa3) {
  const s16x4 l0 = tr_read<v_rd_off2(D0, 0, 0)>(vb), h0 = tr_read<v_rd_off2(D0, 0, 1)>(vb), l1 = tr_read<v_rd_off2(D0, 1, 0)>(vb), h1 = tr_read<v_rd_off2(D0, 1, 1)>(vb);
  const s16x4 l2 = tr_read<v_rd_off2(D0, 2, 0)>(vb), h2 = tr_read<v_rd_off2(D0, 2, 1)>(vb), l3 = tr_read<v_rd_off2(D0, 3, 0)>(vb), h3 = tr_read<v_rd_off2(D0, 3, 1)>(vb);
  asm volatile("s_waitcnt lgkmcnt(0)" ::: "memory"); SBAR();
#define PK(L, H) (bf16x8){L[0], L[1], L[2], L[3], H[0], H[1], H[2], H[3]}
  od = __builtin_amdgcn_mfma_f32_32x32x16_bf16(pa0, PK(l0, h0), od, 0, 0, 0);
  od = __builtin_amdgcn_mfma_f32_32x32x16_bf16(pa1, PK(l1, h1), od, 0, 0, 0);
  od = __builtin_amdgcn_mfma_f32_32x32x16_bf16(pa2, PK(l2, h2), od, 0, 0, 0);
  od = __builtin_amdgcn_mfma_f32_32x32x16_bf16(pa3, PK(l3, h3), od, 0, 0, 0);
#undef PK
}
__device__ __forceinline__ void pv_all(f32x16* o, int vb, bf16x8 pa0, bf16x8 pa1, bf16x8 pa2, bf16x8 pa3) {
  pv_one<0>(o[0], vb, pa0, pa1, pa2, pa3); pv_one<1>(o[1], vb, pa0, pa1, pa2, pa3);
}
__device__ __forceinline__ void pv_exp(f32x16* o, int vb, bf16x8 pa0, bf16x8 pa1, bf16x8 pa2, bf16x8 pa3, f32x16& n0, f32x16& n1) {
#define PK(L, H) (bf16x8){L[0], L[1], L[2], L[3], H[0], H[1], H[2], H[3]}
  { const s16x4 l0 = tr_read<v_rd_off2(0, 0, 0)>(vb), h0 = tr_read<v_rd_off2(0, 0, 1)>(vb), l1 = tr_read<v_rd_off2(0, 1, 0)>(vb), h1 = tr_read<v_rd_off2(0, 1, 1)>(vb);
    const s16x4 l2 = tr_read<v_rd_off2(0, 2, 0)>(vb), h2 = tr_read<v_rd_off2(0, 2, 1)>(vb), l3 = tr_read<v_rd_off2(0, 3, 0)>(vb), h3 = tr_read<v_rd_off2(0, 3, 1)>(vb);
#pragma unroll
    for (int r = 0; r < 8; ++r) n0[r] = __builtin_amdgcn_exp2f(n0[r]);
    asm volatile("s_waitcnt lgkmcnt(0)" ::: "memory"); SBAR();
    o[0] = __builtin_amdgcn_mfma_f32_32x32x16_bf16(pa0, PK(l0, h0), o[0], 0, 0, 0);
    o[0] = __builtin_amdgcn_mfma_f32_32x32x16_bf16(pa1, PK(l1, h1), o[0], 0, 0, 0);
    o[0] = __builtin_amdgcn_mfma_f32_32x32x16_bf16(pa2, PK(l2, h2), o[0], 0, 0, 0);
    o[0] = __builtin_amdgcn_mfma_f32_32x32x16_bf16(pa3, PK(l3, h3), o[0], 0, 0, 0); }
  { const s16x4 l0 = tr_read<v_rd_off2(1, 0, 0)>(vb), h0 = tr_read<v_rd_off2(1, 0, 1)>(vb), l1 = tr_read<v_rd_off2(1, 1, 0)>(vb), h1 = tr_read<v_rd_off2(1, 1, 1)>(vb);
    const s16x4 l2 = tr_read<v_rd_off2(1, 2, 0)>(vb), h2 = tr_read<v_rd_off2(1, 2, 1)>(vb), l3 = tr_read<v_rd_off2(1, 3, 0)>(vb), h3 = tr_read<v_rd_off2(1, 3, 1)>(vb);
#pragma unroll
    for (int r = 8; r < 16; ++r) n0[r] = __builtin_amdgcn_exp2f(n0[r]);
    asm volatile("s_waitcnt lgkmcnt(0)" ::: "memory"); SBAR();
    o[1] = __builtin_amdgcn_mfma_f32_32x32x16_bf16(pa0, PK(l0, h0), o[1], 0, 0, 0);
    o[1] = __builtin_amdgcn_mfma_f32_32x32x16_bf16(pa1, PK(l1, h1), o[1], 0, 0, 0);
    o[1] = __builtin_amdgcn_mfma_f32_32x32x16_bf16(pa2, PK(l2, h2), o[1], 0, 0, 0);
    o[1] = __builtin_amdgcn_mfma_f32_32x32x16_bf16(pa3, PK(l3, h3), o[1], 0, 0, 0); }
#undef PK
#pragma unroll
  for (int r = 0; r < 16; ++r) n1[r] = __builtin_amdgcn_exp2f(n1[r]);
}

__device__ __forceinline__ void expall(f32x16& p0, f32x16& p1) {
#pragma unroll
  for (int r = 0; r < 16; ++r) p0[r] = __builtin_amdgcn_exp2f(p0[r]);
#pragma unroll
  for (int r = 0; r < 16; ++r) p1[r] = __builtin_amdgcn_exp2f(p1[r]);
}
__device__ __forceinline__ void finishSM(f32x16& p0, f32x16& p1, float& lsum, bf16x8& pa0, bf16x8& pa1, bf16x8& pa2, bf16x8& pa3) {
  float ps = 0;
#pragma unroll
  for (int r = 0; r < 16; ++r) ps += p0[r];
#pragma unroll
  for (int r = 0; r < 16; ++r) ps += p1[r];
  lsum += ps;
#define PK4(P, BASE, OUT) do { u32x4 w = {cvtpk(P[BASE + 0], P[BASE + 1]), cvtpk(P[BASE + 2], P[BASE + 3]), cvtpk(P[BASE + 4], P[BASE + 5]), cvtpk(P[BASE + 6], P[BASE + 7])}; \
    OUT = *reinterpret_cast<bf16x8*>(&w); } while (0)
  PK4(p0, 0, pa0); PK4(p0, 8, pa1); PK4(p1, 0, pa2); PK4(p1, 8, pa3);
#undef PK4
}
template <int NQK>
__device__ __forceinline__ void qkt(f32x16& p0, f32x16& p1, const char* Ks, const bf16x8* qr, int r32, int hi, const float shift) {
  p0 = f32x16{}; p1 = f32x16{};
#pragma unroll
  for (int d0 = 0; d0 < NQK; ++d0) { int cb = (d0 * 16 + hi * 8) * 2;
    bf16x8 b0 = *reinterpret_cast<const bf16x8*>(Ks + KSWZ(r32, cb));
    bf16x8 b1 = *reinterpret_cast<const bf16x8*>(Ks + KSWZ(32 + r32, cb));
    p0 = __builtin_amdgcn_mfma_f32_32x32x16_bf16(b0, qr[d0], p0, 0, 0, 0);
    p1 = __builtin_amdgcn_mfma_f32_32x32x16_bf16(b1, qr[d0], p1, 0, 0, 0); }
  if (__builtin_expect(shift != 0.f, 0)) {
#pragma unroll
    for (int r = 0; r < 16; ++r) { p0[r] -= shift; p1[r] -= shift; }
  }
}

#define PK4X(P, BASE, OUT) do { u32x4 w_ = {cvtpk(P[BASE + 0], P[BASE + 1]), cvtpk(P[BASE + 2], P[BASE + 3]), cvtpk(P[BASE + 4], P[BASE + 5]), cvtpk(P[BASE + 6], P[BASE + 7])}; \
    OUT = *reinterpret_cast<bf16x8*>(&w_); } while (0)
template <int NQK>
__device__ __forceinline__ void qkt_fin(f32x16& n0, f32x16& n1, const char* Ks, const bf16x8* qr, int r32, int hi, const float shift,
                                        f32x16& o0, f32x16& o1, float& lsum, bf16x8& pa0, bf16x8& pa1, bf16x8& pa2, bf16x8& pa3) {
  n0 = f32x16{}; n1 = f32x16{};
  float ps = 0.f;
  bf16x8 kc0 = *reinterpret_cast<const bf16x8*>(Ks + KSWZ(r32, (hi * 8) * 2));
  bf16x8 kc1 = *reinterpret_cast<const bf16x8*>(Ks + KSWZ(32 + r32, (hi * 8) * 2));
#pragma unroll
  for (int d0 = 0; d0 < NQK; ++d0) {
    bf16x8 kn0 = kc0, kn1 = kc1;
    if (d0 + 1 < NQK) { const int cb = ((d0 + 1) * 16 + hi * 8) * 2;
      kn0 = *reinterpret_cast<const bf16x8*>(Ks + KSWZ(r32, cb)); kn1 = *reinterpret_cast<const bf16x8*>(Ks + KSWZ(32 + r32, cb)); }
    n0 = __builtin_amdgcn_mfma_f32_32x32x16_bf16(kc0, qr[d0], n0, 0, 0, 0);
    n1 = __builtin_amdgcn_mfma_f32_32x32x16_bf16(kc1, qr[d0], n1, 0, 0, 0);
#define PIN(X) asm volatile("" : "+v"(X))
    if (NQK == 6) {
      if (d0 == 0) { PK4X(o0, 0, pa0); }
      if (d0 == 1) { PIN(o0); PK4X(o0, 8, pa1); }
      if (d0 == 2) { _Pragma("unroll") for (int r = 0; r < 16; ++r) ps += o0[r]; }
      if (d0 == 3) { PIN(o1); PK4X(o1, 0, pa2); _Pragma("unroll") for (int r = 0; r < 8; ++r) ps += o1[r]; }
      if (d0 == 4) { PIN(o1); PK4X(o1, 8, pa3); _Pragma("unroll") for (int r = 8; r < 16; ++r) ps += o1[r]; }
    } else {
      if (d0 == 0) { PK4X(o0, 0, pa0); PK4X(o0, 8, pa1); }
      if (d0 == 1) { _Pragma("unroll") for (int r = 0; r < 16; ++r) ps += o0[r]; }
      if (d0 == 2) { PIN(o1); PK4X(o1, 0, pa2); _Pragma("unroll") for (int r = 0; r < 8; ++r) ps += o1[r]; }
      if (d0 == 3) { PIN(o1); PK4X(o1, 8, pa3); _Pragma("unroll") for (int r = 8; r < 16; ++r) ps += o1[r]; }
    }
#undef PIN
    asm volatile("" : "+v"(ps), "+v"(pa0), "+v"(pa1), "+v"(pa2), "+v"(pa3));
    kc0 = kn0; kc1 = kn1;
    SBAR();
  }
  lsum += ps;
  if (__builtin_expect(shift != 0.f, 0)) {
#pragma unroll
    for (int r = 0; r < 16; ++r) { n0[r] -= shift; n1[r] -= shift; }
  }
}

template <int NQK, int MODE, int LDG>
__device__ __forceinline__ void attn_body(const u16* __restrict__ Qb, const u16* __restrict__ Kh, const u16* __restrict__ Vh,
                                          const int NT, const int q0, const float sink2, const float mbound,
                                          u16* __restrict__ mix0, const u16* __restrict__ gate0, char* lds) {
  constexpr int DK = NQK * 16;
  constexpr int SHM_V = 8192, SHM_K = 17408;
  int tid_ = threadIdx.x; asm volatile("" : "+v"(tid_));
  const int tid = tid_, wid = __builtin_amdgcn_readfirstlane(tid >> 6), lane = tid & 63, r32 = lane & 31, hi = lane >> 5;
  char* V_lds = lds; char* K_lds = lds + 5 * SHM_V;
  float* wsf = (float*)(lds + 5 * SHM_V + 5 * SHM_K) + wid * 64; float* li_l = wsf;
  float lsum = 0; f32x16 o[2] = {}; bf16x8 qr[NQK];
  const float shift = mbound > 80.f ? mbound - 80.f : 0.f;
  const u16* Qw = Qb + (size_t)(wid * 32 + r32) * DK + hi * 8;
#pragma unroll
  for (int d0 = 0; d0 < NQK; ++d0) qr[d0] = *(const bf16x8*)(Qw + d0 * 16);
  const int srow = tid >> 3, sc8 = tid & 7;
  const int kst0 = KSWZ(srow, sc8 * 16), kst1 = KSWZ(srow, 128 + sc8 * 16), vst = v_st2(srow, sc8 * 8);
  const int vb0 = (int)(uintptr_t)V_lds + v_rd_base(lane);
  const bool k1on = (NQK == 6) && (sc8 < 4);
  const unsigned koff0 = srow * DK + sc8 * 8, voff0 = srow * 64 + sc8 * 8;
  struct { bf16x8 k0, k1, v0; } st[2];
#define TROW(j) (MODE == 0 ? (j) * 64 : ((j) < 4 ? (j) * 64 : q0 + 128 + ((j) - 4) * 64))
#define SLOAD(i, kr) do { const u16* kp_ = Kh + (unsigned)((kr) * DK); st[i].k0 = *(const bf16x8*)(kp_ + koff0);   \
    if (k1on) st[i].k1 = *(const bf16x8*)(kp_ + koff0 + 64);                                                           \
    const u16* vp_ = Vh + (unsigned)((kr) * 64); st[i].v0 = *(const bf16x8*)(vp_ + voff0); } while (0)
#define SWRITE(b, i) do { *(bf16x8*)(K_lds + (b) * SHM_K + kst0) = st[i].k0; if (k1on) *(bf16x8*)(K_lds + (b) * SHM_K + kst1) = st[i].k1; \
    *(bf16x8*)(V_lds + (b) * SHM_V + vst) = st[i].v0; } while (0)
#define MASKT(P0, P1, j) do { if (MODE == 1 && (j) >= 4) { const int kb_ = q0 - 128 + ((j) - 4) * 64, qp_ = q0 + wid * 32 + r32;    \
    _Pragma("unroll") for (int r = 0; r < 16; ++r) { int k0_ = kb_ + crow(r, hi), k1_ = k0_ + 32; int d0_ = qp_ - k0_, d1_ = qp_ - k1_; \
      bool ok0 = (d0_ <= 128) && (d0_ >= -128) && (k0_ >= 0) && (k0_ < SEQ); bool ok1 = (d1_ <= 128) && (d1_ >= -128) && (k1_ >= 0) && (k1_ < SEQ); \
      P0[r] = ok0 ? P0[r] : -1e30f; P1[r] = ok1 ? P1[r] : -1e30f; } } } while (0)
  f32x16 pA0, pA1, pB0, pB1; bf16x8 pa0, pa1, pa2, pa3;
#define NXS(x) ((x) + 1 == 5 ? 0 : (x) + 1)
  __syncthreads();
  SLOAD(0, TROW(0)); asm volatile("s_waitcnt vmcnt(0)" ::: "memory"); SWRITE(0, 0);
  SLOAD(0, TROW(1)); SWRITE(1, 0);
  SLOAD(0, TROW(2)); SWRITE(2, 0);
  if (3 < NT) SLOAD(0, TROW(3));
  if (4 < NT) SLOAD(1, TROW(4));
  __syncthreads();
  qkt<NQK>(pA0, pA1, K_lds, qr, r32, hi, shift); MASKT(pA0, pA1, 0); expall(pA0, pA1);
  int c = 0;
  for (int j = 1; j + 1 < NT; j += 2) {
    const int sj = NXS(c), sj1 = NXS(sj), sj2 = NXS(sj1), sj3 = NXS(sj2);
    SBAR(); SWRITE(sj2, 0); if (j + 3 < NT) SWRITE(sj3, 1); SBAR();
    qkt_fin<NQK>(pB0, pB1, K_lds + sj * SHM_K, qr, r32, hi, shift, pA0, pA1, lsum, pa0, pa1, pa2, pa3); MASKT(pB0, pB1, j); SBAR();
    if (j + 4 < NT) SLOAD(0, TROW(j + 4)); SBAR();
    pv_exp(o, vb0 + c * SHM_V, pa0, pa1, pa2, pa3, pB0, pB1);
    SBAR();
    qkt_fin<NQK>(pA0, pA1, K_lds + sj1 * SHM_K, qr, r32, hi, shift, pB0, pB1, lsum, pa0, pa1, pa2, pa3); MASKT(pA0, pA1, j + 1); SBAR();
    if (j + 5 < NT) SLOAD(1, TROW(j + 5)); SBAR();
    pv_exp(o, vb0 + sj * SHM_V, pa0, pa1, pa2, pa3, pA0, pA1);
    __syncthreads();
    c = sj1;
  }
  { const int sl = NXS(c);
    SBAR(); qkt_fin<NQK>(pB0, pB1, K_lds + sl * SHM_K, qr, r32, hi, shift, pA0, pA1, lsum, pa0, pa1, pa2, pa3); MASKT(pB0, pB1, NT - 1); SBAR();
    pv_all(o, vb0 + c * SHM_V, pa0, pa1, pa2, pa3); expall(pB0, pB1);
    finishSM(pB0, pB1, lsum, pa0, pa1, pa2, pa3); SBAR();
    pv_all(o, vb0 + sl * SHM_V, pa0, pa1, pa2, pa3); }
#undef NXS
  float l_reg;
  { auto rr = __builtin_amdgcn_permlane32_swap(__float_as_uint(lsum), __float_as_uint(lsum), false, false);
    l_reg = __uint_as_float(rr[0]) + __uint_as_float(rr[1]); }
  if (MODE == 1) l_reg += __builtin_amdgcn_exp2f(sink2 - shift);
  if (hi == 0) li_l[r32] = l_reg; asm volatile("s_waitcnt lgkmcnt(0)" ::: "memory");
  float rli[16];
#pragma unroll
  for (int r = 0; r < 16; ++r) rli[r] = __builtin_amdgcn_rcpf(li_l[crow(r, hi)]);
#pragma unroll
  for (int r = 0; r < 16; ++r) { const int orow = wid * 32 + crow(r, hi);
#pragma unroll
    for (int d0 = 0; d0 < 2; ++d0) {
      const float g = bf2f(gate0[(size_t)orow * LDG + d0 * 32 + r32]);
      mix0[(size_t)orow * 1024 + d0 * 32 + r32] = f2bf(o[d0][r] * rli[r] * silu_f(g));
    } }
#undef TROW
#undef SLOAD
#undef SWRITE
#undef MASKT
}

template <int NQK, int LDG, bool R5>
__device__ __forceinline__ void attn_body2(const u16* __restrict__ Qb, const u16* __restrict__ Kh, const u16* __restrict__ Vh,
                                           const int NT, const float mbound, u16* __restrict__ mix0, const u16* __restrict__ gate0, char* lds) {
  constexpr int DK = NQK * 16;
  constexpr int SHM_V = 8192, SHM_K = 17408;
  int tid_ = threadIdx.x; asm volatile("" : "+v"(tid_));
  const int tid = tid_, wid = __builtin_amdgcn_readfirstlane(tid >> 6), lane = tid & 63, r32 = lane & 31, hi = lane >> 5;
  char* V_lds = lds; char* K_lds = lds + 5 * SHM_V;
  float* wsf = (float*)(lds + 5 * SHM_V + 5 * SHM_K) + wid * 64;
  float lsA = 0, lsB = 0; f32x16 oA[2] = {}, oB[2] = {}; bf16x8 qA[NQK], qB[NQK];
  const float shift = mbound > 80.f ? mbound - 80.f : 0.f;
  const u16* Qw = Qb + (size_t)(wid * 64 + r32) * DK + hi * 8;
#pragma unroll
  for (int d0 = 0; d0 < NQK; ++d0) { qA[d0] = *(const bf16x8*)(Qw + d0 * 16); qB[d0] = *(const bf16x8*)(Qw + 32 * DK + d0 * 16); }
  const int srow = tid >> 3, sc8 = tid & 7;
  const int kst0 = KSWZ(srow, sc8 * 16), kst1 = KSWZ(srow, 128 + sc8 * 16), vst = v_st2(srow, sc8 * 8);
  const int vb0 = (int)(uintptr_t)V_lds + v_rd_base(lane);
  const bool k1on = (NQK == 6) && (sc8 < 4);
  const unsigned koff0 = srow * DK + sc8 * 8, voff0 = srow * 64 + sc8 * 8;
  struct { bf16x8 k0, k1, v0; } st[R5 ? 2 : 1];
#define SLOAD(i, kr) do { const u16* kp_ = Kh + (unsigned)((kr) * DK); st[i].k0 = *(const bf16x8*)(kp_ + koff0);   \
    if (k1on) st[i].k1 = *(const bf16x8*)(kp_ + koff0 + 64);                                                           \
    const u16* vp_ = Vh + (unsigned)((kr) * 64); st[i].v0 = *(const bf16x8*)(vp_ + voff0); } while (0)
#define SWRITE(b, i) do { *(bf16x8*)(K_lds + (b) * SHM_K + kst0) = st[i].k0; if (k1on) *(bf16x8*)(K_lds + (b) * SHM_K + kst1) = st[i].k1; \
    *(bf16x8*)(V_lds + (b) * SHM_V + vst) = st[i].v0; } while (0)
#define NXS(x) ((x) + 1 == 5 ? 0 : (x) + 1)
#define UNIT(PN0, PN1, QN, KS, PO0, PO1, LSO, OO, VS) do {                                                                      \
    qkt_fin<NQK>(PN0, PN1, K_lds + (KS) * SHM_K, QN, r32, hi, shift, PO0, PO1, LSO, pa0, pa1, pa2, pa3); SBAR();               \
    pv_exp(OO, vb0 + (VS) * SHM_V, pa0, pa1, pa2, pa3, PN0, PN1); SBAR(); } while (0)
  f32x16 pA0, pA1, pB0, pB1; bf16x8 pa0, pa1, pa2, pa3;
  if constexpr (R5) {
  __syncthreads();
  SLOAD(0, 0); asm volatile("s_waitcnt vmcnt(0)" ::: "memory"); SWRITE(0, 0);
  SLOAD(0, 64); SWRITE(1, 0);
  SLOAD(0, 128); SWRITE(2, 0);
  if (3 < NT) SLOAD(0, 3 * 64);
  if (4 < NT) SLOAD(1, 4 * 64);
  __syncthreads();
  qkt<NQK>(pA0, pA1, K_lds, qA, r32, hi, shift); expall(pA0, pA1);
  int c = 0;
  for (int i = 0; 2 * i + 2 < NT; ++i) {
    const int s1 = NXS(c), s2 = NXS(s1), s3 = NXS(s2), s4 = NXS(s3);
    SBAR(); if (2 * i + 3 < NT) SWRITE(s3, 0); if (2 * i + 4 < NT) SWRITE(s4, 1); SBAR();
    UNIT(pB0, pB1, qB, c, pA0, pA1, lsA, oA, c);
    if (2 * i + 5 < NT) SLOAD(0, (2 * i + 5) * 64); SBAR();
    UNIT(pA0, pA1, qA, s1, pB0, pB1, lsB, oB, c);
    if (2 * i + 6 < NT) SLOAD(1, (2 * i + 6) * 64); SBAR();
    UNIT(pB0, pB1, qB, s1, pA0, pA1, lsA, oA, s1);
    UNIT(pA0, pA1, qA, s2, pB0, pB1, lsB, oB, s1);
    __syncthreads();
    c = s2;
  }
  { const int s1 = NXS(c);
    UNIT(pB0, pB1, qB, c, pA0, pA1, lsA, oA, c);
    UNIT(pA0, pA1, qA, s1, pB0, pB1, lsB, oB, c);
    UNIT(pB0, pB1, qB, s1, pA0, pA1, lsA, oA, s1);
    finishSM(pB0, pB1, lsB, pa0, pa1, pa2, pa3); SBAR();
    pv_all(oB, vb0 + s1 * SHM_V, pa0, pa1, pa2, pa3); }
  } else {
#define NX3(x) ((x) + 1 == 3 ? 0 : (x) + 1)
    __syncthreads();
    SLOAD(0, 0); asm volatile("s_waitcnt vmcnt(0)" ::: "memory"); SWRITE(0, 0);
    SLOAD(0, 64); SWRITE(1, 0);
    if (2 < NT) SLOAD(0, 128);
    __syncthreads();
    qkt<NQK>(pA0, pA1, K_lds, qA, r32, hi, shift); expall(pA0, pA1);
    int c = 0;
    for (int t = 0; t + 1 < NT; ++t) {
      const int s1 = NX3(c), s2 = NX3(s1);
      SBAR(); if (t + 2 < NT) SWRITE(s2, 0); SBAR();
      UNIT(pB0, pB1, qB, c, pA0, pA1, lsA, oA, c);
      if (t + 3 < NT) SLOAD(0, (t + 3) * 64); SBAR();
      UNIT(pA0, pA1, qA, s1, pB0, pB1, lsB, oB, c);
      __syncthreads();
      c = s1;
    }
    UNIT(pB0, pB1, qB, c, pA0, pA1, lsA, oA, c);
    finishSM(pB0, pB1, lsB, pa0, pa1, pa2, pa3); SBAR();
    pv_all(oB, vb0 + c * SHM_V, pa0, pa1, pa2, pa3);
#undef NX3
  }
#undef UNIT
#undef NXS
#undef SLOAD
#undef SWRITE
  float lA, lB;
  { auto rr = __builtin_amdgcn_permlane32_swap(__float_as_uint(lsA), __float_as_uint(lsA), false, false); lA = __uint_as_float(rr[0]) + __uint_as_float(rr[1]); }
  { auto rr = __builtin_amdgcn_permlane32_swap(__float_as_uint(lsB), __float_as_uint(lsB), false, false); lB = __uint_as_float(rr[0]) + __uint_as_float(rr[1]); }
  if (hi == 0) { wsf[r32] = lA; wsf[32 + r32] = lB; }
  asm volatile("s_waitcnt lgkmcnt(0)" ::: "memory");
#pragma unroll
  for (int g = 0; g < 2; ++g) {
    float rli[16];
#pragma unroll
    for (int r = 0; r < 16; ++r) rli[r] = __builtin_amdgcn_rcpf(wsf[g * 32 + crow(r, hi)]);
#pragma unroll
    for (int r = 0; r < 16; ++r) { const int orow = wid * 64 + g * 32 + crow(r, hi);
#pragma unroll
      for (int d0 = 0; d0 < 2; ++d0) {
        const float gt = bf2f(gate0[(size_t)orow * LDG + d0 * 32 + r32]);
        const float ov = g == 0 ? oA[d0][r] : oB[d0][r];
        mix0[(size_t)orow * 1024 + d0 * 32 + r32] = f2bf(ov * rli[r] * silu_f(gt));
      } }
  }
}

__global__ void __launch_bounds__(512, 1) mega(Params p) {
  extern __shared__ __attribute__((aligned(16))) char lds[];
  cg::grid_group grid = cg::this_grid();
  const int bid = blockIdx.x, nblk = gridDim.x;
  char* ws = p.ws;
  float* modv = (float*)(ws + OFF_MODV);
  u16* H = (u16*)(ws + OFF_H);
  u16* PP = (u16*)(ws + OFF_PP);
  float* XC1 = (float*)(ws + OFF_XC1);
  unsigned* gcnt = (unsigned*)(ws + OFF_END);
  if (bid == 0 && threadIdx.x == 0) __hip_atomic_store(gcnt, 0u, __ATOMIC_RELAXED, __HIP_MEMORY_SCOPE_AGENT);

  if (p.ph_lo <= 0 && 0 < p.ph_hi) {
  for (int u = bid; u < 192; u += nblk) mod_unit(p, u, lds);
  }
  if (p.ph_lo <= 0 && 0 + 1 < p.ph_hi) grid.sync();
  if (p.ph_lo <= 1 && 1 < p.ph_hi) {
  for (int u = bid; u < 2064; u += nblk) transpose_unit(p, u, lds);
  adaln_phase(p.x, nullptr, p.ctx, modv, H);
  }
  if (p.ph_lo <= 1 && 1 + 1 < p.ph_hi) gbar(gcnt, 1u * gridDim.x);
  if (p.ph_lo <= 2 && 2 < p.ph_hi) {
  { TileIter ti(130, 19); GPre g; int nt = 0, mt = 0; const u16* Wt = (const u16*)(ws + OFF_WT_IN_AB);
    if (ti.valid()) { ti.get(mt, nt); gemm_preload(H, 1024, Wt, 1024, mt * 256, nt * 128, g); }
    while (ti.valid()) {
      f32x16 acc[2][2]; const int m0 = mt * 256, n0 = nt * 128;
      gemm_tile<0>(H, 1024, Wt, 1024, 1024, m0, n0, acc, lds, g);
      ti.next(); if (ti.valid()) { ti.get(mt, nt); gemm_preload(H, 1024, Wt, 1024, mt * 256, nt * 128, g); }
      epi_bf16(acc, PP, LD_AB, m0, n0, lds);
    } }
  }
  if (p.ph_lo <= 2 && 2 + 1 < p.ph_hi) gbar(gcnt, 2u * gridDim.x);
  if (p.ph_lo <= 3 && 3 < p.ph_hi) {
  { TileIter ti(130, 14); GPre g; int nt = 0, mt = 0;
    const u16* Wq = (const u16*)(ws + OFF_WT_UQ); const u16* Wkv = (const u16*)(ws + OFF_WT_UKV);
    if (ti.valid()) { ti.get(mt, nt); gemm_preload(nt < 6 ? PP : PP + 256, LD_AB, nt < 6 ? Wq : Wkv, 256, mt * 256, (nt < 6 ? nt : nt - 6) * 128, g); }
    while (ti.valid()) {
      f32x16 acc[2][2]; const int m0 = mt * 256, cn = nt, n0 = (nt < 6 ? nt : nt - 6) * 128;
      gemm_tile<0>(cn < 6 ? PP : PP + 256, LD_AB, cn < 6 ? Wq : Wkv, 256, 256, m0, n0, acc, lds, g);
      ti.next(); if (ti.valid()) { ti.get(mt, nt); gemm_preload(nt < 6 ? PP : PP + 256, LD_AB, nt < 6 ? Wq : Wkv, 256, mt * 256, (nt < 6 ? nt : nt - 6) * 128, g); }
      if (cn < 6) epi_bf16(acc, H, 768, m0, n0, lds); else epi_bf16(acc, (u16*)p.out, 1024, m0, n0, lds);
    } }
  }
  if (p.ph_lo <= 3 && 3 + 1 < p.ph_hi) gbar(gcnt, 3u * gridDim.x);
  if (p.ph_lo <= 4 && 4 < p.ph_hi) {
  finalize0(p);
  }
  if (p.ph_lo <= 4 && 4 + 1 < p.ph_hi) gbar(gcnt, 4u * gridDim.x);
  if (p.ph_lo <= 5 && 5 < p.ph_hi) {
  const float mbA = LOG2E * 9.7979590f * 1.02f * vmaxabs(p.q_gain, 96) * vmaxabs(p.k_gain, 96);
  const float mbB = LOG2E * 8.f * 1.02f * vmaxabs(p.gq_gain, 64) * vmaxabs(p.gk_gain, 64);
  for (int it = bid; it < 1056; it += nblk) {
    if (it < 512) {
      const int round = it >> 8, blk = it & 255, xcd = blk & 7, cl = blk >> 3;
      const int pair = xcd * 2 + round, b = pair >> 3, h = pair & 7, qoff = cl * 512;
      const size_t r0 = (size_t)b * SEQ + qoff;
      attn_body2<6, LD_AB, false>((const u16*)(ws + OFF_QA) + ((size_t)(b * 8 + h) * SEQ + qoff) * 96,
                                  (const u16*)(ws + OFF_KA) + (size_t)(b * 8 + h) * KVLEN * 96, (const u16*)(ws + OFF_VA) + (size_t)(b * 8 + h) * KVLEN * 64,
                                  KVLEN / 64, mbA, H + r0 * 1024 + h * 64, PP + r0 * LD_AB + 1312 + h * 64, lds);
    } else if (it < 1024) {
      const int i2 = it - 512, g = i2 >> 8, blk = i2 & 255, xcd = blk & 7, cl = blk >> 3;
      const int pi = xcd >> 1, b = pi >> 1, kvh = pi & 1, idx = (xcd & 1) * 64 + g * 32 + cl;
      const int h = kvh * 4 + (idx >> 5), qoff = (idx & 31) * 512;
      const size_t r0 = (size_t)b * SEQ + qoff;
      attn_body2<4, LD_AB, true>((const u16*)(ws + OFF_QB) + ((size_t)(b * 8 + h) * SEQ + qoff) * 64,
                           (const u16*)(ws + OFF_KB) + (size_t)(b * 2 + kvh) * KVLEN * 64, (const u16*)(ws + OFF_VB) + (size_t)(b * 2 + kvh) * KVLEN * 64,
                           KVLEN / 64, mbB, H + r0 * 1024 + 512 + h * 64, PP + r0 * LD_AB + 1312 + 512 + h * 64, lds);
    } else {
      const int ci = it - 1024, b = (ci >> 3) & 1, h = ci & 7; const bool mla = ci < 16; const int kvh = mla ? h : (h >> 2);
      const size_t r0 = (size_t)NLAT + b * CL, qrow = (size_t)(b * 8 + h) * CL;
      if (mla) attn_body<6, 0, LD_AB>((const u16*)(ws + OFF_QCA) + qrow * 96, (const u16*)(ws + OFF_KA) + (size_t)(b * 8 + kvh) * KVLEN * 96,
                                      (const u16*)(ws + OFF_VA) + (size_t)(b * 8 + kvh) * KVLEN * 64, CL / 64, 0, 0.f, mbA, H + r0 * 1024 + h * 64, PP + r0 * LD_AB + 1312 + h * 64, lds);
      else attn_body<4, 0, LD_AB>((const u16*)(ws + OFF_QCB) + qrow * 64, (const u16*)(ws + OFF_KB) + (size_t)(b * 2 + kvh) * KVLEN * 64,
                                  (const u16*)(ws + OFF_VB) + (size_t)(b * 2 + kvh) * KVLEN * 64, CL / 64, 0, 0.f, mbB, H + r0 * 1024 + 512 + h * 64, PP + r0 * LD_AB + 1312 + 512 + h * 64, lds);
    }
  }
  }
  if (p.ph_lo <= 5 && 5 + 1 < p.ph_hi) gbar(gcnt, 5u * gridDim.x);
  if (p.ph_lo <= 6 && 6 < p.ph_hi) {
  { TileIter ti(130, 8); GPre g; int nt = 0, mt = 0; const u16* Wt = (const u16*)(ws + OFF_WT_OUT_AB);
    if (ti.valid()) { ti.get(mt, nt); gemm_preload(H, 1024, Wt, 1024, mt * 256, nt * 128, g); }
    while (ti.valid()) {
      f32x16 acc[2][2]; const int m0 = mt * 256, n0 = nt * 128; const bool lat = m0 < NLAT;
      const int tid_ = opaque_tid(), wid_ = tid_ >> 6, lane_ = tid_ & 63;
      const size_t eoff = (size_t)((lat ? m0 : m0 - NLAT) + (wid_ & 3) * 64 + (lane_ >> 4)) * 1024 + n0 + (wid_ >> 2) * 64 + 4 * (lane_ & 15);
      ResPre rp;
      gemm_tile<1>(H, 1024, Wt, 1024, 1024, m0, n0, acc, lds, g, (lat ? p.x : p.ctx) + eoff, &rp);
      ti.next(); if (ti.valid()) { ti.get(mt, nt); gemm_preload(H, 1024, Wt, 1024, mt * 256, nt * 128, g); }
      if (lat) epi_res<false, true>(acc, rp, (u16*)(ws + OFF_X1B) + eoff, modv + (m0 >> 14) * 3072 + 2048, n0, lds);
      else epi_res<false, false>(acc, rp, XC1 + eoff, modv + 2 * 3072 + 2048, n0, lds);
    } }
  }
  if (p.ph_lo <= 6 && 6 + 1 < p.ph_hi) gbar(gcnt, 6u * gridDim.x);
  if (p.ph_lo <= 7 && 7 < p.ph_hi) {
  adaln_phase(nullptr, (const u16*)(ws + OFF_X1B), XC1, modv + 3 * 3072, H);
  }
  if (p.ph_lo <= 7 && 7 + 1 < p.ph_hi) gbar(gcnt, 7u * gridDim.x);
  if (p.ph_lo <= 8 && 8 < p.ph_hi) {
  { TileIter ti(130, 26); GPre g; int nt = 0, mt = 0; const u16* Wt = (const u16*)(ws + OFF_WT_IN_CD);
    if (ti.valid()) { ti.get(mt, nt); gemm_preload(H, 1024, Wt, 1024, mt * 256, nt * 128, g); }
    while (ti.valid()) {
      f32x16 acc[2][2]; const int m0 = mt * 256, n0 = nt * 128;
      gemm_tile<0>(H, 1024, Wt, 1024, 1024, m0, n0, acc, lds, g);
      ti.next(); if (ti.valid()) { ti.get(mt, nt); gemm_preload(H, 1024, Wt, 1024, mt * 256, nt * 128, g); }
      epi_bf16(acc, PP, LD_CD, m0, n0, lds);
    } }
  }
  if (p.ph_lo <= 8 && 8 + 1 < p.ph_hi) gbar(gcnt, 8u * gridDim.x);
  if (p.ph_lo <= 9 && 9 < p.ph_hi) {
  finalize1(p);
  }
  if (p.ph_lo <= 9 && 9 + 1 < p.ph_hi) gbar(gcnt, 9u * gridDim.x);
  if (p.ph_lo <= 10 && 10 < p.ph_hi) {
  const float mbW = LOG2E * 8.f * 1.02f * vmaxabs(p.win_q_gain, 64) * vmaxabs(p.win_k_gain, 64);
  for (int it = bid; it < 1024; it += nblk) {
    const int g = it >> 8, blk = it & 255, xcd = blk & 7, cl = blk >> 3;
    const int pi = xcd >> 1, b = pi >> 1, kvh = pi & 1, idx = (xcd & 1) * 128 + g * 32 + cl;
    const int h = kvh * 4 + (idx >> 6), qblk = idx & 63;
    const size_t r0 = (size_t)b * SEQ + qblk * 256;
    attn_body<4, 1, LD_CD>((const u16*)(ws + OFF_Q2) + ((size_t)(b * 8 + h) * SEQ + qblk * 256) * 64,
                    (const u16*)(ws + OFF_K2) + (size_t)(b * 2 + kvh) * KV2LEN * 64, (const u16*)(ws + OFF_V2) + (size_t)(b * 2 + kvh) * KV2LEN * 64,
                    12, qblk * 256, p.win_sink[h] * LOG2E, mbW, H + r0 * 1024 + h * 64, PP + r0 * LD_CD + 2304 + h * 64, lds);
  }
  }
  if (p.ph_lo <= 10 && 10 + 1 < p.ph_hi) gbar(gcnt, 10u * gridDim.x);
  if (p.ph_lo <= 11 && 11 < p.ph_hi) {
  { TileIter ti(128, 8); GPre g; int nt = 0, mt = 0; const u16* Wt = (const u16*)(ws + OFF_WT_OUT_CD);
    if (ti.valid()) { ti.get(mt, nt); gemm_preload(H, 1024, Wt, 1024, mt * 256, nt * 128, g); }
    while (ti.valid()) {
      f32x16 acc[2][2]; const int m0 = mt * 256, n0 = nt * 128;
      const int tid_ = opaque_tid(), wid_ = tid_ >> 6, lane_ = tid_ & 63;
      const size_t eoff = (size_t)(m0 + (wid_ & 3) * 64 + (lane_ >> 4)) * 1024 + n0 + (wid_ >> 2) * 64 + 4 * (lane_ & 15);
      ResPre rp;
      gemm_tile<2>(H, 1024, Wt, 1024, 1024, m0, n0, acc, lds, g, (const u16*)(ws + OFF_X1B) + eoff, &rp);
      ti.next(); if (ti.valid()) { ti.get(mt, nt); gemm_preload(H, 1024, Wt, 1024, mt * 256, nt * 128, g); }
      epi_res<true, false>(acc, rp, p.out + eoff, modv + 3 * 3072 + (m0 >> 14) * 3072 + 2048, n0, lds);
    } }
  }
}

extern "C" void kernel_launch(void* const* d_in, const int* in_sizes, int n_in, void* d_out, int out_size, void* d_ws, size_t ws_size, hipStream_t stream) {
  static int grid_blocks = 0;
  if (!grid_blocks) {
    if (n_in != 22 || out_size != NLAT * DM || ws_size < OFF_END + 4096) {
      fprintf(stderr, "kernel_launch: shape/ws mismatch n_in %d out %d ws %zu need %zu\n", n_in, out_size, ws_size, (size_t)OFF_END);
      return;
    }
    if (hipFuncSetAttribute((const void*)mega, hipFuncAttributeMaxDynamicSharedMemorySize, LDS_BYTES) != hipSuccess) {
      fprintf(stderr, "kernel_launch: hipFuncSetAttribute failed\n"); return;
    }
    int dev = 0, cus = 0, per_cu = 0;
    (void)hipGetDevice(&dev);
    (void)hipDeviceGetAttribute(&cus, hipDeviceAttributeMultiprocessorCount, dev);
    (void)hipOccupancyMaxActiveBlocksPerMultiprocessor(&per_cu, mega, 512, LDS_BYTES);
    if (per_cu < 1) { fprintf(stderr, "kernel_launch: occupancy 0\n"); return; }
    grid_blocks = cus;
  }
  Params p{};
  p.x = (const float*)d_in[0]; p.c = (const float*)d_in[1]; p.ctx = (const float*)d_in[2]; p.c_ctx = (const float*)d_in[3];
  p.mod_w = (const float*)d_in[4]; p.mod_b = (const float*)d_in[5]; p.ab_w_in = (const float*)d_in[6]; p.ab_w_out = (const float*)d_in[7];
  p.cq_gain = (const float*)d_in[8]; p.ckv_gain = (const float*)d_in[9]; p.w_uq = (const float*)d_in[10]; p.w_ukv = (const float*)d_in[11];
  p.q_gain = (const float*)d_in[12]; p.k_gain = (const float*)d_in[13]; p.gq_gain = (const float*)d_in[14]; p.gk_gain = (const float*)d_in[15];
  p.cd_w_in = (const float*)d_in[16]; p.cd_w_out = (const float*)d_in[17]; p.win_q_gain = (const float*)d_in[18]; p.win_k_gain = (const float*)d_in[19];
  p.win_sink = (const float*)d_in[20]; p.conv_w = (const float*)d_in[21];
  p.out = (float*)d_out; p.ws = (char*)d_ws;
#if MULTI_LAUNCH
  for (int ph = 0; ph < 12; ++ph) {
    p.ph_lo = ph; p.ph_hi = ph + 1;
    hipLaunchKernelGGL(mega, dim3(grid_blocks), dim3(512), LDS_BYTES, stream, p);
  }
#else
  p.ph_lo = 0; p.ph_hi = 12;
  void* args[] = {&p};
  hipError_t e = hipLaunchCooperativeKernel((void*)mega, dim3(grid_blocks), dim3(512), args, LDS_BYTES, stream);
  if (e != hipSuccess) fprintf(stderr, "cooperative launch failed: %s (grid %d)\n", hipGetErrorString(e), grid_blocks);
#endif
}
```

```cpp
#include <hip/hip_runtime.h>
#include <hip/hip_cooperative_groups.h>
#include <cstdio>
#include <cstdint>
namespace cg = cooperative_groups;

typedef unsigned short u16;
using bf16x8 = __attribute__((ext_vector_type(8))) short;
using s16x4  = __attribute__((ext_vector_type(4))) short;
using f32x16 = __attribute__((ext_vector_type(16))) float;
using u32x4  = __attribute__((ext_vector_type(4))) unsigned;
using u32x2  = __attribute__((ext_vector_type(2))) unsigned;

constexpr int NB = 2, SEQ = 16384, DM = 1024, CL = 256;
constexpr int NLAT = NB * SEQ;
constexpr int NROW = NLAT + NB * CL;
constexpr int KVLEN = CL + SEQ;
constexpr int KV2LEN = KVLEN + 128;
constexpr int LD_AB = 2432, LD_CD = 3328;
constexpr float EPS = 1e-6f;
constexpr float QS_A = 0.14724461f;
constexpr float QS_B = 0.18033688f;
constexpr float LOG2E = 1.4426950408889634f;

constexpr size_t OFF_MODV      = 0;
constexpr size_t OFF_WT_IN_AB  = 73728;
constexpr size_t OFF_WT_OUT_AB = OFF_WT_IN_AB + (size_t)LD_AB * 1024 * 2;
constexpr size_t OFF_WT_UQ     = OFF_WT_OUT_AB + (size_t)1024 * 1024 * 2;
constexpr size_t OFF_WT_UKV    = OFF_WT_UQ + (size_t)768 * 256 * 2;
constexpr size_t OFF_WT_IN_CD  = OFF_WT_UKV + (size_t)1024 * 256 * 2;
constexpr size_t OFF_WT_OUT_CD = OFF_WT_IN_CD + (size_t)3328 * 1024 * 2;
constexpr size_t OFF_XC1       = OFF_WT_OUT_CD + (size_t)1024 * 1024 * 2;
constexpr size_t OFF_H         = OFF_XC1 + (size_t)512 * 1024 * 4;
constexpr size_t OFF_PP        = OFF_H + (size_t)NROW * 1024 * 2;
constexpr size_t OFF_QA        = OFF_PP + (size_t)NROW * 3328 * 2;
constexpr size_t OFF_QCA       = OFF_QA + (size_t)NB * 8 * SEQ * 96 * 2;
constexpr size_t OFF_KA        = OFF_QCA + (size_t)NB * 8 * CL * 96 * 2;
constexpr size_t OFF_VA        = OFF_KA + (size_t)NB * 8 * KVLEN * 96 * 2;
constexpr size_t OFF_QB        = OFF_VA + (size_t)NB * 8 * KVLEN * 64 * 2;
constexpr size_t OFF_QCB       = OFF_QB + (size_t)NB * 8 * SEQ * 64 * 2;
constexpr size_t OFF_KB        = OFF_QCB + (size_t)NB * 8 * CL * 64 * 2;
constexpr size_t OFF_VB        = OFF_KB + (size_t)NB * 2 * KVLEN * 64 * 2;
constexpr size_t OFF_END       = OFF_VB + (size_t)NB * 2 * KVLEN * 64 * 2;
constexpr size_t OFF_Q2        = OFF_QA;
constexpr size_t OFF_K2        = OFF_Q2 + (size_t)NB * 8 * SEQ * 64 * 2;
constexpr size_t OFF_V2        = OFF_K2 + (size_t)NB * 2 * KV2LEN * 64 * 2;
constexpr size_t OFF_X1B       = OFF_QA + ((size_t)64 << 20);
static_assert(OFF_V2 + (size_t)NB * 2 * KV2LEN * 64 * 2 <= OFF_X1B && OFF_X1B + (size_t)NLAT * 1024 * 2 <= OFF_END, "x1 alias");
static_assert(OFF_V2 + (size_t)NB * 2 * KV2LEN * 64 * 2 <= OFF_END, "alias overflow");

constexpr int LDS_BYTES = 147456;
#ifndef MULTI_LAUNCH
#define MULTI_LAUNCH 0
#endif

struct Params {
  const float *x, *c, *ctx, *c_ctx, *mod_w, *mod_b, *ab_w_in, *ab_w_out, *cq_gain, *ckv_gain, *w_uq, *w_ukv,
      *q_gain, *k_gain, *gq_gain, *gk_gain, *cd_w_in, *cd_w_out, *win_q_gain, *win_k_gain, *win_sink, *conv_w;
  float* out;
  char* ws;
  int ph_lo, ph_hi;
};

#define SBAR() __builtin_amdgcn_sched_barrier(0)
__device__ __forceinline__ int crow(int r, int hi) { return (r & 3) + 8 * (r >> 2) + 4 * hi; }
typedef float f32x2_t __attribute__((ext_vector_type(2)));
typedef __bf16 bf16x2_t __attribute__((ext_vector_type(2)));
__device__ __forceinline__ unsigned cvtpk(float lo, float hi) { f32x2_t v = {lo, hi}; bf16x2_t b = __builtin_convertvector(v, bf16x2_t); return __builtin_bit_cast(unsigned, b); }
__device__ __forceinline__ u16 f2bf(float x) { return (u16)(cvtpk(x, 0.f) & 0xffffu); }
__device__ __forceinline__ float bf2f(u16 x) { return __uint_as_float(((unsigned)x) << 16); }
__device__ __forceinline__ float bflo(unsigned w) { return __uint_as_float(w << 16); }
__device__ __forceinline__ float bfhi(unsigned w) { return __uint_as_float(w & 0xffff0000u); }
__device__ __forceinline__ float wave_sum(float v) {
#pragma unroll
  for (int o = 32; o >= 1; o >>= 1) v += __shfl_xor(v, o);
  return v;
}
__device__ __forceinline__ int opaque_tid() { int t = threadIdx.x; asm volatile("" : "+v"(t)); return t; }
__device__ __forceinline__ float vmaxabs(const float* g, int n) { float m = 0.f; for (int i = 0; i < n; ++i) m = fmaxf(m, fabsf(g[i])); return m; }
__device__ __forceinline__ float silu_f(float g) { return g / (1.f + __expf(-g)); }


__device__ __forceinline__ void gbar(unsigned* cnt, unsigned target) {
  asm volatile("s_waitcnt vmcnt(0)" ::: "memory");
  __syncthreads();
  if (threadIdx.x == 0) {
    __builtin_amdgcn_fence(__ATOMIC_RELEASE, "agent");
    asm volatile("s_waitcnt vmcnt(0)" ::: "memory");
    __hip_atomic_fetch_add(cnt, 1u, __ATOMIC_RELAXED, __HIP_MEMORY_SCOPE_AGENT);
    unsigned sp = 0;
    while (__hip_atomic_load(cnt, __ATOMIC_RELAXED, __HIP_MEMORY_SCOPE_AGENT) < target) { __builtin_amdgcn_s_sleep(1); if (++sp > (1u << 24)) break; }
    __builtin_amdgcn_fence(__ATOMIC_ACQUIRE, "agent");
    asm volatile("s_waitcnt vmcnt(0)" ::: "memory");
  }
  __syncthreads();
}

__device__ void mod_unit(const Params& p, int u, char* lds) {
  const int tid = opaque_tid();
  const int layer = u / 96, n0 = (u % 96) * 32, col = tid & 31, ks = tid >> 5;
  const float* W = p.mod_w + (size_t)layer * 1024 * 3072 + n0 + col;
  float a0 = 0, a1 = 0, a2 = 0;
  for (int k = ks * 64; k < ks * 64 + 64; ++k) {
    float w = W[(size_t)k * 3072];
    a0 += silu_f(p.c[k]) * w; a1 += silu_f(p.c[1024 + k]) * w; a2 += silu_f(p.c_ctx[k]) * w;
  }
  float* red = (float*)lds;
  red[(0 * 16 + ks) * 32 + col] = a0; red[(1 * 16 + ks) * 32 + col] = a1; red[(2 * 16 + ks) * 32 + col] = a2;
  __syncthreads();
  if (tid < 96) {
    int w = tid >> 5, cc = tid & 31; float s = 0;
    for (int i = 0; i < 16; ++i) s += red[(w * 16 + i) * 32 + cc];
    float* modv = (float*)(p.ws + OFF_MODV);
    modv[(layer * 3 + w) * 3072 + n0 + cc] = s + p.mod_b[layer * 3072 + n0 + cc];
  }
  __syncthreads();
}

__device__ void transpose_unit(const Params& p, int u, char* lds) {
  const float* src; const float* gain = nullptr; int K, N; u16* dst; int ul;
  if (u < 608)       { ul = u;        src = p.ab_w_in;  K = 1024; N = 2336; dst = (u16*)(p.ws + OFF_WT_IN_AB); }
  else if (u < 864)  { ul = u - 608;  src = p.ab_w_out; K = 1024; N = 1024; dst = (u16*)(p.ws + OFF_WT_OUT_AB); }
  else if (u < 912)  { ul = u - 864;  src = p.w_uq;     K = 256;  N = 768;  dst = (u16*)(p.ws + OFF_WT_UQ); gain = p.cq_gain; }
  else if (u < 976)  { ul = u - 912;  src = p.w_ukv;    K = 256;  N = 1024; dst = (u16*)(p.ws + OFF_WT_UKV); gain = p.ckv_gain; }
  else if (u < 1808) { ul = u - 976;  src = p.cd_w_in;  K = 1024; N = 3328; dst = (u16*)(p.ws + OFF_WT_IN_CD); }
  else               { ul = u - 1808; src = p.cd_w_out; K = 1024; N = 1024; dst = (u16*)(p.ws + OFF_WT_OUT_CD); }
  const int nkt = K / 64, kt = ul % nkt, nt = ul / nkt, k0 = kt * 64, n0 = nt * 64, tid = opaque_tid();
  float* tile = (float*)lds;
#pragma unroll
  for (int e = 0; e < 8; ++e) {
    int i = (tid >> 6) + 8 * e, j = tid & 63, n = n0 + j;
    float v = (n < N) ? src[(size_t)(k0 + i) * N + n] : 0.f;
    if (gain) v *= gain[k0 + i];
    tile[i * 65 + j] = v;
  }
  __syncthreads();
#pragma unroll
  for (int e = 0; e < 8; ++e) {
    int i2 = (tid >> 6) + 8 * e, j2 = tid & 63;
    dst[(size_t)(n0 + i2) * K + k0 + j2] = f2bf(tile[j2 * 65 + i2]);
  }
  __syncthreads();
}

__device__ void adaln_phase(const float* xlat, const u16* xlat_bf, const float* xctx, const float* modl, u16* H) {
  const int tid = opaque_tid(), lane = tid & 63, gw = blockIdx.x * 8 + (tid >> 6), nw = gridDim.x * 8;
  for (int r = gw; r < NROW; r += nw) {
    if (xlat_bf != nullptr && r < NLAT) {
      const float* m = modl + (r >> 14) * 3072;
      u32x4 w[2]; float f[16]; float ss = 0;
#pragma unroll
      for (int i = 0; i < 2; ++i) w[i] = *(const u32x4*)(xlat_bf + (size_t)r * 1024 + 8 * (lane + 64 * i));
#pragma unroll
      for (int i = 0; i < 2; ++i)
#pragma unroll
        for (int e = 0; e < 4; ++e) { f[i * 8 + 2 * e] = bflo(w[i][e]); f[i * 8 + 2 * e + 1] = bfhi(w[i][e]); }
#pragma unroll
      for (int e = 0; e < 16; ++e) ss += f[e] * f[e];
      ss = wave_sum(ss);
      const float rstd = rsqrtf(ss * (1.f / 1024) + EPS);
#pragma unroll
      for (int i = 0; i < 2; ++i) {
        const int c = 8 * (lane + 64 * i);
        const float4 sh0 = *(const float4*)(m + c), sh1 = *(const float4*)(m + c + 4), sc0 = *(const float4*)(m + 1024 + c), sc1 = *(const float4*)(m + 1024 + c + 4);
        const float shv[8] = {sh0.x, sh0.y, sh0.z, sh0.w, sh1.x, sh1.y, sh1.z, sh1.w}, scv[8] = {sc0.x, sc0.y, sc0.z, sc0.w, sc1.x, sc1.y, sc1.z, sc1.w};
        float y[8];
#pragma unroll
        for (int e = 0; e < 8; ++e) y[e] = f[i * 8 + e] * rstd * (1.f + scv[e]) + shv[e];
        const u32x4 o = {cvtpk(y[0], y[1]), cvtpk(y[2], y[3]), cvtpk(y[4], y[5]), cvtpk(y[6], y[7])};
        *(u32x4*)(H + (size_t)r * 1024 + c) = o;
      }
      continue;
    }
    const float* src = r < NLAT ? xlat + (size_t)r * 1024 : xctx + (size_t)(r - NLAT) * 1024;
    const float* m = modl + (r < NLAT ? (r >> 14) : 2) * 3072;
    float4 v[4]; float ss = 0;
#pragma unroll
    for (int i = 0; i < 4; ++i) { v[i] = ((const float4*)src)[lane + 64 * i]; ss += v[i].x * v[i].x + v[i].y * v[i].y + v[i].z * v[i].z + v[i].w * v[i].w; }
    ss = wave_sum(ss);
    const float rstd = rsqrtf(ss * (1.f / 1024) + EPS);
#pragma unroll
    for (int i = 0; i < 4; ++i) {
      int c = 4 * (lane + 64 * i);
      float4 sh = *(const float4*)(m + c), sc = *(const float4*)(m + 1024 + c);
      float y0 = v[i].x * rstd * (1.f + sc.x) + sh.x, y1 = v[i].y * rstd * (1.f + sc.y) + sh.y;
      float y2 = v[i].z * rstd * (1.f + sc.z) + sh.z, y3 = v[i].w * rstd * (1.f + sc.w) + sh.w;
      u32x2 o = {cvtpk(y0, y1), cvtpk(y2, y3)};
      *(u32x2*)(H + (size_t)r * 1024 + c) = o;
    }
  }
}

#define GSWZ(row, colB) ((row) * 128 + ((colB) ^ ((((row) >> 1) & 7) << 4)))
struct ResPre { float4 v[16]; u32x2 w[16]; };
struct GPre { bf16x8 ra[4], rb[2]; };
__device__ __forceinline__ void gemm_preload(const u16* __restrict__ A, int lda, const u16* __restrict__ Bt, int ldb, int m0, int n0, GPre& g) {
  const int tid = opaque_tid(), srow = tid >> 3, sch = tid & 7;
  const u16* ap = A + (size_t)(m0 + srow) * lda + sch * 8;
  const u16* bp = Bt + (size_t)(n0 + srow) * ldb + sch * 8;
#pragma unroll
  for (int i = 0; i < 4; ++i) g.ra[i] = *(const bf16x8*)(ap + (size_t)(64 * i) * lda);
#pragma unroll
  for (int i = 0; i < 2; ++i) g.rb[i] = *(const bf16x8*)(bp + (size_t)(64 * i) * ldb);
}
template <int PRE>
__device__ __forceinline__ void gemm_tile(const u16* __restrict__ A, int lda, const u16* __restrict__ Bt, int ldb, int K,
                                          int m0, int n0, f32x16 (&acc)[2][2], char* lds, GPre& g, const void* resp = nullptr, ResPre* rp = nullptr) {
  const int tid = opaque_tid(), wid = tid >> 6, lane = tid & 63, r32 = lane & 31, hi = lane >> 5;
  const int wm = wid & 3, wn = wid >> 2;
  char* As = lds;
  char* Bs = lds + 98304;
  const int srow = tid >> 3, sch = tid & 7;
  const u16* ap = A + (size_t)(m0 + srow) * lda + sch * 8;
  const u16* bp = Bt + (size_t)(n0 + srow) * ldb + sch * 8;
  const int sw = GSWZ(srow, sch * 16);
  bf16x8 (&ra)[4] = g.ra; bf16x8 (&rb)[2] = g.rb;
#pragma unroll
  for (int i = 0; i < 2; ++i) for (int j = 0; j < 2; ++j) acc[i][j] = f32x16{};
  const int nk = K / 64;
  __syncthreads();
#pragma unroll
  for (int i = 0; i < 4; ++i) *(bf16x8*)(As + sw + i * 8192) = ra[i];
#pragma unroll
  for (int i = 0; i < 2; ++i) *(bf16x8*)(Bs + sw + i * 8192) = rb[i];
  if (1 < nk) {
#pragma unroll
    for (int i = 0; i < 4; ++i) ra[i] = *(const bf16x8*)(ap + (size_t)(64 * i) * lda + 64);
#pragma unroll
    for (int i = 0; i < 2; ++i) rb[i] = *(const bf16x8*)(bp + (size_t)(64 * i) * ldb + 64);
  }
  __syncthreads();
  const int arow0 = wm * 64 + r32, brow0 = wn * 64 + r32;
  int st = 0;
  for (int kt = 0; kt < nk; ++kt) {
    const int stn = (st == 2) ? 0 : st + 1;
    if (kt + 1 < nk) {
      char* An = As + stn * 32768; char* Bn = Bs + stn * 16384;
#pragma unroll
      for (int i = 0; i < 4; ++i) *(bf16x8*)(An + sw + i * 8192) = ra[i];
#pragma unroll
      for (int i = 0; i < 2; ++i) *(bf16x8*)(Bn + sw + i * 8192) = rb[i];
    }
    if (kt + 2 < nk) {
#pragma unroll
      for (int i = 0; i < 4; ++i) ra[i] = *(const bf16x8*)(ap + (size_t)(64 * i) * lda + (kt + 2) * 64);
#pragma unroll
      for (int i = 0; i < 2; ++i) rb[i] = *(const bf16x8*)(bp + (size_t)(64 * i) * ldb + (kt + 2) * 64);
    }
    if (PRE == 1 && kt == 0) {
#pragma unroll
      for (int q = 0; q < 16; ++q) rp->v[q] = *(const float4*)((const float*)resp + (size_t)((q >> 3) * 32 + 4 * (q & 7)) * 1024);
    }
    if (PRE == 2 && kt == 0) {
#pragma unroll
      for (int q = 0; q < 16; ++q) rp->w[q] = *(const u32x2*)((const u16*)resp + (size_t)((q >> 3) * 32 + 4 * (q & 7)) * 1024);
    }
    SBAR();
    const char* Ac = As + st * 32768; const char* Bc = Bs + st * 16384;
#pragma unroll
    for (int kk = 0; kk < 4; ++kk) {
      const int cb = kk * 32 + hi * 16;
      bf16x8 a0 = *(const bf16x8*)(Ac + GSWZ(arow0, cb));
      bf16x8 a1 = *(const bf16x8*)(Ac + GSWZ(arow0 + 32, cb));
      bf16x8 b0 = *(const bf16x8*)(Bc + GSWZ(brow0, cb));
      bf16x8 b1 = *(const bf16x8*)(Bc + GSWZ(brow0 + 32, cb));
      acc[0][0] = __builtin_amdgcn_mfma_f32_32x32x16_bf16(a0, b0, acc[0][0], 0, 0, 0);
      acc[0][1] = __builtin_amdgcn_mfma_f32_32x32x16_bf16(a0, b1, acc[0][1], 0, 0, 0);
      acc[1][0] = __builtin_amdgcn_mfma_f32_32x32x16_bf16(a1, b0, acc[1][0], 0, 0, 0);
      acc[1][1] = __builtin_amdgcn_mfma_f32_32x32x16_bf16(a1, b1, acc[1][1], 0, 0, 0);
    }
    __syncthreads();
    st = stn;
  }
}

struct TileIter {
  int f, fend, step, MT, NT;
  __device__ __forceinline__ TileIter(int MT_, int NT_) : MT(MT_), NT(NT_) {
    const int T = MT_ * NT_, bid = blockIdx.x, nblk = gridDim.x;
    if (nblk == 256) { const int x = bid & 7, cl = bid >> 3; f = (int)(((long)T * x) >> 3) + cl; fend = (int)(((long)T * (x + 1)) >> 3); step = 32; }
    else { f = bid; fend = T; step = nblk; }
  }
  __device__ __forceinline__ bool valid() const { return f < fend; }
  __device__ __forceinline__ void next() { f += step; }
  __device__ __forceinline__ void get(int& mt, int& nt) const {
    const int full = (MT >> 2) * 4 * NT;
    if (f < full) { const int g = f / (4 * NT), rem = f - g * 4 * NT; nt = rem >> 2; mt = g * 4 + (rem & 3); }
    else { const int rem = f - full, gs = MT - (MT >> 2) * 4; nt = rem / gs; mt = (MT >> 2) * 4 + (rem - nt * gs); }
  }
};

__device__ __forceinline__ void epi_bf16(f32x16 (&acc)[2][2], u16* C, int ldc, int m0, int n0, char* lds) {
  const int tid = opaque_tid(), wid = tid >> 6, lane = tid & 63, r32 = lane & 31, hi = lane >> 5;
  const int wm = wid & 3, wn = wid >> 2;
  char* wl = lds + wid * 9216;
#pragma unroll
  for (int i = 0; i < 2; ++i)
#pragma unroll
    for (int j = 0; j < 2; ++j)
#pragma unroll
      for (int r = 0; r < 16; ++r) *(u16*)(wl + (i * 32 + crow(r, hi)) * 144 + (j * 32 + r32) * 2) = f2bf(acc[i][j][r]);
  asm volatile("s_waitcnt lgkmcnt(0)" ::: "memory");
  const int rr = lane >> 3, ch = lane & 7;
  u16* cbase = C + (size_t)(m0 + wm * 64 + rr) * ldc + n0 + wn * 64 + ch * 8;
#pragma unroll
  for (int k = 0; k < 8; ++k) {
    const u32x4 v = *(const u32x4*)(wl + (rr + 8 * k) * 144 + ch * 16);
    *(u32x4*)(cbase + (size_t)(8 * k) * ldc) = v;
  }
}
template <bool IN_BF, bool OUT_BF>
__device__ __forceinline__ void epi_res(f32x16 (&acc)[2][2], const ResPre& rp, void* outp, const float* gsrc, int n0, char* lds) {
  const int tid = opaque_tid(), wid = tid >> 6, lane = tid & 63, r32 = lane & 31, hi = lane >> 5;
  const int wn = wid >> 2;
  char* wl = lds + wid * 8704;
  const int rl = lane >> 4, c4 = lane & 15;
  const float4 g = *(const float4*)(gsrc + n0 + wn * 64 + 4 * c4);
#pragma unroll
  for (int i = 0; i < 2; ++i) {
#pragma unroll
    for (int j = 0; j < 2; ++j)
#pragma unroll
      for (int r = 0; r < 16; ++r) *(float*)(wl + crow(r, hi) * 272 + (j * 32 + r32) * 4) = acc[i][j][r];
    asm volatile("s_waitcnt lgkmcnt(0)" ::: "memory");
#pragma unroll
    for (int k = 0; k < 8; ++k) {
      const float4 a = *(const float4*)(wl + (rl + 4 * k) * 272 + c4 * 16);
      float4 x;
      if (IN_BF) { const u32x2 xw = rp.w[i * 8 + k]; x.x = bflo(xw[0]); x.y = bfhi(xw[0]); x.z = bflo(xw[1]); x.w = bfhi(xw[1]); } else x = rp.v[i * 8 + k];
      float4 o; o.x = x.x + g.x * a.x; o.y = x.y + g.y * a.y; o.z = x.z + g.z * a.z; o.w = x.w + g.w * a.w;
      if (OUT_BF) { const u32x2 ow = {cvtpk(o.x, o.y), cvtpk(o.z, o.w)}; *(u32x2*)((u16*)outp + (size_t)(i * 32 + 4 * k) * 1024) = ow; }
      else *(float4*)((float*)outp + (size_t)(i * 32 + 4 * k) * 1024) = o;
    }
    asm volatile("s_waitcnt lgkmcnt(0)" ::: "memory");
  }
}

__device__ __forceinline__ float red8(float v) { v += __shfl_xor(v, 1); v += __shfl_xor(v, 2); v += __shfl_xor(v, 4); return v; }
__device__ __forceinline__ void rope_cs(float pos, float inv, bool on, float& c, float& s) {
  if (on) { float a = pos * inv * 0.15915494309189535f; a -= floorf(a); c = __builtin_amdgcn_cosf(a); s = __builtin_amdgcn_sinf(a); } else { c = 1.f; s = 0.f; }
}
__device__ __forceinline__ void head64(const u16* src, u16* dst, int gb, const float* g, const float* cG, const float* sG, float qs) {
  const u32x2 lo = *(const u32x2*)(src + gb), hi2 = *(const u32x2*)(src + gb + 16);
  float x[8] = {bflo(lo[0]), bfhi(lo[0]), bflo(lo[1]), bfhi(lo[1]), bflo(hi2[0]), bfhi(hi2[0]), bflo(hi2[1]), bfhi(hi2[1])};
  float ss = 0;
#pragma unroll
  for (int e = 0; e < 8; ++e) ss += x[e] * x[e];
  const float rn = rsqrtf(red8(ss) * (1.f / 64) + EPS) ;
#pragma unroll
  for (int e = 0; e < 8; ++e) x[e] *= rn * g[e];
  float y[8];
#pragma unroll
  for (int e = 0; e < 4; ++e) { y[e] = (x[e] * cG[e] - x[e + 4] * sG[e]) * qs; y[e + 4] = (x[e + 4] * cG[e] + x[e] * sG[e]) * qs; }
  const u32x2 o0 = {cvtpk(y[0], y[1]), cvtpk(y[2], y[3])}, o1 = {cvtpk(y[4], y[5]), cvtpk(y[6], y[7])};
  *(u32x2*)(dst + gb) = o0; *(u32x2*)(dst + gb + 16) = o1;
}
__device__ __forceinline__ void head96(float* n, float r1a, float r1b, float r2a, float r2b, u16* dst, int t, int rb,
                                       const float* gn, const float* gr, const float* cM, const float* sM, float qs) {
  float ss = r1a * r1a + r1b * r1b + r2a * r2a + r2b * r2b;
#pragma unroll
  for (int e = 0; e < 8; ++e) ss += n[e] * n[e];
  const float rn = rsqrtf(red8(ss) * (1.f / 96) + EPS);
#pragma unroll
  for (int e = 0; e < 8; ++e) n[e] *= rn * gn[e] * qs;
  r1a *= rn * gr[0]; r1b *= rn * gr[1]; r2a *= rn * gr[2]; r2b *= rn * gr[3];
  const float y1a = (r1a * cM[0] - r2a * sM[0]) * qs, y2a = (r2a * cM[0] + r1a * sM[0]) * qs;
  const float y1b = (r1b * cM[1] - r2b * sM[1]) * qs, y2b = (r2b * cM[1] + r1b * sM[1]) * qs;
  const u32x4 o = {cvtpk(n[0], n[1]), cvtpk(n[2], n[3]), cvtpk(n[4], n[5]), cvtpk(n[6], n[7])};
  *(u32x4*)(dst + 8 * t) = o;
  *(unsigned*)(dst + 64 + rb) = cvtpk(y1a, y1b); *(unsigned*)(dst + 64 + rb + 8) = cvtpk(y2a, y2b);
}
__device__ void finalize0(const Params& p) {
  const int tid = opaque_tid(), lane = tid & 63, gw = blockIdx.x * 8 + (tid >> 6), nw = gridDim.x * 8;
  const int h = lane >> 3, t = lane & 7;
  char* ws = p.ws;
  const u16* PP = (const u16*)(ws + OFF_PP);
  const u16* QAR = (const u16*)(ws + OFF_H);
  const u16* KVR = (const u16*)p.out;
  u16* QA = (u16*)(ws + OFF_QA); u16* QCA = (u16*)(ws + OFF_QCA); u16* KA = (u16*)(ws + OFF_KA); u16* VA = (u16*)(ws + OFF_VA);
  u16* QB = (u16*)(ws + OFF_QB); u16* QCB = (u16*)(ws + OFF_QCB); u16* KB = (u16*)(ws + OFF_KB); u16* VB = (u16*)(ws + OFF_VB);
  const int gb = t < 4 ? 4 * t : 32 + 4 * (t - 4), rb = t < 4 ? 2 * t : 16 + 2 * (t - 4);
  float qgn[8], kgn[8], qgr[4], kgr[4], gqg[8], gkg[8], invG[4], invM[2];
#pragma unroll
  for (int e = 0; e < 8; ++e) { qgn[e] = p.q_gain[8 * t + e]; kgn[e] = p.k_gain[8 * t + e];
    const int d = gb + (e & 3) + (e >> 2) * 16; gqg[e] = p.gq_gain[d]; gkg[e] = p.gk_gain[d]; }
#pragma unroll
  for (int k = 0; k < 4; ++k) { const int d = 64 + rb + (k & 1) + (k >> 1) * 8; qgr[k] = p.q_gain[d]; kgr[k] = p.k_gain[d]; }
#pragma unroll
  for (int e = 0; e < 4; ++e) invG[e] = exp2f(-(float)(4 * (t & 3) + e) * (13.287712379549449f / 16.f));
#pragma unroll
  for (int k = 0; k < 2; ++k) invM[k] = exp2f(-(float)(2 * (t & 3) + k) * (13.287712379549449f / 8.f));
  for (int r = gw; r < NROW; r += nw) {
    const bool isctx = r >= NLAT;
    int b, s, kpos; float pos = 0.f;
    if (!isctx) { b = r >> 14; s = r & 16383; kpos = CL + s; pos = t < 4 ? (float)(s >> 6) : (float)(s & 63); }
    else { int rc = r - NLAT; b = rc >> 8; s = rc & 255; kpos = s; }
    float cG[4], sG[4], cM[2], sM[2];
#pragma unroll
    for (int e = 0; e < 4; ++e) rope_cs(pos, invG[e], !isctx, cG[e], sG[e]);
#pragma unroll
    for (int k = 0; k < 2; ++k) rope_cs(pos, invM[k], !isctx, cM[k], sM[k]);
    const u16* pp = PP + (size_t)r * LD_AB;
    const u32x2 wq = *(const u32x2*)(pp + lane * 4), wk = *(const u32x2*)(pp + 256 + lane * 4);
    float s1 = bflo(wq[0]) * bflo(wq[0]) + bfhi(wq[0]) * bfhi(wq[0]) + bflo(wq[1]) * bflo(wq[1]) + bfhi(wq[1]) * bfhi(wq[1]);
    float s2 = bflo(wk[0]) * bflo(wk[0]) + bfhi(wk[0]) * bfhi(wk[0]) + bflo(wk[1]) * bflo(wk[1]) + bfhi(wk[1]) * bfhi(wk[1]);
    s1 = wave_sum(s1); s2 = wave_sum(s2);
    const float rstd_cq = rsqrtf(s1 * (1.f / 256) + EPS), rstd_ckv = rsqrtf(s2 * (1.f / 256) + EPS);
    { const u16* qa = QAR + (size_t)r * 768 + h * 96;
      const u32x4 nv = *(const u32x4*)(qa + 8 * t); const unsigned w1 = *(const unsigned*)(qa + 64 + rb), w2 = *(const unsigned*)(qa + 64 + rb + 8);
      float n[8] = {bflo(nv[0]) * rstd_cq, bfhi(nv[0]) * rstd_cq, bflo(nv[1]) * rstd_cq, bfhi(nv[1]) * rstd_cq, bflo(nv[2]) * rstd_cq, bfhi(nv[2]) * rstd_cq, bflo(nv[3]) * rstd_cq, bfhi(nv[3]) * rstd_cq};
      u16* dq = isctx ? QCA + ((size_t)(b * 8 + h) * CL + s) * 96 : QA + ((size_t)(b * 8 + h) * SEQ + s) * 96;
      head96(n, bflo(w1) * rstd_cq, bfhi(w1) * rstd_cq, bflo(w2) * rstd_cq, bfhi(w2) * rstd_cq, dq, t, rb, qgn, qgr, cM, sM, QS_A); }
    { const u16* kv = KVR + (size_t)r * 1024 + h * 128;
      const u32x4 nv = *(const u32x4*)(kv + 8 * t), vv = *(const u32x4*)(kv + 64 + 8 * t);
      const unsigned w1 = *(const unsigned*)(pp + 512 + rb), w2 = *(const unsigned*)(pp + 512 + rb + 8);
      float n[8] = {bflo(nv[0]) * rstd_ckv, bfhi(nv[0]) * rstd_ckv, bflo(nv[1]) * rstd_ckv, bfhi(nv[1]) * rstd_ckv, bflo(nv[2]) * rstd_ckv, bfhi(nv[2]) * rstd_ckv, bflo(nv[3]) * rstd_ckv, bfhi(nv[3]) * rstd_ckv};
      const size_t kr = (size_t)(b * 8 + h) * KVLEN + kpos;
      head96(n, bflo(w1), bfhi(w1), bflo(w2), bfhi(w2), KA + kr * 96, t, rb, kgn, kgr, cM, sM, 1.f);
      const u32x4 vo = {cvtpk(bflo(vv[0]) * rstd_ckv, bfhi(vv[0]) * rstd_ckv), cvtpk(bflo(vv[1]) * rstd_ckv, bfhi(vv[1]) * rstd_ckv),
                        cvtpk(bflo(vv[2]) * rstd_ckv, bfhi(vv[2]) * rstd_ckv), cvtpk(bflo(vv[3]) * rstd_ckv, bfhi(vv[3]) * rstd_ckv)};
      *(u32x4*)(VA + kr * 64 + 8 * t) = vo; }
    { u16* dg = isctx ? QCB + ((size_t)(b * 8 + h) * CL + s) * 64 : QB + ((size_t)(b * 8 + h) * SEQ + s) * 64;
      head64(pp + 544 + h * 64, dg, gb, gqg, cG, sG, QS_B); }
    if (h < 2) {
      const size_t kr = (size_t)(b * 2 + h) * KVLEN + kpos;
      head64(pp + 1056 + h * 64, KB + kr * 64, gb, gkg, cG, sG, 1.f);
      *(u32x4*)(VB + kr * 64 + 8 * t) = *(const u32x4*)(pp + 1184 + h * 64 + 8 * t);
    }
  }
}

__device__ void finalize1(const Params& p) {
  const int tid = opaque_tid(), lane = tid & 63, gw = blockIdx.x * 8 + (tid >> 6), nw = gridDim.x * 8;
  const int h = lane >> 3, t = lane & 7;
  char* ws = p.ws;
  const u16* PP = (const u16*)(ws + OFF_PP);
  u16* Q2 = (u16*)(ws + OFF_Q2); u16* K2 = (u16*)(ws + OFF_K2); u16* V2 = (u16*)(ws + OFF_V2);
  u16* MIX = (u16*)(ws + OFF_H);
  const int gb = t < 4 ? 4 * t : 32 + 4 * (t - 4);
  float qg[8], kg[8], invG[4];
#pragma unroll
  for (int e = 0; e < 8; ++e) { const int d = gb + (e & 3) + (e >> 2) * 16; qg[e] = p.win_q_gain[d]; kg[e] = p.win_k_gain[d]; }
#pragma unroll
  for (int e = 0; e < 4; ++e) invG[e] = exp2f(-(float)(4 * (t & 3) + e) * (13.287712379549449f / 16.f));
  float cw[3][8];
#pragma unroll
  for (int j = 0; j < 3; ++j)
#pragma unroll
    for (int e = 0; e < 8; ++e) cw[j][e] = p.conv_w[j * 512 + lane * 8 + e];
  for (int r = gw; r < NROW + 512; r += nw) {
    if (r >= NROW) {
      int slab = (r - NROW) >> 7, pr = (r - NROW) & 127;
      size_t kr = (size_t)slab * KV2LEN + KVLEN + pr;
      K2[kr * 64 + lane] = 0; V2[kr * 64 + lane] = 0;
      continue;
    }
    const bool isctx = r >= NLAT;
    int b, s, kpos; float pos = 0.f;
    if (!isctx) { b = r >> 14; s = r & 16383; kpos = CL + s; pos = t < 4 ? (float)(s >> 6) : (float)(s & 63); }
    else { int rc = r - NLAT; b = rc >> 8; s = rc & 255; kpos = s; }
    float cG[4], sG[4];
#pragma unroll
    for (int e = 0; e < 4; ++e) rope_cs(pos, invG[e], !isctx, cG[e], sG[e]);
    const u16* pp = PP + (size_t)r * LD_CD;
    if (!isctx) head64(pp + h * 64, Q2 + ((size_t)(b * 8 + h) * SEQ + s) * 64, gb, qg, cG, sG, QS_B);
    if (h < 2) {
      const size_t kr = (size_t)(b * 2 + h) * KV2LEN + kpos;
      head64(pp + 512 + h * 64, K2 + kr * 64, gb, kg, cG, sG, 1.f);
      *(u32x4*)(V2 + kr * 64 + 8 * t) = *(const u32x4*)(pp + 640 + h * 64 + 8 * t);
    }
    if (!isctx) {
      const int c0 = lane * 8;
      float y[8];
#pragma unroll
      for (int e = 0; e < 8; ++e) y[e] = 0.f;
#pragma unroll
      for (int j = 0; j < 3; ++j) {
        const int sj = s + j - 1;
        if (sj >= 0 && sj < SEQ) {
          const u16* pj = pp + (ptrdiff_t)(j - 1) * LD_CD;
          u32x4 a = *(const u32x4*)(pj + 1280 + c0), bb = *(const u32x4*)(pj + 1792 + c0);
#pragma unroll
          for (int e = 0; e < 4; ++e) {
            y[2 * e]     += bflo(a[e]) * bflo(bb[e]) * cw[j][2 * e];
            y[2 * e + 1] += bfhi(a[e]) * bfhi(bb[e]) * cw[j][2 * e + 1];
          }
        }
      }
      u32x4 gbv = *(const u32x4*)(pp + 768 + c0), gt = *(const u32x4*)(pp + 2304 + 512 + c0);
      u32x4 o;
#pragma unroll
      for (int e = 0; e < 4; ++e) {
        float v0 = bflo(gbv[e]) * y[2 * e] * silu_f(bflo(gt[e]));
        float v1 = bfhi(gbv[e]) * y[2 * e + 1] * silu_f(bfhi(gt[e]));
        o[e] = cvtpk(v0, v1);
      }
      *(u32x4*)(MIX + (size_t)r * 1024 + 512 + c0) = o;
    }
  }
}

#define KSWZ(row, colB) ((row) * 272 + (colB))
__device__ __forceinline__ int v_st2(int k, int c) { const int kk = k; return ((kk >> 3) * 2 + (c >> 5)) * 512 + ((kk & 7) * 32 + (c & 31)) * 2; }
__device__ __forceinline__ int v_rd_base(int lane) { return ((lane & 3) << 3) | (((lane >> 2) & 3) << 6) | (((lane >> 4) & 1) << 5) | (((lane >> 5) & 1) << 8); }
constexpr int v_rd_off2(int d0, int ks, int half) { return d0 * 512 + ks * 2048 + half * 1024; }
template <int OFF> __device__ __forceinline__ s16x4 tr_read(int vb) {
  s16x4 r; asm volatile("ds_read_b64_tr_b16 %0, %1 offset:%2" : "=&v"(r) : "v"(vb), "i"(OFF) : "memory"); return r;
}
template <int D0> __device__ __forceinline__ void pv_one(f32x16& od, int vb, bf16x8 pa0, bf16x8 pa1, bf16x8 pa2, bf16x8 pa3) {
  const s16x4 l0 = tr_read<v_rd_off2(D0, 0, 0)>(vb), h0 = tr_read<v_rd_off2(D0, 0, 1)>(vb), l1 = tr_read<v_rd_off2(D0, 1, 0)>(vb), h1 = tr_read<v_rd_off2(D0, 1, 1)>(vb);
  const s16x4 l2 = tr_read<v_rd_off2(D0, 2, 0)>(vb), h2 = tr_read<v_rd_off2(D0, 2, 1)>(vb), l3 = tr_read<v_rd_off2(D0, 3, 0)>(vb), h3 = tr_read<v_rd_off2(D0, 3, 1)>(vb);
  asm volatile("s_waitcnt lgkmcnt(0)" ::: "memory"); SBAR();
#define PK(L, H) (bf16x8){L[0], L[1], L[2], L[3], H[0], H[1], H[2], H[3]}
  od = __builtin_amdgcn_mfma_f32_32x32x16_bf16(pa0, PK(l0, h0), od, 0, 0, 0);
  od = __builtin_amdgcn_mfma_f32_32x32x16_bf16(pa1, PK(l1, h1), od, 0, 0, 0);
  od = __builtin_amdgcn_mfma_f32_32x32x16_bf16(pa2, PK(l2, h2), od, 0, 0, 0);
  od = __builtin_amdgcn_mfma_f32_32x32x16_bf16(pa3, PK(l3, h3), od, 0, 0, 0);
#undef PK
}
__device__ __forceinline__ void pv_all(f32x16* o, int vb, bf16x8 pa0, bf16x8 pa1, bf16x8 pa2, bf16x8 pa3) {
  pv_one<0>(o[0], vb, pa0, pa1, pa2, pa3); pv_one<1>(o[1], vb, pa0, pa1, pa2, pa3);
}
__device__ __forceinline__ void pv_exp(f32x16* o, int vb, bf16x8 pa0, bf16x8 pa1, bf16x8 pa2, bf16x8 pa3, f32x16& n0, f32x16& n1) {
#define PK(L, H) (bf16x8){L[0], L[1], L[2], L[3], H[0], H[1], H[2], H[3]}
  { const s16x4 l0 = tr_read<v_rd_off2(0, 0, 0)>(vb), h0 = tr_read<v_rd_off2(0, 0, 1)>(vb), l1 = tr_read<v_rd_off2(0, 1, 0)>(vb), h1 = tr_read<v_rd_off2(0, 1, 1)>(vb);
    const s16x4 l2 = tr_read<v_rd_off2(0, 2, 0)>(vb), h2 = tr_read<v_rd_off2(0, 2, 1)>(vb), l3 = tr_read<v_rd_off2(0, 3, 0)>(vb), h3 = tr_read<v_rd_off2(0, 3, 1)>(vb);
#pragma unroll
    for (int r = 0; r < 8; ++r) n0[r] = __builtin_amdgcn_exp2f(n0[r]);
    asm volatile("s_waitcnt lgkmcnt(0)" ::: "memory"); SBAR();
    o[0] = __builtin_amdgcn_mfma_f32_32x32x16_bf16(pa0, PK(l0, h0), o[0], 0, 0, 0);
    o[0] = __builtin_amdgcn_mfma_f32_32x32x16_bf16(pa1, PK(l1, h1), o[0], 0, 0, 0);
    o[0] = __builtin_amdgcn_mfma_f32_32x32x16_bf16(pa2, PK(l2, h2), o[0], 0, 0, 0);
    o[0] = __builtin_amdgcn_mfma_f32_32x32x16_bf16(pa3, PK(l3, h3), o[0], 0, 0, 0); }
  { const s16x4 l0 = tr_read<v_rd_off2(1, 0, 0)>(vb), h0 = tr_read<v_rd_off2(1, 0, 1)>(vb), l1 = tr_read<v_rd_off2(1, 1, 0)>(vb), h1 = tr_read<v_rd_off2(1, 1, 1)>(vb);
    const s16x4 l2 = tr_read<v_rd_off2(1, 2, 0)>(vb), h2 = tr_read<v_rd_off2(1, 2, 1)>(vb), l3 = tr_read<v_rd_off2(1, 3, 0)>(vb), h3 = tr_read<v_rd_off2(1, 3, 1)>(vb);
#pragma unroll
    for (int r = 8; r < 16; ++r) n0[r] = __builtin_amdgcn_exp2f(n0[r]);
    asm volatile("s_waitcnt lgkmcnt(0)" ::: "memory"); SBAR();
    o[1] = __builtin_amdgcn_mfma_f32_32x32x16_bf16(pa0, PK(l0, h0), o[1], 0, 0, 0);
    o[1] = __builtin_amdgcn_mfma_f32_32x32x16_bf16(pa1, PK(l1, h1), o[1], 0, 0, 0);
    o[1] = __builtin_amdgcn_mfma_f32_32x32x16_bf16(pa2, PK(l2, h2), o[1], 0, 0, 0);
    o[1] = __builtin_amdgcn_mfma_f32_32x32x16_bf16(pa3, PK(l3, h3), o[1], 0, 0, 0); }
#undef PK
#pragma unroll
  for (int r = 0; r < 16; ++r) n1[r] = __builtin_amdgcn_exp2f(n1[r]);
}

__device__ __forceinline__ void expall(f32x16& p0, f32x16& p1) {
#pragma unroll
  for (int r = 0; r < 16; ++r) p0[r] = __builtin_amdgcn_exp2f(p0[r]);
#pragma unroll
  for (int r = 0; r < 16; ++r) p1[r] = __builtin_amdgcn_exp2f(p1[r]);
}
__device__ __forceinline__ void finishSM(f32x16& p0, f32x16& p1, float& lsum, bf16x8& pa0, bf16x8& pa1, bf16x8& pa2, bf16x8& pa3) {
  float ps = 0;
#pragma unroll
  for (int r = 0; r < 16; ++r) ps += p0[r];
#pragma unroll
  for (int r = 0; r < 16; ++r) ps += p1[r];
  lsum += ps;
#define PK4(P, BASE, OUT) do { u32x4 w = {cvtpk(P[BASE + 0], P[BASE + 1]), cvtpk(P[BASE + 2], P[BASE + 3]), cvtpk(P[BASE + 4], P[BASE + 5]), cvtpk(P[BASE + 6], P[BASE + 7])}; \
    OUT = *reinterpret_cast<bf16x8*>(&w); } while (0)
  PK4(p0, 0, pa0); PK4(p0, 8, pa1); PK4(p1, 0, pa2); PK4(p1, 8, pa3);
#undef PK4
}
template <int NQK>
__device__ __forceinline__ void qkt(f32x16& p0, f32x16& p1, const char* Ks, const bf16x8* qr, int r32, int hi, const float shift) {
  p0 = f32x16{}; p1 = f32x16{};
#pragma unroll
  for (int d0 = 0; d0 < NQK; ++d0) { int cb = (d0 * 16 + hi * 8) * 2;
    bf16x8 b0 = *reinterpret_cast<const bf16x8*>(Ks + KSWZ(r32, cb));
    bf16x8 b1 = *reinterpret_cast<const bf16x8*>(Ks + KSWZ(32 + r32, cb));
    p0 = __builtin_amdgcn_mfma_f32_32x32x16_bf16(b0, qr[d0], p0, 0, 0, 0);
    p1 = __builtin_amdgcn_mfma_f32_32x32x16_bf16(b1, qr[d0], p1, 0, 0, 0); }
  if (__builtin_expect(shift != 0.f, 0)) {
#pragma unroll
    for (int r = 0; r < 16; ++r) { p0[r] -= shift; p1[r] -= shift; }
  }
}

#define PK4X(P, BASE, OUT) do { u32x4 w_ = {cvtpk(P[BASE + 0], P[BASE + 1]), cvtpk(P[BASE + 2], P[BASE + 3]), cvtpk(P[BASE + 4], P[BASE + 5]), cvtpk(P[BASE + 6], P[BASE + 7])}; \
    OUT = *reinterpret_cast<bf16x8*>(&w_); } while (0)
template <int NQK>
__device__ __forceinline__ void qkt_fin(f32x16& n0, f32x16& n1, const char* Ks, const bf16x8* qr, int r32, int hi, const float shift,
                                        f32x16& o0, f32x16& o1, float& lsum, bf16x8& pa0, bf16x8& pa1, bf16x8& pa2, bf16x8& pa3) {
  n0 = f32x16{}; n1 = f32x16{};
  float ps = 0.f;
  bf16x8 kc0 = *reinterpret_cast<const bf16x8*>(Ks + KSWZ(r32, (hi * 8) * 2));
  bf16x8 kc1 = *reinterpret_cast<const bf16x8*>(Ks + KSWZ(32 + r32, (hi * 8) * 2));
#pragma unroll
  for (int d0 = 0; d0 < NQK; ++d0) {
    bf16x8 kn0 = kc0, kn1 = kc1;
    if (d0 + 1 < NQK) { const int cb = ((d0 + 1) * 16 + hi * 8) * 2;
      kn0 = *reinterpret_cast<const bf16x8*>(Ks + KSWZ(r32, cb)); kn1 = *reinterpret_cast<const bf16x8*>(Ks + KSWZ(32 + r32, cb)); }
    n0 = __builtin_amdgcn_mfma_f32_32x32x16_bf16(kc0, qr[d0], n0, 0, 0, 0);
    n1 = __builtin_amdgcn_mfma_f32_32x32x16_bf16(kc1, qr[d0], n1, 0, 0, 0);
#define PIN(X) asm volatile("" : "+v"(X))
    if (NQK == 6) {
      if (d0 == 0) { PK4X(o0, 0, pa0); }
      if (d0 == 1) { PIN(o0); PK4X(o0, 8, pa1); }
      if (d0 == 2) { _Pragma("unroll") for (int r = 0; r < 16; ++r) ps += o0[r]; }
      if (d0 == 3) { PIN(o1); PK4X(o1, 0, pa2); _Pragma("unroll") for (int r = 0; r < 8; ++r) ps += o1[r]; }
      if (d0 == 4) { PIN(o1); PK4X(o1, 8, pa3); _Pragma("unroll") for (int r = 8; r < 16; ++r) ps += o1[r]; }
    } else {
      if (d0 == 0) { PK4X(o0, 0, pa0); PK4X(o0, 8, pa1); }
      if (d0 == 1) { _Pragma("unroll") for (int r = 0; r < 16; ++r) ps += o0[r]; }
      if (d0 == 2) { PIN(o1); PK4X(o1, 0, pa2); _Pragma("unroll") for (int r = 0; r < 8; ++r) ps += o1[r]; }
      if (d0 == 3) { PIN(o1); PK4X(o1, 8, pa3); _Pragma("unroll") for (int r = 8; r < 16; ++r) ps += o1[r]; }
    }
#undef PIN
    asm volatile("" : "+v"(ps), "+v"(pa0), "+v"(pa1), "+v"(pa2), "+v"(pa3));
    kc0 = kn0; kc1 = kn1;
    SBAR();
  }
  lsum += ps;
  if (__builtin_expect(shift != 0.f, 0)) {
#pragma unroll
    for (int r = 0; r < 16; ++r) { n0[r] -= shift; n1[r] -= shift; }
  }
}

template <int NQK, int MODE, int LDG>
__device__ __forceinline__ void attn_body(const u16* __restrict__ Qb, const u16* __restrict__ Kh, const u16* __restrict__ Vh,
                                          const int NT, const int q0, const float sink2, const float mbound,
                                          u16* __restrict__ mix0, const u16* __restrict__ gate0, char* lds) {
  constexpr int DK = NQK * 16;
  constexpr int SHM_V = 8192, SHM_K = 17408;
  int tid_ = threadIdx.x; asm volatile("" : "+v"(tid_));
  const int tid = tid_, wid = __builtin_amdgcn_readfirstlane(tid >> 6), lane = tid & 63, r32 = lane & 31, hi = lane >> 5;
  char* V_lds = lds; char* K_lds = lds + 5 * SHM_V;
  float* wsf = (float*)(lds + 5 * SHM_V + 5 * SHM_K) + wid * 64; float* li_l = wsf;
  float lsum = 0; f32x16 o[2] = {}; bf16x8 qr[NQK];
  const float shift = mbound > 80.f ? mbound - 80.f : 0.f;
  const u16* Qw = Qb + (size_t)(wid * 32 + r32) * DK + hi * 8;
#pragma unroll
  for (int d0 = 0; d0 < NQK; ++d0) qr[d0] = *(const bf16x8*)(Qw + d0 * 16);
  const int srow = tid >> 3, sc8 = tid & 7;
  const int kst0 = KSWZ(srow, sc8 * 16), kst1 = KSWZ(srow, 128 + sc8 * 16), vst = v_st2(srow, sc8 * 8);
  const int vb0 = (int)(uintptr_t)V_lds + v_rd_base(lane);
  const bool k1on = (NQK == 6) && (sc8 < 4);
  const unsigned koff0 = srow * DK + sc8 * 8, voff0 = srow * 64 + sc8 * 8;
  struct { bf16x8 k0, k1, v0; } st[2];
#define TROW(j) (MODE == 0 ? (j) * 64 : ((j) < 4 ? (j) * 64 : q0 + 128 + ((j) - 4) * 64))
#define SLOAD(i, kr) do { const u16* kp_ = Kh + (unsigned)((kr) * DK); st[i].k0 = *(const bf16x8*)(kp_ + koff0);   \
    if (k1on) st[i].k1 = *(const bf16x8*)(kp_ + koff0 + 64);                                                           \
    const u16* vp_ = Vh + (unsigned)((kr) * 64); st[i].v0 = *(const bf16x8*)(vp_ + voff0); } while (0)
#define SWRITE(b, i) do { *(bf16x8*)(K_lds + (b) * SHM_K + kst0) = st[i].k0; if (k1on) *(bf16x8*)(K_lds + (b) * SHM_K + kst1) = st[i].k1; \
    *(bf16x8*)(V_lds + (b) * SHM_V + vst) = st[i].v0; } while (0)
#define MASKT(P0, P1, j) do { if (MODE == 1 && (j) >= 4) { const int kb_ = q0 - 128 + ((j) - 4) * 64, qp_ = q0 + wid * 32 + r32;    \
    _Pragma("unroll") for (int r = 0; r < 16; ++r) { int k0_ = kb_ + crow(r, hi), k1_ = k0_ + 32; int d0_ = qp_ - k0_, d1_ = qp_ - k1_; \
      bool ok0 = (d0_ <= 128) && (d0_ >= -128) && (k0_ >= 0) && (k0_ < SEQ); bool ok1 = (d1_ <= 128) && (d1_ >= -128) && (k1_ >= 0) && (k1_ < SEQ); \
      P0[r] = ok0 ? P0[r] : -1e30f; P1[r] = ok1 ? P1[r] : -1e30f; } } } while (0)
  f32x16 pA0, pA1, pB0, pB1; bf16x8 pa0, pa1, pa2, pa3;
#define NXS(x) ((x) + 1 == 5 ? 0 : (x) + 1)
  __syncthreads();
  SLOAD(0, TROW(0)); asm volatile("s_waitcnt vmcnt(0)" ::: "memory"); SWRITE(0, 0);
  SLOAD(0, TROW(1)); SWRITE(1, 0);
  SLOAD(0, TROW(2)); SWRITE(2, 0);
  if (3 < NT) SLOAD(0, TROW(3));
  if (4 < NT) SLOAD(1, TROW(4));
  __syncthreads();
  qkt<NQK>(pA0, pA1, K_lds, qr, r32, hi, shift); MASKT(pA0, pA1, 0); expall(pA0, pA1);
  int c = 0;
  for (int j = 1; j + 1 < NT; j += 2) {
    const int sj = NXS(c), sj1 = NXS(sj), sj2 = NXS(sj1), sj3 = NXS(sj2);
    SBAR(); SWRITE(sj2, 0); if (j + 3 < NT) SWRITE(sj3, 1); SBAR();
    qkt_fin<NQK>(pB0, pB1, K_lds + sj * SHM_K, qr, r32, hi, shift, pA0, pA1, lsum, pa0, pa1, pa2, pa3); MASKT(pB0, pB1, j); SBAR();
    if (j + 4 < NT) SLOAD(0, TROW(j + 4)); SBAR();
    pv_exp(o, vb0 + c * SHM_V, pa0, pa1, pa2, pa3, pB0, pB1);
    SBAR();
    qkt_fin<NQK>(pA0, pA1, K_lds + sj1 * SHM_K, qr, r32, hi, shift, pB0, pB1, lsum, pa0, pa1, pa2, pa3); MASKT(pA0, pA1, j + 1); SBAR();
    if (j + 5 < NT) SLOAD(1, TROW(j + 5)); SBAR();
    pv_exp(o, vb0 + sj * SHM_V, pa0, pa1, pa2, pa3, pA0, pA1);
    __syncthreads();
    c = sj1;
  }
  { const int sl = NXS(c);
    SBAR(); qkt_fin<NQK>(pB0, pB1, K_lds + sl * SHM_K, qr, r32, hi, shift, pA0, pA1, lsum, pa0, pa1, pa2, pa3); MASKT(pB0, pB1, NT - 1); SBAR();
    pv_all(o, vb0 + c * SHM_V, pa0, pa1, pa2, pa3); expall(pB0, pB1);
    finishSM(pB0, pB1, lsum, pa0, pa1, pa2, pa3); SBAR();
    pv_all(o, vb0 + sl * SHM_V, pa0, pa1, pa2, pa3); }
#undef NXS
  float l_reg;
  { auto rr = __builtin_amdgcn_permlane32_swap(__float_as_uint(lsum), __float_as_uint(lsum), false, false);
    l_reg = __uint_as_float(rr[0]) + __uint_as_float(rr[1]); }
  if (MODE == 1) l_reg += __builtin_amdgcn_exp2f(sink2 - shift);
  if (hi == 0) li_l[r32] = l_reg; asm volatile("s_waitcnt lgkmcnt(0)" ::: "memory");
  float rli[16];
#pragma unroll
  for (int r = 0; r < 16; ++r) rli[r] = __builtin_amdgcn_rcpf(li_l[crow(r, hi)]);
#pragma unroll
  for (int r = 0; r < 16; ++r) { const int orow = wid * 32 + crow(r, hi);
#pragma unroll
    for (int d0 = 0; d0 < 2; ++d0) {
      const float g = bf2f(gate0[(size_t)orow * LDG + d0 * 32 + r32]);
      mix0[(size_t)orow * 1024 + d0 * 32 + r32] = f2bf(o[d0][r] * rli[r] * silu_f(g));
    } }
#undef TROW
#undef SLOAD
#undef SWRITE
#undef MASKT
}

template <int NQK, int LDG, bool R5>
__device__ __forceinline__ void attn_body2(const u16* __restrict__ Qb, const u16* __restrict__ Kh, const u16* __restrict__ Vh,
                                           const int NT, const float mbound, u16* __restrict__ mix0, const u16* __restrict__ gate0, char* lds) {
  constexpr int DK = NQK * 16;
  constexpr int SHM_V = 8192, SHM_K = 17408;
  int tid_ = threadIdx.x; asm volatile("" : "+v"(tid_));
  const int tid = tid_, wid = __builtin_amdgcn_readfirstlane(tid >> 6), lane = tid & 63, r32 = lane & 31, hi = lane >> 5;
  char* V_lds = lds; char* K_lds = lds + 5 * SHM_V;
  float* wsf = (float*)(lds + 5 * SHM_V + 5 * SHM_K) + wid * 64;
  float lsA = 0, lsB = 0; f32x16 oA[2] = {}, oB[2] = {}; bf16x8 qA[NQK], qB[NQK];
  const float shift = mbound > 80.f ? mbound - 80.f : 0.f;
  const u16* Qw = Qb + (size_t)(wid * 64 + r32) * DK + hi * 8;
#pragma unroll
  for (int d0 = 0; d0 < NQK; ++d0) { qA[d0] = *(const bf16x8*)(Qw + d0 * 16); qB[d0] = *(const bf16x8*)(Qw + 32 * DK + d0 * 16); }
  const int srow = tid >> 3, sc8 = tid & 7;
  const int kst0 = KSWZ(srow, sc8 * 16), kst1 = KSWZ(srow, 128 + sc8 * 16), vst = v_st2(srow, sc8 * 8);
  const int vb0 = (int)(uintptr_t)V_lds + v_rd_base(lane);
  const bool k1on = (NQK == 6) && (sc8 < 4);
  const unsigned koff0 = srow * DK + sc8 * 8, voff0 = srow * 64 + sc8 * 8;
  struct { bf16x8 k0, k1, v0; } st[R5 ? 2 : 1];
#define SLOAD(i, kr) do { const u16* kp_ = Kh + (unsigned)((kr) * DK); st[i].k0 = *(const bf16x8*)(kp_ + koff0);   \
    if (k1on) st[i].k1 = *(const bf16x8*)(kp_ + koff0 + 64);                                                           \
    const u16* vp_ = Vh + (unsigned)((kr) * 64); st[i].v0 = *(const bf16x8*)(vp_ + voff0); } while (0)
#define SWRITE(b, i) do { *(bf16x8*)(K_lds + (b) * SHM_K + kst0) = st[i].k0; if (k1on) *(bf16x8*)(K_lds + (b) * SHM_K + kst1) = st[i].k1; \
    *(bf16x8*)(V_lds + (b) * SHM_V + vst) = st[i].v0; } while (0)
#define NXS(x) ((x) + 1 == 5 ? 0 : (x) + 1)
#define UNIT(PN0, PN1, QN, KS, PO0, PO1, LSO, OO, VS) do {                                                                      \
    qkt_fin<NQK>(PN0, PN1, K_lds + (KS) * SHM_K, QN, r32, hi, shift, PO0, PO1, LSO, pa0, pa1, pa2, pa3); SBAR();               \
    pv_exp(OO, vb0 + (VS) * SHM_V, pa0, pa1, pa2, pa3, PN0, PN1); SBAR(); } while (0)
  f32x16 pA0, pA1, pB0, pB1; bf16x8 pa0, pa1, pa2, pa3;
  if constexpr (R5) {
  __syncthreads();
  SLOAD(0, 0); asm volatile("s_waitcnt vmcnt(0)" ::: "memory"); SWRITE(0, 0);
  SLOAD(0, 64); SWRITE(1, 0);
  SLOAD(0, 128); SWRITE(2, 0);
  if (3 < NT) SLOAD(0, 3 * 64);
  if (4 < NT) SLOAD(1, 4 * 64);
  __syncthreads();
  qkt<NQK>(pA0, pA1, K_lds, qA, r32, hi, shift); expall(pA0, pA1);
  int c = 0;
  for (int i = 0; 2 * i + 2 < NT; ++i) {
    const int s1 = NXS(c), s2 = NXS(s1), s3 = NXS(s2), s4 = NXS(s3);
    SBAR(); if (2 * i + 3 < NT) SWRITE(s3, 0); if (2 * i + 4 < NT) SWRITE(s4, 1); SBAR();
    UNIT(pB0, pB1, qB, c, pA0, pA1, lsA, oA, c);
    if (2 * i + 5 < NT) SLOAD(0, (2 * i + 5) * 64); SBAR();
    UNIT(pA0, pA1, qA, s1, pB0, pB1, lsB, oB, c);
    if (2 * i + 6 < NT) SLOAD(1, (2 * i + 6) * 64); SBAR();
    UNIT(pB0, pB1, qB, s1, pA0, pA1, lsA, oA, s1);
    UNIT(pA0, pA1, qA, s2, pB0, pB1, lsB, oB, s1);
    __syncthreads();
    c = s2;
  }
  { const int s1 = NXS(c);
    UNIT(pB0, pB1, qB, c, pA0, pA1, lsA, oA, c);
    UNIT(pA0, pA1, qA, s1, pB0, pB1, lsB, oB, c);
    UNIT(pB0, pB1, qB, s1, pA0, pA1, lsA, oA, s1);
    finishSM(pB0, pB1, lsB, pa0, pa1, pa2, pa3); SBAR();
    pv_all(oB, vb0 + s1 * SHM_V, pa0, pa1, pa2, pa3); }
  } else {
#define NX3(x) ((x) + 1 == 3 ? 0 : (x) + 1)
    __syncthreads();
    SLOAD(0, 0); asm volatile("s_waitcnt vmcnt(0)" ::: "memory"); SWRITE(0, 0);
    SLOAD(0, 64); SWRITE(1, 0);
    if (2 < NT) SLOAD(0, 128);
    __syncthreads();
    qkt<NQK>(pA0, pA1, K_lds, qA, r32, hi, shift); expall(pA0, pA1);
    int c = 0;
    for (int t = 0; t + 1 < NT; ++t) {
      const int s1 = NX3(c), s2 = NX3(s1);
      SBAR(); if (t + 2 < NT) SWRITE(s2, 0);
      if (t + 3 < NT) SLOAD(0, (t + 3) * 64); SBAR();
      UNIT(pB0, pB1, qB, c, pA0, pA1, lsA, oA, c);
      UNIT(pA0, pA1, qA, s1, pB0, pB1, lsB, oB, c);
      __syncthreads();
      c = s1;
    }
    UNIT(pB0, pB1, qB, c, pA0, pA1, lsA, oA, c);
    finishSM(pB0, pB1, lsB, pa0, pa1, pa2, pa3); SBAR();
    pv_all(oB, vb0 + c * SHM_V, pa0, pa1, pa2, pa3);
#undef NX3
  }
#undef UNIT
#undef NXS
#undef SLOAD
#undef SWRITE
  float lA, lB;
  { auto rr = __builtin_amdgcn_permlane32_swap(__float_as_uint(lsA), __float_as_uint(lsA), false, false); lA = __uint_as_float(rr[0]) + __uint_as_float(rr[1]); }
  { auto rr = __builtin_amdgcn_permlane32_swap(__float_as_uint(lsB), __float_as_uint(lsB), false, false); lB = __uint_as_float(rr[0]) + __uint_as_float(rr[1]); }
  if (hi == 0) { wsf[r32] = lA; wsf[32 + r32] = lB; }
  asm volatile("s_waitcnt lgkmcnt(0)" ::: "memory");
#pragma unroll
  for (int g = 0; g < 2; ++g) {
    float rli[16];
#pragma unroll
    for (int r = 0; r < 16; ++r) rli[r] = __builtin_amdgcn_rcpf(wsf[g * 32 + crow(r, hi)]);
#pragma unroll
    for (int r = 0; r < 16; ++r) { const int orow = wid * 64 + g * 32 + crow(r, hi);
#pragma unroll
      for (int d0 = 0; d0 < 2; ++d0) {
        const float gt = bf2f(gate0[(size_t)orow * LDG + d0 * 32 + r32]);
        const float ov = g == 0 ? oA[d0][r] : oB[d0][r];
        mix0[(size_t)orow * 1024 + d0 * 32 + r32] = f2bf(ov * rli[r] * silu_f(gt));
      } }
  }
}

__global__ void __launch_bounds__(512, 1) mega(Params p) {
  extern __shared__ __attribute__((aligned(16))) char lds[];
  cg::grid_group grid = cg::this_grid();
  const int bid = blockIdx.x, nblk = gridDim.x;
  char* ws = p.ws;
  float* modv = (float*)(ws + OFF_MODV);
  u16* H = (u16*)(ws + OFF_H);
  u16* PP = (u16*)(ws + OFF_PP);
  float* XC1 = (float*)(ws + OFF_XC1);
  unsigned* gcnt = (unsigned*)(ws + OFF_END);
  if (bid == 0 && threadIdx.x == 0) __hip_atomic_store(gcnt, 0u, __ATOMIC_RELAXED, __HIP_MEMORY_SCOPE_AGENT);

  if (p.ph_lo <= 0 && 0 < p.ph_hi) {
  for (int u = bid; u < 192; u += nblk) mod_unit(p, u, lds);
  }
  if (p.ph_lo <= 0 && 0 + 1 < p.ph_hi) grid.sync();
  if (p.ph_lo <= 1 && 1 < p.ph_hi) {
  for (int u = bid; u < 2064; u += nblk) transpose_unit(p, u, lds);
  adaln_phase(p.x, nullptr, p.ctx, modv, H);
  }
  if (p.ph_lo <= 1 && 1 + 1 < p.ph_hi) gbar(gcnt, 1u * gridDim.x);
  if (p.ph_lo <= 2 && 2 < p.ph_hi) {
  { TileIter ti(130, 19); GPre g; int nt = 0, mt = 0; const u16* Wt = (const u16*)(ws + OFF_WT_IN_AB);
    if (ti.valid()) { ti.get(mt, nt); gemm_preload(H, 1024, Wt, 1024, mt * 256, nt * 128, g); }
    while (ti.valid()) {
      f32x16 acc[2][2]; const int m0 = mt * 256, n0 = nt * 128;
      gemm_tile<0>(H, 1024, Wt, 1024, 1024, m0, n0, acc, lds, g);
      ti.next(); if (ti.valid()) { ti.get(mt, nt); gemm_preload(H, 1024, Wt, 1024, mt * 256, nt * 128, g); }
      epi_bf16(acc, PP, LD_AB, m0, n0, lds);
    } }
  }
  if (p.ph_lo <= 2 && 2 + 1 < p.ph_hi) gbar(gcnt, 2u * gridDim.x);
  if (p.ph_lo <= 3 && 3 < p.ph_hi) {
  { TileIter ti(130, 14); GPre g; int nt = 0, mt = 0;
    const u16* Wq = (const u16*)(ws + OFF_WT_UQ); const u16* Wkv = (const u16*)(ws + OFF_WT_UKV);
    if (ti.valid()) { ti.get(mt, nt); gemm_preload(nt < 6 ? PP : PP + 256, LD_AB, nt < 6 ? Wq : Wkv, 256, mt * 256, (nt < 6 ? nt : nt - 6) * 128, g); }
    while (ti.valid()) {
      f32x16 acc[2][2]; const int m0 = mt * 256, cn = nt, n0 = (nt < 6 ? nt : nt - 6) * 128;
      gemm_tile<0>(cn < 6 ? PP : PP + 256, LD_AB, cn < 6 ? Wq : Wkv, 256, 256, m0, n0, acc, lds, g);
      ti.next(); if (ti.valid()) { ti.get(mt, nt); gemm_preload(nt < 6 ? PP : PP + 256, LD_AB, nt < 6 ? Wq : Wkv, 256, mt * 256, (nt < 6 ? nt : nt - 6) * 128, g); }
      if (cn < 6) epi_bf16(acc, H, 768, m0, n0, lds); else epi_bf16(acc, (u16*)p.out, 1024, m0, n0, lds);
    } }
  }
  if (p.ph_lo <= 3 && 3 + 1 < p.ph_hi) gbar(gcnt, 3u * gridDim.x);
  if (p.ph_lo <= 4 && 4 < p.ph_hi) {
  finalize0(p);
  }
  if (p.ph_lo <= 4 && 4 + 1 < p.ph_hi) gbar(gcnt, 4u * gridDim.x);
  if (p.ph_lo <= 5 && 5 < p.ph_hi) {
  const float mbA = LOG2E * 9.7979590f * 1.02f * vmaxabs(p.q_gain, 96) * vmaxabs(p.k_gain, 96);
  const float mbB = LOG2E * 8.f * 1.02f * vmaxabs(p.gq_gain, 64) * vmaxabs(p.gk_gain, 64);
  for (int it = bid; it < 1056; it += nblk) {
    if (it < 512) {
      const int round = it >> 8, blk = it & 255, xcd = blk & 7, cl = blk >> 3;
      const int pair = xcd * 2 + round, b = pair >> 3, h = pair & 7, qoff = cl * 512;
      const size_t r0 = (size_t)b * SEQ + qoff;
      attn_body2<6, LD_AB, false>((const u16*)(ws + OFF_QA) + ((size_t)(b * 8 + h) * SEQ + qoff) * 96,
                                  (const u16*)(ws + OFF_KA) + (size_t)(b * 8 + h) * KVLEN * 96, (const u16*)(ws + OFF_VA) + (size_t)(b * 8 + h) * KVLEN * 64,
                                  KVLEN / 64, mbA, H + r0 * 1024 + h * 64, PP + r0 * LD_AB + 1312 + h * 64, lds);
    } else if (it < 1024) {
      const int i2 = it - 512, g = i2 >> 8, blk = i2 & 255, xcd = blk & 7, cl = blk >> 3;
      const int pi = xcd >> 1, b = pi >> 1, kvh = pi & 1, idx = (xcd & 1) * 64 + g * 32 + cl;
      const int h = kvh * 4 + (idx >> 5), qoff = (idx & 31) * 512;
      const size_t r0 = (size_t)b * SEQ + qoff;
      attn_body2<4, LD_AB, true>((const u16*)(ws + OFF_QB) + ((size_t)(b * 8 + h) * SEQ + qoff) * 64,
                           (const u16*)(ws + OFF_KB) + (size_t)(b * 2 + kvh) * KVLEN * 64, (const u16*)(ws + OFF_VB) + (size_t)(b * 2 + kvh) * KVLEN * 64,
                           KVLEN / 64, mbB, H + r0 * 1024 + 512 + h * 64, PP + r0 * LD_AB + 1312 + 512 + h * 64, lds);
    } else {
      const int ci = it - 1024, b = (ci >> 3) & 1, h = ci & 7; const bool mla = ci < 16; const int kvh = mla ? h : (h >> 2);
      const size_t r0 = (size_t)NLAT + b * CL, qrow = (size_t)(b * 8 + h) * CL;
      if (mla) attn_body<6, 0, LD_AB>((const u16*)(ws + OFF_QCA) + qrow * 96, (const u16*)(ws + OFF_KA) + (size_t)(b * 8 + kvh) * KVLEN * 96,
                                      (const u16*)(ws + OFF_VA) + (size_t)(b * 8 + kvh) * KVLEN * 64, CL / 64, 0, 0.f, mbA, H + r0 * 1024 + h * 64, PP + r0 * LD_AB + 1312 + h * 64, lds);
      else attn_body<4, 0, LD_AB>((const u16*)(ws + OFF_QCB) + qrow * 64, (const u16*)(ws + OFF_KB) + (size_t)(b * 2 + kvh) * KVLEN * 64,
                                  (const u16*)(ws + OFF_VB) + (size_t)(b * 2 + kvh) * KVLEN * 64, CL / 64, 0, 0.f, mbB, H + r0 * 1024 + 512 + h * 64, PP + r0 * LD_AB + 1312 + 512 + h * 64, lds);
    }
  }
  }
  if (p.ph_lo <= 5 && 5 + 1 < p.ph_hi) gbar(gcnt, 5u * gridDim.x);
  if (p.ph_lo <= 6 && 6 < p.ph_hi) {
  { TileIter ti(130, 8); GPre g; int nt = 0, mt = 0; const u16* Wt = (const u16*)(ws + OFF_WT_OUT_AB);
    if (ti.valid()) { ti.get(mt, nt); gemm_preload(H, 1024, Wt, 1024, mt * 256, nt * 128, g); }
    while (ti.valid()) {
      f32x16 acc[2][2]; const int m0 = mt * 256, n0 = nt * 128; const bool lat = m0 < NLAT;
      const int tid_ = opaque_tid(), wid_ = tid_ >> 6, lane_ = tid_ & 63;
      const size_t eoff = (size_t)((lat ? m0 : m0 - NLAT) + (wid_ & 3) * 64 + (lane_ >> 4)) * 1024 + n0 + (wid_ >> 2) * 64 + 4 * (lane_ & 15);
      ResPre rp;
      gemm_tile<1>(H, 1024, Wt, 1024, 1024, m0, n0, acc, lds, g, (lat ? p.x : p.ctx) + eoff, &rp);
      ti.next(); if (ti.valid()) { ti.get(mt, nt); gemm_preload(H, 1024, Wt, 1024, mt * 256, nt * 128, g); }
      if (lat) epi_res<false, true>(acc, rp, (u16*)(ws + OFF_X1B) + eoff, modv + (m0 >> 14) * 3072 + 2048, n0, lds);
      else epi_res<false, false>(acc, rp, XC1 + eoff, modv + 2 * 3072 + 2048, n0, lds);
    } }
  }
  if (p.ph_lo <= 6 && 6 + 1 < p.ph_hi) gbar(gcnt, 6u * gridDim.x);
  if (p.ph_lo <= 7 && 7 < p.ph_hi) {
  adaln_phase(nullptr, (const u16*)(ws + OFF_X1B), XC1, modv + 3 * 3072, H);
  }
  if (p.ph_lo <= 7 && 7 + 1 < p.ph_hi) gbar(gcnt, 7u * gridDim.x);
  if (p.ph_lo <= 8 && 8 < p.ph_hi) {
  { TileIter ti(130, 26); GPre g; int nt = 0, mt = 0; const u16* Wt = (const u16*)(ws + OFF_WT_IN_CD);
    if (ti.valid()) { ti.get(mt, nt); gemm_preload(H, 1024, Wt, 1024, mt * 256, nt * 128, g); }
    while (ti.valid()) {
      f32x16 acc[2][2]; const int m0 = mt * 256, n0 = nt * 128;
      gemm_tile<0>(H, 1024, Wt, 1024, 1024, m0, n0, acc, lds, g);
      ti.next(); if (ti.valid()) { ti.get(mt, nt); gemm_preload(H, 1024, Wt, 1024, mt * 256, nt * 128, g); }
      epi_bf16(acc, PP, LD_CD, m0, n0, lds);
    } }
  }
  if (p.ph_lo <= 8 && 8 + 1 < p.ph_hi) gbar(gcnt, 8u * gridDim.x);
  if (p.ph_lo <= 9 && 9 < p.ph_hi) {
  finalize1(p);
  }
  if (p.ph_lo <= 9 && 9 + 1 < p.ph_hi) gbar(gcnt, 9u * gridDim.x);
  if (p.ph_lo <= 10 && 10 < p.ph_hi) {
  const float mbW = LOG2E * 8.f * 1.02f * vmaxabs(p.win_q_gain, 64) * vmaxabs(p.win_k_gain, 64);
  for (int it = bid; it < 1024; it += nblk) {
    const int g = it >> 8, blk = it & 255, xcd = blk & 7, cl = blk >> 3;
    const int pi = xcd >> 1, b = pi >> 1, kvh = pi & 1, idx = (xcd & 1) * 128 + g * 32 + cl;
    const int h = kvh * 4 + (idx >> 6), qblk = idx & 63;
    const size_t r0 = (size_t)b * SEQ + qblk * 256;
    attn_body<4, 1, LD_CD>((const u16*)(ws + OFF_Q2) + ((size_t)(b * 8 + h) * SEQ + qblk * 256) * 64,
                    (const u16*)(ws + OFF_K2) + (size_t)(b * 2 + kvh) * KV2LEN * 64, (const u16*)(ws + OFF_V2) + (size_t)(b * 2 + kvh) * KV2LEN * 64,
                    12, qblk * 256, p.win_sink[h] * LOG2E, mbW, H + r0 * 1024 + h * 64, PP + r0 * LD_CD + 2304 + h * 64, lds);
  }
  }
  if (p.ph_lo <= 10 && 10 + 1 < p.ph_hi) gbar(gcnt, 10u * gridDim.x);
  if (p.ph_lo <= 11 && 11 < p.ph_hi) {
  { TileIter ti(128, 8); GPre g; int nt = 0, mt = 0; const u16* Wt = (const u16*)(ws + OFF_WT_OUT_CD);
    if (ti.valid()) { ti.get(mt, nt); gemm_preload(H, 1024, Wt, 1024, mt * 256, nt * 128, g); }
    while (ti.valid()) {
      f32x16 acc[2][2]; const int m0 = mt * 256, n0 = nt * 128;
      const int tid_ = opaque_tid(), wid_ = tid_ >> 6, lane_ = tid_ & 63;
      const size_t eoff = (size_t)(m0 + (wid_ & 3) * 64 + (lane_ >> 4)) * 1024 + n0 + (wid_ >> 2) * 64 + 4 * (lane_ & 15);
      ResPre rp;
      gemm_tile<2>(H, 1024, Wt, 1024, 1024, m0, n0, acc, lds, g, (const u16*)(ws + OFF_X1B) + eoff, &rp);
      ti.next(); if (ti.valid()) { ti.get(mt, nt); gemm_preload(H, 1024, Wt, 1024, mt * 256, nt * 128, g); }
      epi_res<true, false>(acc, rp, p.out + eoff, modv + 3 * 3072 + (m0 >> 14) * 3072 + 2048, n0, lds);
    } }
  }
}

extern "C" void kernel_launch(void* const* d_in, const int* in_sizes, int n_in, void* d_out, int out_size, void* d_ws, size_t ws_size, hipStream_t stream) {
  static int grid_blocks = 0;
  if (!grid_blocks) {
    if (n_in != 22 || out_size != NLAT * DM || ws_size < OFF_END + 4096) {
      fprintf(stderr, "kernel_launch: shape/ws mismatch n_in %d out %d ws %zu need %zu\n", n_in, out_size, ws_size, (size_t)OFF_END);
      return;
    }
    if (hipFuncSetAttribute((const void*)mega, hipFuncAttributeMaxDynamicSharedMemorySize, LDS_BYTES) != hipSuccess) {
      fprintf(stderr, "kernel_launch: hipFuncSetAttribute failed\n"); return;
    }
    int dev = 0, cus = 0, per_cu = 0;
    (void)hipGetDevice(&dev);
    (void)hipDeviceGetAttribute(&cus, hipDeviceAttributeMultiprocessorCount, dev);
    (void)hipOccupancyMaxActiveBlocksPerMultiprocessor(&per_cu, mega, 512, LDS_BYTES);
    if (per_cu < 1) { fprintf(stderr, "kernel_launch: occupancy 0\n"); return; }
    grid_blocks = cus;
  }
  Params p{};
  p.x = (const float*)d_in[0]; p.c = (const float*)d_in[1]; p.ctx = (const float*)d_in[2]; p.c_ctx = (const float*)d_in[3];
  p.mod_w = (const float*)d_in[4]; p.mod_b = (const float*)d_in[5]; p.ab_w_in = (const float*)d_in[6]; p.ab_w_out = (const float*)d_in[7];
  p.cq_gain = (const float*)d_in[8]; p.ckv_gain = (const float*)d_in[9]; p.w_uq = (const float*)d_in[10]; p.w_ukv = (const float*)d_in[11];
  p.q_gain = (const float*)d_in[12]; p.k_gain = (const float*)d_in[13]; p.gq_gain = (const float*)d_in[14]; p.gk_gain = (const float*)d_in[15];
  p.cd_w_in = (const float*)d_in[16]; p.cd_w_out = (const float*)d_in[17]; p.win_q_gain = (const float*)d_in[18]; p.win_k_gain = (const float*)d_in[19];
  p.win_sink = (const float*)d_in[20]; p.conv_w = (const float*)d_in[21];
  p.out = (float*)d_out; p.ws = (char*)d_ws;
#if MULTI_LAUNCH
  for (int ph = 0; ph < 12; ++ph) {
    p.ph_lo = ph; p.ph_hi = ph + 1;
    hipLaunchKernelGGL(mega, dim3(grid_blocks), dim3(512), LDS_BYTES, stream, p);
  }
#else
  p.ph_lo = 0; p.ph_hi = 12;
  void* args[] = {&p};
  hipError_t e = hipLaunchCooperativeKernel((void*)mega, dim3(grid_blocks), dim3(512), args, LDS_BYTES, stream);
  if (e != hipSuccess) fprintf(stderr, "cooperative launch failed: %s (grid %d)\n", hipGetErrorString(e), grid_blocks);
#endif
}
```

```cpp
#include <hip/hip_runtime.h>
#include <hip/hip_cooperative_groups.h>
#include <cstdio>
#include <cstdint>
namespace cg = cooperative_groups;

typedef unsigned short u16;
using bf16x8 = __attribute__((ext_vector_type(8))) short;
using s16x4  = __attribute__((ext_vector_type(4))) short;
using f32x16 = __attribute__((ext_vector_type(16))) float;
using u32x4  = __attribute__((ext_vector_type(4))) unsigned;
using u32x2  = __attribute__((ext_vector_type(2))) unsigned;

constexpr int NB = 2, SEQ = 16384, DM = 1024, CL = 256;
constexpr int NLAT = NB * SEQ;
constexpr int NROW = NLAT + NB * CL;
constexpr int KVLEN = CL + SEQ;
constexpr int KV2LEN = KVLEN + 128;
constexpr int LD_AB = 2432, LD_CD = 3328;
constexpr float EPS = 1e-6f;
constexpr float QS_A = 0.14724461f;
constexpr float QS_B = 0.18033688f;
constexpr float LOG2E = 1.4426950408889634f;

constexpr size_t OFF_MODV      = 0;
constexpr size_t OFF_WT_IN_AB  = 73728;
constexpr size_t OFF_WT_OUT_AB = OFF_WT_IN_AB + (size_t)LD_AB * 1024 * 2;
constexpr size_t OFF_WT_UQ     = OFF_WT_OUT_AB + (size_t)1024 * 1024 * 2;
constexpr size_t OFF_WT_UKV    = OFF_WT_UQ + (size_t)768 * 256 * 2;
constexpr size_t OFF_WT_IN_CD  = OFF_WT_UKV + (size_t)1024 * 256 * 2;
constexpr size_t OFF_WT_OUT_CD = OFF_WT_IN_CD + (size_t)3328 * 1024 * 2;
constexpr size_t OFF_XC1       = OFF_WT_OUT_CD + (size_t)1024 * 1024 * 2;
constexpr size_t OFF_H         = OFF_XC1 + (size_t)512 * 1024 * 4;
constexpr size_t OFF_PP        = OFF_H + (size_t)NROW * 1024 * 2;
constexpr size_t OFF_QA        = OFF_PP + (size_t)NROW * 3328 * 2;
constexpr size_t OFF_QCA       = OFF_QA + (size_t)NB * 8 * SEQ * 96 * 2;
constexpr size_t OFF_KA        = OFF_QCA + (size_t)NB * 8 * CL * 96 * 2;
constexpr size_t OFF_VA        = OFF_KA + (size_t)NB * 8 * KVLEN * 96 * 2;
constexpr size_t OFF_QB        = OFF_VA + (size_t)NB * 8 * KVLEN * 64 * 2;
constexpr size_t OFF_QCB       = OFF_QB + (size_t)NB * 8 * SEQ * 64 * 2;
constexpr size_t OFF_KB        = OFF_QCB + (size_t)NB * 8 * CL * 64 * 2;
constexpr size_t OFF_VB        = OFF_KB + (size_t)NB * 2 * KVLEN * 64 * 2;
constexpr size_t OFF_END       = OFF_VB + (size_t)NB * 2 * KVLEN * 64 * 2;
constexpr size_t OFF_Q2        = OFF_QA;
constexpr size_t OFF_K2        = OFF_Q2 + (size_t)NB * 8 * SEQ * 64 * 2;
constexpr size_t OFF_V2        = OFF_K2 + (size_t)NB * 2 * KV2LEN * 64 * 2;
constexpr size_t OFF_X1B       = OFF_QA + ((size_t)64 << 20);
static_assert(OFF_V2 + (size_t)NB * 2 * KV2LEN * 64 * 2 <= OFF_X1B && OFF_X1B + (size_t)NLAT * 1024 * 2 <= OFF_END, "x1 alias");
static_assert(OFF_V2 + (size_t)NB * 2 * KV2LEN * 64 * 2 <= OFF_END, "alias overflow");

constexpr int LDS_BYTES = 147456;
#ifndef MULTI_LAUNCH
#define MULTI_LAUNCH 0
#endif

struct Params {
  const float *x, *c, *ctx, *c_ctx, *mod_w, *mod_b, *ab_w_in, *ab_w_out, *cq_gain, *ckv_gain, *w_uq, *w_ukv,
      *q_gain, *k_gain, *gq_gain, *gk_gain, *cd_w_in, *cd_w_out, *win_q_gain, *win_k_gain, *win_sink, *conv_w;
  float* out;
  char* ws;
  int ph_lo, ph_hi;
};

#define SBAR() __builtin_amdgcn_sched_barrier(0)
__device__ __forceinline__ int crow(int r, int hi) { return (r & 3) + 8 * (r >> 2) + 4 * hi; }
typedef float f32x2_t __attribute__((ext_vector_type(2)));
typedef __bf16 bf16x2_t __attribute__((ext_vector_type(2)));
__device__ __forceinline__ unsigned cvtpk(float lo, float hi) { f32x2_t v = {lo, hi}; bf16x2_t b = __builtin_convertvector(v, bf16x2_t); return __builtin_bit_cast(unsigned, b); }
__device__ __forceinline__ u16 f2bf(float x) { return (u16)(cvtpk(x, 0.f) & 0xffffu); }
__device__ __forceinline__ float bf2f(u16 x) { return __uint_as_float(((unsigned)x) << 16); }
__device__ __forceinline__ float bflo(unsigned w) { return __uint_as_float(w << 16); }
__device__ __forceinline__ float bfhi(unsigned w) { return __uint_as_float(w & 0xffff0000u); }
__device__ __forceinline__ float wave_sum(float v) {
#pragma unroll
  for (int o = 32; o >= 1; o >>= 1) v += __shfl_xor(v, o);
  return v;
}
__device__ __forceinline__ int opaque_tid() { int t = threadIdx.x; asm volatile("" : "+v"(t)); return t; }
__device__ __forceinline__ float vmaxabs(const float* g, int n) { float m = 0.f; for (int i = 0; i < n; ++i) m = fmaxf(m, fabsf(g[i])); return m; }
__device__ __forceinline__ float silu_f(float g) { return g / (1.f + __expf(-g)); }


__device__ __forceinline__ void gbar(unsigned* cnt, unsigned target) {
  asm volatile("s_waitcnt vmcnt(0)" ::: "memory");
  __syncthreads();
  if (threadIdx.x == 0) {
    __builtin_amdgcn_fence(__ATOMIC_RELEASE, "agent");
    asm volatile("s_waitcnt vmcnt(0)" ::: "memory");
    __hip_atomic_fetch_add(cnt, 1u, __ATOMIC_RELAXED, __HIP_MEMORY_SCOPE_AGENT);
    unsigned sp = 0;
    while (__hip_atomic_load(cnt, __ATOMIC_RELAXED, __HIP_MEMORY_SCOPE_AGENT) < target) { __builtin_amdgcn_s_sleep(1); if (++sp > (1u << 24)) break; }
    __builtin_amdgcn_fence(__ATOMIC_ACQUIRE, "agent");
    asm volatile("s_waitcnt vmcnt(0)" ::: "memory");
  }
  __syncthreads();
}

__device__ void mod_unit(const Params& p, int u, char* lds) {
  const int tid = opaque_tid();
  const int layer = u / 96, n0 = (u % 96) * 32, col = tid & 31, ks = tid >> 5;
  const float* W = p.mod_w + (size_t)layer * 1024 * 3072 + n0 + col;
  float a0 = 0, a1 = 0, a2 = 0;
  for (int k = ks * 64; k < ks * 64 + 64; ++k) {
    float w = W[(size_t)k * 3072];
    a0 += silu_f(p.c[k]) * w; a1 += silu_f(p.c[1024 + k]) * w; a2 += silu_f(p.c_ctx[k]) * w;
  }
  float* red = (float*)lds;
  red[(0 * 16 + ks) * 32 + col] = a0; red[(1 * 16 + ks) * 32 + col] = a1; red[(2 * 16 + ks) * 32 + col] = a2;
  __syncthreads();
  if (tid < 96) {
    int w = tid >> 5, cc = tid & 31; float s = 0;
    for (int i = 0; i < 16; ++i) s += red[(w * 16 + i) * 32 + cc];
    float* modv = (float*)(p.ws + OFF_MODV);
    modv[(layer * 3 + w) * 3072 + n0 + cc] = s + p.mod_b[layer * 3072 + n0 + cc];
  }
  __syncthreads();
}

__device__ void transpose_unit(const Params& p, int u, char* lds) {
  const float* src; const float* gain = nullptr; int K, N; u16* dst; int ul;
  if (u < 608)       { ul = u;        src = p.ab_w_in;  K = 1024; N = 2336; dst = (u16*)(p.ws + OFF_WT_IN_AB); }
  else if (u < 864)  { ul = u - 608;  src = p.ab_w_out; K = 1024; N = 1024; dst = (u16*)(p.ws + OFF_WT_OUT_AB); }
  else if (u < 912)  { ul = u - 864;  src = p.w_uq;     K = 256;  N = 768;  dst = (u16*)(p.ws + OFF_WT_UQ); gain = p.cq_gain; }
  else if (u < 976)  { ul = u - 912;  src = p.w_ukv;    K = 256;  N = 1024; dst = (u16*)(p.ws + OFF_WT_UKV); gain = p.ckv_gain; }
  else if (u < 1808) { ul = u - 976;  src = p.cd_w_in;  K = 1024; N = 3328; dst = (u16*)(p.ws + OFF_WT_IN_CD); }
  else               { ul = u - 1808; src = p.cd_w_out; K = 1024; N = 1024; dst = (u16*)(p.ws + OFF_WT_OUT_CD); }
  const int nkt = K / 64, kt = ul % nkt, nt = ul / nkt, k0 = kt * 64, n0 = nt * 64, tid = opaque_tid();
  float* tile = (float*)lds;
#pragma unroll
  for (int e = 0; e < 8; ++e) {
    int i = (tid >> 6) + 8 * e, j = tid & 63, n = n0 + j;
    float v = (n < N) ? src[(size_t)(k0 + i) * N + n] : 0.f;
    if (gain) v *= gain[k0 + i];
    tile[i * 65 + j] = v;
  }
  __syncthreads();
#pragma unroll
  for (int e = 0; e < 8; ++e) {
    int i2 = (tid >> 6) + 8 * e, j2 = tid & 63;
    dst[(size_t)(n0 + i2) * K + k0 + j2] = f2bf(tile[j2 * 65 + i2]);
  }
  __syncthreads();
}

__device__ void adaln_phase(const float* xlat, const u16* xlat_bf, const float* xctx, const float* modl, u16* H) {
  const int tid = opaque_tid(), lane = tid & 63, gw = blockIdx.x * 8 + (tid >> 6), nw = gridDim.x * 8;
  for (int r = gw; r < NROW; r += nw) {
    if (xlat_bf != nullptr && r < NLAT) {
      const float* m = modl + (r >> 14) * 3072;
      u32x4 w[2]; float f[16]; float ss = 0;
#pragma unroll
      for (int i = 0; i < 2; ++i) w[i] = *(const u32x4*)(xlat_bf + (size_t)r * 1024 + 8 * (lane + 64 * i));
#pragma unroll
      for (int i = 0; i < 2; ++i)
#pragma unroll
        for (int e = 0; e < 4; ++e) { f[i * 8 + 2 * e] = bflo(w[i][e]); f[i * 8 + 2 * e + 1] = bfhi(w[i][e]); }
#pragma unroll
      for (int e = 0; e < 16; ++e) ss += f[e] * f[e];
      ss = wave_sum(ss);
      const float rstd = rsqrtf(ss * (1.f / 1024) + EPS);
#pragma unroll
      for (int i = 0; i < 2; ++i) {
        const int c = 8 * (lane + 64 * i);
        const float4 sh0 = *(const float4*)(m + c), sh1 = *(const float4*)(m + c + 4), sc0 = *(const float4*)(m + 1024 + c), sc1 = *(const float4*)(m + 1024 + c + 4);
        const float shv[8] = {sh0.x, sh0.y, sh0.z, sh0.w, sh1.x, sh1.y, sh1.z, sh1.w}, scv[8] = {sc0.x, sc0.y, sc0.z, sc0.w, sc1.x, sc1.y, sc1.z, sc1.w};
        float y[8];
#pragma unroll
        for (int e = 0; e < 8; ++e) y[e] = f[i * 8 + e] * rstd * (1.f + scv[e]) + shv[e];
        const u32x4 o = {cvtpk(y[0], y[1]), cvtpk(y[2], y[3]), cvtpk(y[4], y[5]), cvtpk(y[6], y[7])};
        *(u32x4*)(H + (size_t)r * 1024 + c) = o;
      }
      continue;
    }
    const float* src = r < NLAT ? xlat + (size_t)r * 1024 : xctx + (size_t)(r - NLAT) * 1024;
    const float* m = modl + (r < NLAT ? (r >> 14) : 2) * 3072;
    float4 v[4]; float ss = 0;
#pragma unroll
    for (int i = 0; i < 4; ++i) { v[i] = ((const float4*)src)[lane + 64 * i]; ss += v[i].x * v[i].x + v[i].y * v[i].y + v[i].z * v[i].z + v[i].w * v[i].w; }
    ss = wave_sum(ss);
    const float rstd = rsqrtf(ss * (1.f / 1024) + EPS);
#pragma unroll
    for (int i = 0; i < 4; ++i) {
      int c = 4 * (lane + 64 * i);
      float4 sh = *(const float4*)(m + c), sc = *(const float4*)(m + 1024 + c);
      float y0 = v[i].x * rstd * (1.f + sc.x) + sh.x, y1 = v[i].y * rstd * (1.f + sc.y) + sh.y;
      float y2 = v[i].z * rstd * (1.f + sc.z) + sh.z, y3 = v[i].w * rstd * (1.f + sc.w) + sh.w;
      u32x2 o = {cvtpk(y0, y1), cvtpk(y2, y3)};
      *(u32x2*)(H + (size_t)r * 1024 + c) = o;
    }
  }
}

#define GSWZ(row, colB) ((row) * 128 + ((colB) ^ ((((row) >> 1) & 7) << 4)))
struct ResPre { float4 v[16]; u32x2 w[16]; };
struct GPre { bf16x8 ra[4], rb[2]; };
__device__ __forceinline__ void gemm_preload(const u16* __restrict__ A, int lda, const u16* __restrict__ Bt, int ldb, int m0, int n0, GPre& g) {
  const int tid = opaque_tid(), srow = tid >> 3, sch = tid & 7;
  const u16* ap = A + (size_t)(m0 + srow) * lda + sch * 8;
  const u16* bp = Bt + (size_t)(n0 + srow) * ldb + sch * 8;
#pragma unroll
  for (int i = 0; i < 4; ++i) g.ra[i] = *(const bf16x8*)(ap + (size_t)(64 * i) * lda);
#pragma unroll
  for (int i = 0; i < 2; ++i) g.rb[i] = *(const bf16x8*)(bp + (size_t)(64 * i) * ldb);
}
template <int PRE>
__device__ __forceinline__ void gemm_tile(const u16* __restrict__ A, int lda, const u16* __restrict__ Bt, int ldb, int K,
                                          int m0, int n0, f32x16 (&acc)[2][2], char* lds, GPre& g, const void* resp = nullptr, ResPre* rp = nullptr) {
  const int tid = opaque_tid(), wid = tid >> 6, lane = tid & 63, r32 = lane & 31, hi = lane >> 5;
  const int wm = wid & 3, wn = wid >> 2;
  char* As = lds;
  char* Bs = lds + 98304;
  const int srow = tid >> 3, sch = tid & 7;
  const u16* ap = A + (size_t)(m0 + srow) * lda + sch * 8;
  const u16* bp = Bt + (size_t)(n0 + srow) * ldb + sch * 8;
  const int sw = GSWZ(srow, sch * 16);
  bf16x8 (&ra)[4] = g.ra; bf16x8 (&rb)[2] = g.rb;
#pragma unroll
  for (int i = 0; i < 2; ++i) for (int j = 0; j < 2; ++j) acc[i][j] = f32x16{};
  const int nk = K / 64;
  __syncthreads();
#pragma unroll
  for (int i = 0; i < 4; ++i) *(bf16x8*)(As + sw + i * 8192) = ra[i];
#pragma unroll
  for (int i = 0; i < 2; ++i) *(bf16x8*)(Bs + sw + i * 8192) = rb[i];
  if (1 < nk) {
#pragma unroll
    for (int i = 0; i < 4; ++i) ra[i] = *(const bf16x8*)(ap + (size_t)(64 * i) * lda + 64);
#pragma unroll
    for (int i = 0; i < 2; ++i) rb[i] = *(const bf16x8*)(bp + (size_t)(64 * i) * ldb + 64);
  }
  __syncthreads();
  const int arow0 = wm * 64 + r32, brow0 = wn * 64 + r32;
  int st = 0;
  for (int kt = 0; kt < nk; ++kt) {
    const int stn = (st == 2) ? 0 : st + 1;
    if (kt + 1 < nk) {
      char* An = As + stn * 32768; char* Bn = Bs + stn * 16384;
#pragma unroll
      for (int i = 0; i < 4; ++i) *(bf16x8*)(An + sw + i * 8192) = ra[i];
#pragma unroll
      for (int i = 0; i < 2; ++i) *(bf16x8*)(Bn + sw + i * 8192) = rb[i];
    }
    if (kt + 2 < nk) {
#pragma unroll
      for (int i = 0; i < 4; ++i) ra[i] = *(const bf16x8*)(ap + (size_t)(64 * i) * lda + (kt + 2) * 64);
#pragma unroll
      for (int i = 0; i < 2; ++i) rb[i] = *(const bf16x8*)(bp + (size_t)(64 * i) * ldb + (kt + 2) * 64);
    }
    if (PRE == 1 && kt == 0) {
#pragma unroll
      for (int q = 0; q < 16; ++q) rp->v[q] = *(const float4*)((const float*)resp + (size_t)((q >> 3) * 32 + 4 * (q & 7)) * 1024);
    }
    if (PRE == 2 && kt == 0) {
#pragma unroll
      for (int q = 0; q < 16; ++q) rp->w[q] = *(const u32x2*)((const u16*)resp + (size_t)((q >> 3) * 32 + 4 * (q & 7)) * 1024);
    }
    SBAR();
    const char* Ac = As + st * 32768; const char* Bc = Bs + st * 16384;
#pragma unroll
    for (int kk = 0; kk < 4; ++kk) {
      const int cb = kk * 32 + hi * 16;
      bf16x8 a0 = *(const bf16x8*)(Ac + GSWZ(arow0, cb));
      bf16x8 a1 = *(const bf16x8*)(Ac + GSWZ(arow0 + 32, cb));
      bf16x8 b0 = *(const bf16x8*)(Bc + GSWZ(brow0, cb));
      bf16x8 b1 = *(const bf16x8*)(Bc + GSWZ(brow0 + 32, cb));
      acc[0][0] = __builtin_amdgcn_mfma_f32_32x32x16_bf16(a0, b0, acc[0][0], 0, 0, 0);
      acc[0][1] = __builtin_amdgcn_mfma_f32_32x32x16_bf16(a0, b1, acc[0][1], 0, 0, 0);
      acc[1][0] = __builtin_amdgcn_mfma_f32_32x32x16_bf16(a1, b0, acc[1][0], 0, 0, 0);
      acc[1][1] = __builtin_amdgcn_mfma_f32_32x32x16_bf16(a1, b1, acc[1][1], 0, 0, 0);
    }
    __syncthreads();
    st = stn;
  }
}

struct TileIter {
  int f, fend, step, MT, NT;
  __device__ __forceinline__ TileIter(int MT_, int NT_) : MT(MT_), NT(NT_) {
    const int T = MT_ * NT_, bid = blockIdx.x, nblk = gridDim.x;
    if (nblk == 256) { const int x = bid & 7, cl = bid >> 3; f = (int)(((long)T * x) >> 3) + cl; fend = (int)(((long)T * (x + 1)) >> 3); step = 32; }
    else { f = bid; fend = T; step = nblk; }
  }
  __device__ __forceinline__ bool valid() const { return f < fend; }
  __device__ __forceinline__ void next() { f += step; }
  __device__ __forceinline__ void get(int& mt, int& nt) const {
    const int full = (MT >> 2) * 4 * NT;
    if (f < full) { const int g = f / (4 * NT), rem = f - g * 4 * NT; nt = rem >> 2; mt = g * 4 + (rem & 3); }
    else { const int rem = f - full, gs = MT - (MT >> 2) * 4; nt = rem / gs; mt = (MT >> 2) * 4 + (rem - nt * gs); }
  }
};

__device__ __forceinline__ void epi_bf16(f32x16 (&acc)[2][2], u16* C, int ldc, int m0, int n0, char* lds) {
  const int tid = opaque_tid(), wid = tid >> 6, lane = tid & 63, r32 = lane & 31, hi = lane >> 5;
  const int wm = wid & 3, wn = wid >> 2;
  char* wl = lds + wid * 9216;
#pragma unroll
  for (int i = 0; i < 2; ++i)
#pragma unroll
    for (int j = 0; j < 2; ++j)
#pragma unroll
      for (int r = 0; r < 16; ++r) *(u16*)(wl + (i * 32 + crow(r, hi)) * 144 + (j * 32 + r32) * 2) = f2bf(acc[i][j][r]);
  asm volatile("s_waitcnt lgkmcnt(0)" ::: "memory");
  const int rr = lane >> 3, ch = lane & 7;
  u16* cbase = C + (size_t)(m0 + wm * 64 + rr) * ldc + n0 + wn * 64 + ch * 8;
#pragma unroll
  for (int k = 0; k < 8; ++k) {
    const u32x4 v = *(const u32x4*)(wl + (rr + 8 * k) * 144 + ch * 16);
    *(u32x4*)(cbase + (size_t)(8 * k) * ldc) = v;
  }
}
template <bool IN_BF, bool OUT_BF>
__device__ __forceinline__ void epi_res(f32x16 (&acc)[2][2], const ResPre& rp, void* outp, const float* gsrc, int n0, char* lds) {
  const int tid = opaque_tid(), wid = tid >> 6, lane = tid & 63, r32 = lane & 31, hi = lane >> 5;
  const int wn = wid >> 2;
  char* wl = lds + wid * 8704;
  const int rl = lane >> 4, c4 = lane & 15;
  const float4 g = *(const float4*)(gsrc + n0 + wn * 64 + 4 * c4);
#pragma unroll
  for (int i = 0; i < 2; ++i) {
#pragma unroll
    for (int j = 0; j < 2; ++j)
#pragma unroll
      for (int r = 0; r < 16; ++r) *(float*)(wl + crow(r, hi) * 272 + (j * 32 + r32) * 4) = acc[i][j][r];
    asm volatile("s_waitcnt lgkmcnt(0)" ::: "memory");
#pragma unroll
    for (int k = 0; k < 8; ++k) {
      const float4 a = *(const float4*)(wl + (rl + 4 * k) * 272 + c4 * 16);
      float4 x;
      if (IN_BF) { const u32x2 xw = rp.w[i * 8 + k]; x.x = bflo(xw[0]); x.y = bfhi(xw[0]); x.z = bflo(xw[1]); x.w = bfhi(xw[1]); } else x = rp.v[i * 8 + k];
      float4 o; o.x = x.x + g.x * a.x; o.y = x.y + g.y * a.y; o.z = x.z + g.z * a.z; o.w = x.w + g.w * a.w;
      if (OUT_BF) { const u32x2 ow = {cvtpk(o.x, o.y), cvtpk(o.z, o.w)}; *(u32x2*)((u16*)outp + (size_t)(i * 32 + 4 * k) * 1024) = ow; }
      else *(float4*)((float*)outp + (size_t)(i * 32 + 4 * k) * 1024) = o;
    }
    asm volatile("s_waitcnt lgkmcnt(0)" ::: "memory");
  }
}

__device__ __forceinline__ float red8(float v) { v += __shfl_xor(v, 1); v += __shfl_xor(v, 2); v += __shfl_xor(v, 4); return v; }
__device__ __forceinline__ void rope_cs(float pos, float inv, bool on, float& c, float& s) {
  if (on) { float a = pos * inv * 0.15915494309189535f; a -= floorf(a); c = __builtin_amdgcn_cosf(a); s = __builtin_amdgcn_sinf(a); } else { c = 1.f; s = 0.f; }
}
__device__ __forceinline__ void head64(const u16* src, u16* dst, int gb, const float* g, const float* cG, const float* sG, float qs) {
  const u32x2 lo = *(const u32x2*)(src + gb), hi2 = *(const u32x2*)(src + gb + 16);
  float x[8] = {bflo(lo[0]), bfhi(lo[0]), bflo(lo[1]), bfhi(lo[1]), bflo(hi2[0]), bfhi(hi2[0]), bflo(hi2[1]), bfhi(hi2[1])};
  float ss = 0;
#pragma unroll
  for (int e = 0; e < 8; ++e) ss += x[e] * x[e];
  const float rn = rsqrtf(red8(ss) * (1.f / 64) + EPS) ;
#pragma unroll
  for (int e = 0; e < 8; ++e) x[e] *= rn * g[e];
  float y[8];
#pragma unroll
  for (int e = 0; e < 4; ++e) { y[e] = (x[e] * cG[e] - x[e + 4] * sG[e]) * qs; y[e + 4] = (x[e + 4] * cG[e] + x[e] * sG[e]) * qs; }
  const u32x2 o0 = {cvtpk(y[0], y[1]), cvtpk(y[2], y[3])}, o1 = {cvtpk(y[4], y[5]), cvtpk(y[6], y[7])};
  *(u32x2*)(dst + gb) = o0; *(u32x2*)(dst + gb + 16) = o1;
}
__device__ __forceinline__ void head96(float* n, float r1a, float r1b, float r2a, float r2b, u16* dst, int t, int rb,
                                       const float* gn, const float* gr, const float* cM, const float* sM, float qs) {
  float ss = r1a * r1a + r1b * r1b + r2a * r2a + r2b * r2b;
#pragma unroll
  for (int e = 0; e < 8; ++e) ss += n[e] * n[e];
  const float rn = rsqrtf(red8(ss) * (1.f / 96) + EPS);
#pragma unroll
  for (int e = 0; e < 8; ++e) n[e] *= rn * gn[e] * qs;
  r1a *= rn * gr[0]; r1b *= rn * gr[1]; r2a *= rn * gr[2]; r2b *= rn * gr[3];
  const float y1a = (r1a * cM[0] - r2a * sM[0]) * qs, y2a = (r2a * cM[0] + r1a * sM[0]) * qs;
  const float y1b = (r1b * cM[1] - r2b * sM[1]) * qs, y2b = (r2b * cM[1] + r1b * sM[1]) * qs;
  const u32x4 o = {cvtpk(n[0], n[1]), cvtpk(n[2], n[3]), cvtpk(n[4], n[5]), cvtpk(n[6], n[7])};
  *(u32x4*)(dst + 8 * t) = o;
  *(unsigned*)(dst + 64 + rb) = cvtpk(y1a, y1b); *(unsigned*)(dst + 64 + rb + 8) = cvtpk(y2a, y2b);
}
__device__ void finalize0(const Params& p) {
  const int tid = opaque_tid(), lane = tid & 63, gw = blockIdx.x * 8 + (tid >> 6), nw = gridDim.x * 8;
  const int h = lane >> 3, t = lane & 7;
  char* ws = p.ws;
  const u16* PP = (const u16*)(ws + OFF_PP);
  const u16* QAR = (const u16*)(ws + OFF_H);
  const u16* KVR = (const u16*)p.out;
  u16* QA = (u16*)(ws + OFF_QA); u16* QCA = (u16*)(ws + OFF_QCA); u16* KA = (u16*)(ws + OFF_KA); u16* VA = (u16*)(ws + OFF_VA);
  u16* QB = (u16*)(ws + OFF_QB); u16* QCB = (u16*)(ws + OFF_QCB); u16* KB = (u16*)(ws + OFF_KB); u16* VB = (u16*)(ws + OFF_VB);
  const int gb = t < 4 ? 4 * t : 32 + 4 * (t - 4), rb = t < 4 ? 2 * t : 16 + 2 * (t - 4);
  float qgn[8], kgn[8], qgr[4], kgr[4], gqg[8], gkg[8], invG[4], invM[2];
#pragma unroll
  for (int e = 0; e < 8; ++e) { qgn[e] = p.q_gain[8 * t + e]; kgn[e] = p.k_gain[8 * t + e];
    const int d = gb + (e & 3) + (e >> 2) * 16; gqg[e] = p.gq_gain[d]; gkg[e] = p.gk_gain[d]; }
#pragma unroll
  for (int k = 0; k < 4; ++k) { const int d = 64 + rb + (k & 1) + (k >> 1) * 8; qgr[k] = p.q_gain[d]; kgr[k] = p.k_gain[d]; }
#pragma unroll
  for (int e = 0; e < 4; ++e) invG[e] = exp2f(-(float)(4 * (t & 3) + e) * (13.287712379549449f / 16.f));
#pragma unroll
  for (int k = 0; k < 2; ++k) invM[k] = exp2f(-(float)(2 * (t & 3) + k) * (13.287712379549449f / 8.f));
  for (int r = gw; r < NROW; r += nw) {
    const bool isctx = r >= NLAT;
    int b, s, kpos; float pos = 0.f;
    if (!isctx) { b = r >> 14; s = r & 16383; kpos = CL + s; pos = t < 4 ? (float)(s >> 6) : (float)(s & 63); }
    else { int rc = r - NLAT; b = rc >> 8; s = rc & 255; kpos = s; }
    float cG[4], sG[4], cM[2], sM[2];
#pragma unroll
    for (int e = 0; e < 4; ++e) rope_cs(pos, invG[e], !isctx, cG[e], sG[e]);
#pragma unroll
    for (int k = 0; k < 2; ++k) rope_cs(pos, invM[k], !isctx, cM[k], sM[k]);
    const u16* pp = PP + (size_t)r * LD_AB;
    const u32x2 wq = *(const u32x2*)(pp + lane * 4), wk = *(const u32x2*)(pp + 256 + lane * 4);
    float s1 = bflo(wq[0]) * bflo(wq[0]) + bfhi(wq[0]) * bfhi(wq[0]) + bflo(wq[1]) * bflo(wq[1]) + bfhi(wq[1]) * bfhi(wq[1]);
    float s2 = bflo(wk[0]) * bflo(wk[0]) + bfhi(wk[0]) * bfhi(wk[0]) + bflo(wk[1]) * bflo(wk[1]) + bfhi(wk[1]) * bfhi(wk[1]);
    s1 = wave_sum(s1); s2 = wave_sum(s2);
    const float rstd_cq = rsqrtf(s1 * (1.f / 256) + EPS), rstd_ckv = rsqrtf(s2 * (1.f / 256) + EPS);
    { const u16* qa = QAR + (size_t)r * 768 + h * 96;
      const u32x4 nv = *(const u32x4*)(qa + 8 * t); const unsigned w1 = *(const unsigned*)(qa + 64 + rb), w2 = *(const unsigned*)(qa + 64 + rb + 8);
      float n[8] = {bflo(nv[0]) * rstd_cq, bfhi(nv[0]) * rstd_cq, bflo(nv[1]) * rstd_cq, bfhi(nv[1]) * rstd_cq, bflo(nv[2]) * rstd_cq, bfhi(nv[2]) * rstd_cq, bflo(nv[3]) * rstd_cq, bfhi(nv[3]) * rstd_cq};
      u16* dq = isctx ? QCA + ((size_t)(b * 8 + h) * CL + s) * 96 : QA + ((size_t)(b * 8 + h) * SEQ + s) * 96;
      head96(n, bflo(w1) * rstd_cq, bfhi(w1) * rstd_cq, bflo(w2) * rstd_cq, bfhi(w2) * rstd_cq, dq, t, rb, qgn, qgr, cM, sM, QS_A); }
    { const u16* kv = KVR + (size_t)r * 1024 + h * 128;
      const u32x4 nv = *(const u32x4*)(kv + 8 * t), vv = *(const u32x4*)(kv + 64 + 8 * t);
      const unsigned w1 = *(const unsigned*)(pp + 512 + rb), w2 = *(const unsigned*)(pp + 512 + rb + 8);
      float n[8] = {bflo(nv[0]) * rstd_ckv, bfhi(nv[0]) * rstd_ckv, bflo(nv[1]) * rstd_ckv, bfhi(nv[1]) * rstd_ckv, bflo(nv[2]) * rstd_ckv, bfhi(nv[2]) * rstd_ckv, bflo(nv[3]) * rstd_ckv, bfhi(nv[3]) * rstd_ckv};
      const size_t kr = (size_t)(b * 8 + h) * KVLEN + kpos;
      head96(n, bflo(w1), bfhi(w1), bflo(w2), bfhi(w2), KA + kr * 96, t, rb, kgn, kgr, cM, sM, 1.f);
      const u32x4 vo = {cvtpk(bflo(vv[0]) * rstd_ckv, bfhi(vv[0]) * rstd_ckv), cvtpk(bflo(vv[1]) * rstd_ckv, bfhi(vv[1]) * rstd_ckv),
                        cvtpk(bflo(vv[2]) * rstd_ckv, bfhi(vv[2]) * rstd_ckv), cvtpk(bflo(vv[3]) * rstd_ckv, bfhi(vv[3]) * rstd_ckv)};
      *(u32x4*)(VA + kr * 64 + 8 * t) = vo; }
    { u16* dg = isctx ? QCB + ((size_t)(b * 8 + h) * CL + s) * 64 : QB + ((size_t)(b * 8 + h) * SEQ + s) * 64;
      head64(pp + 544 + h * 64, dg, gb, gqg, cG, sG, QS_B); }
    if (h < 2) {
      const size_t kr = (size_t)(b * 2 + h) * KVLEN + kpos;
      head64(pp + 1056 + h * 64, KB + kr * 64, gb, gkg, cG, sG, 1.f);
      *(u32x4*)(VB + kr * 64 + 8 * t) = *(const u32x4*)(pp + 1184 + h * 64 + 8 * t);
    }
  }
}

__device__ void finalize1(const Params& p) {
  const int tid = opaque_tid(), lane = tid & 63, gw = blockIdx.x * 8 + (tid >> 6), nw = gridDim.x * 8;
  const int h = lane >> 3, t = lane & 7;
  char* ws = p.ws;
  const u16* PP = (const u16*)(ws + OFF_PP);
  u16* Q2 = (u16*)(ws + OFF_Q2); u16* K2 = (u16*)(ws + OFF_K2); u16* V2 = (u16*)(ws + OFF_V2);
  u16* MIX = (u16*)(ws + OFF_H);
  const int gb = t < 4 ? 4 * t : 32 + 4 * (t - 4);
  float qg[8], kg[8], invG[4];
#pragma unroll
  for (int e = 0; e < 8; ++e) { const int d = gb + (e & 3) + (e >> 2) * 16; qg[e] = p.win_q_gain[d]; kg[e] = p.win_k_gain[d]; }
#pragma unroll
  for (int e = 0; e < 4; ++e) invG[e] = exp2f(-(float)(4 * (t & 3) + e) * (13.287712379549449f / 16.f));
  float cw[3][8];
#pragma unroll
  for (int j = 0; j < 3; ++j)
#pragma unroll
    for (int e = 0; e < 8; ++e) cw[j][e] = p.conv_w[j * 512 + lane * 8 + e];
  for (int r = gw; r < NROW + 512; r += nw) {
    if (r >= NROW) {
      int slab = (r - NROW) >> 7, pr = (r - NROW) & 127;
      size_t kr = (size_t)slab * KV2LEN + KVLEN + pr;
      K2[kr * 64 + lane] = 0; V2[kr * 64 + lane] = 0;
      continue;
    }
    const bool isctx = r >= NLAT;
    int b, s, kpos; float pos = 0.f;
    if (!isctx) { b = r >> 14; s = r & 16383; kpos = CL + s; pos = t < 4 ? (float)(s >> 6) : (float)(s & 63); }
    else { int rc = r - NLAT; b = rc >> 8; s = rc & 255; kpos = s; }
    float cG[4], sG[4];
#pragma unroll
    for (int e = 0; e < 4; ++e) rope_cs(pos, invG[e], !isctx, cG[e], sG[e]);
    const u16* pp = PP + (size_t)r * LD_CD;
    if (!isctx) head64(pp + h * 64, Q2 + ((size_t)(b * 8 + h) * SEQ + s) * 64, gb, qg, cG, sG, QS_B);
    if (h < 2) {
      const size_t kr = (size_t)(b * 2 + h) * KV2LEN + kpos;
      head64(pp + 512 + h * 64, K2 + kr * 64, gb, kg, cG, sG, 1.f);
      *(u32x4*)(V2 + kr * 64 + 8 * t) = *(const u32x4*)(pp + 640 + h * 64 + 8 * t);
    }
    if (!isctx) {
      const int c0 = lane * 8;
      float y[8];
#pragma unroll
      for (int e = 0; e < 8; ++e) y[e] = 0.f;
#pragma unroll
      for (int j = 0; j < 3; ++j) {
        const int sj = s + j - 1;
        if (sj >= 0 && sj < SEQ) {
          const u16* pj = pp + (ptrdiff_t)(j - 1) * LD_CD;
          u32x4 a = *(const u32x4*)(pj + 1280 + c0), bb = *(const u32x4*)(pj + 1792 + c0);
#pragma unroll
          for (int e = 0; e < 4; ++e) {
            y[2 * e]     += bflo(a[e]) * bflo(bb[e]) * cw[j][2 * e];
            y[2 * e + 1] += bfhi(a[e]) * bfhi(bb[e]) * cw[j][2 * e + 1];
          }
        }
      }
      u32x4 gbv = *(const u32x4*)(pp + 768 + c0), gt = *(const u32x4*)(pp + 2304 + 512 + c0);
      u32x4 o;
#pragma unroll
      for (int e = 0; e < 4; ++e) {
        float v0 = bflo(gbv[e]) * y[2 * e] * silu_f(bflo(gt[e]));
        float v1 = bfhi(gbv[e]) * y[2 * e + 1] * silu_f(bfhi(gt[e]));
        o[e] = cvtpk(v0, v1);
      }
      *(u32x4*)(MIX + (size_t)r * 1024 + 512 + c0) = o;
    }
  }
}

#define KSWZ(row, colB) ((row) * 272 + (colB))
__device__ __forceinline__ int v_st2(int k, int c) { const int kk = k; return ((kk >> 3) * 2 + (c >> 5)) * 512 + ((kk & 7) * 32 + (c & 31)) * 2; }
__device__ __forceinline__ int v_rd_base(int lane) { return ((lane & 3) << 3) | (((lane >> 2) & 3) << 6) | (((lane >> 4) & 1) << 5) | (((lane >> 5) & 1) << 8); }
constexpr int v_rd_off2(int d0, int ks, int half) { return d0 * 512 + ks * 2048 + half * 1024; }
template <int OFF> __device__ __forceinline__ s16x4 tr_read(int vb) {
  s16x4 r; asm volatile("ds_read_b64_tr_b16 %0, %1 offset:%2" : "=&v"(r) : "v"(vb), "i"(OFF) : "memory"); return r;
}
template <int D0> __device__ __forceinline__ void pv_one(f32x16& od, int vb, bf16x8 pa0, bf16x8 pa1, bf16x8 pa2, bf16x8 pa3) {
  const s16x4 l0 = tr_read<v_rd_off2(D0, 0, 0)>(vb), h0 = tr_read<v_rd_off2(D0, 0, 1)>(vb), l1 = tr_read<v_rd_off2(D0, 1, 0)>(vb), h1 = tr_read<v_rd_off2(D0, 1, 1)>(vb);
  const s16x4 l2 = tr_read<v_rd_off2(D0, 2, 0)>(vb), h2 = tr_read<v_rd_off2(D0, 2, 1)>(vb), l3 = tr_read<v_rd_off2(D0, 3, 0)>(vb), h3 = tr_read<v_rd_off2(D0, 3, 1)>(vb);
  asm volatile("s_waitcnt lgkmcnt(0)" ::: "memory"); SBAR();
#define PK(L, H) (bf16x8){L[0], L[1], L[2], L[3], H[0], H[1], H[2], H[3]}
  od = __builtin_amdgcn_mfma_f32_32x32x16_bf16(pa0, PK(l0, h0), od, 0, 0, 0);
  od = __builtin_amdgcn_mfma_f32_32x32x16_bf16(pa1, PK(l1, h1), od, 0, 0, 0);
  od = __builtin_amdgcn_mfma_f32_32x32x16_bf16(pa2, PK(l2, h2), od, 0, 0, 0);
  od = __builtin_amdgcn_mfma_f32_32x32x16_bf16(pa3, PK(l3, h3), od, 0, 0, 0);
#undef PK
}
__device__ __forceinline__ void pv_all(f32x16* o, int vb, bf16x8 pa0, bf16x8 pa1, bf16x8 pa2, bf16x8 pa3) {
  pv_one<0>(o[0], vb, pa0, pa1, pa2, pa3); pv_one<1>(o[1], vb, pa0, pa1, pa2, pa3);
}
__device__ __forceinline__ void pv_exp(f32x16* o, int vb, bf16x8 pa0, bf16x8 pa1, bf16x8 pa2, bf16x8 pa3, f32x16& n0, f32x16& n1) {
#define PK(L, H) (bf16x8){L[0], L[1], L[2], L[3], H[0], H[1], H[2], H[3]}
  { const s16x4 l0 = tr_read<v_rd_off2(0, 0, 0)>(vb), h0 = tr_read<v_rd_off2(0, 0, 1)>(vb), l1 = tr_read<v_rd_off2(0, 1, 0)>(vb), h1 = tr_read<v_rd_off2(0, 1, 1)>(vb);
    const s16x4 l2 = tr_read<v_rd_off2(0, 2, 0)>(vb), h2 = tr_read<v_rd_off2(0, 2, 1)>(vb), l3 = tr_read<v_rd_off2(0, 3, 0)>(vb), h3 = tr_read<v_rd_off2(0, 3, 1)>(vb);
#pragma unroll
    for (int r = 0; r < 8; ++r) n0[r] = __builtin_amdgcn_exp2f(n0[r]);
    asm volatile("s_waitcnt lgkmcnt(0)" ::: "memory"); SBAR();
    o[0] = __builtin_amdgcn_mfma_f32_32x32x16_bf16(pa0, PK(l0, h0), o[0], 0, 0, 0);
    o[0] = __builtin_amdgcn_mfma_f32_32x32x16_bf16(pa1, PK(l1, h1), o[0], 0, 0, 0);
    o[0] = __builtin_amdgcn_mfma_f32_32x32x16_bf16(pa2, PK(l2, h2), o[0], 0, 0, 0);
    o[0] = __builtin_amdgcn_mfma_f32_32x32x16_bf16(pa3, PK(l3, h3), o[0], 0, 0, 0); }
  { const s16x4 l0 = tr_read<v_rd_off2(1, 0, 0)>(vb), h0 = tr_read<v_rd_off2(1, 0, 1)>(vb), l1 = tr_read<v_rd_off2(1, 1, 0)>(vb), h1 = tr_read<v_rd_off2(1, 1, 1)>(vb);
    const s16x4 l2 = tr_read<v_rd_off2(1, 2, 0)>(vb), h2 = tr_read<v_rd_off2(1, 2, 1)>(vb), l3 = tr_read<v_rd_off2(1, 3, 0)>(vb), h3 = tr_read<v_rd_off2(1, 3, 1)>(vb);
#pragma unroll
    for (int r = 8; r < 16; ++r) n0[r] = __builtin_amdgcn_exp2f(n0[r]);
    asm volatile("s_waitcnt lgkmcnt(0)" ::: "memory"); SBAR();
    o[1] = __builtin_amdgcn_mfma_f32_32x32x16_bf16(pa0, PK(l0, h0), o[1], 0, 0, 0);
    o[1] = __builtin_amdgcn_mfma_f32_32x32x16_bf16(pa1, PK(l1, h1), o[1], 0, 0, 0);
    o[1] = __builtin_amdgcn_mfma_f32_32x32x16_bf16(pa2, PK(l2, h2), o[1], 0, 0, 0);
    o[1] = __builtin_amdgcn_mfma_f32_32x32x16_bf16(pa3, PK(l3, h3), o[1], 0, 0, 0); }
#undef PK
#pragma unroll
  for (int r = 0; r < 16; ++r) n1[r] = __builtin_amdgcn_exp2f(n1[r]);
}

__device__ __forceinline__ void expall(f32x16& p0, f32x16& p1) {
#pragma unroll
  for (int r = 0; r < 16; ++r) p0[r] = __builtin_amdgcn_exp2f(p0[r]);
#pragma unroll
  for (int r = 0; r < 16; ++r) p1[r] = __builtin_amdgcn_exp2f(p1[r]);
}
__device__ __forceinline__ void finishSM(f32x16& p0, f32x16& p1, float& lsum, bf16x8& pa0, bf16x8& pa1, bf16x8& pa2, bf16x8& pa3) {
  float ps = 0;
#pragma unroll
  for (int r = 0; r < 16; ++r) ps += p0[r];
#pragma unroll
  for (int r = 0; r < 16; ++r) ps += p1[r];
  lsum += ps;
#define PK4(P, BASE, OUT) do { u32x4 w = {cvtpk(P[BASE + 0], P[BASE + 1]), cvtpk(P[BASE + 2], P[BASE + 3]), cvtpk(P[BASE + 4], P[BASE + 5]), cvtpk(P[BASE + 6], P[BASE + 7])}; \
    OUT = *reinterpret_cast<bf16x8*>(&w); } while (0)
  PK4(p0, 0, pa0); PK4(p0, 8, pa1); PK4(p1, 0, pa2); PK4(p1, 8, pa3);
#undef PK4
}
template <int NQK>
__device__ __forceinline__ void qkt(f32x16& p0, f32x16& p1, const char* Ks, const bf16x8* qr, int r32, int hi, const float shift) {
  p0 = f32x16{}; p1 = f32x16{};
#pragma unroll
  for (int d0 = 0; d0 < NQK; ++d0) { int cb = (d0 * 16 + hi * 8) * 2;
    bf16x8 b0 = *reinterpret_cast<const bf16x8*>(Ks + KSWZ(r32, cb));
    bf16x8 b1 = *reinterpret_cast<const bf16x8*>(Ks + KSWZ(32 + r32, cb));
    p0 = __builtin_amdgcn_mfma_f32_32x32x16_bf16(b0, qr[d0], p0, 0, 0, 0);
    p1 = __builtin_amdgcn_mfma_f32_32x32x16_bf16(b1, qr[d0], p1, 0, 0, 0); }
  if (__builtin_expect(shift != 0.f, 0)) {
#pragma unroll
    for (int r = 0; r < 16; ++r) { p0[r] -= shift; p1[r] -= shift; }
  }
}

#define PK4X(P, BASE, OUT) do { u32x4 w_ = {cvtpk(P[BASE + 0], P[BASE + 1]), cvtpk(P[BASE + 2], P[BASE + 3]), cvtpk(P[BASE + 4], P[BASE + 5]), cvtpk(P[BASE + 6], P[BASE + 7])}; \
    OUT = *reinterpret_cast<bf16x8*>(&w_); } while (0)
template <int NQK>
__device__ __forceinline__ void qkt_fin(f32x16& n0, f32x16& n1, const char* Ks, const bf16x8* qr, int r32, int hi, const float shift,
                                        f32x16& o0, f32x16& o1, float& lsum, bf16x8& pa0, bf16x8& pa1, bf16x8& pa2, bf16x8& pa3) {
  n0 = f32x16{}; n1 = f32x16{};
  float ps = 0.f;
  bf16x8 kc0 = *reinterpret_cast<const bf16x8*>(Ks + KSWZ(r32, (hi * 8) * 2));
  bf16x8 kc1 = *reinterpret_cast<const bf16x8*>(Ks + KSWZ(32 + r32, (hi * 8) * 2));
#pragma unroll
  for (int d0 = 0; d0 < NQK; ++d0) {
    bf16x8 kn0 = kc0, kn1 = kc1;
    if (d0 + 1 < NQK) { const int cb = ((d0 + 1) * 16 + hi * 8) * 2;
      kn0 = *reinterpret_cast<const bf16x8*>(Ks + KSWZ(r32, cb)); kn1 = *reinterpret_cast<const bf16x8*>(Ks + KSWZ(32 + r32, cb)); }
    n0 = __builtin_amdgcn_mfma_f32_32x32x16_bf16(kc0, qr[d0], n0, 0, 0, 0);
    n1 = __builtin_amdgcn_mfma_f32_32x32x16_bf16(kc1, qr[d0], n1, 0, 0, 0);
#define PIN(X) asm volatile("" : "+v"(X))
    if (NQK == 6) {
      if (d0 == 0) { PK4X(o0, 0, pa0); }
      if (d0 == 1) { PIN(o0); PK4X(o0, 8, pa1); }
      if (d0 == 2) { _Pragma("unroll") for (int r = 0; r < 16; ++r) ps += o0[r]; }
      if (d0 == 3) { PIN(o1); PK4X(o1, 0, pa2); _Pragma("unroll") for (int r = 0; r < 8; ++r) ps += o1[r]; }
      if (d0 == 4) { PIN(o1); PK4X(o1, 8, pa3); _Pragma("unroll") for (int r = 8; r < 16; ++r) ps += o1[r]; }
    } else {
      if (d0 == 0) { PK4X(o0, 0, pa0); PK4X(o0, 8, pa1); }
      if (d0 == 1) { _Pragma("unroll") for (int r = 0; r < 16; ++r) ps += o0[r]; }
      if (d0 == 2) { PIN(o1); PK4X(o1, 0, pa2); _Pragma("unroll") for (int r = 0; r < 8; ++r) ps += o1[r]; }
      if (d0 == 3) { PIN(o1); PK4X(o1, 8, pa3); _Pragma("unroll") for (int r = 8; r < 16; ++r) ps += o1[r]; }
    }
#undef PIN
    asm volatile("" : "+v"(ps), "+v"(pa0), "+v"(pa1), "+v"(pa2), "+v"(pa3));
    kc0 = kn0; kc1 = kn1;
    SBAR();
  }
  lsum += ps;
  if (__builtin_expect(shift != 0.f, 0)) {
#pragma unroll
    for (int r = 0; r < 16; ++r) { n0[r] -= shift; n1[r] -= shift; }
  }
}

template <int NQK, int MODE, int LDG>
__device__ __forceinline__ void attn_body(const u16* __restrict__ Qb, const u16* __restrict__ Kh, const u16* __restrict__ Vh,
                                          const int NT, const int q0, const float sink2, const float mbound,
                                          u16* __restrict__ mix0, const u16* __restrict__ gate0, char* lds) {
  constexpr int DK = NQK * 16;
  constexpr int SHM_V = 8192, SHM_K = 17408;
  int tid_ = threadIdx.x; asm volatile("" : "+v"(tid_));
  const int tid = tid_, wid = __builtin_amdgcn_readfirstlane(tid >> 6), lane = tid & 63, r32 = lane & 31, hi = lane >> 5;
  char* V_lds = lds; char* K_lds = lds + 5 * SHM_V;
  float* wsf = (float*)(lds + 5 * SHM_V + 5 * SHM_K) + wid * 64; float* li_l = wsf;
  float lsum = 0; f32x16 o[2] = {}; bf16x8 qr[NQK];
  const float shift = mbound > 80.f ? mbound - 80.f : 0.f;
  const u16* Qw = Qb + (size_t)(wid * 32 + r32) * DK + hi * 8;
#pragma unroll
  for (int d0 = 0; d0 < NQK; ++d0) qr[d0] = *(const bf16x8*)(Qw + d0 * 16);
  const int srow = tid >> 3, sc8 = tid & 7;
  const int kst0 = KSWZ(srow, sc8 * 16), kst1 = KSWZ(srow, 128 + sc8 * 16), vst = v_st2(srow, sc8 * 8);
  const int vb0 = (int)(uintptr_t)V_lds + v_rd_base(lane);
  const bool k1on = (NQK == 6) && (sc8 < 4);
  const unsigned koff0 = srow * DK + sc8 * 8, voff0 = srow * 64 + sc8 * 8;
  struct { bf16x8 k0, k1, v0; } st[2];
#define TROW(j) (MODE == 0 ? (j) * 64 : ((j) < 4 ? (j) * 64 : q0 + 128 + ((j) - 4) * 64))
#define SLOAD(i, kr) do { const u16* kp_ = Kh + (unsigned)((kr) * DK); st[i].k0 = *(const bf16x8*)(kp_ + koff0);   \
    if (k1on) st[i].k1 = *(const bf16x8*)(kp_ + koff0 + 64);                                                           \
    const u16* vp_ = Vh + (unsigned)((kr) * 64); st[i].v0 = *(const bf16x8*)(vp_ + voff0); } while (0)
#define SWRITE(b, i) do { *(bf16x8*)(K_lds + (b) * SHM_K + kst0) = st[i].k0; if (k1on) *(bf16x8*)(K_lds + (b) * SHM_K + kst1) = st[i].k1; \
    *(bf16x8*)(V_lds + (b) * SHM_V + vst) = st[i].v0; } while (0)
#define MASKT(P0, P1, j) do { if (MODE == 1 && (j) >= 4) { const int kb_ = q0 - 128 + ((j) - 4) * 64, qp_ = q0 + wid * 32 + r32;    \
    _Pragma("unroll") for (int r = 0; r < 16; ++r) { int k0_ = kb_ + crow(r, hi), k1_ = k0_ + 32; int d0_ = qp_ - k0_, d1_ = qp_ - k1_; \
      bool ok0 = (d0_ <= 128) && (d0_ >= -128) && (k0_ >= 0) && (k0_ < SEQ); bool ok1 = (d1_ <= 128) && (d1_ >= -128) && (k1_ >= 0) && (k1_ < SEQ); \
      P0[r] = ok0 ? P0[r] : -1e30f; P1[r] = ok1 ? P1[r] : -1e30f; } } } while (0)
  f32x16 pA0, pA1, pB0, pB1; bf16x8 pa0, pa1, pa2, pa3;
#define NXS(x) ((x) + 1 == 5 ? 0 : (x) + 1)
  __syncthreads();
  SLOAD(0, TROW(0)); asm volatile("s_waitcnt vmcnt(0)" ::: "memory"); SWRITE(0, 0);
  SLOAD(0, TROW(1)); SWRITE(1, 0);
  SLOAD(0, TROW(2)); SWRITE(2, 0);
  if (3 < NT) SLOAD(0, TROW(3));
  if (4 < NT) SLOAD(1, TROW(4));
  __syncthreads();
  qkt<NQK>(pA0, pA1, K_lds, qr, r32, hi, shift); MASKT(pA0, pA1, 0); expall(pA0, pA1);
  int c = 0;
  for (int j = 1; j + 1 < NT; j += 2) {
    const int sj = NXS(c), sj1 = NXS(sj), sj2 = NXS(sj1), sj3 = NXS(sj2);
    SBAR(); SWRITE(sj2, 0); if (j + 3 < NT) SWRITE(sj3, 1); SBAR();
    qkt_fin<NQK>(pB0, pB1, K_lds + sj * SHM_K, qr, r32, hi, shift, pA0, pA1, lsum, pa0, pa1, pa2, pa3); MASKT(pB0, pB1, j); SBAR();
    if (j + 4 < NT) SLOAD(0, TROW(j + 4)); SBAR();
    pv_exp(o, vb0 + c * SHM_V, pa0, pa1, pa2, pa3, pB0, pB1);
    SBAR();
    qkt_fin<NQK>(pA0, pA1, K_lds + sj1 * SHM_K, qr, r32, hi, shift, pB0, pB1, lsum, pa0, pa1, pa2, pa3); MASKT(pA0, pA1, j + 1); SBAR();
    if (j + 5 < NT) SLOAD(1, TROW(j + 5)); SBAR();
    pv_exp(o, vb0 + sj * SHM_V, pa0, pa1, pa2, pa3, pA0, pA1);
    __syncthreads();
    c = sj1;
  }
  { const int sl = NXS(c);
    SBAR(); qkt_fin<NQK>(pB0, pB1, K_lds + sl * SHM_K, qr, r32, hi, shift, pA0, pA1, lsum, pa0, pa1, pa2, pa3); MASKT(pB0, pB1, NT - 1); SBAR();
    pv_all(o, vb0 + c * SHM_V, pa0, pa1, pa2, pa3); expall(pB0, pB1);
    finishSM(pB0, pB1, lsum, pa0, pa1, pa2, pa3); SBAR();
    pv_all(o, vb0 + sl * SHM_V, pa0, pa1, pa2, pa3); }
#undef NXS
  float l_reg;
  { auto rr = __builtin_amdgcn_permlane32_swap(__float_as_uint(lsum), __float_as_uint(lsum), false, false);
    l_reg = __uint_as_float(rr[0]) + __uint_as_float(rr[1]); }
  if (MODE == 1) l_reg += __builtin_amdgcn_exp2f(sink2 - shift);
  if (hi == 0) li_l[r32] = l_reg; asm volatile("s_waitcnt lgkmcnt(0)" ::: "memory");
  float rli[16];
#pragma unroll
  for (int r = 0; r < 16; ++r) rli[r] = __builtin_amdgcn_rcpf(li_l[crow(r, hi)]);
#pragma unroll
  for (int r = 0; r < 16; ++r) { const int orow = wid * 32 + crow(r, hi);
#pragma unroll
    for (int d0 = 0; d0 < 2; ++d0) {
      const float g = bf2f(gate0[(size_t)orow * LDG + d0 * 32 + r32]);
      mix0[(size_t)orow * 1024 + d0 * 32 + r32] = f2bf(o[d0][r] * rli[r] * silu_f(g));
    } }
#undef TROW
#undef SLOAD
#undef SWRITE
#undef MASKT
}

template <int NQK, int LDG, bool R5>
__device__ __forceinline__ void attn_body2(const u16* __restrict__ Qb, const u16* __restrict__ Kh, const u16* __restrict__ Vh,
                                           const int NT, const float mbound, u16* __restrict__ mix0, const u16* __restrict__ gate0, char* lds) {
  constexpr int DK = NQK * 16;
  constexpr int SHM_V = 8192, SHM_K = 17408;
  int tid_ = threadIdx.x; asm volatile("" : "+v"(tid_));
  const int tid = tid_, wid = __builtin_amdgcn_readfirstlane(tid >> 6), lane = tid & 63, r32 = lane & 31, hi = lane >> 5;
  char* V_lds = lds; char* K_lds = lds + 5 * SHM_V;
  float* wsf = (float*)(lds + 5 * SHM_V + 5 * SHM_K) + wid * 64;
  float lsA = 0, lsB = 0; f32x16 oA[2] = {}, oB[2] = {}; bf16x8 qA[NQK], qB[NQK];
  const float shift = mbound > 80.f ? mbound - 80.f : 0.f;
  const u16* Qw = Qb + (size_t)(wid * 64 + r32) * DK + hi * 8;
#pragma unroll
  for (int d0 = 0; d0 < NQK; ++d0) { qA[d0] = *(const bf16x8*)(Qw + d0 * 16); qB[d0] = *(const bf16x8*)(Qw + 32 * DK + d0 * 16); }
  const int srow = tid >> 3, sc8 = tid & 7;
  const int kst0 = KSWZ(srow, sc8 * 16), kst1 = KSWZ(srow, 128 + sc8 * 16), vst = v_st2(srow, sc8 * 8);
  const int vb0 = (int)(uintptr_t)V_lds + v_rd_base(lane);
  const bool k1on = (NQK == 6) && (sc8 < 4);
  const unsigned koff0 = srow * DK + sc8 * 8, voff0 = srow * 64 + sc8 * 8;
  struct { bf16x8 k0, k1, v0; } st[R5 ? 2 : 1];
#define SLOAD(i, kr) do { const u16* kp_ = Kh + (unsigned)((kr) * DK); st[i].k0 = *(const bf16x8*)(kp_ + koff0);   \
    if (k1on) st[i].k1 = *(const bf16x8*)(kp_ + koff0 + 64);                                                           \
    const u16* vp_ = Vh + (unsigned)((kr) * 64); st[i].v0 = *(const bf16x8*)(vp_ + voff0); } while (0)
#define SWRITE(b, i) do { *(bf16x8*)(K_lds + (b) * SHM_K + kst0) = st[i].k0; if (k1on) *(bf16x8*)(K_lds + (b) * SHM_K + kst1) = st[i].k1; \
    *(bf16x8*)(V_lds + (b) * SHM_V + vst) = st[i].v0; } while (0)
#define NXS(x) ((x) + 1 == 5 ? 0 : (x) + 1)
#define UNIT(PN0, PN1, QN, KS, PO0, PO1, LSO, OO, VS) do {                                                                      \
    qkt_fin<NQK>(PN0, PN1, K_lds + (KS) * SHM_K, QN, r32, hi, shift, PO0, PO1, LSO, pa0, pa1, pa2, pa3); SBAR();               \
    pv_exp(OO, vb0 + (VS) * SHM_V, pa0, pa1, pa2, pa3, PN0, PN1); SBAR(); } while (0)
  f32x16 pA0, pA1, pB0, pB1; bf16x8 pa0, pa1, pa2, pa3;
  if constexpr (R5) {
  __syncthreads();
  SLOAD(0, 0); asm volatile("s_waitcnt vmcnt(0)" ::: "memory"); SWRITE(0, 0);
  SLOAD(0, 64); SWRITE(1, 0);
  SLOAD(0, 128); SWRITE(2, 0);
  if (3 < NT) SLOAD(0, 3 * 64);
  if (4 < NT) SLOAD(1, 4 * 64);
  __syncthreads();
  qkt<NQK>(pA0, pA1, K_lds, qA, r32, hi, shift); expall(pA0, pA1);
  int c = 0;
  for (int i = 0; 2 * i + 2 < NT; ++i) {
    const int s1 = NXS(c), s2 = NXS(s1), s3 = NXS(s2), s4 = NXS(s3);
    SBAR(); if (2 * i + 3 < NT) SWRITE(s3, 0); if (2 * i + 4 < NT) SWRITE(s4, 1);
    if (2 * i + 5 < NT) SLOAD(0, (2 * i + 5) * 64); if (2 * i + 6 < NT) SLOAD(1, (2 * i + 6) * 64); SBAR();
    UNIT(pB0, pB1, qB, c, pA0, pA1, lsA, oA, c);
    UNIT(pA0, pA1, qA, s1, pB0, pB1, lsB, oB, c);
    UNIT(pB0, pB1, qB, s1, pA0, pA1, lsA, oA, s1);
    UNIT(pA0, pA1, qA, s2, pB0, pB1, lsB, oB, s1);
    __syncthreads();
    c = s2;
  }
  { const int s1 = NXS(c);
    UNIT(pB0, pB1, qB, c, pA0, pA1, lsA, oA, c);
    UNIT(pA0, pA1, qA, s1, pB0, pB1, lsB, oB, c);
    UNIT(pB0, pB1, qB, s1, pA0, pA1, lsA, oA, s1);
    finishSM(pB0, pB1, lsB, pa0, pa1, pa2, pa3); SBAR();
    pv_all(oB, vb0 + s1 * SHM_V, pa0, pa1, pa2, pa3); }
  } else {
#define NX3(x) ((x) + 1 == 3 ? 0 : (x) + 1)
    __syncthreads();
    SLOAD(0, 0); asm volatile("s_waitcnt vmcnt(0)" ::: "memory"); SWRITE(0, 0);
    SLOAD(0, 64); SWRITE(1, 0);
    if (2 < NT) SLOAD(0, 128);
    __syncthreads();
    qkt<NQK>(pA0, pA1, K_lds, qA, r32, hi, shift); expall(pA0, pA1);
    int c = 0;
    for (int t = 0; t + 1 < NT; ++t) {
      const int s1 = NX3(c), s2 = NX3(s1);
      SBAR(); if (t + 2 < NT) SWRITE(s2, 0);
      if (t + 3 < NT) SLOAD(0, (t + 3) * 64); SBAR();
      UNIT(pB0, pB1, qB, c, pA0, pA1, lsA, oA, c);
      UNIT(pA0, pA1, qA, s1, pB0, pB1, lsB, oB, c);
      __syncthreads();
      c = s1;
    }
    UNIT(pB0, pB1, qB, c, pA0, pA1, lsA, oA, c);
    finishSM(pB0, pB1, lsB, pa0, pa1, pa2, pa3); SBAR();
    pv_all(oB, vb0 + c * SHM_V, pa0, pa1, pa2, pa3);
#undef NX3
  }
#undef UNIT
#undef NXS
#undef SLOAD
#undef SWRITE
  float lA, lB;
  { auto rr = __builtin_amdgcn_permlane32_swap(__float_as_uint(lsA), __float_as_uint(lsA), false, false); lA = __uint_as_float(rr[0]) + __uint_as_float(rr[1]); }
  { auto rr = __builtin_amdgcn_permlane32_swap(__float_as_uint(lsB), __float_as_uint(lsB), false, false); lB = __uint_as_float(rr[0]) + __uint_as_float(rr[1]); }
  if (hi == 0) { wsf[r32] = lA; wsf[32 + r32] = lB; }
  asm volatile("s_waitcnt lgkmcnt(0)" ::: "memory");
#pragma unroll
  for (int g = 0; g < 2; ++g) {
    float rli[16];
#pragma unroll
    for (int r = 0; r < 16; ++r) rli[r] = __builtin_amdgcn_rcpf(wsf[g * 32 + crow(r, hi)]);
#pragma unroll
    for (int r = 0; r < 16; ++r) { const int orow = wid * 64 + g * 32 + crow(r, hi);
#pragma unroll
      for (int d0 = 0; d0 < 2; ++d0) {
        const float gt = bf2f(gate0[(size_t)orow * LDG + d0 * 32 + r32]);
        const float ov = g == 0 ? oA[d0][r] : oB[d0][r];
        mix0[(size_t)orow * 1024 + d0 * 32 + r32] = f2bf(ov * rli[r] * silu_f(gt));
      } }
  }
}

__global__ void __launch_bounds__(512, 1) mega(Params p) {
  extern __shared__ __attribute__((aligned(16))) char lds[];
  cg::grid_group grid = cg::this_grid();
  const int bid = blockIdx.x, nblk = gridDim.x;
  char* ws = p.ws;
  float* modv = (float*)(ws + OFF_MODV);
  u16* H = (u16*)(ws + OFF_H);
  u16* PP = (u16*)(ws + OFF_PP);
  float* XC1 = (float*)(ws + OFF_XC1);
  unsigned* gcnt = (unsigned*)(ws + OFF_END);
  if (bid == 0 && threadIdx.x == 0) __hip_atomic_store(gcnt, 0u, __ATOMIC_RELAXED, __HIP_MEMORY_SCOPE_AGENT);

  if (p.ph_lo <= 0 && 0 < p.ph_hi) {
  for (int u = bid; u < 192; u += nblk) mod_unit(p, u, lds);
  }
  if (p.ph_lo <= 0 && 0 + 1 < p.ph_hi) grid.sync();
  if (p.ph_lo <= 1 && 1 < p.ph_hi) {
  for (int u = bid; u < 2064; u += nblk) transpose_unit(p, u, lds);
  adaln_phase(p.x, nullptr, p.ctx, modv, H);
  }
  if (p.ph_lo <= 1 && 1 + 1 < p.ph_hi) gbar(gcnt, 1u * gridDim.x);
  if (p.ph_lo <= 2 && 2 < p.ph_hi) {
  { TileIter ti(130, 19); GPre g; int nt = 0, mt = 0; const u16* Wt = (const u16*)(ws + OFF_WT_IN_AB);
    if (ti.valid()) { ti.get(mt, nt); gemm_preload(H, 1024, Wt, 1024, mt * 256, nt * 128, g); }
    while (ti.valid()) {
      f32x16 acc[2][2]; const int m0 = mt * 256, n0 = nt * 128;
      gemm_tile<0>(H, 1024, Wt, 1024, 1024, m0, n0, acc, lds, g);
      ti.next(); if (ti.valid()) { ti.get(mt, nt); gemm_preload(H, 1024, Wt, 1024, mt * 256, nt * 128, g); }
      epi_bf16(acc, PP, LD_AB, m0, n0, lds);
    } }
  }
  if (p.ph_lo <= 2 && 2 + 1 < p.ph_hi) gbar(gcnt, 2u * gridDim.x);
  if (p.ph_lo <= 3 && 3 < p.ph_hi) {
  { TileIter ti(130, 14); GPre g; int nt = 0, mt = 0;
    const u16* Wq = (const u16*)(ws + OFF_WT_UQ); const u16* Wkv = (const u16*)(ws + OFF_WT_UKV);
    if (ti.valid()) { ti.get(mt, nt); gemm_preload(nt < 6 ? PP : PP + 256, LD_AB, nt < 6 ? Wq : Wkv, 256, mt * 256, (nt < 6 ? nt : nt - 6) * 128, g); }
    while (ti.valid()) {
      f32x16 acc[2][2]; const int m0 = mt * 256, cn = nt, n0 = (nt < 6 ? nt : nt - 6) * 128;
      gemm_tile<0>(cn < 6 ? PP : PP + 256, LD_AB, cn < 6 ? Wq : Wkv, 256, 256, m0, n0, acc, lds, g);
      ti.next(); if (ti.valid()) { ti.get(mt, nt); gemm_preload(nt < 6 ? PP : PP + 256, LD_AB, nt < 6 ? Wq : Wkv, 256, mt * 256, (nt < 6 ? nt : nt - 6) * 128, g); }
      if (cn < 6) epi_bf16(acc, H, 768, m0, n0, lds); else epi_bf16(acc, (u16*)p.out, 1024, m0, n0, lds);
    } }
  }
  if (p.ph_lo <= 3 && 3 + 1 < p.ph_hi) gbar(gcnt, 3u * gridDim.x);
  if (p.ph_lo <= 4 && 4 < p.ph_hi) {
  finalize0(p);
  }
  if (p.ph_lo <= 4 && 4 + 1 < p.ph_hi) gbar(gcnt, 4u * gridDim.x);
  if (p.ph_lo <= 5 && 5 < p.ph_hi) {
  const float mbA = LOG2E * 9.7979590f * 1.02f * vmaxabs(p.q_gain, 96) * vmaxabs(p.k_gain, 96);
  const float mbB = LOG2E * 8.f * 1.02f * vmaxabs(p.gq_gain, 64) * vmaxabs(p.gk_gain, 64);
  for (int it = bid; it < 1056; it += nblk) {
    if (it < 512) {
      const int round = it >> 8, blk = it & 255, xcd = blk & 7, cl = blk >> 3;
      const int pair = xcd * 2 + round, b = pair >> 3, h = pair & 7, qoff = cl * 512;
      const size_t r0 = (size_t)b * SEQ + qoff;
      attn_body2<6, LD_AB, false>((const u16*)(ws + OFF_QA) + ((size_t)(b * 8 + h) * SEQ + qoff) * 96,
                                  (const u16*)(ws + OFF_KA) + (size_t)(b * 8 + h) * KVLEN * 96, (const u16*)(ws + OFF_VA) + (size_t)(b * 8 + h) * KVLEN * 64,
                                  KVLEN / 64, mbA, H + r0 * 1024 + h * 64, PP + r0 * LD_AB + 1312 + h * 64, lds);
    } else if (it < 1024) {
      const int i2 = it - 512, g = i2 >> 8, blk = i2 & 255, xcd = blk & 7, cl = blk >> 3;
      const int pi = xcd >> 1, b = pi >> 1, kvh = pi & 1, idx = (xcd & 1) * 64 + g * 32 + cl;
      const int h = kvh * 4 + (idx >> 5), qoff = (idx & 31) * 512;
      const size_t r0 = (size_t)b * SEQ + qoff;
      attn_body2<4, LD_AB, true>((const u16*)(ws + OFF_QB) + ((size_t)(b * 8 + h) * SEQ + qoff) * 64,
                           (const u16*)(ws + OFF_KB) + (size_t)(b * 2 + kvh) * KVLEN * 64, (const u16*)(ws + OFF_VB) + (size_t)(b * 2 + kvh) * KVLEN * 64,
                           KVLEN / 64, mbB, H + r0 * 1024 + 512 + h * 64, PP + r0 * LD_AB + 1312 + 512 + h * 64, lds);
    } else {
      const int ci = it - 1024, b = (ci >> 3) & 1, h = ci & 7; const bool mla = ci < 16; const int kvh = mla ? h : (h >> 2);
      const size_t r0 = (size_t)NLAT + b * CL, qrow = (size_t)(b * 8 + h) * CL;
      if (mla) attn_body<6, 0, LD_AB>((const u16*)(ws + OFF_QCA) + qrow * 96, (const u16*)(ws + OFF_KA) + (size_t)(b * 8 + kvh) * KVLEN * 96,
                                      (const u16*)(ws + OFF_VA) + (size_t)(b * 8 + kvh) * KVLEN * 64, CL / 64, 0, 0.f, mbA, H + r0 * 1024 + h * 64, PP + r0 * LD_AB + 1312 + h * 64, lds);
      else attn_body<4, 0, LD_AB>((const u16*)(ws + OFF_QCB) + qrow * 64, (const u16*)(ws + OFF_KB) + (size_t)(b * 2 + kvh) * KVLEN * 64,
                                  (const u16*)(ws + OFF_VB) + (size_t)(b * 2 + kvh) * KVLEN * 64, CL / 64, 0, 0.f, mbB, H + r0 * 1024 + 512 + h * 64, PP + r0 * LD_AB + 1312 + 512 + h * 64, lds);
    }
  }
  }
  if (p.ph_lo <= 5 && 5 + 1 < p.ph_hi) gbar(gcnt, 5u * gridDim.x);
  if (p.ph_lo <= 6 && 6 < p.ph_hi) {
  { TileIter ti(130, 8); GPre g; int nt = 0, mt = 0; const u16* Wt = (const u16*)(ws + OFF_WT_OUT_AB);
    if (ti.valid()) { ti.get(mt, nt); gemm_preload(H, 1024, Wt, 1024, mt * 256, nt * 128, g); }
    while (ti.valid()) {
      f32x16 acc[2][2]; const int m0 = mt * 256, n0 = nt * 128; const bool lat = m0 < NLAT;
      const int tid_ = opaque_tid(), wid_ = tid_ >> 6, lane_ = tid_ & 63;
      const size_t eoff = (size_t)((lat ? m0 : m0 - NLAT) + (wid_ & 3) * 64 + (lane_ >> 4)) * 1024 + n0 + (wid_ >> 2) * 64 + 4 * (lane_ & 15);
      ResPre rp;
      gemm_tile<1>(H, 1024, Wt, 1024, 1024, m0, n0, acc, lds, g, (lat ? p.x : p.ctx) + eoff, &rp);
      ti.next(); if (ti.valid()) { ti.get(mt, nt); gemm_preload(H, 1024, Wt, 1024, mt * 256, nt * 128, g); }
      if (lat) epi_res<false, true>(acc, rp, (u16*)(ws + OFF_X1B) + eoff, modv + (m0 >> 14) * 3072 + 2048, n0, lds);
      else epi_res<false, false>(acc, rp, XC1 + eoff, modv + 2 * 3072 + 2048, n0, lds);
    } }
  }
  if (p.ph_lo <= 6 && 6 + 1 < p.ph_hi) gbar(gcnt, 6u * gridDim.x);
  if (p.ph_lo <= 7 && 7 < p.ph_hi) {
  adaln_phase(nullptr, (const u16*)(ws + OFF_X1B), XC1, modv + 3 * 3072, H);
  }
  if (p.ph_lo <= 7 && 7 + 1 < p.ph_hi) gbar(gcnt, 7u * gridDim.x);
  if (p.ph_lo <= 8 && 8 < p.ph_hi) {
  { TileIter ti(130, 26); GPre g; int nt = 0, mt = 0; const u16* Wt = (const u16*)(ws + OFF_WT_IN_CD);
    if (ti.valid()) { ti.get(mt, nt); gemm_preload(H, 1024, Wt, 1024, mt * 256, nt * 128, g); }
    while (ti.valid()) {
      f32x16 acc[2][2]; const int m0 = mt * 256, n0 = nt * 128;
      gemm_tile<0>(H, 1024, Wt, 1024, 1024, m0, n0, acc, lds, g);
      ti.next(); if (ti.valid()) { ti.get(mt, nt); gemm_preload(H, 1024, Wt, 1024, mt * 256, nt * 128, g); }
      epi_bf16(acc, PP, LD_CD, m0, n0, lds);
    } }
  }
  if (p.ph_lo <= 8 && 8 + 1 < p.ph_hi) gbar(gcnt, 8u * gridDim.x);
  if (p.ph_lo <= 9 && 9 < p.ph_hi) {
  finalize1(p);
  }
  if (p.ph_lo <= 9 && 9 + 1 < p.ph_hi) gbar(gcnt, 9u * gridDim.x);
  if (p.ph_lo <= 10 && 10 < p.ph_hi) {
  const float mbW = LOG2E * 8.f * 1.02f * vmaxabs(p.win_q_gain, 64) * vmaxabs(p.win_k_gain, 64);
  for (int it = bid; it < 1024; it += nblk) {
    const int g = it >> 8, blk = it & 255, xcd = blk & 7, cl = blk >> 3;
    const int pi = xcd >> 1, b = pi >> 1, kvh = pi & 1, idx = (xcd & 1) * 128 + g * 32 + cl;
    const int h = kvh * 4 + (idx >> 6), qblk = idx & 63;
    const size_t r0 = (size_t)b * SEQ + qblk * 256;
    attn_body<4, 1, LD_CD>((const u16*)(ws + OFF_Q2) + ((size_t)(b * 8 + h) * SEQ + qblk * 256) * 64,
                    (const u16*)(ws + OFF_K2) + (size_t)(b * 2 + kvh) * KV2LEN * 64, (const u16*)(ws + OFF_V2) + (size_t)(b * 2 + kvh) * KV2LEN * 64,
                    12, qblk * 256, p.win_sink[h] * LOG2E, mbW, H + r0 * 1024 + h * 64, PP + r0 * LD_CD + 2304 + h * 64, lds);
  }
  }
  if (p.ph_lo <= 10 && 10 + 1 < p.ph_hi) gbar(gcnt, 10u * gridDim.x);
  if (p.ph_lo <= 11 && 11 < p.ph_hi) {
  { TileIter ti(128, 8); GPre g; int nt = 0, mt = 0; const u16* Wt = (const u16*)(ws + OFF_WT_OUT_CD);
    if (ti.valid()) { ti.get(mt, nt); gemm_preload(H, 1024, Wt, 1024, mt * 256, nt * 128, g); }
    while (ti.valid()) {
      f32x16 acc[2][2]; const int m0 = mt * 256, n0 = nt * 128;
      const int tid_ = opaque_tid(), wid_ = tid_ >> 6, lane_ = tid_ & 63;
      const size_t eoff = (size_t)(m0 + (wid_ & 3) * 64 + (lane_ >> 4)) * 1024 + n0 + (wid_ >> 2) * 64 + 4 * (lane_ & 15);
      ResPre rp;
      gemm_tile<2>(H, 1024, Wt, 1024, 1024, m0, n0, acc, lds, g, (const u16*)(ws + OFF_X1B) + eoff, &rp);
      ti.next(); if (ti.valid()) { ti.get(mt, nt); gemm_preload(H, 1024, Wt, 1024, mt * 256, nt * 128, g); }
      epi_res<true, false>(acc, rp, p.out + eoff, modv + 3 * 3072 + (m0 >> 14) * 3072 + 2048, n0, lds);
    } }
  }
}

extern "C" void kernel_launch(void* const* d_in, const int* in_sizes, int n_in, void* d_out, int out_size, void* d_ws, size_t ws_size, hipStream_t stream) {
  static int grid_blocks = 0;
  if (!grid_blocks) {
    if (n_in != 22 || out_size != NLAT * DM || ws_size < OFF_END + 4096) {
      fprintf(stderr, "kernel_launch: shape/ws mismatch n_in %d out %d ws %zu need %zu\n", n_in, out_size, ws_size, (size_t)OFF_END);
      return;
    }
    if (hipFuncSetAttribute((const void*)mega, hipFuncAttributeMaxDynamicSharedMemorySize, LDS_BYTES) != hipSuccess) {
      fprintf(stderr, "kernel_launch: hipFuncSetAttribute failed\n"); return;
    }
    int dev = 0, cus = 0, per_cu = 0;
    (void)hipGetDevice(&dev);
    (void)hipDeviceGetAttribute(&cus, hipDeviceAttributeMultiprocessorCount, dev);
    (void)hipOccupancyMaxActiveBlocksPerMultiprocessor(&per_cu, mega, 512, LDS_BYTES);
    if (per_cu < 1) { fprintf(stderr, "kernel_launch: occupancy 0\n"); return; }
    grid_blocks = cus;
  }
  Params p{};
  p.x = (const float*)d_in[0]; p.c = (const float*)d_in[1]; p.ctx = (const float*)d_in[2]; p.c_ctx = (const float*)d_in[3];
  p.mod_w = (const float*)d_in[4]; p.mod_b = (const float*)d_in[5]; p.ab_w_in = (const float*)d_in[6]; p.ab_w_out = (const float*)d_in[7];
  p.cq_gain = (const float*)d_in[8]; p.ckv_gain = (const float*)d_in[9]; p.w_uq = (const float*)d_in[10]; p.w_ukv = (const float*)d_in[11];
  p.q_gain = (const float*)d_in[12]; p.k_gain = (const float*)d_in[13]; p.gq_gain = (const float*)d_in[14]; p.gk_gain = (const float*)d_in[15];
  p.cd_w_in = (const float*)d_in[16]; p.cd_w_out = (const float*)d_in[17]; p.win_q_gain = (const float*)d_in[18]; p.win_k_gain = (const float*)d_in[19];
  p.win_sink = (const float*)d_in[20]; p.conv_w = (const float*)d_in[21];
  p.out = (float*)d_out; p.ws = (char*)d_ws;
#if MULTI_LAUNCH
  for (int ph = 0; ph < 12; ++ph) {
    p.ph_lo = ph; p.ph_hi = ph + 1;
    hipLaunchKernelGGL(mega, dim3(grid_blocks), dim3(512), LDS_BYTES, stream, p);
  }
#else
  p.ph_lo = 0; p.ph_hi = 12;
  void* args[] = {&p};
  hipError_t e = hipLaunchCooperativeKernel((void*)mega, dim3(grid_blocks), dim3(512), args, LDS_BYTES, stream);
  if (e != hipSuccess) fprintf(stderr, "cooperative launch failed: %s (grid %d)\n", hipGetErrorString(e), grid_blocks);
#endif
}
```

```cpp
#include <hip/hip_runtime.h>
#include <hip/hip_cooperative_groups.h>
#include <cstdio>
#include <cstdint>
namespace cg = cooperative_groups;

typedef unsigned short u16;
using bf16x8 = __attribute__((ext_vector_type(8))) short;
using s16x4  = __attribute__((ext_vector_type(4))) short;
using f32x16 = __attribute__((ext_vector_type(16))) float;
using u32x4  = __attribute__((ext_vector_type(4))) unsigned;
using u32x2  = __attribute__((ext_vector_type(2))) unsigned;

constexpr int NB = 2, SEQ = 16384, DM = 1024, CL = 256;
constexpr int NLAT = NB * SEQ;
constexpr int NROW = NLAT + NB * CL;
constexpr int KVLEN = CL + SEQ;
constexpr int KV2LEN = KVLEN + 128;
constexpr int LD_AB = 2432, LD_CD = 3328;
constexpr float EPS = 1e-6f;
constexpr float QS_A = 0.14724461f;
constexpr float QS_B = 0.18033688f;
constexpr float LOG2E = 1.4426950408889634f;

constexpr size_t OFF_MODV      = 0;
constexpr size_t OFF_WT_IN_AB  = 73728;
constexpr size_t OFF_WT_OUT_AB = OFF_WT_IN_AB + (size_t)LD_AB * 1024 * 2;
constexpr size_t OFF_WT_UQ     = OFF_WT_OUT_AB + (size_t)1024 * 1024 * 2;
constexpr size_t OFF_WT_UKV    = OFF_WT_UQ + (size_t)768 * 256 * 2;
constexpr size_t OFF_WT_IN_CD  = OFF_WT_UKV + (size_t)1024 * 256 * 2;
constexpr size_t OFF_WT_OUT_CD = OFF_WT_IN_CD + (size_t)3328 * 1024 * 2;
constexpr size_t OFF_XC1       = OFF_WT_OUT_CD + (size_t)1024 * 1024 * 2;
constexpr size_t OFF_H         = OFF_XC1 + (size_t)512 * 1024 * 4;
constexpr size_t OFF_PP        = OFF_H + (size_t)NROW * 1024 * 2;
constexpr size_t OFF_QA        = OFF_PP + (size_t)NROW * 3328 * 2;
constexpr size_t OFF_QCA       = OFF_QA + (size_t)NB * 8 * SEQ * 96 * 2;
constexpr size_t OFF_KA        = OFF_QCA + (size_t)NB * 8 * CL * 96 * 2;
constexpr size_t OFF_VA        = OFF_KA + (size_t)NB * 8 * KVLEN * 96 * 2;
constexpr size_t OFF_QB        = OFF_VA + (size_t)NB * 8 * KVLEN * 64 * 2;
constexpr size_t OFF_QCB       = OFF_QB + (size_t)NB * 8 * SEQ * 64 * 2;
constexpr size_t OFF_KB        = OFF_QCB + (size_t)NB * 8 * CL * 64 * 2;
constexpr size_t OFF_VB        = OFF_KB + (size_t)NB * 2 * KVLEN * 64 * 2;
constexpr size_t OFF_END       = OFF_VB + (size_t)NB * 2 * KVLEN * 64 * 2;
constexpr size_t OFF_Q2        = OFF_QA;
constexpr size_t OFF_K2        = OFF_Q2 + (size_t)NB * 8 * SEQ * 64 * 2;
constexpr size_t OFF_V2        = OFF_K2 + (size_t)NB * 2 * KV2LEN * 64 * 2;
constexpr size_t OFF_X1B       = OFF_QA + ((size_t)64 << 20);
static_assert(OFF_V2 + (size_t)NB * 2 * KV2LEN * 64 * 2 <= OFF_X1B && OFF_X1B + (size_t)NLAT * 1024 * 2 <= OFF_END, "x1 alias");
static_assert(OFF_V2 + (size_t)NB * 2 * KV2LEN * 64 * 2 <= OFF_END, "alias overflow");

constexpr int LDS_BYTES = 147456;
#ifndef MULTI_LAUNCH
#define MULTI_LAUNCH 0
#endif

struct Params {
  const float *x, *c, *ctx, *c_ctx, *mod_w, *mod_b, *ab_w_in, *ab_w_out, *cq_gain, *ckv_gain, *w_uq, *w_ukv,
      *q_gain, *k_gain, *gq_gain, *gk_gain, *cd_w_in, *cd_w_out, *win_q_gain, *win_k_gain, *win_sink, *conv_w;
  float* out;
  char* ws;
  int ph_lo, ph_hi;
};

#define SBAR() __builtin_amdgcn_sched_barrier(0)
__device__ __forceinline__ int crow(int r, int hi) { return (r & 3) + 8 * (r >> 2) + 4 * hi; }
typedef float f32x2_t __attribute__((ext_vector_type(2)));
typedef __bf16 bf16x2_t __attribute__((ext_vector_type(2)));
__device__ __forceinline__ unsigned cvtpk(float lo, float hi) { f32x2_t v = {lo, hi}; bf16x2_t b = __builtin_convertvector(v, bf16x2_t); return __builtin_bit_cast(unsigned, b); }
__device__ __forceinline__ u16 f2bf(float x) { return (u16)(cvtpk(x, 0.f) & 0xffffu); }
__device__ __forceinline__ float bf2f(u16 x) { return __uint_as_float(((unsigned)x) << 16); }
__device__ __forceinline__ float bflo(unsigned w) { return __uint_as_float(w << 16); }
__device__ __forceinline__ float bfhi(unsigned w) { return __uint_as_float(w & 0xffff0000u); }
__device__ __forceinline__ float wave_sum(float v) {
#pragma unroll
  for (int o = 32; o >= 1; o >>= 1) v += __shfl_xor(v, o);
  return v;
}
__device__ __forceinline__ int opaque_tid() { int t = threadIdx.x; asm volatile("" : "+v"(t)); return t; }
__device__ __forceinline__ float vmaxabs(const float* g, int n) { float m = 0.f; for (int i = 0; i < n; ++i) m = fmaxf(m, fabsf(g[i])); return m; }
__device__ __forceinline__ float silu_f(float g) { return g / (1.f + __expf(-g)); }


__device__ __forceinline__ void gbar(unsigned* cnt, unsigned target) {
  asm volatile("s_waitcnt vmcnt(0)" ::: "memory");
  __syncthreads();
  if (threadIdx.x == 0) {
    __builtin_amdgcn_fence(__ATOMIC_RELEASE, "agent");
    asm volatile("s_waitcnt vmcnt(0)" ::: "memory");
    __hip_atomic_fetch_add(cnt, 1u, __ATOMIC_RELAXED, __HIP_MEMORY_SCOPE_AGENT);
    unsigned sp = 0;
    while (__hip_atomic_load(cnt, __ATOMIC_RELAXED, __HIP_MEMORY_SCOPE_AGENT) < target) { __builtin_amdgcn_s_sleep(1); if (++sp > (1u << 24)) break; }
    __builtin_amdgcn_fence(__ATOMIC_ACQUIRE, "agent");
    asm volatile("s_waitcnt vmcnt(0)" ::: "memory");
  }
  __syncthreads();
}

__device__ void mod_unit(const Params& p, int u, char* lds) {
  const int tid = opaque_tid();
  const int layer = u / 96, n0 = (u % 96) * 32, col = tid & 31, ks = tid >> 5;
  const float* W = p.mod_w + (size_t)layer * 1024 * 3072 + n0 + col;
  float a0 = 0, a1 = 0, a2 = 0;
  for (int k = ks * 64; k < ks * 64 + 64; ++k) {
    float w = W[(size_t)k * 3072];
    a0 += silu_f(p.c[k]) * w; a1 += silu_f(p.c[1024 + k]) * w; a2 += silu_f(p.c_ctx[k]) * w;
  }
  float* red = (float*)lds;
  red[(0 * 16 + ks) * 32 + col] = a0; red[(1 * 16 + ks) * 32 + col] = a1; red[(2 * 16 + ks) * 32 + col] = a2;
  __syncthreads();
  if (tid < 96) {
    int w = tid >> 5, cc = tid & 31; float s = 0;
    for (int i = 0; i < 16; ++i) s += red[(w * 16 + i) * 32 + cc];
    float* modv = (float*)(p.ws + OFF_MODV);
    modv[(layer * 3 + w) * 3072 + n0 + cc] = s + p.mod_b[layer * 3072 + n0 + cc];
  }
  __syncthreads();
}

__device__ void transpose_unit(const Params& p, int u, char* lds) {
  const float* src; const float* gain = nullptr; int K, N; u16* dst; int ul;
  if (u < 608)       { ul = u;        src = p.ab_w_in;  K = 1024; N = 2336; dst = (u16*)(p.ws + OFF_WT_IN_AB); }
  else if (u < 864)  { ul = u - 608;  src = p.ab_w_out; K = 1024; N = 1024; dst = (u16*)(p.ws + OFF_WT_OUT_AB); }
  else if (u < 912)  { ul = u - 864;  src = p.w_uq;     K = 256;  N = 768;  dst = (u16*)(p.ws + OFF_WT_UQ); gain = p.cq_gain; }
  else if (u < 976)  { ul = u - 912;  src = p.w_ukv;    K = 256;  N = 1024; dst = (u16*)(p.ws + OFF_WT_UKV); gain = p.ckv_gain; }
  else if (u < 1808) { ul = u - 976;  src = p.cd_w_in;  K = 1024; N = 3328; dst = (u16*)(p.ws + OFF_WT_IN_CD); }
  else               { ul = u - 1808; src = p.cd_w_out; K = 1024; N = 1024; dst = (u16*)(p.ws + OFF_WT_OUT_CD); }
  const int nkt = K / 64, kt = ul % nkt, nt = ul / nkt, k0 = kt * 64, n0 = nt * 64, tid = opaque_tid();
  float* tile = (float*)lds;
#pragma unroll
  for (int e = 0; e < 8; ++e) {
    int i = (tid >> 6) + 8 * e, j = tid & 63, n = n0 + j;
    float v = (n < N) ? src[(size_t)(k0 + i) * N + n] : 0.f;
    if (gain) v *= gain[k0 + i];
    tile[i * 65 + j] = v;
  }
  __syncthreads();
#pragma unroll
  for (int e = 0; e < 8; ++e) {
    int i2 = (tid >> 6) + 8 * e, j2 = tid & 63;
    dst[(size_t)(n0 + i2) * K + k0 + j2] = f2bf(tile[j2 * 65 + i2]);
  }
  __syncthreads();
}

__device__ void adaln_phase(const float* xlat, const u16* xlat_bf, const float* xctx, const float* modl, u16* H) {
  const int tid = opaque_tid(), lane = tid & 63, gw = blockIdx.x * 8 + (tid >> 6), nw = gridDim.x * 8;
  for (int r = gw; r < NROW; r += nw) {
    if (xlat_bf != nullptr && r < NLAT) {
      const float* m = modl + (r >> 14) * 3072;
      u32x4 w[2]; float f[16]; float ss = 0;
#pragma unroll
      for (int i = 0; i < 2; ++i) w[i] = *(const u32x4*)(xlat_bf + (size_t)r * 1024 + 8 * (lane + 64 * i));
#pragma unroll
      for (int i = 0; i < 2; ++i)
#pragma unroll
        for (int e = 0; e < 4; ++e) { f[i * 8 + 2 * e] = bflo(w[i][e]); f[i * 8 + 2 * e + 1] = bfhi(w[i][e]); }
#pragma unroll
      for (int e = 0; e < 16; ++e) ss += f[e] * f[e];
      ss = wave_sum(ss);
      const float rstd = rsqrtf(ss * (1.f / 1024) + EPS);
#pragma unroll
      for (int i = 0; i < 2; ++i) {
        const int c = 8 * (lane + 64 * i);
        const float4 sh0 = *(const float4*)(m + c), sh1 = *(const float4*)(m + c + 4), sc0 = *(const float4*)(m + 1024 + c), sc1 = *(const float4*)(m + 1024 + c + 4);
        const float shv[8] = {sh0.x, sh0.y, sh0.z, sh0.w, sh1.x, sh1.y, sh1.z, sh1.w}, scv[8] = {sc0.x, sc0.y, sc0.z, sc0.w, sc1.x, sc1.y, sc1.z, sc1.w};
        float y[8];
#pragma unroll
        for (int e = 0; e < 8; ++e) y[e] = f[i * 8 + e] * rstd * (1.f + scv[e]) + shv[e];
        const u32x4 o = {cvtpk(y[0], y[1]), cvtpk(y[2], y[3]), cvtpk(y[4], y[5]), cvtpk(y[6], y[7])};
        *(u32x4*)(H + (size_t)r * 1024 + c) = o;
      }
      continue;
    }
    const float* src = r < NLAT ? xlat + (size_t)r * 1024 : xctx + (size_t)(r - NLAT) * 1024;
    const float* m = modl + (r < NLAT ? (r >> 14) : 2) * 3072;
    float4 v[4]; float ss = 0;
#pragma unroll
    for (int i = 0; i < 4; ++i) { v[i] = ((const float4*)src)[lane + 64 * i]; ss += v[i].x * v[i].x + v[i].y * v[i].y + v[i].z * v[i].z + v[i].w * v[i].w; }
    ss = wave_sum(ss);
    const float rstd = rsqrtf(ss * (1.f / 1024) + EPS);
#pragma unroll
    for (int i = 0; i < 4; ++i) {
      int c = 4 * (lane + 64 * i);
      float4 sh = *(const float4*)(m + c), sc = *(const float4*)(m + 1024 + c);
      float y0 = v[i].x * rstd * (1.f + sc.x) + sh.x, y1 = v[i].y * rstd * (1.f + sc.y) + sh.y;
      float y2 = v[i].z * rstd * (1.f + sc.z) + sh.z, y3 = v[i].w * rstd * (1.f + sc.w) + sh.w;
      u32x2 o = {cvtpk(y0, y1), cvtpk(y2, y3)};
      *(u32x2*)(H + (size_t)r * 1024 + c) = o;
    }
  }
}

#define GSWZ(row, colB) ((row) * 128 + ((colB) ^ ((((row) >> 1) & 7) << 4)))
struct ResPre { float4 v[16]; u32x2 w[16]; };
struct GPre { bf16x8 ra[4], rb[2]; };
__device__ __forceinline__ void gemm_preload(const u16* __restrict__ A, int lda, const u16* __restrict__ Bt, int ldb, int m0, int n0, GPre& g) {
  const int tid = opaque_tid(), srow = tid >> 3, sch = tid & 7;
  const u16* ap = A + (size_t)(m0 + srow) * lda + sch * 8;
  const u16* bp = Bt + (size_t)(n0 + srow) * ldb + sch * 8;
#pragma unroll
  for (int i = 0; i < 4; ++i) g.ra[i] = *(const bf16x8*)(ap + (size_t)(64 * i) * lda);
#pragma unroll
  for (int i = 0; i < 2; ++i) g.rb[i] = *(const bf16x8*)(bp + (size_t)(64 * i) * ldb);
}
template <int PRE>
__device__ __forceinline__ void gemm_tile(const u16* __restrict__ A, int lda, const u16* __restrict__ Bt, int ldb, int K,
                                          int m0, int n0, f32x16 (&acc)[2][2], char* lds, GPre& g, const void* resp = nullptr, ResPre* rp = nullptr) {
  const int tid = opaque_tid(), wid = tid >> 6, lane = tid & 63, r32 = lane & 31, hi = lane >> 5;
  const int wm = wid & 3, wn = wid >> 2;
  char* As = lds;
  char* Bs = lds + 98304;
  const int srow = tid >> 3, sch = tid & 7;
  const u16* ap = A + (size_t)(m0 + srow) * lda + sch * 8;
  const u16* bp = Bt + (size_t)(n0 + srow) * ldb + sch * 8;
  const int sw = GSWZ(srow, sch * 16);
  bf16x8 (&ra)[4] = g.ra; bf16x8 (&rb)[2] = g.rb;
#pragma unroll
  for (int i = 0; i < 2; ++i) for (int j = 0; j < 2; ++j) acc[i][j] = f32x16{};
  const int nk = K / 64;
  __syncthreads();
#pragma unroll
  for (int i = 0; i < 4; ++i) *(bf16x8*)(As + sw + i * 8192) = ra[i];
#pragma unroll
  for (int i = 0; i < 2; ++i) *(bf16x8*)(Bs + sw + i * 8192) = rb[i];
  if (1 < nk) {
#pragma unroll
    for (int i = 0; i < 4; ++i) ra[i] = *(const bf16x8*)(ap + (size_t)(64 * i) * lda + 64);
#pragma unroll
    for (int i = 0; i < 2; ++i) rb[i] = *(const bf16x8*)(bp + (size_t)(64 * i) * ldb + 64);
  }
  __syncthreads();
  const int arow0 = wm * 64 + r32, brow0 = wn * 64 + r32;
  int st = 0;
  for (int kt = 0; kt < nk; ++kt) {
    const int stn = (st == 2) ? 0 : st + 1;
    if (kt + 1 < nk) {
      char* An = As + stn * 32768; char* Bn = Bs + stn * 16384;
#pragma unroll
      for (int i = 0; i < 4; ++i) *(bf16x8*)(An + sw + i * 8192) = ra[i];
#pragma unroll
      for (int i = 0; i < 2; ++i) *(bf16x8*)(Bn + sw + i * 8192) = rb[i];
    }
    if (kt + 2 < nk) {
#pragma unroll
      for (int i = 0; i < 4; ++i) ra[i] = *(const bf16x8*)(ap + (size_t)(64 * i) * lda + (kt + 2) * 64);
#pragma unroll
      for (int i = 0; i < 2; ++i) rb[i] = *(const bf16x8*)(bp + (size_t)(64 * i) * ldb + (kt + 2) * 64);
    }
    if (PRE == 1 && kt == 0) {
#pragma unroll
      for (int q = 0; q < 16; ++q) rp->v[q] = *(const float4*)((const float*)resp + (size_t)((q >> 3) * 32 + 4 * (q & 7)) * 1024);
    }
    if (PRE == 2 && kt == 0) {
#pragma unroll
      for (int q = 0; q < 16; ++q) rp->w[q] = *(const u32x2*)((const u16*)resp + (size_t)((q >> 3) * 32 + 4 * (q & 7)) * 1024);
    }
    SBAR();
    const char* Ac = As + st * 32768; const char* Bc = Bs + st * 16384;
#pragma unroll
    for (int kk = 0; kk < 4; ++kk) {
      const int cb = kk * 32 + hi * 16;
      bf16x8 a0 = *(const bf16x8*)(Ac + GSWZ(arow0, cb));
      bf16x8 a1 = *(const bf16x8*)(Ac + GSWZ(arow0 + 32, cb));
      bf16x8 b0 = *(const bf16x8*)(Bc + GSWZ(brow0, cb));
      bf16x8 b1 = *(const bf16x8*)(Bc + GSWZ(brow0 + 32, cb));
      acc[0][0] = __builtin_amdgcn_mfma_f32_32x32x16_bf16(a0, b0, acc[0][0], 0, 0, 0);
      acc[0][1] = __builtin_amdgcn_mfma_f32_32x32x16_bf16(a0, b1, acc[0][1], 0, 0, 0);
      acc[1][0] = __builtin_amdgcn_mfma_f32_32x32x16_bf16(a1, b0, acc[1][0], 0, 0, 0);
      acc[1][1] = __builtin_amdgcn_mfma_f32_32x32x16_bf16(a1, b1, acc[1][1], 0, 0, 0);
    }
    __syncthreads();
    st = stn;
  }
}

struct TileIter {
  int f, fend, step, MT, NT;
  __device__ __forceinline__ TileIter(int MT_, int NT_) : MT(MT_), NT(NT_) {
    const int T = MT_ * NT_, bid = blockIdx.x, nblk = gridDim.x;
    if (nblk == 256) { const int x = bid & 7, cl = bid >> 3; f = (int)(((long)T * x) >> 3) + cl; fend = (int)(((long)T * (x + 1)) >> 3); step = 32; }
    else { f = bid; fend = T; step = nblk; }
  }
  __device__ __forceinline__ bool valid() const { return f < fend; }
  __device__ __forceinline__ void next() { f += step; }
  __device__ __forceinline__ void get(int& mt, int& nt) const {
    const int full = (MT >> 2) * 4 * NT;
    if (f < full) { const int g = f / (4 * NT), rem = f - g * 4 * NT; nt = rem >> 2; mt = g * 4 + (rem & 3); }
    else { const int rem = f - full, gs = MT - (MT >> 2) * 4; nt = rem / gs; mt = (MT >> 2) * 4 + (rem - nt * gs); }
  }
};

__device__ __forceinline__ void epi_bf16(f32x16 (&acc)[2][2], u16* C, int ldc, int m0, int n0, char* lds) {
  const int tid = opaque_tid(), wid = tid >> 6, lane = tid & 63, r32 = lane & 31, hi = lane >> 5;
  const int wm = wid & 3, wn = wid >> 2;
  char* wl = lds + wid * 9216;
#pragma unroll
  for (int i = 0; i < 2; ++i)
#pragma unroll
    for (int j = 0; j < 2; ++j)
#pragma unroll
      for (int r = 0; r < 16; ++r) *(u16*)(wl + (i * 32 + crow(r, hi)) * 144 + (j * 32 + r32) * 2) = f2bf(acc[i][j][r]);
  asm volatile("s_waitcnt lgkmcnt(0)" ::: "memory");
  const int rr = lane >> 3, ch = lane & 7;
  u16* cbase = C + (size_t)(m0 + wm * 64 + rr) * ldc + n0 + wn * 64 + ch * 8;
#pragma unroll
  for (int k = 0; k < 8; ++k) {
    const u32x4 v = *(const u32x4*)(wl + (rr + 8 * k) * 144 + ch * 16);
    *(u32x4*)(cbase + (size_t)(8 * k) * ldc) = v;
  }
}
template <bool IN_BF, bool OUT_BF>
__device__ __forceinline__ void epi_res(f32x16 (&acc)[2][2], const ResPre& rp, void* outp, const float* gsrc, int n0, char* lds) {
  const int tid = opaque_tid(), wid = tid >> 6, lane = tid & 63, r32 = lane & 31, hi = lane >> 5;
  const int wn = wid >> 2;
  char* wl = lds + wid * 8704;
  const int rl = lane >> 4, c4 = lane & 15;
  const float4 g = *(const float4*)(gsrc + n0 + wn * 64 + 4 * c4);
#pragma unroll
  for (int i = 0; i < 2; ++i) {
#pragma unroll
    for (int j = 0; j < 2; ++j)
#pragma unroll
      for (int r = 0; r < 16; ++r) *(float*)(wl + crow(r, hi) * 272 + (j * 32 + r32) * 4) = acc[i][j][r];
    asm volatile("s_waitcnt lgkmcnt(0)" ::: "memory");
#pragma unroll
    for (int k = 0; k < 8; ++k) {
      const float4 a = *(const float4*)(wl + (rl + 4 * k) * 272 + c4 * 16);
      float4 x;
      if (IN_BF) { const u32x2 xw = rp.w[i * 8 + k]; x.x = bflo(xw[0]); x.y = bfhi(xw[0]); x.z = bflo(xw[1]); x.w = bfhi(xw[1]); } else x = rp.v[i * 8 + k];
      float4 o; o.x = x.x + g.x * a.x; o.y = x.y + g.y * a.y; o.z = x.z + g.z * a.z; o.w = x.w + g.w * a.w;
      if (OUT_BF) { const u32x2 ow = {cvtpk(o.x, o.y), cvtpk(o.z, o.w)}; *(u32x2*)((u16*)outp + (size_t)(i * 32 + 4 * k) * 1024) = ow; }
      else *(float4*)((float*)outp + (size_t)(i * 32 + 4 * k) * 1024) = o;
    }
    asm volatile("s_waitcnt lgkmcnt(0)" ::: "memory");
  }
}

__device__ __forceinline__ float red8(float v) { v += __shfl_xor(v, 1); v += __shfl_xor(v, 2); v += __shfl_xor(v, 4); return v; }
__device__ __forceinline__ void rope_cs(float pos, float inv, bool on, float& c, float& s) {
  if (on) { float a = pos * inv * 0.15915494309189535f; a -= floorf(a); c = __builtin_amdgcn_cosf(a); s = __builtin_amdgcn_sinf(a); } else { c = 1.f; s = 0.f; }
}
__device__ __forceinline__ void head64(const u16* src, u16* dst, int gb, const float* g, const float* cG, const float* sG, float qs) {
  const u32x2 lo = *(const u32x2*)(src + gb), hi2 = *(const u32x2*)(src + gb + 16);
  float x[8] = {bflo(lo[0]), bfhi(lo[0]), bflo(lo[1]), bfhi(lo[1]), bflo(hi2[0]), bfhi(hi2[0]), bflo(hi2[1]), bfhi(hi2[1])};
  float ss = 0;
#pragma unroll
  for (int e = 0; e < 8; ++e) ss += x[e] * x[e];
  const float rn = rsqrtf(red8(ss) * (1.f / 64) + EPS) ;
#pragma unroll
  for (int e = 0; e < 8; ++e) x[e] *= rn * g[e];
  float y[8];
#pragma unroll
  for (int e = 0; e < 4; ++e) { y[e] = (x[e] * cG[e] - x[e + 4] * sG[e]) * qs; y[e + 4] = (x[e + 4] * cG[e] + x[e] * sG[e]) * qs; }
  const u32x2 o0 = {cvtpk(y[0], y[1]), cvtpk(y[2], y[3])}, o1 = {cvtpk(y[4], y[5]), cvtpk(y[6], y[7])};
  *(u32x2*)(dst + gb) = o0; *(u32x2*)(dst + gb + 16) = o1;
}
__device__ __forceinline__ void head96(float* n, float r1a, float r1b, float r2a, float r2b, u16* dst, int t, int rb,
                                       const float* gn, const float* gr, const float* cM, const float* sM, float qs) {
  float ss = r1a * r1a + r1b * r1b + r2a * r2a + r2b * r2b;
#pragma unroll
  for (int e = 0; e < 8; ++e) ss += n[e] * n[e];
  const float rn = rsqrtf(red8(ss) * (1.f / 96) + EPS);
#pragma unroll
  for (int e = 0; e < 8; ++e) n[e] *= rn * gn[e] * qs;
  r1a *= rn * gr[0]; r1b *= rn * gr[1]; r2a *= rn * gr[2]; r2b *= rn * gr[3];
  const float y1a = (r1a * cM[0] - r2a * sM[0]) * qs, y2a = (r2a * cM[0] + r1a * sM[0]) * qs;
  const float y1b = (r1b * cM[1] - r2b * sM[1]) * qs, y2b = (r2b * cM[1] + r1b * sM[1]) * qs;
  const u32x4 o = {cvtpk(n[0], n[1]), cvtpk(n[2], n[3]), cvtpk(n[4], n[5]), cvtpk(n[6], n[7])};
  *(u32x4*)(dst + 8 * t) = o;
  *(unsigned*)(dst + 64 + rb) = cvtpk(y1a, y1b); *(unsigned*)(dst + 64 + rb + 8) = cvtpk(y2a, y2b);
}
__device__ void finalize0(const Params& p) {
  const int tid = opaque_tid(), lane = tid & 63, gw = blockIdx.x * 8 + (tid >> 6), nw = gridDim.x * 8;
  const int h = lane >> 3, t = lane & 7;
  char* ws = p.ws;
  const u16* PP = (const u16*)(ws + OFF_PP);
  const u16* QAR = (const u16*)(ws + OFF_H);
  const u16* KVR = (const u16*)p.out;
  u16* QA = (u16*)(ws + OFF_QA); u16* QCA = (u16*)(ws + OFF_QCA); u16* KA = (u16*)(ws + OFF_KA); u16* VA = (u16*)(ws + OFF_VA);
  u16* QB = (u16*)(ws + OFF_QB); u16* QCB = (u16*)(ws + OFF_QCB); u16* KB = (u16*)(ws + OFF_KB); u16* VB = (u16*)(ws + OFF_VB);
  const int gb = t < 4 ? 4 * t : 32 + 4 * (t - 4), rb = t < 4 ? 2 * t : 16 + 2 * (t - 4);
  float qgn[8], kgn[8], qgr[4], kgr[4], gqg[8], gkg[8], invG[4], invM[2];
#pragma unroll
  for (int e = 0; e < 8; ++e) { qgn[e] = p.q_gain[8 * t + e]; kgn[e] = p.k_gain[8 * t + e];
    const int d = gb + (e & 3) + (e >> 2) * 16; gqg[e] = p.gq_gain[d]; gkg[e] = p.gk_gain[d]; }
#pragma unroll
  for (int k = 0; k < 4; ++k) { const int d = 64 + rb + (k & 1) + (k >> 1) * 8; qgr[k] = p.q_gain[d]; kgr[k] = p.k_gain[d]; }
#pragma unroll
  for (int e = 0; e < 4; ++e) invG[e] = exp2f(-(float)(4 * (t & 3) + e) * (13.287712379549449f / 16.f));
#pragma unroll
  for (int k = 0; k < 2; ++k) invM[k] = exp2f(-(float)(2 * (t & 3) + k) * (13.287712379549449f / 8.f));
  for (int r = gw; r < NROW; r += nw) {
    const bool isctx = r >= NLAT;
    int b, s, kpos; float pos = 0.f;
    if (!isctx) { b = r >> 14; s = r & 16383; kpos = CL + s; pos = t < 4 ? (float)(s >> 6) : (float)(s & 63); }
    else { int rc = r - NLAT; b = rc >> 8; s = rc & 255; kpos = s; }
    float cG[4], sG[4], cM[2], sM[2];
#pragma unroll
    for (int e = 0; e < 4; ++e) rope_cs(pos, invG[e], !isctx, cG[e], sG[e]);
#pragma unroll
    for (int k = 0; k < 2; ++k) rope_cs(pos, invM[k], !isctx, cM[k], sM[k]);
    const u16* pp = PP + (size_t)r * LD_AB;
    const u32x2 wq = *(const u32x2*)(pp + lane * 4), wk = *(const u32x2*)(pp + 256 + lane * 4);
    float s1 = bflo(wq[0]) * bflo(wq[0]) + bfhi(wq[0]) * bfhi(wq[0]) + bflo(wq[1]) * bflo(wq[1]) + bfhi(wq[1]) * bfhi(wq[1]);
    float s2 = bflo(wk[0]) * bflo(wk[0]) + bfhi(wk[0]) * bfhi(wk[0]) + bflo(wk[1]) * bflo(wk[1]) + bfhi(wk[1]) * bfhi(wk[1]);
    s1 = wave_sum(s1); s2 = wave_sum(s2);
    const float rstd_cq = rsqrtf(s1 * (1.f / 256) + EPS), rstd_ckv = rsqrtf(s2 * (1.f / 256) + EPS);
    { const u16* qa = QAR + (size_t)r * 768 + h * 96;
      const u32x4 nv = *(const u32x4*)(qa + 8 * t); const unsigned w1 = *(const unsigned*)(qa + 64 + rb), w2 = *(const unsigned*)(qa + 64 + rb + 8);
      float n[8] = {bflo(nv[0]) * rstd_cq, bfhi(nv[0]) * rstd_cq, bflo(nv[1]) * rstd_cq, bfhi(nv[1]) * rstd_cq, bflo(nv[2]) * rstd_cq, bfhi(nv[2]) * rstd_cq, bflo(nv[3]) * rstd_cq, bfhi(nv[3]) * rstd_cq};
      u16* dq = isctx ? QCA + ((size_t)(b * 8 + h) * CL + s) * 96 : QA + ((size_t)(b * 8 + h) * SEQ + s) * 96;
      head96(n, bflo(w1) * rstd_cq, bfhi(w1) * rstd_cq, bflo(w2) * rstd_cq, bfhi(w2) * rstd_cq, dq, t, rb, qgn, qgr, cM, sM, QS_A); }
    { const u16* kv = KVR + (size_t)r * 1024 + h * 128;
      const u32x4 nv = *(const u32x4*)(kv + 8 * t), vv = *(const u32x4*)(kv + 64 + 8 * t);
      const unsigned w1 = *(const unsigned*)(pp + 512 + rb), w2 = *(const unsigned*)(pp + 512 + rb + 8);
      float n[8] = {bflo(nv[0]) * rstd_ckv, bfhi(nv[0]) * rstd_ckv, bflo(nv[1]) * rstd_ckv, bfhi(nv[1]) * rstd_ckv, bflo(nv[2]) * rstd_ckv, bfhi(nv[2]) * rstd_ckv, bflo(nv[3]) * rstd_ckv, bfhi(nv[3]) * rstd_ckv};
      const size_t kr = (size_t)(b * 8 + h) * KVLEN + kpos;
      head96(n, bflo(w1), bfhi(w1), bflo(w2), bfhi(w2), KA + kr * 96, t, rb, kgn, kgr, cM, sM, 1.f);
      const u32x4 vo = {cvtpk(bflo(vv[0]) * rstd_ckv, bfhi(vv[0]) * rstd_ckv), cvtpk(bflo(vv[1]) * rstd_ckv, bfhi(vv[1]) * rstd_ckv),
                        cvtpk(bflo(vv[2]) * rstd_ckv, bfhi(vv[2]) * rstd_ckv), cvtpk(bflo(vv[3]) * rstd_ckv, bfhi(vv[3]) * rstd_ckv)};
      *(u32x4*)(VA + kr * 64 + 8 * t) = vo; }
    { u16* dg = isctx ? QCB + ((size_t)(b * 8 + h) * CL + s) * 64 : QB + ((size_t)(b * 8 + h) * SEQ + s) * 64;
      head64(pp + 544 + h * 64, dg, gb, gqg, cG, sG, QS_B); }
    if (h < 2) {
      const size_t kr = (size_t)(b * 2 + h) * KVLEN + kpos;
      head64(pp + 1056 + h * 64, KB + kr * 64, gb, gkg, cG, sG, 1.f);
      *(u32x4*)(VB + kr * 64 + 8 * t) = *(const u32x4*)(pp + 1184 + h * 64 + 8 * t);
    }
  }
}

__device__ void finalize1(const Params& p) {
  const int tid = opaque_tid(), lane = tid & 63, gw = blockIdx.x * 8 + (tid >> 6), nw = gridDim.x * 8;
  const int h = lane >> 3, t = lane & 7;
  char* ws = p.ws;
  const u16* PP = (const u16*)(ws + OFF_PP);
  u16* Q2 = (u16*)(ws + OFF_Q2); u16* K2 = (u16*)(ws + OFF_K2); u16* V2 = (u16*)(ws + OFF_V2);
  u16* MIX = (u16*)(ws + OFF_H);
  const int gb = t < 4 ? 4 * t : 32 + 4 * (t - 4);
  float qg[8], kg[8], invG[4];
#pragma unroll
  for (int e = 0; e < 8; ++e) { const int d = gb + (e & 3) + (e >> 2) * 16; qg[e] = p.win_q_gain[d]; kg[e] = p.win_k_gain[d]; }
#pragma unroll
  for (int e = 0; e < 4; ++e) invG[e] = exp2f(-(float)(4 * (t & 3) + e) * (13.287712379549449f / 16.f));
  float cw[3][8];
#pragma unroll
  for (int j = 0; j < 3; ++j)
#pragma unroll
    for (int e = 0; e < 8; ++e) cw[j][e] = p.conv_w[j * 512 + lane * 8 + e];
  for (int r = gw; r < NROW + 512; r += nw) {
    if (r >= NROW) {
      int slab = (r - NROW) >> 7, pr = (r - NROW) & 127;
      size_t kr = (size_t)slab * KV2LEN + KVLEN + pr;
      K2[kr * 64 + lane] = 0; V2[kr * 64 + lane] = 0;
      continue;
    }
    const bool isctx = r >= NLAT;
    int b, s, kpos; float pos = 0.f;
    if (!isctx) { b = r >> 14; s = r & 16383; kpos = CL + s; pos = t < 4 ? (float)(s >> 6) : (float)(s & 63); }
    else { int rc = r - NLAT; b = rc >> 8; s = rc & 255; kpos = s; }
    float cG[4], sG[4];
#pragma unroll
    for (int e = 0; e < 4; ++e) rope_cs(pos, invG[e], !isctx, cG[e], sG[e]);
    const u16* pp = PP + (size_t)r * LD_CD;
    if (!isctx) head64(pp + h * 64, Q2 + ((size_t)(b * 8 + h) * SEQ + s) * 64, gb, qg, cG, sG, QS_B);
    if (h < 2) {
      const size_t kr = (size_t)(b * 2 + h) * KV2LEN + kpos;
      head64(pp + 512 + h * 64, K2 + kr * 64, gb, kg, cG, sG, 1.f);
      *(u32x4*)(V2 + kr * 64 + 8 * t) = *(const u32x4*)(pp + 640 + h * 64 + 8 * t);
    }
    if (!isctx) {
      const int c0 = lane * 8;
      float y[8];
#pragma unroll
      for (int e = 0; e < 8; ++e) y[e] = 0.f;
#pragma unroll
      for (int j = 0; j < 3; ++j) {
        const int sj = s + j - 1;
        if (sj >= 0 && sj < SEQ) {
          const u16* pj = pp + (ptrdiff_t)(j - 1) * LD_CD;
          u32x4 a = *(const u32x4*)(pj + 1280 + c0), bb = *(const u32x4*)(pj + 1792 + c0);
#pragma unroll
          for (int e = 0; e < 4; ++e) {
            y[2 * e]     += bflo(a[e]) * bflo(bb[e]) * cw[j][2 * e];
            y[2 * e + 1] += bfhi(a[e]) * bfhi(bb[e]) * cw[j][2 * e + 1];
          }
        }
      }
      u32x4 gbv = *(const u32x4*)(pp + 768 + c0), gt = *(const u32x4*)(pp + 2304 + 512 + c0);
      u32x4 o;
#pragma unroll
      for (int e = 0; e < 4; ++e) {
        float v0 = bflo(gbv[e]) * y[2 * e] * silu_f(bflo(gt[e]));
        float v1 = bfhi(gbv[e]) * y[2 * e + 1] * silu_f(bfhi(gt[e]));
        o[e] = cvtpk(v0, v1);
      }
      *(u32x4*)(MIX + (size_t)r * 1024 + 512 + c0) = o;
    }
  }
}

#define KSWZ(row, colB) ((row) * 272 + (colB))
__device__ __forceinline__ int v_st2(int k, int c) { const int kk = k; return ((kk >> 3) * 2 + (c >> 5)) * 512 + ((kk & 7) * 32 + (c & 31)) * 2; }
__device__ __forceinline__ int v_rd_base(int lane) { return ((lane & 3) << 3) | (((lane >> 2) & 3) << 6) | (((lane >> 4) & 1) << 5) | (((lane >> 5) & 1) << 8); }
constexpr int v_rd_off2(int d0, int ks, int half) { return d0 * 512 + ks * 2048 + half * 1024; }
template <int OFF> __device__ __forceinline__ s16x4 tr_read(int vb) {
  s16x4 r; asm volatile("ds_read_b64_tr_b16 %0, %1 offset:%2" : "=&v"(r) : "v"(vb), "i"(OFF) : "memory"); return r;
}
template <int D0> __device__ __forceinline__ void pv_one(f32x16& od, int vb, bf16x8 pa0, bf16x8 pa1, bf16x8 pa2, bf16x8 pa3) {
  const s16x4 l0 = tr_read<v_rd_off2(D0, 0, 0)>(vb), h0 = tr_read<v_rd_off2(D0, 0, 1)>(vb), l1 = tr_read<v_rd_off2(D0, 1, 0)>(vb), h1 = tr_read<v_rd_off2(D0, 1, 1)>(vb);
  const s16x4 l2 = tr_read<v_rd_off2(D0, 2, 0)>(vb), h2 = tr_read<v_rd_off2(D0, 2, 1)>(vb), l3 = tr_read<v_rd_off2(D0, 3, 0)>(vb), h3 = tr_read<v_rd_off2(D0, 3, 1)>(vb);
  asm volatile("s_waitcnt lgkmcnt(0)" ::: "memory"); SBAR();
#define PK(L, H) (bf16x8){L[0], L[1], L[2], L[3], H[0], H[1], H[2], H[3]}
  od = __builtin_amdgcn_mfma_f32_32x32x16_bf16(pa0, PK(l0, h0), od, 0, 0, 0);
  od = __builtin_amdgcn_mfma_f32_32x32x16_bf16(pa1, PK(l1, h1), od, 0, 0, 0);
  od = __builtin_amdgcn_mfma_f32_32x32x16_bf16(pa2, PK(l2, h2), od, 0, 0, 0);
  od = __builtin_amdgcn_mfma_f32_32x32x16_bf16(pa3, PK(l3, h3), od, 0, 0, 0);
#undef PK
}
__device__ __forceinline__ void pv_all(f32x16* o, int vb, bf16x8 pa0, bf16x8 pa1, bf16x8 pa2, bf16x8 pa3) {
  pv_one<0>(o[0], vb, pa0, pa1, pa2, pa3); pv_one<1>(o[1], vb, pa0, pa1, pa2, pa3);
}
__device__ __forceinline__ void pv_exp(f32x16* o, int vb, bf16x8 pa0, bf16x8 pa1, bf16x8 pa2, bf16x8 pa3, f32x16& n0, f32x16& n1) {
#define PK(L, H) (bf16x8){L[0], L[1], L[2], L[3], H[0], H[1], H[2], H[3]}
  { const s16x4 l0 = tr_read<v_rd_off2(0, 0, 0)>(vb), h0 = tr_read<v_rd_off2(0, 0, 1)>(vb), l1 = tr_read<v_rd_off2(0, 1, 0)>(vb), h1 = tr_read<v_rd_off2(0, 1, 1)>(vb);
    const s16x4 l2 = tr_read<v_rd_off2(0, 2, 0)>(vb), h2 = tr_read<v_rd_off2(0, 2, 1)>(vb), l3 = tr_read<v_rd_off2(0, 3, 0)>(vb), h3 = tr_read<v_rd_off2(0, 3, 1)>(vb);
#pragma unroll
    for (int r = 0; r < 8; ++r) n0[r] = __builtin_amdgcn_exp2f(n0[r]);
    asm volatile("s_waitcnt lgkmcnt(0)" ::: "memory"); SBAR();
    o[0] = __builtin_amdgcn_mfma_f32_32x32x16_bf16(pa0, PK(l0, h0), o[0], 0, 0, 0);
    o[0] = __builtin_amdgcn_mfma_f32_32x32x16_bf16(pa1, PK(l1, h1), o[0], 0, 0, 0);
    o[0] = __builtin_amdgcn_mfma_f32_32x32x16_bf16(pa2, PK(l2, h2), o[0], 0, 0, 0);
    o[0] = __builtin_amdgcn_mfma_f32_32x32x16_bf16(pa3, PK(l3, h3), o[0], 0, 0, 0); }
  { const s16x4 l0 = tr_read<v_rd_off2(1, 0, 0)>(vb), h0 = tr_read<v_rd_off2(1, 0, 1)>(vb), l1 = tr_read<v_rd_off2(1, 1, 0)>(vb), h1 = tr_read<v_rd_off2(1, 1, 1)>(vb);
    const s16x4 l2 = tr_read<v_rd_off2(1, 2, 0)>(vb), h2 = tr_read<v_rd_off2(1, 2, 1)>(vb), l3 = tr_read<v_rd_off2(1, 3, 0)>(vb), h3 = tr_read<v_rd_off2(1, 3, 1)>(vb);
#pragma unroll
    for (int r = 8; r < 16; ++r) n0[r] = __builtin_amdgcn_exp2f(n0[r]);
    asm volatile("s_waitcnt lgkmcnt(0)" ::: "memory"); SBAR();
    o[1] = __builtin_amdgcn_mfma_f32_32x32x16_bf16(pa0, PK(l0, h0), o[1], 0, 0, 0);
    o[1] = __builtin_amdgcn_mfma_f32_32x32x16_bf16(pa1, PK(l1, h1), o[1], 0, 0, 0);
    o[1] = __builtin_amdgcn_mfma_f32_32x32x16_bf16(pa2, PK(l2, h2), o[1], 0, 0, 0);
    o[1] = __builtin_amdgcn_mfma_f32_32x32x16_bf16(pa3, PK(l3, h3), o[1], 0, 0, 0); }
#undef PK
#pragma unroll
  for (int r = 0; r < 16; ++r) n1[r] = __builtin_amdgcn_exp2f(n1[r]);
}

__device__ __forceinline__ void expall(f32x16& p0, f32x16& p1) {
#pragma unroll
  for (int r = 0; r < 16; ++r) p0[r] = __builtin_amdgcn_exp2f(p0[r]);
#pragma unroll
  for (int r = 0; r < 16; ++r) p1[r] = __builtin_amdgcn_exp2f(p1[r]);
}
__device__ __forceinline__ void finishSM(f32x16& p0, f32x16& p1, float& lsum, bf16x8& pa0, bf16x8& pa1, bf16x8& pa2, bf16x8& pa3) {
  float ps = 0;
#pragma unroll
  for (int r = 0; r < 16; ++r) ps += p0[r];
#pragma unroll
  for (int r = 0; r < 16; ++r) ps += p1[r];
  lsum += ps;
#define PK4(P, BASE, OUT) do { u32x4 w = {cvtpk(P[BASE + 0], P[BASE + 1]), cvtpk(P[BASE + 2], P[BASE + 3]), cvtpk(P[BASE + 4], P[BASE + 5]), cvtpk(P[BASE + 6], P[BASE + 7])}; \
    OUT = *reinterpret_cast<bf16x8*>(&w); } while (0)
  PK4(p0, 0, pa0); PK4(p0, 8, pa1); PK4(p1, 0, pa2); PK4(p1, 8, pa3);
#undef PK4
}
template <int NQK>
__device__ __forceinline__ void qkt(f32x16& p0, f32x16& p1, const char* Ks, const bf16x8* qr, int r32, int hi, const float shift) {
  p0 = f32x16{}; p1 = f32x16{};
#pragma unroll
  for (int d0 = 0; d0 < NQK; ++d0) { int cb = (d0 * 16 + hi * 8) * 2;
    bf16x8 b0 = *reinterpret_cast<const bf16x8*>(Ks + KSWZ(r32, cb));
    bf16x8 b1 = *reinterpret_cast<const bf16x8*>(Ks + KSWZ(32 + r32, cb));
    p0 = __builtin_amdgcn_mfma_f32_32x32x16_bf16(b0, qr[d0], p0, 0, 0, 0);
    p1 = __builtin_amdgcn_mfma_f32_32x32x16_bf16(b1, qr[d0], p1, 0, 0, 0); }
  if (__builtin_expect(shift != 0.f, 0)) {
#pragma unroll
    for (int r = 0; r < 16; ++r) { p0[r] -= shift; p1[r] -= shift; }
  }
}

#define PK4X(P, BASE, OUT) do { u32x4 w_ = {cvtpk(P[BASE + 0], P[BASE + 1]), cvtpk(P[BASE + 2], P[BASE + 3]), cvtpk(P[BASE + 4], P[BASE + 5]), cvtpk(P[BASE + 6], P[BASE + 7])}; \
    OUT = *reinterpret_cast<bf16x8*>(&w_); } while (0)
template <int NQK>
__device__ __forceinline__ void qkt_fin(f32x16& n0, f32x16& n1, const char* Ks, const bf16x8* qr, int r32, int hi, const float shift,
                                        f32x16& o0, f32x16& o1, float& lsum, bf16x8& pa0, bf16x8& pa1, bf16x8& pa2, bf16x8& pa3) {
  n0 = f32x16{}; n1 = f32x16{};
  float ps = 0.f;
  bf16x8 kc0 = *reinterpret_cast<const bf16x8*>(Ks + KSWZ(r32, (hi * 8) * 2));
  bf16x8 kc1 = *reinterpret_cast<const bf16x8*>(Ks + KSWZ(32 + r32, (hi * 8) * 2));
#pragma unroll
  for (int d0 = 0; d0 < NQK; ++d0) {
    bf16x8 kn0 = kc0, kn1 = kc1;
    if (d0 + 1 < NQK) { const int cb = ((d0 + 1) * 16 + hi * 8) * 2;
      kn0 = *reinterpret_cast<const bf16x8*>(Ks + KSWZ(r32, cb)); kn1 = *reinterpret_cast<const bf16x8*>(Ks + KSWZ(32 + r32, cb)); }
    n0 = __builtin_amdgcn_mfma_f32_32x32x16_bf16(kc0, qr[d0], n0, 0, 0, 0);
    n1 = __builtin_amdgcn_mfma_f32_32x32x16_bf16(kc1, qr[d0], n1, 0, 0, 0);
#define PIN(X) asm volatile("" : "+v"(X))
    if (NQK == 6) {
      if (d0 == 0) { PK4X(o0, 0, pa0); }
      if (d0 == 1) { PIN(o0); PK4X(o0, 8, pa1); }
      if (d0 == 2) { _Pragma("unroll") for (int r = 0; r < 16; ++r) ps += o0[r]; }
      if (d0 == 3) { PIN(o1); PK4X(o1, 0, pa2); _Pragma("unroll") for (int r = 0; r < 8; ++r) ps += o1[r]; }
      if (d0 == 4) { PIN(o1); PK4X(o1, 8, pa3); _Pragma("unroll") for (int r = 8; r < 16; ++r) ps += o1[r]; }
    } else {
      if (d0 == 0) { PK4X(o0, 0, pa0); PK4X(o0, 8, pa1); }
      if (d0 == 1) { _Pragma("unroll") for (int r = 0; r < 16; ++r) ps += o0[r]; }
      if (d0 == 2) { PIN(o1); PK4X(o1, 0, pa2); _Pragma("unroll") for (int r = 0; r < 8; ++r) ps += o1[r]; }
      if (d0 == 3) { PIN(o1); PK4X(o1, 8, pa3); _Pragma("unroll") for (int r = 8; r < 16; ++r) ps += o1[r]; }
    }
#undef PIN
    asm volatile("" : "+v"(ps), "+v"(pa0), "+v"(pa1), "+v"(pa2), "+v"(pa3));
    kc0 = kn0; kc1 = kn1;
    SBAR();
  }
  lsum += ps;
  if (__builtin_expect(shift != 0.f, 0)) {
#pragma unroll
    for (int r = 0; r < 16; ++r) { n0[r] -= shift; n1[r] -= shift; }
  }
}

template <int NQK, int MODE, int LDG>
__device__ __forceinline__ void attn_body(const u16* __restrict__ Qb, const u16* __restrict__ Kh, const u16* __restrict__ Vh,
                                          const int NT, const int q0, const float sink2, const float mbound,
                                          u16* __restrict__ mix0, const u16* __restrict__ gate0, char* lds) {
  constexpr int DK = NQK * 16;
  constexpr int SHM_V = 8192, SHM_K = 17408;
  int tid_ = threadIdx.x; asm volatile("" : "+v"(tid_));
  const int tid = tid_, wid = __builtin_amdgcn_readfirstlane(tid >> 6), lane = tid & 63, r32 = lane & 31, hi = lane >> 5;
  char* V_lds = lds; char* K_lds = lds + 5 * SHM_V;
  float* wsf = (float*)(lds + 5 * SHM_V + 5 * SHM_K) + wid * 64; float* li_l = wsf;
  float lsum = 0; f32x16 o[2] = {}; bf16x8 qr[NQK];
  const float shift = mbound > 80.f ? mbound - 80.f : 0.f;
  const u16* Qw = Qb + (size_t)(wid * 32 + r32) * DK + hi * 8;
#pragma unroll
  for (int d0 = 0; d0 < NQK; ++d0) qr[d0] = *(const bf16x8*)(Qw + d0 * 16);
  const int srow = tid >> 3, sc8 = tid & 7;
  const int kst0 = KSWZ(srow, sc8 * 16), kst1 = KSWZ(srow, 128 + sc8 * 16), vst = v_st2(srow, sc8 * 8);
  const int vb0 = (int)(uintptr_t)V_lds + v_rd_base(lane);
  const bool k1on = (NQK == 6) && (sc8 < 4);
  const unsigned koff0 = srow * DK + sc8 * 8, voff0 = srow * 64 + sc8 * 8;
  struct { bf16x8 k0, k1, v0; } st[2];
#define TROW(j) (MODE == 0 ? (j) * 64 : ((j) < 4 ? (j) * 64 : q0 + 128 + ((j) - 4) * 64))
#define SLOAD(i, kr) do { const u16* kp_ = Kh + (unsigned)((kr) * DK); st[i].k0 = *(const bf16x8*)(kp_ + koff0);   \
    if (k1on) st[i].k1 = *(const bf16x8*)(kp_ + koff0 + 64);                                                           \
    const u16* vp_ = Vh + (unsigned)((kr) * 64); st[i].v0 = *(const bf16x8*)(vp_ + voff0); } while (0)
#define SWRITE(b, i) do { *(bf16x8*)(K_lds + (b) * SHM_K + kst0) = st[i].k0; if (k1on) *(bf16x8*)(K_lds + (b) * SHM_K + kst1) = st[i].k1; \
    *(bf16x8*)(V_lds + (b) * SHM_V + vst) = st[i].v0; } while (0)
#define MASKT(P0, P1, j) do { if (MODE == 1 && (j) >= 4) { const int kb_ = q0 - 128 + ((j) - 4) * 64, qp_ = q0 + wid * 32 + r32;    \
    _Pragma("unroll") for (int r = 0; r < 16; ++r) { int k0_ = kb_ + crow(r, hi), k1_ = k0_ + 32; int d0_ = qp_ - k0_, d1_ = qp_ - k1_; \
      bool ok0 = (d0_ <= 128) && (d0_ >= -128) && (k0_ >= 0) && (k0_ < SEQ); bool ok1 = (d1_ <= 128) && (d1_ >= -128) && (k1_ >= 0) && (k1_ < SEQ); \
      P0[r] = ok0 ? P0[r] : -1e30f; P1[r] = ok1 ? P1[r] : -1e30f; } } } while (0)
  f32x16 pA0, pA1, pB0, pB1; bf16x8 pa0, pa1, pa2, pa3;
#define NXS(x) ((x) + 1 == 5 ? 0 : (x) + 1)
  __syncthreads();
  SLOAD(0, TROW(0)); asm volatile("s_waitcnt vmcnt(0)" ::: "memory"); SWRITE(0, 0);
  SLOAD(0, TROW(1)); SWRITE(1, 0);
  SLOAD(0, TROW(2)); SWRITE(2, 0);
  if (3 < NT) SLOAD(0, TROW(3));
  if (4 < NT) SLOAD(1, TROW(4));
  __syncthreads();
  qkt<NQK>(pA0, pA1, K_lds, qr, r32, hi, shift); MASKT(pA0, pA1, 0); expall(pA0, pA1);
  int c = 0;
  for (int j = 1; j + 1 < NT; j += 2) {
    const int sj = NXS(c), sj1 = NXS(sj), sj2 = NXS(sj1), sj3 = NXS(sj2);
    SBAR(); SWRITE(sj2, 0); if (j + 3 < NT) SWRITE(sj3, 1); SBAR();
    qkt_fin<NQK>(pB0, pB1, K_lds + sj * SHM_K, qr, r32, hi, shift, pA0, pA1, lsum, pa0, pa1, pa2, pa3); MASKT(pB0, pB1, j); SBAR();
    if (j + 4 < NT) SLOAD(0, TROW(j + 4)); SBAR();
    pv_exp(o, vb0 + c * SHM_V, pa0, pa1, pa2, pa3, pB0, pB1);
    SBAR();
    qkt_fin<NQK>(pA0, pA1, K_lds + sj1 * SHM_K, qr, r32, hi, shift, pB0, pB1, lsum, pa0, pa1, pa2, pa3); MASKT(pA0, pA1, j + 1); SBAR();
    if (j + 5 < NT) SLOAD(1, TROW(j + 5)); SBAR();
    pv_exp(o, vb0 + sj * SHM_V, pa0, pa1, pa2, pa3, pA0, pA1);
    __syncthreads();
    c = sj1;
  }
  { const int sl = NXS(c);
    SBAR(); qkt_fin<NQK>(pB0, pB1, K_lds + sl * SHM_K, qr, r32, hi, shift, pA0, pA1, lsum, pa0, pa1, pa2, pa3); MASKT(pB0, pB1, NT - 1); SBAR();
    pv_all(o, vb0 + c * SHM_V, pa0, pa1, pa2, pa3); expall(pB0, pB1);
    finishSM(pB0, pB1, lsum, pa0, pa1, pa2, pa3); SBAR();
    pv_all(o, vb0 + sl * SHM_V, pa0, pa1, pa2, pa3); }
#undef NXS
  float l_reg;
  { auto rr = __builtin_amdgcn_permlane32_swap(__float_as_uint(lsum), __float_as_uint(lsum), false, false);
    l_reg = __uint_as_float(rr[0]) + __uint_as_float(rr[1]); }
  if (MODE == 1) l_reg += __builtin_amdgcn_exp2f(sink2 - shift);
  if (hi == 0) li_l[r32] = l_reg; asm volatile("s_waitcnt lgkmcnt(0)" ::: "memory");
  float rli[16];
#pragma unroll
  for (int r = 0; r < 16; ++r) rli[r] = __builtin_amdgcn_rcpf(li_l[crow(r, hi)]);
#pragma unroll
  for (int r = 0; r < 16; ++r) { const int orow = wid * 32 + crow(r, hi);
#pragma unroll
    for (int d0 = 0; d0 < 2; ++d0) {
      const float g = bf2f(gate0[(size_t)orow * LDG + d0 * 32 + r32]);
      mix0[(size_t)orow * 1024 + d0 * 32 + r32] = f2bf(o[d0][r] * rli[r] * silu_f(g));
    } }
#undef TROW
#undef SLOAD
#undef SWRITE
#undef MASKT
}

template <int NQK, int LDG, int RING>
__device__ __forceinline__ void attn_body2(const u16* __restrict__ Qb, const u16* __restrict__ Kh, const u16* __restrict__ Vh,
                                           const int NT, const float mbound, u16* __restrict__ mix0, const u16* __restrict__ gate0, char* lds) {
  constexpr int DK = NQK * 16;
  constexpr int SHM_V = 8192, SHM_K = 17408;
  int tid_ = threadIdx.x; asm volatile("" : "+v"(tid_));
  const int tid = tid_, wid = __builtin_amdgcn_readfirstlane(tid >> 6), lane = tid & 63, r32 = lane & 31, hi = lane >> 5;
  char* V_lds = lds; char* K_lds = lds + 5 * SHM_V;
  float* wsf = (float*)(lds + 5 * SHM_V + 5 * SHM_K) + wid * 64;
  float lsA = 0, lsB = 0; f32x16 oA[2] = {}, oB[2] = {}; bf16x8 qA[NQK], qB[NQK];
  const float shift = mbound > 80.f ? mbound - 80.f : 0.f;
  const u16* Qw = Qb + (size_t)(wid * 64 + r32) * DK + hi * 8;
#pragma unroll
  for (int d0 = 0; d0 < NQK; ++d0) { qA[d0] = *(const bf16x8*)(Qw + d0 * 16); qB[d0] = *(const bf16x8*)(Qw + 32 * DK + d0 * 16); }
  const int srow = tid >> 3, sc8 = tid & 7;
  const int kst0 = KSWZ(srow, sc8 * 16), kst1 = KSWZ(srow, 128 + sc8 * 16), vst = v_st2(srow, sc8 * 8);
  const int vb0 = (int)(uintptr_t)V_lds + v_rd_base(lane);
  const bool k1on = (NQK == 6) && (sc8 < 4);
  const unsigned koff0 = srow * DK + sc8 * 8, voff0 = srow * 64 + sc8 * 8;
  struct { bf16x8 k0, k1, v0; } st[RING == 1 ? 2 : 1];
#define SLOAD(i, kr) do { const u16* kp_ = Kh + (unsigned)((kr) * DK); st[i].k0 = *(const bf16x8*)(kp_ + koff0);   \
    if (k1on) st[i].k1 = *(const bf16x8*)(kp_ + koff0 + 64);                                                           \
    const u16* vp_ = Vh + (unsigned)((kr) * 64); st[i].v0 = *(const bf16x8*)(vp_ + voff0); } while (0)
#define SWRITE(b, i) do { *(bf16x8*)(K_lds + (b) * SHM_K + kst0) = st[i].k0; if (k1on) *(bf16x8*)(K_lds + (b) * SHM_K + kst1) = st[i].k1; \
    *(bf16x8*)(V_lds + (b) * SHM_V + vst) = st[i].v0; } while (0)
#define NXS(x) ((x) + 1 == 5 ? 0 : (x) + 1)
#define UNIT(PN0, PN1, QN, KS, PO0, PO1, LSO, OO, VS) do {                                                                      \
    qkt_fin<NQK>(PN0, PN1, K_lds + (KS) * SHM_K, QN, r32, hi, shift, PO0, PO1, LSO, pa0, pa1, pa2, pa3); SBAR();               \
    pv_exp(OO, vb0 + (VS) * SHM_V, pa0, pa1, pa2, pa3, PN0, PN1); SBAR(); } while (0)
  f32x16 pA0, pA1, pB0, pB1; bf16x8 pa0, pa1, pa2, pa3;
  if constexpr (RING == 1) {
  __syncthreads();
  SLOAD(0, 0); asm volatile("s_waitcnt vmcnt(0)" ::: "memory"); SWRITE(0, 0);
  SLOAD(0, 64); SWRITE(1, 0);
  SLOAD(0, 128); SWRITE(2, 0);
  if (3 < NT) SLOAD(0, 3 * 64);
  if (4 < NT) SLOAD(1, 4 * 64);
  __syncthreads();
  qkt<NQK>(pA0, pA1, K_lds, qA, r32, hi, shift); expall(pA0, pA1);
  int c = 0;
  for (int i = 0; 2 * i + 2 < NT; ++i) {
    const int s1 = NXS(c), s2 = NXS(s1), s3 = NXS(s2), s4 = NXS(s3);
    SBAR(); if (2 * i + 3 < NT) SWRITE(s3, 0); if (2 * i + 4 < NT) SWRITE(s4, 1);
    if (2 * i + 5 < NT) SLOAD(0, (2 * i + 5) * 64); if (2 * i + 6 < NT) SLOAD(1, (2 * i + 6) * 64); SBAR();
    UNIT(pB0, pB1, qB, c, pA0, pA1, lsA, oA, c);
    UNIT(pA0, pA1, qA, s1, pB0, pB1, lsB, oB, c);
    UNIT(pB0, pB1, qB, s1, pA0, pA1, lsA, oA, s1);
    UNIT(pA0, pA1, qA, s2, pB0, pB1, lsB, oB, s1);
    __syncthreads();
    c = s2;
  }
  { const int s1 = NXS(c);
    UNIT(pB0, pB1, qB, c, pA0, pA1, lsA, oA, c);
    UNIT(pA0, pA1, qA, s1, pB0, pB1, lsB, oB, c);
    UNIT(pB0, pB1, qB, s1, pA0, pA1, lsA, oA, s1);
    finishSM(pB0, pB1, lsB, pa0, pa1, pa2, pa3); SBAR();
    pv_all(oB, vb0 + s1 * SHM_V, pa0, pa1, pa2, pa3); }
  } else if constexpr (RING == 2) {
    __syncthreads();
    SLOAD(0, 0); asm volatile("s_waitcnt vmcnt(0)" ::: "memory"); SWRITE(0, 0);
    SLOAD(0, 64); SWRITE(1, 0);
    SLOAD(0, 128); SWRITE(2, 0);
    if (3 < NT) SLOAD(0, 3 * 64);
    __syncthreads();
    qkt<NQK>(pA0, pA1, K_lds, qA, r32, hi, shift); expall(pA0, pA1);
    int c = 0;
    for (int i = 0; 2 * i + 2 < NT; ++i) {
      const int s1 = NXS(c), s2 = NXS(s1), s3 = NXS(s2), s4 = NXS(s3);
      SBAR(); if (2 * i + 3 < NT) SWRITE(s3, 0); if (2 * i + 4 < NT) SLOAD(0, (2 * i + 4) * 64); SBAR();
      UNIT(pB0, pB1, qB, c, pA0, pA1, lsA, oA, c);
      UNIT(pA0, pA1, qA, s1, pB0, pB1, lsB, oB, c);
      SBAR(); if (2 * i + 4 < NT) SWRITE(s4, 0); if (2 * i + 5 < NT) SLOAD(0, (2 * i + 5) * 64); SBAR();
      UNIT(pB0, pB1, qB, s1, pA0, pA1, lsA, oA, s1);
      UNIT(pA0, pA1, qA, s2, pB0, pB1, lsB, oB, s1);
      __syncthreads();
      c = s2;
    }
    { const int s1 = NXS(c);
      UNIT(pB0, pB1, qB, c, pA0, pA1, lsA, oA, c);
      UNIT(pA0, pA1, qA, s1, pB0, pB1, lsB, oB, c);
      UNIT(pB0, pB1, qB, s1, pA0, pA1, lsA, oA, s1);
      finishSM(pB0, pB1, lsB, pa0, pa1, pa2, pa3); SBAR();
      pv_all(oB, vb0 + s1 * SHM_V, pa0, pa1, pa2, pa3); }
  } else {
#define NX3(x) ((x) + 1 == 3 ? 0 : (x) + 1)
    __syncthreads();
    SLOAD(0, 0); asm volatile("s_waitcnt vmcnt(0)" ::: "memory"); SWRITE(0, 0);
    SLOAD(0, 64); SWRITE(1, 0);
    if (2 < NT) SLOAD(0, 128);
    __syncthreads();
    qkt<NQK>(pA0, pA1, K_lds, qA, r32, hi, shift); expall(pA0, pA1);
    int c = 0;
    for (int t = 0; t + 1 < NT; ++t) {
      const int s1 = NX3(c), s2 = NX3(s1);
      SBAR(); if (t + 2 < NT) SWRITE(s2, 0);
      if (t + 3 < NT) SLOAD(0, (t + 3) * 64); SBAR();
      UNIT(pB0, pB1, qB, c, pA0, pA1, lsA, oA, c);
      UNIT(pA0, pA1, qA, s1, pB0, pB1, lsB, oB, c);
      __syncthreads();
      c = s1;
    }
    UNIT(pB0, pB1, qB, c, pA0, pA1, lsA, oA, c);
    finishSM(pB0, pB1, lsB, pa0, pa1, pa2, pa3); SBAR();
    pv_all(oB, vb0 + c * SHM_V, pa0, pa1, pa2, pa3);
#undef NX3
  }
#undef UNIT
#undef NXS
#undef SLOAD
#undef SWRITE
  float lA, lB;
  { auto rr = __builtin_amdgcn_permlane32_swap(__float_as_uint(lsA), __float_as_uint(lsA), false, false); lA = __uint_as_float(rr[0]) + __uint_as_float(rr[1]); }
  { auto rr = __builtin_amdgcn_permlane32_swap(__float_as_uint(lsB), __float_as_uint(lsB), false, false); lB = __uint_as_float(rr[0]) + __uint_as_float(rr[1]); }
  if (hi == 0) { wsf[r32] = lA; wsf[32 + r32] = lB; }
  asm volatile("s_waitcnt lgkmcnt(0)" ::: "memory");
#pragma unroll
  for (int g = 0; g < 2; ++g) {
    float rli[16];
#pragma unroll
    for (int r = 0; r < 16; ++r) rli[r] = __builtin_amdgcn_rcpf(wsf[g * 32 + crow(r, hi)]);
#pragma unroll
    for (int r = 0; r < 16; ++r) { const int orow = wid * 64 + g * 32 + crow(r, hi);
#pragma unroll
      for (int d0 = 0; d0 < 2; ++d0) {
        const float gt = bf2f(gate0[(size_t)orow * LDG + d0 * 32 + r32]);
        const float ov = g == 0 ? oA[d0][r] : oB[d0][r];
        mix0[(size_t)orow * 1024 + d0 * 32 + r32] = f2bf(ov * rli[r] * silu_f(gt));
      } }
  }
}

__global__ void __launch_bounds__(512, 1) mega(Params p) {
  extern __shared__ __attribute__((aligned(16))) char lds[];
  cg::grid_group grid = cg::this_grid();
  const int bid = blockIdx.x, nblk = gridDim.x;
  char* ws = p.ws;
  float* modv = (float*)(ws + OFF_MODV);
  u16* H = (u16*)(ws + OFF_H);
  u16* PP = (u16*)(ws + OFF_PP);
  float* XC1 = (float*)(ws + OFF_XC1);
  unsigned* gcnt = (unsigned*)(ws + OFF_END);
  if (bid == 0 && threadIdx.x == 0) __hip_atomic_store(gcnt, 0u, __ATOMIC_RELAXED, __HIP_MEMORY_SCOPE_AGENT);

  if (p.ph_lo <= 0 && 0 < p.ph_hi) {
  for (int u = bid; u < 192; u += nblk) mod_unit(p, u, lds);
  }
  if (p.ph_lo <= 0 && 0 + 1 < p.ph_hi) grid.sync();
  if (p.ph_lo <= 1 && 1 < p.ph_hi) {
  for (int u = bid; u < 2064; u += nblk) transpose_unit(p, u, lds);
  adaln_phase(p.x, nullptr, p.ctx, modv, H);
  }
  if (p.ph_lo <= 1 && 1 + 1 < p.ph_hi) gbar(gcnt, 1u * gridDim.x);
  if (p.ph_lo <= 2 && 2 < p.ph_hi) {
  { TileIter ti(130, 19); GPre g; int nt = 0, mt = 0; const u16* Wt = (const u16*)(ws + OFF_WT_IN_AB);
    if (ti.valid()) { ti.get(mt, nt); gemm_preload(H, 1024, Wt, 1024, mt * 256, nt * 128, g); }
    while (ti.valid()) {
      f32x16 acc[2][2]; const int m0 = mt * 256, n0 = nt * 128;
      gemm_tile<0>(H, 1024, Wt, 1024, 1024, m0, n0, acc, lds, g);
      ti.next(); if (ti.valid()) { ti.get(mt, nt); gemm_preload(H, 1024, Wt, 1024, mt * 256, nt * 128, g); }
      epi_bf16(acc, PP, LD_AB, m0, n0, lds);
    } }
  }
  if (p.ph_lo <= 2 && 2 + 1 < p.ph_hi) gbar(gcnt, 2u * gridDim.x);
  if (p.ph_lo <= 3 && 3 < p.ph_hi) {
  { TileIter ti(130, 14); GPre g; int nt = 0, mt = 0;
    const u16* Wq = (const u16*)(ws + OFF_WT_UQ); const u16* Wkv = (const u16*)(ws + OFF_WT_UKV);
    if (ti.valid()) { ti.get(mt, nt); gemm_preload(nt < 6 ? PP : PP + 256, LD_AB, nt < 6 ? Wq : Wkv, 256, mt * 256, (nt < 6 ? nt : nt - 6) * 128, g); }
    while (ti.valid()) {
      f32x16 acc[2][2]; const int m0 = mt * 256, cn = nt, n0 = (nt < 6 ? nt : nt - 6) * 128;
      gemm_tile<0>(cn < 6 ? PP : PP + 256, LD_AB, cn < 6 ? Wq : Wkv, 256, 256, m0, n0, acc, lds, g);
      ti.next(); if (ti.valid()) { ti.get(mt, nt); gemm_preload(nt < 6 ? PP : PP + 256, LD_AB, nt < 6 ? Wq : Wkv, 256, mt * 256, (nt < 6 ? nt : nt - 6) * 128, g); }
      if (cn < 6) epi_bf16(acc, H, 768, m0, n0, lds); else epi_bf16(acc, (u16*)p.out, 1024, m0, n0, lds);
    } }
  }
  if (p.ph_lo <= 3 && 3 + 1 < p.ph_hi) gbar(gcnt, 3u * gridDim.x);
  if (p.ph_lo <= 4 && 4 < p.ph_hi) {
  finalize0(p);
  }
  if (p.ph_lo <= 4 && 4 + 1 < p.ph_hi) gbar(gcnt, 4u * gridDim.x);
  if (p.ph_lo <= 5 && 5 < p.ph_hi) {
  const float mbA = LOG2E * 9.7979590f * 1.02f * vmaxabs(p.q_gain, 96) * vmaxabs(p.k_gain, 96);
  const float mbB = LOG2E * 8.f * 1.02f * vmaxabs(p.gq_gain, 64) * vmaxabs(p.gk_gain, 64);
  for (int it = bid; it < 1056; it += nblk) {
    if (it < 512) {
      const int round = it >> 8, blk = it & 255, xcd = blk & 7, cl = blk >> 3;
      const int pair = xcd * 2 + round, b = pair >> 3, h = pair & 7, qoff = cl * 512;
      const size_t r0 = (size_t)b * SEQ + qoff;
      attn_body2<6, LD_AB, 2>((const u16*)(ws + OFF_QA) + ((size_t)(b * 8 + h) * SEQ + qoff) * 96,
                                  (const u16*)(ws + OFF_KA) + (size_t)(b * 8 + h) * KVLEN * 96, (const u16*)(ws + OFF_VA) + (size_t)(b * 8 + h) * KVLEN * 64,
                                  KVLEN / 64, mbA, H + r0 * 1024 + h * 64, PP + r0 * LD_AB + 1312 + h * 64, lds);
    } else if (it < 1024) {
      const int i2 = it - 512, g = i2 >> 8, blk = i2 & 255, xcd = blk & 7, cl = blk >> 3;
      const int pi = xcd >> 1, b = pi >> 1, kvh = pi & 1, idx = (xcd & 1) * 64 + g * 32 + cl;
      const int h = kvh * 4 + (idx >> 5), qoff = (idx & 31) * 512;
      const size_t r0 = (size_t)b * SEQ + qoff;
      attn_body2<4, LD_AB, 1>((const u16*)(ws + OFF_QB) + ((size_t)(b * 8 + h) * SEQ + qoff) * 64,
                           (const u16*)(ws + OFF_KB) + (size_t)(b * 2 + kvh) * KVLEN * 64, (const u16*)(ws + OFF_VB) + (size_t)(b * 2 + kvh) * KVLEN * 64,
                           KVLEN / 64, mbB, H + r0 * 1024 + 512 + h * 64, PP + r0 * LD_AB + 1312 + 512 + h * 64, lds);
    } else {
      const int ci = it - 1024, b = (ci >> 3) & 1, h = ci & 7; const bool mla = ci < 16; const int kvh = mla ? h : (h >> 2);
      const size_t r0 = (size_t)NLAT + b * CL, qrow = (size_t)(b * 8 + h) * CL;
      if (mla) attn_body<6, 0, LD_AB>((const u16*)(ws + OFF_QCA) + qrow * 96, (const u16*)(ws + OFF_KA) + (size_t)(b * 8 + kvh) * KVLEN * 96,
                                      (const u16*)(ws + OFF_VA) + (size_t)(b * 8 + kvh) * KVLEN * 64, CL / 64, 0, 0.f, mbA, H + r0 * 1024 + h * 64, PP + r0 * LD_AB + 1312 + h * 64, lds);
      else attn_body<4, 0, LD_AB>((const u16*)(ws + OFF_QCB) + qrow * 64, (const u16*)(ws + OFF_KB) + (size_t)(b * 2 + kvh) * KVLEN * 64,
                                  (const u16*)(ws + OFF_VB) + (size_t)(b * 2 + kvh) * KVLEN * 64, CL / 64, 0, 0.f, mbB, H + r0 * 1024 + 512 + h * 64, PP + r0 * LD_AB + 1312 + 512 + h * 64, lds);
    }
  }
  }
  if (p.ph_lo <= 5 && 5 + 1 < p.ph_hi) gbar(gcnt, 5u * gridDim.x);
  if (p.ph_lo <= 6 && 6 < p.ph_hi) {
  { TileIter ti(130, 8); GPre g; int nt = 0, mt = 0; const u16* Wt = (const u16*)(ws + OFF_WT_OUT_AB);
    if (ti.valid()) { ti.get(mt, nt); gemm_preload(H, 1024, Wt, 1024, mt * 256, nt * 128, g); }
    while (ti.valid()) {
      f32x16 acc[2][2]; const int m0 = mt * 256, n0 = nt * 128; const bool lat = m0 < NLAT;
      const int tid_ = opaque_tid(), wid_ = tid_ >> 6, lane_ = tid_ & 63;
      const size_t eoff = (size_t)((lat ? m0 : m0 - NLAT) + (wid_ & 3) * 64 + (lane_ >> 4)) * 1024 + n0 + (wid_ >> 2) * 64 + 4 * (lane_ & 15);
      ResPre rp;
      gemm_tile<1>(H, 1024, Wt, 1024, 1024, m0, n0, acc, lds, g, (lat ? p.x : p.ctx) + eoff, &rp);
      ti.next(); if (ti.valid()) { ti.get(mt, nt); gemm_preload(H, 1024, Wt, 1024, mt * 256, nt * 128, g); }
      if (lat) epi_res<false, true>(acc, rp, (u16*)(ws + OFF_X1B) + eoff, modv + (m0 >> 14) * 3072 + 2048, n0, lds);
      else epi_res<false, false>(acc, rp, XC1 + eoff, modv + 2 * 3072 + 2048, n0, lds);
    } }
  }
  if (p.ph_lo <= 6 && 6 + 1 < p.ph_hi) gbar(gcnt, 6u * gridDim.x);
  if (p.ph_lo <= 7 && 7 < p.ph_hi) {
  adaln_phase(nullptr, (const u16*)(ws + OFF_X1B), XC1, modv + 3 * 3072, H);
  }
  if (p.ph_lo <= 7 && 7 + 1 < p.ph_hi) gbar(gcnt, 7u * gridDim.x);
  if (p.ph_lo <= 8 && 8 < p.ph_hi) {
  { TileIter ti(130, 26); GPre g; int nt = 0, mt = 0; const u16* Wt = (const u16*)(ws + OFF_WT_IN_CD);
    if (ti.valid()) { ti.get(mt, nt); gemm_preload(H, 1024, Wt, 1024, mt * 256, nt * 128, g); }
    while (ti.valid()) {
      f32x16 acc[2][2]; const int m0 = mt * 256, n0 = nt * 128;
      gemm_tile<0>(H, 1024, Wt, 1024, 1024, m0, n0, acc, lds, g);
      ti.next(); if (ti.valid()) { ti.get(mt, nt); gemm_preload(H, 1024, Wt, 1024, mt * 256, nt * 128, g); }
      epi_bf16(acc, PP, LD_CD, m0, n0, lds);
    } }
  }
  if (p.ph_lo <= 8 && 8 + 1 < p.ph_hi) gbar(gcnt, 8u * gridDim.x);
  if (p.ph_lo <= 9 && 9 < p.ph_hi) {
  finalize1(p);
  }
  if (p.ph_lo <= 9 && 9 + 1 < p.ph_hi) gbar(gcnt, 9u * gridDim.x);
  if (p.ph_lo <= 10 && 10 < p.ph_hi) {
  const float mbW = LOG2E * 8.f * 1.02f * vmaxabs(p.win_q_gain, 64) * vmaxabs(p.win_k_gain, 64);
  for (int it = bid; it < 1024; it += nblk) {
    const int g = it >> 8, blk = it & 255, xcd = blk & 7, cl = blk >> 3;
    const int pi = xcd >> 1, b = pi >> 1, kvh = pi & 1, idx = (xcd & 1) * 128 + g * 32 + cl;
    const int h = kvh * 4 + (idx >> 6), qblk = idx & 63;
    const size_t r0 = (size_t)b * SEQ + qblk * 256;
    attn_body<4, 1, LD_CD>((const u16*)(ws + OFF_Q2) + ((size_t)(b * 8 + h) * SEQ + qblk * 256) * 64,
                    (const u16*)(ws + OFF_K2) + (size_t)(b * 2 + kvh) * KV2LEN * 64, (const u16*)(ws + OFF_V2) + (size_t)(b * 2 + kvh) * KV2LEN * 64,
                    12, qblk * 256, p.win_sink[h] * LOG2E, mbW, H + r0 * 1024 + h * 64, PP + r0 * LD_CD + 2304 + h * 64, lds);
  }
  }
  if (p.ph_lo <= 10 && 10 + 1 < p.ph_hi) gbar(gcnt, 10u * gridDim.x);
  if (p.ph_lo <= 11 && 11 < p.ph_hi) {
  { TileIter ti(128, 8); GPre g; int nt = 0, mt = 0; const u16* Wt = (const u16*)(ws + OFF_WT_OUT_CD);
    if (ti.valid()) { ti.get(mt, nt); gemm_preload(H, 1024, Wt, 1024, mt * 256, nt * 128, g); }
    while (ti.valid()) {
      f32x16 acc[2][2]; const int m0 = mt * 256, n0 = nt * 128;
      const int tid_ = opaque_tid(), wid_ = tid_ >> 6, lane_ = tid_ & 63;
      const size_t eoff = (size_t)(m0 + (wid_ & 3) * 64 + (lane_ >> 4)) * 1024 + n0 + (wid_ >> 2) * 64 + 4 * (lane_ & 15);
      ResPre rp;
      gemm_tile<2>(H, 1024, Wt, 1024, 1024, m0, n0, acc, lds, g, (const u16*)(ws + OFF_X1B) + eoff, &rp);
      ti.next(); if (ti.valid()) { ti.get(mt, nt); gemm_preload(H, 1024, Wt, 1024, mt * 256, nt * 128, g); }
      epi_res<true, false>(acc, rp, p.out + eoff, modv + 3 * 3072 + (m0 >> 14) * 3072 + 2048, n0, lds);
    } }
  }
}

extern "C" void kernel_launch(void* const* d_in, const int* in_sizes, int n_in, void* d_out, int out_size, void* d_ws, size_t ws_size, hipStream_t stream) {
  static int grid_blocks = 0;
  if (!grid_blocks) {
    if (n_in != 22 || out_size != NLAT * DM || ws_size < OFF_END + 4096) {
      fprintf(stderr, "kernel_launch: shape/ws mismatch n_in %d out %d ws %zu need %zu\n", n_in, out_size, ws_size, (size_t)OFF_END);
      return;
    }
    if (hipFuncSetAttribute((const void*)mega, hipFuncAttributeMaxDynamicSharedMemorySize, LDS_BYTES) != hipSuccess) {
      fprintf(stderr, "kernel_launch: hipFuncSetAttribute failed\n"); return;
    }
    int dev = 0, cus = 0, per_cu = 0;
    (void)hipGetDevice(&dev);
    (void)hipDeviceGetAttribute(&cus, hipDeviceAttributeMultiprocessorCount, dev);
    (void)hipOccupancyMaxActiveBlocksPerMultiprocessor(&per_cu, mega, 512, LDS_BYTES);
    if (per_cu < 1) { fprintf(stderr, "kernel_launch: occupancy 0\n"); return; }
    grid_blocks = cus;
  }
  Params p{};
  p.x = (const float*)d_in[0]; p.c = (const float*)d_in[1]; p.ctx = (const float*)d_in[2]; p.c_ctx = (const float*)d_in[3];
  p.mod_w = (const float*)d_in[4]; p.mod_b = (const float*)d_in[5]; p.ab_w_in = (const float*)d_in[6]; p.ab_w_out = (const float*)d_in[7];
  p.cq_gain = (const float*)d_in[8]; p.ckv_gain = (const float*)d_in[9]; p.w_uq = (const float*)d_in[10]; p.w_ukv = (const float*)d_in[11];
  p.q_gain = (const float*)d_in[12]; p.k_gain = (const float*)d_in[13]; p.gq_gain = (const float*)d_in[14]; p.gk_gain = (const float*)d_in[15];
  p.cd_w_in = (const float*)d_in[16]; p.cd_w_out = (const float*)d_in[17]; p.win_q_gain = (const float*)d_in[18]; p.win_k_gain = (const float*)d_in[19];
  p.win_sink = (const float*)d_in[20]; p.conv_w = (const float*)d_in[21];
  p.out = (float*)d_out; p.ws = (char*)d_ws;
#if MULTI_LAUNCH
  for (int ph = 0; ph < 12; ++ph) {
    p.ph_lo = ph; p.ph_hi = ph + 1;
    hipLaunchKernelGGL(mega, dim3(grid_blocks), dim3(512), LDS_BYTES, stream, p);
  }
#else
  p.ph_lo = 0; p.ph_hi = 12;
  void* args[] = {&p};
  hipError_t e = hipLaunchCooperativeKernel((void*)mega, dim3(grid_blocks), dim3(512), args, LDS_BYTES, stream);
  if (e != hipSuccess) fprintf(stderr, "cooperative launch failed: %s (grid %d)\n", hipGetErrorString(e), grid_blocks);
#endif
}
```

```cpp
#include <hip/hip_runtime.h>
#include <hip/hip_cooperative_groups.h>
#include <cstdio>
#include <cstdint>
namespace cg = cooperative_groups;

typedef unsigned short u16;
using bf16x8 = __attribute__((ext_vector_type(8))) short;
using s16x4  = __attribute__((ext_vector_type(4))) short;
using f32x16 = __attribute__((ext_vector_type(16))) float;
using u32x4  = __attribute__((ext_vector_type(4))) unsigned;
using u32x2  = __attribute__((ext_vector_type(2))) unsigned;

constexpr int NB = 2, SEQ = 16384, DM = 1024, CL = 256;
constexpr int NLAT = NB * SEQ;
constexpr int NROW = NLAT + NB * CL;
constexpr int KVLEN = CL + SEQ;
constexpr int KV2LEN = KVLEN + 128;
constexpr int LD_AB = 2432, LD_CD = 3328;
constexpr float EPS = 1e-6f;
constexpr float QS_A = 0.14724461f;
constexpr float QS_B = 0.18033688f;
constexpr float LOG2E = 1.4426950408889634f;

constexpr size_t OFF_MODV      = 0;
constexpr size_t OFF_WT_IN_AB  = 73728;
constexpr size_t OFF_WT_OUT_AB = OFF_WT_IN_AB + (size_t)LD_AB * 1024 * 2;
constexpr size_t OFF_WT_UQ     = OFF_WT_OUT_AB + (size_t)1024 * 1024 * 2;
constexpr size_t OFF_WT_UKV    = OFF_WT_UQ + (size_t)768 * 256 * 2;
constexpr size_t OFF_WT_IN_CD  = OFF_WT_UKV + (size_t)1024 * 256 * 2;
constexpr size_t OFF_WT_OUT_CD = OFF_WT_IN_CD + (size_t)3328 * 1024 * 2;
constexpr size_t OFF_XC1       = OFF_WT_OUT_CD + (size_t)1024 * 1024 * 2;
constexpr size_t OFF_H         = OFF_XC1 + (size_t)512 * 1024 * 4;
constexpr size_t OFF_PP        = OFF_H + (size_t)NROW * 1024 * 2;
constexpr size_t OFF_QA        = OFF_PP + (size_t)NROW * 3328 * 2;
constexpr size_t OFF_QCA       = OFF_QA + (size_t)NB * 8 * SEQ * 96 * 2;
constexpr size_t OFF_KA        = OFF_QCA + (size_t)NB * 8 * CL * 96 * 2;
constexpr size_t OFF_VA        = OFF_KA + (size_t)NB * 8 * KVLEN * 96 * 2;
constexpr size_t OFF_QB        = OFF_VA + (size_t)NB * 8 * KVLEN * 64 * 2;
constexpr size_t OFF_QCB       = OFF_QB + (size_t)NB * 8 * SEQ * 64 * 2;
constexpr size_t OFF_KB        = OFF_QCB + (size_t)NB * 8 * CL * 64 * 2;
constexpr size_t OFF_VB        = OFF_KB + (size_t)NB * 2 * KVLEN * 64 * 2;
constexpr size_t OFF_END       = OFF_VB + (size_t)NB * 2 * KVLEN * 64 * 2;
constexpr size_t OFF_Q2        = OFF_QA;
constexpr size_t OFF_K2        = OFF_Q2 + (size_t)NB * 8 * SEQ * 64 * 2;
constexpr size_t OFF_V2        = OFF_K2 + (size_t)NB * 2 * KV2LEN * 64 * 2;
constexpr size_t OFF_X1B       = OFF_QA + ((size_t)64 << 20);
static_assert(OFF_V2 + (size_t)NB * 2 * KV2LEN * 64 * 2 <= OFF_X1B && OFF_X1B + (size_t)NLAT * 1024 * 2 <= OFF_END, "x1 alias");
static_assert(OFF_V2 + (size_t)NB * 2 * KV2LEN * 64 * 2 <= OFF_END, "alias overflow");

constexpr int LDS_BYTES = 147456 + 256;
#ifndef MULTI_LAUNCH
#define MULTI_LAUNCH 0
#endif

struct Params {
  const float *x, *c, *ctx, *c_ctx, *mod_w, *mod_b, *ab_w_in, *ab_w_out, *cq_gain, *ckv_gain, *w_uq, *w_ukv,
      *q_gain, *k_gain, *gq_gain, *gk_gain, *cd_w_in, *cd_w_out, *win_q_gain, *win_k_gain, *win_sink, *conv_w;
  float* out;
  char* ws;
  int ph_lo, ph_hi;
};

#define SBAR() __builtin_amdgcn_sched_barrier(0)
__device__ __forceinline__ int crow(int r, int hi) { return (r & 3) + 8 * (r >> 2) + 4 * hi; }
typedef float f32x2_t __attribute__((ext_vector_type(2)));
typedef __bf16 bf16x2_t __attribute__((ext_vector_type(2)));
__device__ __forceinline__ unsigned cvtpk(float lo, float hi) { f32x2_t v = {lo, hi}; bf16x2_t b = __builtin_convertvector(v, bf16x2_t); return __builtin_bit_cast(unsigned, b); }
__device__ __forceinline__ u16 f2bf(float x) { return (u16)(cvtpk(x, 0.f) & 0xffffu); }
__device__ __forceinline__ float bf2f(u16 x) { return __uint_as_float(((unsigned)x) << 16); }
__device__ __forceinline__ float bflo(unsigned w) { return __uint_as_float(w << 16); }
__device__ __forceinline__ float bfhi(unsigned w) { return __uint_as_float(w & 0xffff0000u); }
__device__ __forceinline__ float wave_sum(float v) {
#pragma unroll
  for (int o = 32; o >= 1; o >>= 1) v += __shfl_xor(v, o);
  return v;
}
__device__ __forceinline__ int opaque_tid() { int t = threadIdx.x; asm volatile("" : "+v"(t)); return t; }
__device__ __forceinline__ float vmaxabs(const float* g, int n) { float m = 0.f; for (int i = 0; i < n; ++i) m = fmaxf(m, fabsf(g[i])); return m; }
__device__ __forceinline__ float silu_f(float g) { return g / (1.f + __expf(-g)); }


__device__ __forceinline__ void gbar(unsigned* cnt, unsigned target) {
  asm volatile("s_waitcnt vmcnt(0)" ::: "memory");
  __syncthreads();
  if (threadIdx.x == 0) {
    __builtin_amdgcn_fence(__ATOMIC_RELEASE, "agent");
    asm volatile("s_waitcnt vmcnt(0)" ::: "memory");
    __hip_atomic_fetch_add(cnt, 1u, __ATOMIC_RELAXED, __HIP_MEMORY_SCOPE_AGENT);
    unsigned sp = 0;
    while (__hip_atomic_load(cnt, __ATOMIC_RELAXED, __HIP_MEMORY_SCOPE_AGENT) < target) { __builtin_amdgcn_s_sleep(1); if (++sp > (1u << 24)) break; }
    __builtin_amdgcn_fence(__ATOMIC_ACQUIRE, "agent");
    asm volatile("s_waitcnt vmcnt(0)" ::: "memory");
  }
  __syncthreads();
}


#define XB_TMO      128
#define XB_XCNT(j)  (256  + 64 * (j))
#define XB_XSUB(j)  (1280 + 64 * (j))
#define XB_XGEN(j)  (2304 + 64 * (j))
#define XB_TOP      3328
#define XB_TOPGEN   3392
#define XCD_BAR_WORDS 3456
#define XB_SPIN_CAP (1u << 20)
#define LAS __attribute__((address_space(3)))
__device__ __forceinline__ unsigned xb_ld(unsigned* p)              { return __hip_atomic_load(p, __ATOMIC_RELAXED, __HIP_MEMORY_SCOPE_AGENT); }
__device__ __forceinline__ unsigned xb_add(unsigned* p, unsigned v) { return __hip_atomic_fetch_add(p, v, __ATOMIC_RELAXED, __HIP_MEMORY_SCOPE_AGENT); }
__device__ __forceinline__ unsigned xb_xcc_id() { return (unsigned)__builtin_amdgcn_s_getreg((3 << 11) | 20) & 0xFu; }
#define XB_SPIN(cond, bar) do { unsigned _sp = 0; while (cond) { __builtin_amdgcn_s_sleep(1); \
    if ((++_sp & 255u) == 0u) { if (xb_ld(&(bar)[XB_TMO])) break; if (_sp > XB_SPIN_CAP) { atomicAdd(&(bar)[XB_TMO], 1u); break; } } } } while (0)
struct XcdBarrier { unsigned* bar; unsigned x; volatile LAS unsigned* st; };
__device__ __forceinline__ XcdBarrier xcd_barrier_post(unsigned* bar, volatile LAS unsigned* st) {
  XcdBarrier b; b.bar = bar; b.x = xb_xcc_id(); b.st = st;
  if (threadIdx.x == 0) (void)xb_add(&bar[XB_XCNT(b.x)], 1u);
  return b;
}
__device__ __forceinline__ void xcd_barrier_complete(unsigned* bar, unsigned x, unsigned& nloc, unsigned& nx) {
  const unsigned G = gridDim.x * gridDim.y * gridDim.z;
  unsigned sum, cnt, mine, sp = 0u;
  for (;;) {
    sum = 0u; cnt = 0u; mine = 0u;
#pragma unroll
    for (unsigned j = 0; j < 16; ++j) { const unsigned c = xb_ld(&bar[XB_XCNT(j)]); sum += c; cnt += (c > 0u) ? 1u : 0u; mine = (j == x) ? c : mine; }
    if (sum == G) break;
    __builtin_amdgcn_s_sleep(1);
    if ((++sp & 255u) == 0u) { if (xb_ld(&bar[XB_TMO])) break; if (sp > XB_SPIN_CAP) { atomicAdd(&bar[XB_TMO], 1u); break; } }
  }
  nloc = mine > 0u ? mine : 1u; nx = cnt > 0u ? cnt : 1u;
}
__device__ __forceinline__ void xcd_barrier(const XcdBarrier& b) {
  asm volatile("s_waitcnt vmcnt(0)" ::: "memory");
  __syncthreads();
  if (threadIdx.x == 0) {
    unsigned* bar = b.bar;
    __builtin_amdgcn_s_waitcnt(0);
    unsigned nloc = b.st[0], nx = b.st[1];
    if (nloc == 0u) { xcd_barrier_complete(bar, b.x, nloc, nx); b.st[0] = nloc; b.st[1] = nx; }
    const unsigned old = xb_add(&bar[XB_XSUB(b.x)], 1u);
    const unsigned gen = old / nloc;
    if (old + 1u == (gen + 1u) * nloc) {
      __builtin_amdgcn_fence(__ATOMIC_RELEASE, "agent");
      asm volatile("s_waitcnt vmcnt(0)" ::: "memory");
      const unsigned og = xb_add(&bar[XB_TOP], 1u);
      const unsigned tg = og / nx;
      if (og + 1u == (tg + 1u) * nx) xb_add(&bar[XB_TOPGEN], 1u);
      else XB_SPIN(xb_ld(&bar[XB_TOPGEN]) == tg, bar);
      __builtin_amdgcn_fence(__ATOMIC_ACQUIRE, "agent");
      xb_add(&bar[XB_XGEN(b.x)], 1u);
      asm volatile("s_waitcnt vmcnt(0)" ::: "memory");
    } else {
      XB_SPIN(xb_ld(&bar[XB_XGEN(b.x)]) == gen, bar);
      __builtin_amdgcn_fence(__ATOMIC_ACQUIRE, "agent");
      asm volatile("s_waitcnt vmcnt(0)" ::: "memory");
    }
  }
  __syncthreads();
}

__device__ void mod_unit(const Params& p, int u, char* lds) {
  const int tid = opaque_tid();
  const int layer = u / 96, n0 = (u % 96) * 32, col = tid & 31, ks = tid >> 5;
  const float* W = p.mod_w + (size_t)layer * 1024 * 3072 + n0 + col;
  float a0 = 0, a1 = 0, a2 = 0;
  for (int k = ks * 64; k < ks * 64 + 64; ++k) {
    float w = W[(size_t)k * 3072];
    a0 += silu_f(p.c[k]) * w; a1 += silu_f(p.c[1024 + k]) * w; a2 += silu_f(p.c_ctx[k]) * w;
  }
  float* red = (float*)lds;
  red[(0 * 16 + ks) * 32 + col] = a0; red[(1 * 16 + ks) * 32 + col] = a1; red[(2 * 16 + ks) * 32 + col] = a2;
  __syncthreads();
  if (tid < 96) {
    int w = tid >> 5, cc = tid & 31; float s = 0;
    for (int i = 0; i < 16; ++i) s += red[(w * 16 + i) * 32 + cc];
    float* modv = (float*)(p.ws + OFF_MODV);
    modv[(layer * 3 + w) * 3072 + n0 + cc] = s + p.mod_b[layer * 3072 + n0 + cc];
  }
  __syncthreads();
}

__device__ void transpose_unit(const Params& p, int u, char* lds) {
  const float* src; const float* gain = nullptr; int K, N; u16* dst; int ul;
  if (u < 608)       { ul = u;        src = p.ab_w_in;  K = 1024; N = 2336; dst = (u16*)(p.ws + OFF_WT_IN_AB); }
  else if (u < 864)  { ul = u - 608;  src = p.ab_w_out; K = 1024; N = 1024; dst = (u16*)(p.ws + OFF_WT_OUT_AB); }
  else if (u < 912)  { ul = u - 864;  src = p.w_uq;     K = 256;  N = 768;  dst = (u16*)(p.ws + OFF_WT_UQ); gain = p.cq_gain; }
  else if (u < 976)  { ul = u - 912;  src = p.w_ukv;    K = 256;  N = 1024; dst = (u16*)(p.ws + OFF_WT_UKV); gain = p.ckv_gain; }
  else if (u < 1808) { ul = u - 976;  src = p.cd_w_in;  K = 1024; N = 3328; dst = (u16*)(p.ws + OFF_WT_IN_CD); }
  else               { ul = u - 1808; src = p.cd_w_out; K = 1024; N = 1024; dst = (u16*)(p.ws + OFF_WT_OUT_CD); }
  const int nkt = K / 64, kt = ul % nkt, nt = ul / nkt, k0 = kt * 64, n0 = nt * 64, tid = opaque_tid();
  float* tile = (float*)lds;
#pragma unroll
  for (int e = 0; e < 8; ++e) {
    int i = (tid >> 6) + 8 * e, j = tid & 63, n = n0 + j;
    float v = (n < N) ? src[(size_t)(k0 + i) * N + n] : 0.f;
    if (gain) v *= gain[k0 + i];
    tile[i * 65 + j] = v;
  }
  __syncthreads();
#pragma unroll
  for (int e = 0; e < 8; ++e) {
    int i2 = (tid >> 6) + 8 * e, j2 = tid & 63;
    dst[(size_t)(n0 + i2) * K + k0 + j2] = f2bf(tile[j2 * 65 + i2]);
  }
  __syncthreads();
}

__device__ void adaln_phase(const float* xlat, const u16* xlat_bf, const float* xctx, const float* modl, u16* H) {
  const int tid = opaque_tid(), lane = tid & 63, gw = blockIdx.x * 8 + (tid >> 6), nw = gridDim.x * 8;
  for (int r = gw; r < NROW; r += nw) {
    if (xlat_bf != nullptr && r < NLAT) {
      const float* m = modl + (r >> 14) * 3072;
      u32x4 w[2]; float f[16]; float ss = 0;
#pragma unroll
      for (int i = 0; i < 2; ++i) w[i] = *(const u32x4*)(xlat_bf + (size_t)r * 1024 + 8 * (lane + 64 * i));
#pragma unroll
      for (int i = 0; i < 2; ++i)
#pragma unroll
        for (int e = 0; e < 4; ++e) { f[i * 8 + 2 * e] = bflo(w[i][e]); f[i * 8 + 2 * e + 1] = bfhi(w[i][e]); }
#pragma unroll
      for (int e = 0; e < 16; ++e) ss += f[e] * f[e];
      ss = wave_sum(ss);
      const float rstd = rsqrtf(ss * (1.f / 1024) + EPS);
#pragma unroll
      for (int i = 0; i < 2; ++i) {
        const int c = 8 * (lane + 64 * i);
        const float4 sh0 = *(const float4*)(m + c), sh1 = *(const float4*)(m + c + 4), sc0 = *(const float4*)(m + 1024 + c), sc1 = *(const float4*)(m + 1024 + c + 4);
        const float shv[8] = {sh0.x, sh0.y, sh0.z, sh0.w, sh1.x, sh1.y, sh1.z, sh1.w}, scv[8] = {sc0.x, sc0.y, sc0.z, sc0.w, sc1.x, sc1.y, sc1.z, sc1.w};
        float y[8];
#pragma unroll
        for (int e = 0; e < 8; ++e) y[e] = f[i * 8 + e] * rstd * (1.f + scv[e]) + shv[e];
        const u32x4 o = {cvtpk(y[0], y[1]), cvtpk(y[2], y[3]), cvtpk(y[4], y[5]), cvtpk(y[6], y[7])};
        *(u32x4*)(H + (size_t)r * 1024 + c) = o;
      }
      continue;
    }
    const float* src = r < NLAT ? xlat + (size_t)r * 1024 : xctx + (size_t)(r - NLAT) * 1024;
    const float* m = modl + (r < NLAT ? (r >> 14) : 2) * 3072;
    float4 v[4]; float ss = 0;
#pragma unroll
    for (int i = 0; i < 4; ++i) { v[i] = ((const float4*)src)[lane + 64 * i]; ss += v[i].x * v[i].x + v[i].y * v[i].y + v[i].z * v[i].z + v[i].w * v[i].w; }
    ss = wave_sum(ss);
    const float rstd = rsqrtf(ss * (1.f / 1024) + EPS);
#pragma unroll
    for (int i = 0; i < 4; ++i) {
      int c = 4 * (lane + 64 * i);
      float4 sh = *(const float4*)(m + c), sc = *(const float4*)(m + 1024 + c);
      float y0 = v[i].x * rstd * (1.f + sc.x) + sh.x, y1 = v[i].y * rstd * (1.f + sc.y) + sh.y;
      float y2 = v[i].z * rstd * (1.f + sc.z) + sh.z, y3 = v[i].w * rstd * (1.f + sc.w) + sh.w;
      u32x2 o = {cvtpk(y0, y1), cvtpk(y2, y3)};
      *(u32x2*)(H + (size_t)r * 1024 + c) = o;
    }
  }
}

#define GSWZ(row, colB) ((row) * 128 + ((colB) ^ ((((row) >> 1) & 7) << 4)))
struct ResPre { float4 v[16]; u32x2 w[16]; };
struct GPre { bf16x8 ra[4], rb[2]; };
__device__ __forceinline__ void gemm_preload(const u16* __restrict__ A, int lda, const u16* __restrict__ Bt, int ldb, int m0, int n0, GPre& g) {
  const int tid = opaque_tid(), srow = tid >> 3, sch = tid & 7;
  const u16* ap = A + (size_t)(m0 + srow) * lda + sch * 8;
  const u16* bp = Bt + (size_t)(n0 + srow) * ldb + sch * 8;
#pragma unroll
  for (int i = 0; i < 4; ++i) g.ra[i] = *(const bf16x8*)(ap + (size_t)(64 * i) * lda);
#pragma unroll
  for (int i = 0; i < 2; ++i) g.rb[i] = *(const bf16x8*)(bp + (size_t)(64 * i) * ldb);
}
template <int PRE>
__device__ __forceinline__ void gemm_tile(const u16* __restrict__ A, int lda, const u16* __restrict__ Bt, int ldb, int K,
                                          int m0, int n0, f32x16 (&acc)[2][2], char* lds, GPre& g, const void* resp = nullptr, ResPre* rp = nullptr) {
  const int tid = opaque_tid(), wid = tid >> 6, lane = tid & 63, r32 = lane & 31, hi = lane >> 5;
  const int wm = wid & 3, wn = wid >> 2;
  char* As = lds;
  char* Bs = lds + 98304;
  const int srow = tid >> 3, sch = tid & 7;
  const u16* ap = A + (size_t)(m0 + srow) * lda + sch * 8;
  const u16* bp = Bt + (size_t)(n0 + srow) * ldb + sch * 8;
  const int sw = GSWZ(srow, sch * 16);
  bf16x8 (&ra)[4] = g.ra; bf16x8 (&rb)[2] = g.rb;
#pragma unroll
  for (int i = 0; i < 2; ++i) for (int j = 0; j < 2; ++j) acc[i][j] = f32x16{};
  const int nk = K / 64;
  __syncthreads();
#pragma unroll
  for (int i = 0; i < 4; ++i) *(bf16x8*)(As + sw + i * 8192) = ra[i];
#pragma unroll
  for (int i = 0; i < 2; ++i) *(bf16x8*)(Bs + sw + i * 8192) = rb[i];
  if (1 < nk) {
#pragma unroll
    for (int i = 0; i < 4; ++i) ra[i] = *(const bf16x8*)(ap + (size_t)(64 * i) * lda + 64);
#pragma unroll
    for (int i = 0; i < 2; ++i) rb[i] = *(const bf16x8*)(bp + (size_t)(64 * i) * ldb + 64);
  }
  __syncthreads();
  const int arow0 = wm * 64 + r32, brow0 = wn * 64 + r32;
  int st = 0;
  for (int kt = 0; kt < nk; ++kt) {
    const int stn = (st == 2) ? 0 : st + 1;
    if (kt + 1 < nk) {
      char* An = As + stn * 32768; char* Bn = Bs + stn * 16384;
#pragma unroll
      for (int i = 0; i < 4; ++i) *(bf16x8*)(An + sw + i * 8192) = ra[i];
#pragma unroll
      for (int i = 0; i < 2; ++i) *(bf16x8*)(Bn + sw + i * 8192) = rb[i];
    }
    if (kt + 2 < nk) {
#pragma unroll
      for (int i = 0; i < 4; ++i) ra[i] = *(const bf16x8*)(ap + (size_t)(64 * i) * lda + (kt + 2) * 64);
#pragma unroll
      for (int i = 0; i < 2; ++i) rb[i] = *(const bf16x8*)(bp + (size_t)(64 * i) * ldb + (kt + 2) * 64);
    }
    if (PRE == 1 && kt == 0) {
#pragma unroll
      for (int q = 0; q < 16; ++q) rp->v[q] = *(const float4*)((const float*)resp + (size_t)((q >> 3) * 32 + 4 * (q & 7)) * 1024);
    }
    if (PRE == 2 && kt == 0) {
#pragma unroll
      for (int q = 0; q < 16; ++q) rp->w[q] = *(const u32x2*)((const u16*)resp + (size_t)((q >> 3) * 32 + 4 * (q & 7)) * 1024);
    }
    SBAR();
    const char* Ac = As + st * 32768; const char* Bc = Bs + st * 16384;
#pragma unroll
    for (int kk = 0; kk < 4; ++kk) {
      const int cb = kk * 32 + hi * 16;
      bf16x8 a0 = *(const bf16x8*)(Ac + GSWZ(arow0, cb));
      bf16x8 a1 = *(const bf16x8*)(Ac + GSWZ(arow0 + 32, cb));
      bf16x8 b0 = *(const bf16x8*)(Bc + GSWZ(brow0, cb));
      bf16x8 b1 = *(const bf16x8*)(Bc + GSWZ(brow0 + 32, cb));
      acc[0][0] = __builtin_amdgcn_mfma_f32_32x32x16_bf16(a0, b0, acc[0][0], 0, 0, 0);
      acc[0][1] = __builtin_amdgcn_mfma_f32_32x32x16_bf16(a0, b1, acc[0][1], 0, 0, 0);
      acc[1][0] = __builtin_amdgcn_mfma_f32_32x32x16_bf16(a1, b0, acc[1][0], 0, 0, 0);
      acc[1][1] = __builtin_amdgcn_mfma_f32_32x32x16_bf16(a1, b1, acc[1][1], 0, 0, 0);
    }
    __syncthreads();
    st = stn;
  }
}

struct TileIter {
  int f, fend, step, MT, NT;
  __device__ __forceinline__ TileIter(int MT_, int NT_) : MT(MT_), NT(NT_) {
    const int T = MT_ * NT_, bid = blockIdx.x, nblk = gridDim.x;
    if (nblk == 256) { const int x = bid & 7, cl = bid >> 3; f = (int)(((long)T * x) >> 3) + cl; fend = (int)(((long)T * (x + 1)) >> 3); step = 32; }
    else { f = bid; fend = T; step = nblk; }
  }
  __device__ __forceinline__ bool valid() const { return f < fend; }
  __device__ __forceinline__ void next() { f += step; }
  __device__ __forceinline__ void get(int& mt, int& nt) const {
    const int full = (MT >> 2) * 4 * NT;
    if (f < full) { const int g = f / (4 * NT), rem = f - g * 4 * NT; nt = rem >> 2; mt = g * 4 + (rem & 3); }
    else { const int rem = f - full, gs = MT - (MT >> 2) * 4; nt = rem / gs; mt = (MT >> 2) * 4 + (rem - nt * gs); }
  }
};

__device__ __forceinline__ void epi_bf16(f32x16 (&acc)[2][2], u16* C, int ldc, int m0, int n0, char* lds) {
  const int tid = opaque_tid(), wid = tid >> 6, lane = tid & 63, r32 = lane & 31, hi = lane >> 5;
  const int wm = wid & 3, wn = wid >> 2;
  char* wl = lds + wid * 9216;
#pragma unroll
  for (int i = 0; i < 2; ++i)
#pragma unroll
    for (int j = 0; j < 2; ++j)
#pragma unroll
      for (int r = 0; r < 16; ++r) *(u16*)(wl + (i * 32 + crow(r, hi)) * 144 + (j * 32 + r32) * 2) = f2bf(acc[i][j][r]);
  asm volatile("s_waitcnt lgkmcnt(0)" ::: "memory");
  const int rr = lane >> 3, ch = lane & 7;
  u16* cbase = C + (size_t)(m0 + wm * 64 + rr) * ldc + n0 + wn * 64 + ch * 8;
#pragma unroll
  for (int k = 0; k < 8; ++k) {
    const u32x4 v = *(const u32x4*)(wl + (rr + 8 * k) * 144 + ch * 16);
    *(u32x4*)(cbase + (size_t)(8 * k) * ldc) = v;
  }
}
template <bool IN_BF, bool OUT_BF>
__device__ __forceinline__ void epi_res(f32x16 (&acc)[2][2], const ResPre& rp, void* outp, const float* gsrc, int n0, char* lds) {
  const int tid = opaque_tid(), wid = tid >> 6, lane = tid & 63, r32 = lane & 31, hi = lane >> 5;
  const int wn = wid >> 2;
  char* wl = lds + wid * 8704;
  const int rl = lane >> 4, c4 = lane & 15;
  const float4 g = *(const float4*)(gsrc + n0 + wn * 64 + 4 * c4);
#pragma unroll
  for (int i = 0; i < 2; ++i) {
#pragma unroll
    for (int j = 0; j < 2; ++j)
#pragma unroll
      for (int r = 0; r < 16; ++r) *(float*)(wl + crow(r, hi) * 272 + (j * 32 + r32) * 4) = acc[i][j][r];
    asm volatile("s_waitcnt lgkmcnt(0)" ::: "memory");
#pragma unroll
    for (int k = 0; k < 8; ++k) {
      const float4 a = *(const float4*)(wl + (rl + 4 * k) * 272 + c4 * 16);
      float4 x;
      if (IN_BF) { const u32x2 xw = rp.w[i * 8 + k]; x.x = bflo(xw[0]); x.y = bfhi(xw[0]); x.z = bflo(xw[1]); x.w = bfhi(xw[1]); } else x = rp.v[i * 8 + k];
      float4 o; o.x = x.x + g.x * a.x; o.y = x.y + g.y * a.y; o.z = x.z + g.z * a.z; o.w = x.w + g.w * a.w;
      if (OUT_BF) { const u32x2 ow = {cvtpk(o.x, o.y), cvtpk(o.z, o.w)}; *(u32x2*)((u16*)outp + (size_t)(i * 32 + 4 * k) * 1024) = ow; }
      else *(float4*)((float*)outp + (size_t)(i * 32 + 4 * k) * 1024) = o;
    }
    asm volatile("s_waitcnt lgkmcnt(0)" ::: "memory");
  }
}

__device__ __forceinline__ float red8(float v) { v += __shfl_xor(v, 1); v += __shfl_xor(v, 2); v += __shfl_xor(v, 4); return v; }
__device__ __forceinline__ void rope_cs(float pos, float inv, bool on, float& c, float& s) {
  if (on) { float a = pos * inv * 0.15915494309189535f; a -= floorf(a); c = __builtin_amdgcn_cosf(a); s = __builtin_amdgcn_sinf(a); } else { c = 1.f; s = 0.f; }
}
__device__ __forceinline__ void head64(const u16* src, u16* dst, int gb, const float* g, const float* cG, const float* sG, float qs) {
  const u32x2 lo = *(const u32x2*)(src + gb), hi2 = *(const u32x2*)(src + gb + 16);
  float x[8] = {bflo(lo[0]), bfhi(lo[0]), bflo(lo[1]), bfhi(lo[1]), bflo(hi2[0]), bfhi(hi2[0]), bflo(hi2[1]), bfhi(hi2[1])};
  float ss = 0;
#pragma unroll
  for (int e = 0; e < 8; ++e) ss += x[e] * x[e];
  const float rn = rsqrtf(red8(ss) * (1.f / 64) + EPS) ;
#pragma unroll
  for (int e = 0; e < 8; ++e) x[e] *= rn * g[e];
  float y[8];
#pragma unroll
  for (int e = 0; e < 4; ++e) { y[e] = (x[e] * cG[e] - x[e + 4] * sG[e]) * qs; y[e + 4] = (x[e + 4] * cG[e] + x[e] * sG[e]) * qs; }
  const u32x2 o0 = {cvtpk(y[0], y[1]), cvtpk(y[2], y[3])}, o1 = {cvtpk(y[4], y[5]), cvtpk(y[6], y[7])};
  *(u32x2*)(dst + gb) = o0; *(u32x2*)(dst + gb + 16) = o1;
}
__device__ __forceinline__ void head96(float* n, float r1a, float r1b, float r2a, float r2b, u16* dst, int t, int rb,
                                       const float* gn, const float* gr, const float* cM, const float* sM, float qs) {
  float ss = r1a * r1a + r1b * r1b + r2a * r2a + r2b * r2b;
#pragma unroll
  for (int e = 0; e < 8; ++e) ss += n[e] * n[e];
  const float rn = rsqrtf(red8(ss) * (1.f / 96) + EPS);
#pragma unroll
  for (int e = 0; e < 8; ++e) n[e] *= rn * gn[e] * qs;
  r1a *= rn * gr[0]; r1b *= rn * gr[1]; r2a *= rn * gr[2]; r2b *= rn * gr[3];
  const float y1a = (r1a * cM[0] - r2a * sM[0]) * qs, y2a = (r2a * cM[0] + r1a * sM[0]) * qs;
  const float y1b = (r1b * cM[1] - r2b * sM[1]) * qs, y2b = (r2b * cM[1] + r1b * sM[1]) * qs;
  const u32x4 o = {cvtpk(n[0], n[1]), cvtpk(n[2], n[3]), cvtpk(n[4], n[5]), cvtpk(n[6], n[7])};
  *(u32x4*)(dst + 8 * t) = o;
  *(unsigned*)(dst + 64 + rb) = cvtpk(y1a, y1b); *(unsigned*)(dst + 64 + rb + 8) = cvtpk(y2a, y2b);
}
__device__ void finalize0(const Params& p) {
  const int tid = opaque_tid(), lane = tid & 63, gw = blockIdx.x * 8 + (tid >> 6), nw = gridDim.x * 8;
  const int h = lane >> 3, t = lane & 7;
  char* ws = p.ws;
  const u16* PP = (const u16*)(ws + OFF_PP);
  const u16* QAR = (const u16*)(ws + OFF_H);
  const u16* KVR = (const u16*)p.out;
  u16* QA = (u16*)(ws + OFF_QA); u16* QCA = (u16*)(ws + OFF_QCA); u16* KA = (u16*)(ws + OFF_KA); u16* VA = (u16*)(ws + OFF_VA);
  u16* QB = (u16*)(ws + OFF_QB); u16* QCB = (u16*)(ws + OFF_QCB); u16* KB = (u16*)(ws + OFF_KB); u16* VB = (u16*)(ws + OFF_VB);
  const int gb = t < 4 ? 4 * t : 32 + 4 * (t - 4), rb = t < 4 ? 2 * t : 16 + 2 * (t - 4);
  float qgn[8], kgn[8], qgr[4], kgr[4], gqg[8], gkg[8], invG[4], invM[2];
#pragma unroll
  for (int e = 0; e < 8; ++e) { qgn[e] = p.q_gain[8 * t + e]; kgn[e] = p.k_gain[8 * t + e];
    const int d = gb + (e & 3) + (e >> 2) * 16; gqg[e] = p.gq_gain[d]; gkg[e] = p.gk_gain[d]; }
#pragma unroll
  for (int k = 0; k < 4; ++k) { const int d = 64 + rb + (k & 1) + (k >> 1) * 8; qgr[k] = p.q_gain[d]; kgr[k] = p.k_gain[d]; }
#pragma unroll
  for (int e = 0; e < 4; ++e) invG[e] = exp2f(-(float)(4 * (t & 3) + e) * (13.287712379549449f / 16.f));
#pragma unroll
  for (int k = 0; k < 2; ++k) invM[k] = exp2f(-(float)(2 * (t & 3) + k) * (13.287712379549449f / 8.f));
  for (int r = gw; r < NROW; r += nw) {
    const bool isctx = r >= NLAT;
    int b, s, kpos; float pos = 0.f;
    if (!isctx) { b = r >> 14; s = r & 16383; kpos = CL + s; pos = t < 4 ? (float)(s >> 6) : (float)(s & 63); }
    else { int rc = r - NLAT; b = rc >> 8; s = rc & 255; kpos = s; }
    float cG[4], sG[4], cM[2], sM[2];
#pragma unroll
    for (int e = 0; e < 4; ++e) rope_cs(pos, invG[e], !isctx, cG[e], sG[e]);
#pragma unroll
    for (int k = 0; k < 2; ++k) rope_cs(pos, invM[k], !isctx, cM[k], sM[k]);
    const u16* pp = PP + (size_t)r * LD_AB;
    const u32x2 wq = *(const u32x2*)(pp + lane * 4), wk = *(const u32x2*)(pp + 256 + lane * 4);
    float s1 = bflo(wq[0]) * bflo(wq[0]) + bfhi(wq[0]) * bfhi(wq[0]) + bflo(wq[1]) * bflo(wq[1]) + bfhi(wq[1]) * bfhi(wq[1]);
    float s2 = bflo(wk[0]) * bflo(wk[0]) + bfhi(wk[0]) * bfhi(wk[0]) + bflo(wk[1]) * bflo(wk[1]) + bfhi(wk[1]) * bfhi(wk[1]);
    s1 = wave_sum(s1); s2 = wave_sum(s2);
    const float rstd_cq = rsqrtf(s1 * (1.f / 256) + EPS), rstd_ckv = rsqrtf(s2 * (1.f / 256) + EPS);
    { const u16* qa = QAR + (size_t)r * 768 + h * 96;
      const u32x4 nv = *(const u32x4*)(qa + 8 * t); const unsigned w1 = *(const unsigned*)(qa + 64 + rb), w2 = *(const unsigned*)(qa + 64 + rb + 8);
      float n[8] = {bflo(nv[0]) * rstd_cq, bfhi(nv[0]) * rstd_cq, bflo(nv[1]) * rstd_cq, bfhi(nv[1]) * rstd_cq, bflo(nv[2]) * rstd_cq, bfhi(nv[2]) * rstd_cq, bflo(nv[3]) * rstd_cq, bfhi(nv[3]) * rstd_cq};
      u16* dq = isctx ? QCA + ((size_t)(b * 8 + h) * CL + s) * 96 : QA + ((size_t)(b * 8 + h) * SEQ + s) * 96;
      head96(n, bflo(w1) * rstd_cq, bfhi(w1) * rstd_cq, bflo(w2) * rstd_cq, bfhi(w2) * rstd_cq, dq, t, rb, qgn, qgr, cM, sM, QS_A); }
    { const u16* kv = KVR + (size_t)r * 1024 + h * 128;
      const u32x4 nv = *(const u32x4*)(kv + 8 * t), vv = *(const u32x4*)(kv + 64 + 8 * t);
      const unsigned w1 = *(const unsigned*)(pp + 512 + rb), w2 = *(const unsigned*)(pp + 512 + rb + 8);
      float n[8] = {bflo(nv[0]) * rstd_ckv, bfhi(nv[0]) * rstd_ckv, bflo(nv[1]) * rstd_ckv, bfhi(nv[1]) * rstd_ckv, bflo(nv[2]) * rstd_ckv, bfhi(nv[2]) * rstd_ckv, bflo(nv[3]) * rstd_ckv, bfhi(nv[3]) * rstd_ckv};
      const size_t kr = (size_t)(b * 8 + h) * KVLEN + kpos;
      head96(n, bflo(w1), bfhi(w1), bflo(w2), bfhi(w2), KA + kr * 96, t, rb, kgn, kgr, cM, sM, 1.f);
      const u32x4 vo = {cvtpk(bflo(vv[0]) * rstd_ckv, bfhi(vv[0]) * rstd_ckv), cvtpk(bflo(vv[1]) * rstd_ckv, bfhi(vv[1]) * rstd_ckv),
                        cvtpk(bflo(vv[2]) * rstd_ckv, bfhi(vv[2]) * rstd_ckv), cvtpk(bflo(vv[3]) * rstd_ckv, bfhi(vv[3]) * rstd_ckv)};
      *(u32x4*)(VA + kr * 64 + 8 * t) = vo; }
    { u16* dg = isctx ? QCB + ((size_t)(b * 8 + h) * CL + s) * 64 : QB + ((size_t)(b * 8 + h) * SEQ + s) * 64;
      head64(pp + 544 + h * 64, dg, gb, gqg, cG, sG, QS_B); }
    if (h < 2) {
      const size_t kr = (size_t)(b * 2 + h) * KVLEN + kpos;
      head64(pp + 1056 + h * 64, KB + kr * 64, gb, gkg, cG, sG, 1.f);
      *(u32x4*)(VB + kr * 64 + 8 * t) = *(const u32x4*)(pp + 1184 + h * 64 + 8 * t);
    }
  }
}

__device__ void finalize1(const Params& p) {
  const int tid = opaque_tid(), lane = tid & 63, gw = blockIdx.x * 8 + (tid >> 6), nw = gridDim.x * 8;
  const int h = lane >> 3, t = lane & 7;
  char* ws = p.ws;
  const u16* PP = (const u16*)(ws + OFF_PP);
  u16* Q2 = (u16*)(ws + OFF_Q2); u16* K2 = (u16*)(ws + OFF_K2); u16* V2 = (u16*)(ws + OFF_V2);
  u16* MIX = (u16*)(ws + OFF_H);
  const int gb = t < 4 ? 4 * t : 32 + 4 * (t - 4);
  float qg[8], kg[8], invG[4];
#pragma unroll
  for (int e = 0; e < 8; ++e) { const int d = gb + (e & 3) + (e >> 2) * 16; qg[e] = p.win_q_gain[d]; kg[e] = p.win_k_gain[d]; }
#pragma unroll
  for (int e = 0; e < 4; ++e) invG[e] = exp2f(-(float)(4 * (t & 3) + e) * (13.287712379549449f / 16.f));
  float cw[3][8];
#pragma unroll
  for (int j = 0; j < 3; ++j)
#pragma unroll
    for (int e = 0; e < 8; ++e) cw[j][e] = p.conv_w[j * 512 + lane * 8 + e];
  for (int r = gw; r < NROW + 512; r += nw) {
    if (r >= NROW) {
      int slab = (r - NROW) >> 7, pr = (r - NROW) & 127;
      size_t kr = (size_t)slab * KV2LEN + KVLEN + pr;
      K2[kr * 64 + lane] = 0; V2[kr * 64 + lane] = 0;
      continue;
    }
    const bool isctx = r >= NLAT;
    int b, s, kpos; float pos = 0.f;
    if (!isctx) { b = r >> 14; s = r & 16383; kpos = CL + s; pos = t < 4 ? (float)(s >> 6) : (float)(s & 63); }
    else { int rc = r - NLAT; b = rc >> 8; s = rc & 255; kpos = s; }
    float cG[4], sG[4];
#pragma unroll
    for (int e = 0; e < 4; ++e) rope_cs(pos, invG[e], !isctx, cG[e], sG[e]);
    const u16* pp = PP + (size_t)r * LD_CD;
    if (!isctx) head64(pp + h * 64, Q2 + ((size_t)(b * 8 + h) * SEQ + s) * 64, gb, qg, cG, sG, QS_B);
    if (h < 2) {
      const size_t kr = (size_t)(b * 2 + h) * KV2LEN + kpos;
      head64(pp + 512 + h * 64, K2 + kr * 64, gb, kg, cG, sG, 1.f);
      *(u32x4*)(V2 + kr * 64 + 8 * t) = *(const u32x4*)(pp + 640 + h * 64 + 8 * t);
    }
    if (!isctx) {
      const int c0 = lane * 8;
      float y[8];
#pragma unroll
      for (int e = 0; e < 8; ++e) y[e] = 0.f;
#pragma unroll
      for (int j = 0; j < 3; ++j) {
        const int sj = s + j - 1;
        if (sj >= 0 && sj < SEQ) {
          const u16* pj = pp + (ptrdiff_t)(j - 1) * LD_CD;
          u32x4 a = *(const u32x4*)(pj + 1280 + c0), bb = *(const u32x4*)(pj + 1792 + c0);
#pragma unroll
          for (int e = 0; e < 4; ++e) {
            y[2 * e]     += bflo(a[e]) * bflo(bb[e]) * cw[j][2 * e];
            y[2 * e + 1] += bfhi(a[e]) * bfhi(bb[e]) * cw[j][2 * e + 1];
          }
        }
      }
      u32x4 gbv = *(const u32x4*)(pp + 768 + c0), gt = *(const u32x4*)(pp + 2304 + 512 + c0);
      u32x4 o;
#pragma unroll
      for (int e = 0; e < 4; ++e) {
        float v0 = bflo(gbv[e]) * y[2 * e] * silu_f(bflo(gt[e]));
        float v1 = bfhi(gbv[e]) * y[2 * e + 1] * silu_f(bfhi(gt[e]));
        o[e] = cvtpk(v0, v1);
      }
      *(u32x4*)(MIX + (size_t)r * 1024 + 512 + c0) = o;
    }
  }
}

#define KSWZ(row, colB) ((row) * 272 + (colB))
__device__ __forceinline__ int v_st2(int k, int c) { const int kk = k; return ((kk >> 3) * 2 + (c >> 5)) * 512 + ((kk & 7) * 32 + (c & 31)) * 2; }
__device__ __forceinline__ int v_rd_base(int lane) { return ((lane & 3) << 3) | (((lane >> 2) & 3) << 6) | (((lane >> 4) & 1) << 5) | (((lane >> 5) & 1) << 8); }
constexpr int v_rd_off2(int d0, int ks, int half) { return d0 * 512 + ks * 2048 + half * 1024; }
template <int OFF> __device__ __forceinline__ s16x4 tr_read(int vb) {
  s16x4 r; asm volatile("ds_read_b64_tr_b16 %0, %1 offset:%2" : "=&v"(r) : "v"(vb), "i"(OFF) : "memory"); return r;
}
template <int D0> __device__ __forceinline__ void pv_one(f32x16& od, int vb, bf16x8 pa0, bf16x8 pa1, bf16x8 pa2, bf16x8 pa3) {
  const s16x4 l0 = tr_read<v_rd_off2(D0, 0, 0)>(vb), h0 = tr_read<v_rd_off2(D0, 0, 1)>(vb), l1 = tr_read<v_rd_off2(D0, 1, 0)>(vb), h1 = tr_read<v_rd_off2(D0, 1, 1)>(vb);
  const s16x4 l2 = tr_read<v_rd_off2(D0, 2, 0)>(vb), h2 = tr_read<v_rd_off2(D0, 2, 1)>(vb), l3 = tr_read<v_rd_off2(D0, 3, 0)>(vb), h3 = tr_read<v_rd_off2(D0, 3, 1)>(vb);
  asm volatile("s_waitcnt lgkmcnt(0)" ::: "memory"); SBAR();
#define PK(L, H) (bf16x8){L[0], L[1], L[2], L[3], H[0], H[1], H[2], H[3]}
  od = __builtin_amdgcn_mfma_f32_32x32x16_bf16(pa0, PK(l0, h0), od, 0, 0, 0);
  od = __builtin_amdgcn_mfma_f32_32x32x16_bf16(pa1, PK(l1, h1), od, 0, 0, 0);
  od = __builtin_amdgcn_mfma_f32_32x32x16_bf16(pa2, PK(l2, h2), od, 0, 0, 0);
  od = __builtin_amdgcn_mfma_f32_32x32x16_bf16(pa3, PK(l3, h3), od, 0, 0, 0);
#undef PK
}
__device__ __forceinline__ void pv_all(f32x16* o, int vb, bf16x8 pa0, bf16x8 pa1, bf16x8 pa2, bf16x8 pa3) {
  pv_one<0>(o[0], vb, pa0, pa1, pa2, pa3); pv_one<1>(o[1], vb, pa0, pa1, pa2, pa3);
}
__device__ __forceinline__ void pv_exp(f32x16* o, int vb, bf16x8 pa0, bf16x8 pa1, bf16x8 pa2, bf16x8 pa3, f32x16& n0, f32x16& n1) {
#define PK(L, H) (bf16x8){L[0], L[1], L[2], L[3], H[0], H[1], H[2], H[3]}
  { const s16x4 l0 = tr_read<v_rd_off2(0, 0, 0)>(vb), h0 = tr_read<v_rd_off2(0, 0, 1)>(vb), l1 = tr_read<v_rd_off2(0, 1, 0)>(vb), h1 = tr_read<v_rd_off2(0, 1, 1)>(vb);
    const s16x4 l2 = tr_read<v_rd_off2(0, 2, 0)>(vb), h2 = tr_read<v_rd_off2(0, 2, 1)>(vb), l3 = tr_read<v_rd_off2(0, 3, 0)>(vb), h3 = tr_read<v_rd_off2(0, 3, 1)>(vb);
#pragma unroll
    for (int r = 0; r < 8; ++r) n0[r] = __builtin_amdgcn_exp2f(n0[r]);
    asm volatile("s_waitcnt lgkmcnt(0)" ::: "memory"); SBAR();
    o[0] = __builtin_amdgcn_mfma_f32_32x32x16_bf16(pa0, PK(l0, h0), o[0], 0, 0, 0);
    o[0] = __builtin_amdgcn_mfma_f32_32x32x16_bf16(pa1, PK(l1, h1), o[0], 0, 0, 0);
    o[0] = __builtin_amdgcn_mfma_f32_32x32x16_bf16(pa2, PK(l2, h2), o[0], 0, 0, 0);
    o[0] = __builtin_amdgcn_mfma_f32_32x32x16_bf16(pa3, PK(l3, h3), o[0], 0, 0, 0); }
  { const s16x4 l0 = tr_read<v_rd_off2(1, 0, 0)>(vb), h0 = tr_read<v_rd_off2(1, 0, 1)>(vb), l1 = tr_read<v_rd_off2(1, 1, 0)>(vb), h1 = tr_read<v_rd_off2(1, 1, 1)>(vb);
    const s16x4 l2 = tr_read<v_rd_off2(1, 2, 0)>(vb), h2 = tr_read<v_rd_off2(1, 2, 1)>(vb), l3 = tr_read<v_rd_off2(1, 3, 0)>(vb), h3 = tr_read<v_rd_off2(1, 3, 1)>(vb);
#pragma unroll
    for (int r = 8; r < 16; ++r) n0[r] = __builtin_amdgcn_exp2f(n0[r]);
    asm volatile("s_waitcnt lgkmcnt(0)" ::: "memory"); SBAR();
    o[1] = __builtin_amdgcn_mfma_f32_32x32x16_bf16(pa0, PK(l0, h0), o[1], 0, 0, 0);
    o[1] = __builtin_amdgcn_mfma_f32_32x32x16_bf16(pa1, PK(l1, h1), o[1], 0, 0, 0);
    o[1] = __builtin_amdgcn_mfma_f32_32x32x16_bf16(pa2, PK(l2, h2), o[1], 0, 0, 0);
    o[1] = __builtin_amdgcn_mfma_f32_32x32x16_bf16(pa3, PK(l3, h3), o[1], 0, 0, 0); }
#undef PK
#pragma unroll
  for (int r = 0; r < 16; ++r) n1[r] = __builtin_amdgcn_exp2f(n1[r]);
}

__device__ __forceinline__ void expall(f32x16& p0, f32x16& p1) {
#pragma unroll
  for (int r = 0; r < 16; ++r) p0[r] = __builtin_amdgcn_exp2f(p0[r]);
#pragma unroll
  for (int r = 0; r < 16; ++r) p1[r] = __builtin_amdgcn_exp2f(p1[r]);
}
__device__ __forceinline__ void finishSM(f32x16& p0, f32x16& p1, float& lsum, bf16x8& pa0, bf16x8& pa1, bf16x8& pa2, bf16x8& pa3) {
  float ps = 0;
#pragma unroll
  for (int r = 0; r < 16; ++r) ps += p0[r];
#pragma unroll
  for (int r = 0; r < 16; ++r) ps += p1[r];
  lsum += ps;
#define PK4(P, BASE, OUT) do { u32x4 w = {cvtpk(P[BASE + 0], P[BASE + 1]), cvtpk(P[BASE + 2], P[BASE + 3]), cvtpk(P[BASE + 4], P[BASE + 5]), cvtpk(P[BASE + 6], P[BASE + 7])}; \
    OUT = *reinterpret_cast<bf16x8*>(&w); } while (0)
  PK4(p0, 0, pa0); PK4(p0, 8, pa1); PK4(p1, 0, pa2); PK4(p1, 8, pa3);
#undef PK4
}
template <int NQK>
__device__ __forceinline__ void qkt(f32x16& p0, f32x16& p1, const char* Ks, const bf16x8* qr, int r32, int hi, const float shift) {
  p0 = f32x16{}; p1 = f32x16{};
#pragma unroll
  for (int d0 = 0; d0 < NQK; ++d0) { int cb = (d0 * 16 + hi * 8) * 2;
    bf16x8 b0 = *reinterpret_cast<const bf16x8*>(Ks + KSWZ(r32, cb));
    bf16x8 b1 = *reinterpret_cast<const bf16x8*>(Ks + KSWZ(32 + r32, cb));
    p0 = __builtin_amdgcn_mfma_f32_32x32x16_bf16(b0, qr[d0], p0, 0, 0, 0);
    p1 = __builtin_amdgcn_mfma_f32_32x32x16_bf16(b1, qr[d0], p1, 0, 0, 0); }
  if (__builtin_expect(shift != 0.f, 0)) {
#pragma unroll
    for (int r = 0; r < 16; ++r) { p0[r] -= shift; p1[r] -= shift; }
  }
}

#define PK4X(P, BASE, OUT) do { u32x4 w_ = {cvtpk(P[BASE + 0], P[BASE + 1]), cvtpk(P[BASE + 2], P[BASE + 3]), cvtpk(P[BASE + 4], P[BASE + 5]), cvtpk(P[BASE + 6], P[BASE + 7])}; \
    OUT = *reinterpret_cast<bf16x8*>(&w_); } while (0)
template <int NQK>
__device__ __forceinline__ void qkt_fin(f32x16& n0, f32x16& n1, const char* Ks, const bf16x8* qr, int r32, int hi, const float shift,
                                        f32x16& o0, f32x16& o1, float& lsum, bf16x8& pa0, bf16x8& pa1, bf16x8& pa2, bf16x8& pa3) {
  n0 = f32x16{}; n1 = f32x16{};
  float ps = 0.f;
  bf16x8 kc0 = *reinterpret_cast<const bf16x8*>(Ks + KSWZ(r32, (hi * 8) * 2));
  bf16x8 kc1 = *reinterpret_cast<const bf16x8*>(Ks + KSWZ(32 + r32, (hi * 8) * 2));
#pragma unroll
  for (int d0 = 0; d0 < NQK; ++d0) {
    bf16x8 kn0 = kc0, kn1 = kc1;
    if (d0 + 1 < NQK) { const int cb = ((d0 + 1) * 16 + hi * 8) * 2;
      kn0 = *reinterpret_cast<const bf16x8*>(Ks + KSWZ(r32, cb)); kn1 = *reinterpret_cast<const bf16x8*>(Ks + KSWZ(32 + r32, cb)); }
    n0 = __builtin_amdgcn_mfma_f32_32x32x16_bf16(kc0, qr[d0], n0, 0, 0, 0);
    n1 = __builtin_amdgcn_mfma_f32_32x32x16_bf16(kc1, qr[d0], n1, 0, 0, 0);
#define PIN(X) asm volatile("" : "+v"(X))
    if (NQK == 6) {
      if (d0 == 0) { PK4X(o0, 0, pa0); }
      if (d0 == 1) { PIN(o0); PK4X(o0, 8, pa1); }
      if (d0 == 2) { _Pragma("unroll") for (int r = 0; r < 16; ++r) ps += o0[r]; }
      if (d0 == 3) { PIN(o1); PK4X(o1, 0, pa2); _Pragma("unroll") for (int r = 0; r < 8; ++r) ps += o1[r]; }
      if (d0 == 4) { PIN(o1); PK4X(o1, 8, pa3); _Pragma("unroll") for (int r = 8; r < 16; ++r) ps += o1[r]; }
    } else {
      if (d0 == 0) { PK4X(o0, 0, pa0); PK4X(o0, 8, pa1); }
      if (d0 == 1) { _Pragma("unroll") for (int r = 0; r < 16; ++r) ps += o0[r]; }
      if (d0 == 2) { PIN(o1); PK4X(o1, 0, pa2); _Pragma("unroll") for (int r = 0; r < 8; ++r) ps += o1[r]; }
      if (d0 == 3) { PIN(o1); PK4X(o1, 8, pa3); _Pragma("unroll") for (int r = 8; r < 16; ++r) ps += o1[r]; }
    }
#undef PIN
    asm volatile("" : "+v"(ps), "+v"(pa0), "+v"(pa1), "+v"(pa2), "+v"(pa3));
    kc0 = kn0; kc1 = kn1;
    SBAR();
  }
  lsum += ps;
  if (__builtin_expect(shift != 0.f, 0)) {
#pragma unroll
    for (int r = 0; r < 16; ++r) { n0[r] -= shift; n1[r] -= shift; }
  }
}

template <int NQK, int MODE, int LDG>
__device__ __forceinline__ void attn_body(const u16* __restrict__ Qb, const u16* __restrict__ Kh, const u16* __restrict__ Vh,
                                          const int NT, const int q0, const float sink2, const float mbound,
                                          u16* __restrict__ mix0, const u16* __restrict__ gate0, char* lds) {
  constexpr int DK = NQK * 16;
  constexpr int SHM_V = 8192, SHM_K = 17408;
  int tid_ = threadIdx.x; asm volatile("" : "+v"(tid_));
  const int tid = tid_, wid = __builtin_amdgcn_readfirstlane(tid >> 6), lane = tid & 63, r32 = lane & 31, hi = lane >> 5;
  char* V_lds = lds; char* K_lds = lds + 5 * SHM_V;
  float* wsf = (float*)(lds + 5 * SHM_V + 5 * SHM_K) + wid * 64; float* li_l = wsf;
  float lsum = 0; f32x16 o[2] = {}; bf16x8 qr[NQK];
  const float shift = mbound > 80.f ? mbound - 80.f : 0.f;
  const u16* Qw = Qb + (size_t)(wid * 32 + r32) * DK + hi * 8;
#pragma unroll
  for (int d0 = 0; d0 < NQK; ++d0) qr[d0] = *(const bf16x8*)(Qw + d0 * 16);
  const int srow = tid >> 3, sc8 = tid & 7;
  const int kst0 = KSWZ(srow, sc8 * 16), kst1 = KSWZ(srow, 128 + sc8 * 16), vst = v_st2(srow, sc8 * 8);
  const int vb0 = (int)(uintptr_t)V_lds + v_rd_base(lane);
  const bool k1on = (NQK == 6) && (sc8 < 4);
  const unsigned koff0 = srow * DK + sc8 * 8, voff0 = srow * 64 + sc8 * 8;
  struct { bf16x8 k0, k1, v0; } st[2];
#define TROW(j) (MODE == 0 ? (j) * 64 : ((j) < 4 ? (j) * 64 : q0 + 128 + ((j) - 4) * 64))
#define SLOAD(i, kr) do { const u16* kp_ = Kh + (unsigned)((kr) * DK); st[i].k0 = *(const bf16x8*)(kp_ + koff0);   \
    if (k1on) st[i].k1 = *(const bf16x8*)(kp_ + koff0 + 64);                                                           \
    const u16* vp_ = Vh + (unsigned)((kr) * 64); st[i].v0 = *(const bf16x8*)(vp_ + voff0); } while (0)
#define SWRITE(b, i) do { *(bf16x8*)(K_lds + (b) * SHM_K + kst0) = st[i].k0; if (k1on) *(bf16x8*)(K_lds + (b) * SHM_K + kst1) = st[i].k1; \
    *(bf16x8*)(V_lds + (b) * SHM_V + vst) = st[i].v0; } while (0)
#define MASKT(P0, P1, j) do { if (MODE == 1 && (j) >= 4) { const int kb_ = q0 - 128 + ((j) - 4) * 64, qp_ = q0 + wid * 32 + r32;    \
    _Pragma("unroll") for (int r = 0; r < 16; ++r) { int k0_ = kb_ + crow(r, hi), k1_ = k0_ + 32; int d0_ = qp_ - k0_, d1_ = qp_ - k1_; \
      bool ok0 = (d0_ <= 128) && (d0_ >= -128) && (k0_ >= 0) && (k0_ < SEQ); bool ok1 = (d1_ <= 128) && (d1_ >= -128) && (k1_ >= 0) && (k1_ < SEQ); \
      P0[r] = ok0 ? P0[r] : -1e30f; P1[r] = ok1 ? P1[r] : -1e30f; } } } while (0)
  f32x16 pA0, pA1, pB0, pB1; bf16x8 pa0, pa1, pa2, pa3;
#define NXS(x) ((x) + 1 == 5 ? 0 : (x) + 1)
  __syncthreads();
  SLOAD(0, TROW(0)); asm volatile("s_waitcnt vmcnt(0)" ::: "memory"); SWRITE(0, 0);
  SLOAD(0, TROW(1)); SWRITE(1, 0);
  SLOAD(0, TROW(2)); SWRITE(2, 0);
  if (3 < NT) SLOAD(0, TROW(3));
  if (4 < NT) SLOAD(1, TROW(4));
  __syncthreads();
  qkt<NQK>(pA0, pA1, K_lds, qr, r32, hi, shift); MASKT(pA0, pA1, 0); expall(pA0, pA1);
  int c = 0;
  for (int j = 1; j + 1 < NT; j += 2) {
    const int sj = NXS(c), sj1 = NXS(sj), sj2 = NXS(sj1), sj3 = NXS(sj2);
    SBAR(); SWRITE(sj2, 0); if (j + 3 < NT) SWRITE(sj3, 1); SBAR();
    qkt_fin<NQK>(pB0, pB1, K_lds + sj * SHM_K, qr, r32, hi, shift, pA0, pA1, lsum, pa0, pa1, pa2, pa3); MASKT(pB0, pB1, j); SBAR();
    if (j + 4 < NT) SLOAD(0, TROW(j + 4)); SBAR();
    pv_exp(o, vb0 + c * SHM_V, pa0, pa1, pa2, pa3, pB0, pB1);
    SBAR();
    qkt_fin<NQK>(pA0, pA1, K_lds + sj1 * SHM_K, qr, r32, hi, shift, pB0, pB1, lsum, pa0, pa1, pa2, pa3); MASKT(pA0, pA1, j + 1); SBAR();
    if (j + 5 < NT) SLOAD(1, TROW(j + 5)); SBAR();
    pv_exp(o, vb0 + sj * SHM_V, pa0, pa1, pa2, pa3, pA0, pA1);
    __syncthreads();
    c = sj1;
  }
  { const int sl = NXS(c);
    SBAR(); qkt_fin<NQK>(pB0, pB1, K_lds + sl * SHM_K, qr, r32, hi, shift, pA0, pA1, lsum, pa0, pa1, pa2, pa3); MASKT(pB0, pB1, NT - 1); SBAR();
    pv_all(o, vb0 + c * SHM_V, pa0, pa1, pa2, pa3); expall(pB0, pB1);
    finishSM(pB0, pB1, lsum, pa0, pa1, pa2, pa3); SBAR();
    pv_all(o, vb0 + sl * SHM_V, pa0, pa1, pa2, pa3); }
#undef NXS
  float l_reg;
  { auto rr = __builtin_amdgcn_permlane32_swap(__float_as_uint(lsum), __float_as_uint(lsum), false, false);
    l_reg = __uint_as_float(rr[0]) + __uint_as_float(rr[1]); }
  if (MODE == 1) l_reg += __builtin_amdgcn_exp2f(sink2 - shift);
  if (hi == 0) li_l[r32] = l_reg; asm volatile("s_waitcnt lgkmcnt(0)" ::: "memory");
  float rli[16];
#pragma unroll
  for (int r = 0; r < 16; ++r) rli[r] = __builtin_amdgcn_rcpf(li_l[crow(r, hi)]);
#pragma unroll
  for (int r = 0; r < 16; ++r) { const int orow = wid * 32 + crow(r, hi);
#pragma unroll
    for (int d0 = 0; d0 < 2; ++d0) {
      const float g = bf2f(gate0[(size_t)orow * LDG + d0 * 32 + r32]);
      mix0[(size_t)orow * 1024 + d0 * 32 + r32] = f2bf(o[d0][r] * rli[r] * silu_f(g));
    } }
#undef TROW
#undef SLOAD
#undef SWRITE
#undef MASKT
}

template <int NQK, int LDG, int RING>
__device__ __forceinline__ void attn_body2(const u16* __restrict__ Qb, const u16* __restrict__ Kh, const u16* __restrict__ Vh,
                                           const int NT, const float mbound, u16* __restrict__ mix0, const u16* __restrict__ gate0, char* lds) {
  constexpr int DK = NQK * 16;
  constexpr int SHM_V = 8192, SHM_K = 17408;
  int tid_ = threadIdx.x; asm volatile("" : "+v"(tid_));
  const int tid = tid_, wid = __builtin_amdgcn_readfirstlane(tid >> 6), lane = tid & 63, r32 = lane & 31, hi = lane >> 5;
  char* V_lds = lds; char* K_lds = lds + 5 * SHM_V;
  float* wsf = (float*)(lds + 5 * SHM_V + 5 * SHM_K) + wid * 64;
  float lsA = 0, lsB = 0; f32x16 oA[2] = {}, oB[2] = {}; bf16x8 qA[NQK], qB[NQK];
  const float shift = mbound > 80.f ? mbound - 80.f : 0.f;
  const u16* Qw = Qb + (size_t)(wid * 64 + r32) * DK + hi * 8;
#pragma unroll
  for (int d0 = 0; d0 < NQK; ++d0) { qA[d0] = *(const bf16x8*)(Qw + d0 * 16); qB[d0] = *(const bf16x8*)(Qw + 32 * DK + d0 * 16); }
  const int srow = tid >> 3, sc8 = tid & 7;
  const int kst0 = KSWZ(srow, sc8 * 16), kst1 = KSWZ(srow, 128 + sc8 * 16), vst = v_st2(srow, sc8 * 8);
  const int vb0 = (int)(uintptr_t)V_lds + v_rd_base(lane);
  const bool k1on = (NQK == 6) && (sc8 < 4);
  const unsigned koff0 = srow * DK + sc8 * 8, voff0 = srow * 64 + sc8 * 8;
  struct { bf16x8 k0, k1, v0; } st[RING == 1 ? 2 : 1];
#define SLOAD(i, kr) do { const u16* kp_ = Kh + (unsigned)((kr) * DK); st[i].k0 = *(const bf16x8*)(kp_ + koff0);   \
    if (k1on) st[i].k1 = *(const bf16x8*)(kp_ + koff0 + 64);                                                           \
    const u16* vp_ = Vh + (unsigned)((kr) * 64); st[i].v0 = *(const bf16x8*)(vp_ + voff0); } while (0)
#define SWRITE(b, i) do { *(bf16x8*)(K_lds + (b) * SHM_K + kst0) = st[i].k0; if (k1on) *(bf16x8*)(K_lds + (b) * SHM_K + kst1) = st[i].k1; \
    *(bf16x8*)(V_lds + (b) * SHM_V + vst) = st[i].v0; } while (0)
#define NXS(x) ((x) + 1 == 5 ? 0 : (x) + 1)
#define UNIT(PN0, PN1, QN, KS, PO0, PO1, LSO, OO, VS) do {                                                                      \
    qkt_fin<NQK>(PN0, PN1, K_lds + (KS) * SHM_K, QN, r32, hi, shift, PO0, PO1, LSO, pa0, pa1, pa2, pa3); SBAR();               \
    pv_exp(OO, vb0 + (VS) * SHM_V, pa0, pa1, pa2, pa3, PN0, PN1); SBAR(); } while (0)
  f32x16 pA0, pA1, pB0, pB1; bf16x8 pa0, pa1, pa2, pa3;
  if constexpr (RING == 1) {
  __syncthreads();
  SLOAD(0, 0); asm volatile("s_waitcnt vmcnt(0)" ::: "memory"); SWRITE(0, 0);
  SLOAD(0, 64); SWRITE(1, 0);
  SLOAD(0, 128); SWRITE(2, 0);
  if (3 < NT) SLOAD(0, 3 * 64);
  if (4 < NT) SLOAD(1, 4 * 64);
  __syncthreads();
  qkt<NQK>(pA0, pA1, K_lds, qA, r32, hi, shift); expall(pA0, pA1);
  int c = 0;
  for (int i = 0; 2 * i + 2 < NT; ++i) {
    const int s1 = NXS(c), s2 = NXS(s1), s3 = NXS(s2), s4 = NXS(s3);
    SBAR(); if (2 * i + 3 < NT) SWRITE(s3, 0); if (2 * i + 4 < NT) SWRITE(s4, 1);
    if (2 * i + 5 < NT) SLOAD(0, (2 * i + 5) * 64); if (2 * i + 6 < NT) SLOAD(1, (2 * i + 6) * 64); SBAR();
    UNIT(pB0, pB1, qB, c, pA0, pA1, lsA, oA, c);
    UNIT(pA0, pA1, qA, s1, pB0, pB1, lsB, oB, c);
    UNIT(pB0, pB1, qB, s1, pA0, pA1, lsA, oA, s1);
    UNIT(pA0, pA1, qA, s2, pB0, pB1, lsB, oB, s1);
    __syncthreads();
    c = s2;
  }
  { const int s1 = NXS(c);
    UNIT(pB0, pB1, qB, c, pA0, pA1, lsA, oA, c);
    UNIT(pA0, pA1, qA, s1, pB0, pB1, lsB, oB, c);
    UNIT(pB0, pB1, qB, s1, pA0, pA1, lsA, oA, s1);
    finishSM(pB0, pB1, lsB, pa0, pa1, pa2, pa3); SBAR();
    pv_all(oB, vb0 + s1 * SHM_V, pa0, pa1, pa2, pa3); }
  } else if constexpr (RING == 2) {
    __syncthreads();
    SLOAD(0, 0); asm volatile("s_waitcnt vmcnt(0)" ::: "memory"); SWRITE(0, 0);
    SLOAD(0, 64); SWRITE(1, 0);
    SLOAD(0, 128); SWRITE(2, 0);
    if (3 < NT) SLOAD(0, 3 * 64);
    __syncthreads();
    qkt<NQK>(pA0, pA1, K_lds, qA, r32, hi, shift); expall(pA0, pA1);
    int c = 0;
    for (int i = 0; 2 * i + 2 < NT; ++i) {
      const int s1 = NXS(c), s2 = NXS(s1), s3 = NXS(s2), s4 = NXS(s3);
      SBAR(); if (2 * i + 3 < NT) SWRITE(s3, 0); if (2 * i + 4 < NT) SLOAD(0, (2 * i + 4) * 64); SBAR();
      UNIT(pB0, pB1, qB, c, pA0, pA1, lsA, oA, c);
      UNIT(pA0, pA1, qA, s1, pB0, pB1, lsB, oB, c);
      SBAR(); if (2 * i + 4 < NT) SWRITE(s4, 0); if (2 * i + 5 < NT) SLOAD(0, (2 * i + 5) * 64); SBAR();
      UNIT(pB0, pB1, qB, s1, pA0, pA1, lsA, oA, s1);
      UNIT(pA0, pA1, qA, s2, pB0, pB1, lsB, oB, s1);
      __syncthreads();
      c = s2;
    }
    { const int s1 = NXS(c);
      UNIT(pB0, pB1, qB, c, pA0, pA1, lsA, oA, c);
      UNIT(pA0, pA1, qA, s1, pB0, pB1, lsB, oB, c);
      UNIT(pB0, pB1, qB, s1, pA0, pA1, lsA, oA, s1);
      finishSM(pB0, pB1, lsB, pa0, pa1, pa2, pa3); SBAR();
      pv_all(oB, vb0 + s1 * SHM_V, pa0, pa1, pa2, pa3); }
  } else {
#define NX3(x) ((x) + 1 == 3 ? 0 : (x) + 1)
    __syncthreads();
    SLOAD(0, 0); asm volatile("s_waitcnt vmcnt(0)" ::: "memory"); SWRITE(0, 0);
    SLOAD(0, 64); SWRITE(1, 0);
    if (2 < NT) SLOAD(0, 128);
    __syncthreads();
    qkt<NQK>(pA0, pA1, K_lds, qA, r32, hi, shift); expall(pA0, pA1);
    int c = 0;
    for (int t = 0; t + 1 < NT; ++t) {
      const int s1 = NX3(c), s2 = NX3(s1);
      SBAR(); if (t + 2 < NT) SWRITE(s2, 0);
      if (t + 3 < NT) SLOAD(0, (t + 3) * 64); SBAR();
      UNIT(pB0, pB1, qB, c, pA0, pA1, lsA, oA, c);
      UNIT(pA0, pA1, qA, s1, pB0, pB1, lsB, oB, c);
      __syncthreads();
      c = s1;
    }
    UNIT(pB0, pB1, qB, c, pA0, pA1, lsA, oA, c);
    finishSM(pB0, pB1, lsB, pa0, pa1, pa2, pa3); SBAR();
    pv_all(oB, vb0 + c * SHM_V, pa0, pa1, pa2, pa3);
#undef NX3
  }
#undef UNIT
#undef NXS
#undef SLOAD
#undef SWRITE
  float lA, lB;
  { auto rr = __builtin_amdgcn_permlane32_swap(__float_as_uint(lsA), __float_as_uint(lsA), false, false); lA = __uint_as_float(rr[0]) + __uint_as_float(rr[1]); }
  { auto rr = __builtin_amdgcn_permlane32_swap(__float_as_uint(lsB), __float_as_uint(lsB), false, false); lB = __uint_as_float(rr[0]) + __uint_as_float(rr[1]); }
  if (hi == 0) { wsf[r32] = lA; wsf[32 + r32] = lB; }
  asm volatile("s_waitcnt lgkmcnt(0)" ::: "memory");
#pragma unroll
  for (int g = 0; g < 2; ++g) {
    float rli[16];
#pragma unroll
    for (int r = 0; r < 16; ++r) rli[r] = __builtin_amdgcn_rcpf(wsf[g * 32 + crow(r, hi)]);
#pragma unroll
    for (int r = 0; r < 16; ++r) { const int orow = wid * 64 + g * 32 + crow(r, hi);
#pragma unroll
      for (int d0 = 0; d0 < 2; ++d0) {
        const float gt = bf2f(gate0[(size_t)orow * LDG + d0 * 32 + r32]);
        const float ov = g == 0 ? oA[d0][r] : oB[d0][r];
        mix0[(size_t)orow * 1024 + d0 * 32 + r32] = f2bf(ov * rli[r] * silu_f(gt));
      } }
  }
}

__global__ void __launch_bounds__(512, 1) mega(Params p) {
  extern __shared__ __attribute__((aligned(16))) char lds[];
  cg::grid_group grid = cg::this_grid();
  const int bid = blockIdx.x, nblk = gridDim.x;
  char* ws = p.ws;
  float* modv = (float*)(ws + OFF_MODV);
  u16* H = (u16*)(ws + OFF_H);
  u16* PP = (u16*)(ws + OFF_PP);
  float* XC1 = (float*)(ws + OFF_XC1);
  unsigned* xbar = (unsigned*)(ws + OFF_END);
  if (bid == 0) for (int i = threadIdx.x; i < XCD_BAR_WORDS; i += 512) __hip_atomic_store(xbar + i, 0u, __ATOMIC_RELAXED, __HIP_MEMORY_SCOPE_AGENT);
  volatile LAS unsigned* xst = (volatile LAS unsigned*)(lds + LDS_BYTES - 256);
  if (threadIdx.x == 0) { xst[0] = 0u; xst[1] = 0u; }
  XcdBarrier xb; xb.bar = xbar; xb.x = 0u; xb.st = xst;

  if (p.ph_lo <= 0 && 0 < p.ph_hi) {
  for (int u = bid; u < 192; u += nblk) mod_unit(p, u, lds);
  }
  if (p.ph_lo <= 0 && 0 + 1 < p.ph_hi) { grid.sync(); xb = xcd_barrier_post(xbar, xst); }
  if (p.ph_lo <= 1 && 1 < p.ph_hi) {
  for (int u = bid; u < 2064; u += nblk) transpose_unit(p, u, lds);
  adaln_phase(p.x, nullptr, p.ctx, modv, H);
  }
  if (p.ph_lo <= 1 && 1 + 1 < p.ph_hi) xcd_barrier(xb);
  if (p.ph_lo <= 2 && 2 < p.ph_hi) {
  { TileIter ti(130, 19); GPre g; int nt = 0, mt = 0; const u16* Wt = (const u16*)(ws + OFF_WT_IN_AB);
    if (ti.valid()) { ti.get(mt, nt); gemm_preload(H, 1024, Wt, 1024, mt * 256, nt * 128, g); }
    while (ti.valid()) {
      f32x16 acc[2][2]; const int m0 = mt * 256, n0 = nt * 128;
      gemm_tile<0>(H, 1024, Wt, 1024, 1024, m0, n0, acc, lds, g);
      ti.next(); if (ti.valid()) { ti.get(mt, nt); gemm_preload(H, 1024, Wt, 1024, mt * 256, nt * 128, g); }
      epi_bf16(acc, PP, LD_AB, m0, n0, lds);
    } }
  }
  if (p.ph_lo <= 2 && 2 + 1 < p.ph_hi) xcd_barrier(xb);
  if (p.ph_lo <= 3 && 3 < p.ph_hi) {
  { TileIter ti(130, 14); GPre g; int nt = 0, mt = 0;
    const u16* Wq = (const u16*)(ws + OFF_WT_UQ); const u16* Wkv = (const u16*)(ws + OFF_WT_UKV);
    if (ti.valid()) { ti.get(mt, nt); gemm_preload(nt < 6 ? PP : PP + 256, LD_AB, nt < 6 ? Wq : Wkv, 256, mt * 256, (nt < 6 ? nt : nt - 6) * 128, g); }
    while (ti.valid()) {
      f32x16 acc[2][2]; const int m0 = mt * 256, cn = nt, n0 = (nt < 6 ? nt : nt - 6) * 128;
      gemm_tile<0>(cn < 6 ? PP : PP + 256, LD_AB, cn < 6 ? Wq : Wkv, 256, 256, m0, n0, acc, lds, g);
      ti.next(); if (ti.valid()) { ti.get(mt, nt); gemm_preload(nt < 6 ? PP : PP + 256, LD_AB, nt < 6 ? Wq : Wkv, 256, mt * 256, (nt < 6 ? nt : nt - 6) * 128, g); }
      if (cn < 6) epi_bf16(acc, H, 768, m0, n0, lds); else epi_bf16(acc, (u16*)p.out, 1024, m0, n0, lds);
    } }
  }
  if (p.ph_lo <= 3 && 3 + 1 < p.ph_hi) xcd_barrier(xb);
  if (p.ph_lo <= 4 && 4 < p.ph_hi) {
  finalize0(p);
  }
  if (p.ph_lo <= 4 && 4 + 1 < p.ph_hi) xcd_barrier(xb);
  if (p.ph_lo <= 5 && 5 < p.ph_hi) {
  const float mbA = LOG2E * 9.7979590f * 1.02f * vmaxabs(p.q_gain, 96) * vmaxabs(p.k_gain, 96);
  const float mbB = LOG2E * 8.f * 1.02f * vmaxabs(p.gq_gain, 64) * vmaxabs(p.gk_gain, 64);
  for (int it = bid; it < 1056; it += nblk) {
    if (it < 512) {
      const int round = it >> 8, blk = it & 255, xcd = blk & 7, cl = blk >> 3;
      const int pair = xcd * 2 + round, b = pair >> 3, h = pair & 7, qoff = cl * 512;
      const size_t r0 = (size_t)b * SEQ + qoff;
      attn_body2<6, LD_AB, 2>((const u16*)(ws + OFF_QA) + ((size_t)(b * 8 + h) * SEQ + qoff) * 96,
                                  (const u16*)(ws + OFF_KA) + (size_t)(b * 8 + h) * KVLEN * 96, (const u16*)(ws + OFF_VA) + (size_t)(b * 8 + h) * KVLEN * 64,
                                  KVLEN / 64, mbA, H + r0 * 1024 + h * 64, PP + r0 * LD_AB + 1312 + h * 64, lds);
    } else if (it < 1024) {
      const int i2 = it - 512, g = i2 >> 8, blk = i2 & 255, xcd = blk & 7, cl = blk >> 3;
      const int pi = xcd >> 1, b = pi >> 1, kvh = pi & 1, idx = (xcd & 1) * 64 + g * 32 + cl;
      const int h = kvh * 4 + (idx >> 5), qoff = (idx & 31) * 512;
      const size_t r0 = (size_t)b * SEQ + qoff;
      attn_body2<4, LD_AB, 1>((const u16*)(ws + OFF_QB) + ((size_t)(b * 8 + h) * SEQ + qoff) * 64,
                           (const u16*)(ws + OFF_KB) + (size_t)(b * 2 + kvh) * KVLEN * 64, (const u16*)(ws + OFF_VB) + (size_t)(b * 2 + kvh) * KVLEN * 64,
                           KVLEN / 64, mbB, H + r0 * 1024 + 512 + h * 64, PP + r0 * LD_AB + 1312 + 512 + h * 64, lds);
    } else {
      const int ci = it - 1024, b = (ci >> 3) & 1, h = ci & 7; const bool mla = ci < 16; const int kvh = mla ? h : (h >> 2);
      const size_t r0 = (size_t)NLAT + b * CL, qrow = (size_t)(b * 8 + h) * CL;
      if (mla) attn_body<6, 0, LD_AB>((const u16*)(ws + OFF_QCA) + qrow * 96, (const u16*)(ws + OFF_KA) + (size_t)(b * 8 + kvh) * KVLEN * 96,
                                      (const u16*)(ws + OFF_VA) + (size_t)(b * 8 + kvh) * KVLEN * 64, CL / 64, 0, 0.f, mbA, H + r0 * 1024 + h * 64, PP + r0 * LD_AB + 1312 + h * 64, lds);
      else attn_body<4, 0, LD_AB>((const u16*)(ws + OFF_QCB) + qrow * 64, (const u16*)(ws + OFF_KB) + (size_t)(b * 2 + kvh) * KVLEN * 64,
                                  (const u16*)(ws + OFF_VB) + (size_t)(b * 2 + kvh) * KVLEN * 64, CL / 64, 0, 0.f, mbB, H + r0 * 1024 + 512 + h * 64, PP + r0 * LD_AB + 1312 + 512 + h * 64, lds);
    }
  }
  }
  if (p.ph_lo <= 5 && 5 + 1 < p.ph_hi) xcd_barrier(xb);
  if (p.ph_lo <= 6 && 6 < p.ph_hi) {
  { TileIter ti(130, 8); GPre g; int nt = 0, mt = 0; const u16* Wt = (const u16*)(ws + OFF_WT_OUT_AB);
    if (ti.valid()) { ti.get(mt, nt); gemm_preload(H, 1024, Wt, 1024, mt * 256, nt * 128, g); }
    while (ti.valid()) {
      f32x16 acc[2][2]; const int m0 = mt * 256, n0 = nt * 128; const bool lat = m0 < NLAT;
      const int tid_ = opaque_tid(), wid_ = tid_ >> 6, lane_ = tid_ & 63;
      const size_t eoff = (size_t)((lat ? m0 : m0 - NLAT) + (wid_ & 3) * 64 + (lane_ >> 4)) * 1024 + n0 + (wid_ >> 2) * 64 + 4 * (lane_ & 15);
      ResPre rp;
      gemm_tile<1>(H, 1024, Wt, 1024, 1024, m0, n0, acc, lds, g, (lat ? p.x : p.ctx) + eoff, &rp);
      ti.next(); if (ti.valid()) { ti.get(mt, nt); gemm_preload(H, 1024, Wt, 1024, mt * 256, nt * 128, g); }
      if (lat) epi_res<false, true>(acc, rp, (u16*)(ws + OFF_X1B) + eoff, modv + (m0 >> 14) * 3072 + 2048, n0, lds);
      else epi_res<false, false>(acc, rp, XC1 + eoff, modv + 2 * 3072 + 2048, n0, lds);
    } }
  }
  if (p.ph_lo <= 6 && 6 + 1 < p.ph_hi) xcd_barrier(xb);
  if (p.ph_lo <= 7 && 7 < p.ph_hi) {
  adaln_phase(nullptr, (const u16*)(ws + OFF_X1B), XC1, modv + 3 * 3072, H);
  }
  if (p.ph_lo <= 7 && 7 + 1 < p.ph_hi) xcd_barrier(xb);
  if (p.ph_lo <= 8 && 8 < p.ph_hi) {
  { TileIter ti(130, 26); GPre g; int nt = 0, mt = 0; const u16* Wt = (const u16*)(ws + OFF_WT_IN_CD);
    if (ti.valid()) { ti.get(mt, nt); gemm_preload(H, 1024, Wt, 1024, mt * 256, nt * 128, g); }
    while (ti.valid()) {
      f32x16 acc[2][2]; const int m0 = mt * 256, n0 = nt * 128;
      gemm_tile<0>(H, 1024, Wt, 1024, 1024, m0, n0, acc, lds, g);
      ti.next(); if (ti.valid()) { ti.get(mt, nt); gemm_preload(H, 1024, Wt, 1024, mt * 256, nt * 128, g); }
      epi_bf16(acc, PP, LD_CD, m0, n0, lds);
    } }
  }
  if (p.ph_lo <= 8 && 8 + 1 < p.ph_hi) xcd_barrier(xb);
  if (p.ph_lo <= 9 && 9 < p.ph_hi) {
  finalize1(p);
  }
  if (p.ph_lo <= 9 && 9 + 1 < p.ph_hi) xcd_barrier(xb);
  if (p.ph_lo <= 10 && 10 < p.ph_hi) {
  const float mbW = LOG2E * 8.f * 1.02f * vmaxabs(p.win_q_gain, 64) * vmaxabs(p.win_k_gain, 64);
  for (int it = bid; it < 1024; it += nblk) {
    const int g = it >> 8, blk = it & 255, xcd = blk & 7, cl = blk >> 3;
    const int pi = xcd >> 1, b = pi >> 1, kvh = pi & 1, idx = (xcd & 1) * 128 + g * 32 + cl;
    const int h = kvh * 4 + (idx >> 6), qblk = idx & 63;
    const size_t r0 = (size_t)b * SEQ + qblk * 256;
    attn_body<4, 1, LD_CD>((const u16*)(ws + OFF_Q2) + ((size_t)(b * 8 + h) * SEQ + qblk * 256) * 64,
                    (const u16*)(ws + OFF_K2) + (size_t)(b * 2 + kvh) * KV2LEN * 64, (const u16*)(ws + OFF_V2) + (size_t)(b * 2 + kvh) * KV2LEN * 64,
                    12, qblk * 256, p.win_sink[h] * LOG2E, mbW, H + r0 * 1024 + h * 64, PP + r0 * LD_CD + 2304 + h * 64, lds);
  }
  }
  if (p.ph_lo <= 10 && 10 + 1 < p.ph_hi) xcd_barrier(xb);
  if (p.ph_lo <= 11 && 11 < p.ph_hi) {
  { TileIter ti(128, 8); GPre g; int nt = 0, mt = 0; const u16* Wt = (const u16*)(ws + OFF_WT_OUT_CD);
    if (ti.valid()) { ti.get(mt, nt); gemm_preload(H, 1024, Wt, 1024, mt * 256, nt * 128, g); }
    while (ti.valid()) {
      f32x16 acc[2][2]; const int m0 = mt * 256, n0 = nt * 128;
      const int tid_ = opaque_tid(), wid_ = tid_ >> 6, lane_ = tid_ & 63;
      const size_t eoff = (size_t)(m0 + (wid_ & 3) * 64 + (lane_ >> 4)) * 1024 + n0 + (wid_ >> 2) * 64 + 4 * (lane_ & 15);
      ResPre rp;
      gemm_tile<2>(H, 1024, Wt, 1024, 1024, m0, n0, acc, lds, g, (const u16*)(ws + OFF_X1B) + eoff, &rp);
      ti.next(); if (ti.valid()) { ti.get(mt, nt); gemm_preload(H, 1024, Wt, 1024, mt * 256, nt * 128, g); }
      epi_res<true, false>(acc, rp, p.out + eoff, modv + 3 * 3072 + (m0 >> 14) * 3072 + 2048, n0, lds);
    } }
  }
}

extern "C" void kernel_launch(void* const* d_in, const int* in_sizes, int n_in, void* d_out, int out_size, void* d_ws, size_t ws_size, hipStream_t stream) {
  static int grid_blocks = 0;
  if (!grid_blocks) {
    if (n_in != 22 || out_size != NLAT * DM || ws_size < OFF_END + 16384) {
      fprintf(stderr, "kernel_launch: shape/ws mismatch n_in %d out %d ws %zu need %zu\n", n_in, out_size, ws_size, (size_t)OFF_END);
      return;
    }
    if (hipFuncSetAttribute((const void*)mega, hipFuncAttributeMaxDynamicSharedMemorySize, LDS_BYTES) != hipSuccess) {
      fprintf(stderr, "kernel_launch: hipFuncSetAttribute failed\n"); return;
    }
    int dev = 0, cus = 0, per_cu = 0;
    (void)hipGetDevice(&dev);
    (void)hipDeviceGetAttribute(&cus, hipDeviceAttributeMultiprocessorCount, dev);
    (void)hipOccupancyMaxActiveBlocksPerMultiprocessor(&per_cu, mega, 512, LDS_BYTES);
    if (per_cu < 1) { fprintf(stderr, "kernel_launch: occupancy 0\n"); return; }
    grid_blocks = cus;
  }
  Params p{};
  p.x = (const float*)d_in[0]; p.c = (const float*)d_in[1]; p.ctx = (const float*)d_in[2]; p.c_ctx = (const float*)d_in[3];
  p.mod_w = (const float*)d_in[4]; p.mod_b = (const float*)d_in[5]; p.ab_w_in = (const float*)d_in[6]; p.ab_w_out = (const float*)d_in[7];
  p.cq_gain = (const float*)d_in[8]; p.ckv_gain = (const float*)d_in[9]; p.w_uq = (const float*)d_in[10]; p.w_ukv = (const float*)d_in[11];
  p.q_gain = (const float*)d_in[12]; p.k_gain = (const float*)d_in[13]; p.gq_gain = (const float*)d_in[14]; p.gk_gain = (const float*)d_in[15];
  p.cd_w_in = (const float*)d_in[16]; p.cd_w_out = (const float*)d_in[17]; p.win_q_gain = (const float*)d_in[18]; p.win_k_gain = (const float*)d_in[19];
  p.win_sink = (const float*)d_in[20]; p.conv_w = (const float*)d_in[21];
  p.out = (float*)d_out; p.ws = (char*)d_ws;
#if MULTI_LAUNCH
  for (int ph = 0; ph < 12; ++ph) {
    p.ph_lo = ph; p.ph_hi = ph + 1;
    hipLaunchKernelGGL(mega, dim3(grid_blocks), dim3(512), LDS_BYTES, stream, p);
  }
#else
  p.ph_lo = 0; p.ph_hi = 12;
  void* args[] = {&p};
  hipError_t e = hipLaunchCooperativeKernel((void*)mega, dim3(grid_blocks), dim3(512), args, LDS_BYTES, stream);
  if (e != hipSuccess) fprintf(stderr, "cooperative launch failed: %s (grid %d)\n", hipGetErrorString(e), grid_blocks);
#endif
}
```

```cpp
#include <hip/hip_runtime.h>
#include <hip/hip_cooperative_groups.h>
#include <cstdio>
#include <cstdint>
namespace cg = cooperative_groups;

typedef unsigned short u16;
using bf16x8 = __attribute__((ext_vector_type(8))) short;
using s16x4  = __attribute__((ext_vector_type(4))) short;
using f32x16 = __attribute__((ext_vector_type(16))) float;
using u32x4  = __attribute__((ext_vector_type(4))) unsigned;
using u32x2  = __attribute__((ext_vector_type(2))) unsigned;

constexpr int NB = 2, SEQ = 16384, DM = 1024, CL = 256;
constexpr int NLAT = NB * SEQ;
constexpr int NROW = NLAT + NB * CL;
constexpr int KVLEN = CL + SEQ;
constexpr int KV2LEN = KVLEN + 128;
constexpr int LD_AB = 2432, LD_CD = 3328;
constexpr float EPS = 1e-6f;
constexpr float QS_A = 0.14724461f;
constexpr float QS_B = 0.18033688f;
constexpr float LOG2E = 1.4426950408889634f;

constexpr size_t OFF_MODV      = 0;
constexpr size_t OFF_WT_IN_AB  = 73728;
constexpr size_t OFF_WT_OUT_AB = OFF_WT_IN_AB + (size_t)LD_AB * 1024 * 2;
constexpr size_t OFF_WT_UQ     = OFF_WT_OUT_AB + (size_t)1024 * 1024 * 2;
constexpr size_t OFF_WT_UKV    = OFF_WT_UQ + (size_t)768 * 256 * 2;
constexpr size_t OFF_WT_IN_CD  = OFF_WT_UKV + (size_t)1024 * 256 * 2;
constexpr size_t OFF_WT_OUT_CD = OFF_WT_IN_CD + (size_t)3328 * 1024 * 2;
constexpr size_t OFF_XC1       = OFF_WT_OUT_CD + (size_t)1024 * 1024 * 2;
constexpr size_t OFF_H         = OFF_XC1 + (size_t)512 * 1024 * 4;
constexpr size_t OFF_PP        = OFF_H + (size_t)NROW * 1024 * 2;
constexpr size_t OFF_QA        = OFF_PP + (size_t)NROW * 3328 * 2;
constexpr size_t OFF_QCA       = OFF_QA + (size_t)NB * 8 * SEQ * 96 * 2;
constexpr size_t OFF_KA        = OFF_QCA + (size_t)NB * 8 * CL * 96 * 2;
constexpr size_t OFF_VA        = OFF_KA + (size_t)NB * 8 * KVLEN * 96 * 2;
constexpr size_t OFF_QB        = OFF_VA + (size_t)NB * 8 * KVLEN * 64 * 2;
constexpr size_t OFF_QCB       = OFF_QB + (size_t)NB * 8 * SEQ * 64 * 2;
constexpr size_t OFF_KB        = OFF_QCB + (size_t)NB * 8 * CL * 64 * 2;
constexpr size_t OFF_VB        = OFF_KB + (size_t)NB * 2 * KVLEN * 64 * 2;
constexpr size_t OFF_END       = OFF_VB + (size_t)NB * 2 * KVLEN * 64 * 2;
constexpr size_t OFF_Q2        = OFF_QA;
constexpr size_t OFF_K2        = OFF_Q2 + (size_t)NB * 8 * SEQ * 64 * 2;
constexpr size_t OFF_V2        = OFF_K2 + (size_t)NB * 2 * KV2LEN * 64 * 2;
constexpr size_t OFF_X1B       = OFF_QA + ((size_t)64 << 20);
static_assert(OFF_V2 + (size_t)NB * 2 * KV2LEN * 64 * 2 <= OFF_X1B && OFF_X1B + (size_t)NLAT * 1024 * 2 <= OFF_END, "x1 alias");
static_assert(OFF_V2 + (size_t)NB * 2 * KV2LEN * 64 * 2 <= OFF_END, "alias overflow");

constexpr int LDS_BYTES = 147456 + 256;
#ifndef MULTI_LAUNCH
#define MULTI_LAUNCH 0
#endif

struct Params {
  const float *x, *c, *ctx, *c_ctx, *mod_w, *mod_b, *ab_w_in, *ab_w_out, *cq_gain, *ckv_gain, *w_uq, *w_ukv,
      *q_gain, *k_gain, *gq_gain, *gk_gain, *cd_w_in, *cd_w_out, *win_q_gain, *win_k_gain, *win_sink, *conv_w;
  float* out;
  char* ws;
  int ph_lo, ph_hi;
};

#define SBAR() __builtin_amdgcn_sched_barrier(0)
__device__ __forceinline__ int crow(int r, int hi) { return (r & 3) + 8 * (r >> 2) + 4 * hi; }
typedef float f32x2_t __attribute__((ext_vector_type(2)));
typedef __bf16 bf16x2_t __attribute__((ext_vector_type(2)));
__device__ __forceinline__ unsigned cvtpk(float lo, float hi) { f32x2_t v = {lo, hi}; bf16x2_t b = __builtin_convertvector(v, bf16x2_t); return __builtin_bit_cast(unsigned, b); }
__device__ __forceinline__ u16 f2bf(float x) { return (u16)(cvtpk(x, 0.f) & 0xffffu); }
__device__ __forceinline__ float bf2f(u16 x) { return __uint_as_float(((unsigned)x) << 16); }
__device__ __forceinline__ float bflo(unsigned w) { return __uint_as_float(w << 16); }
__device__ __forceinline__ float bfhi(unsigned w) { return __uint_as_float(w & 0xffff0000u); }
__device__ __forceinline__ float wave_sum(float v) {
#pragma unroll
  for (int o = 32; o >= 1; o >>= 1) v += __shfl_xor(v, o);
  return v;
}
__device__ __forceinline__ int opaque_tid() { int t = threadIdx.x; asm volatile("" : "+v"(t)); return t; }
__device__ __forceinline__ float vmaxabs(const float* g, int n) { float m = 0.f; for (int i = 0; i < n; ++i) m = fmaxf(m, fabsf(g[i])); return m; }
__device__ __forceinline__ float silu_f(float g) { return g / (1.f + __expf(-g)); }


__device__ __forceinline__ void gbar(unsigned* cnt, unsigned target) {
  asm volatile("s_waitcnt vmcnt(0)" ::: "memory");
  __syncthreads();
  if (threadIdx.x == 0) {
    __builtin_amdgcn_fence(__ATOMIC_RELEASE, "agent");
    asm volatile("s_waitcnt vmcnt(0)" ::: "memory");
    __hip_atomic_fetch_add(cnt, 1u, __ATOMIC_RELAXED, __HIP_MEMORY_SCOPE_AGENT);
    unsigned sp = 0;
    while (__hip_atomic_load(cnt, __ATOMIC_RELAXED, __HIP_MEMORY_SCOPE_AGENT) < target) { __builtin_amdgcn_s_sleep(1); if (++sp > (1u << 24)) break; }
    __builtin_amdgcn_fence(__ATOMIC_ACQUIRE, "agent");
    asm volatile("s_waitcnt vmcnt(0)" ::: "memory");
  }
  __syncthreads();
}


#define XB_TMO      128
#define XB_XCNT(j)  (256  + 64 * (j))
#define XB_XSUB(j)  (1280 + 64 * (j))
#define XB_XGEN(j)  (2304 + 64 * (j))
#define XB_TOP      3328
#define XB_TOPGEN   3392
#define XCD_BAR_WORDS 3456
#define XB_SPIN_CAP (1u << 20)
#define LAS __attribute__((address_space(3)))
__device__ __forceinline__ unsigned xb_ld(unsigned* p)              { return __hip_atomic_load(p, __ATOMIC_RELAXED, __HIP_MEMORY_SCOPE_AGENT); }
__device__ __forceinline__ unsigned xb_add(unsigned* p, unsigned v) { return __hip_atomic_fetch_add(p, v, __ATOMIC_RELAXED, __HIP_MEMORY_SCOPE_AGENT); }
__device__ __forceinline__ unsigned xb_xcc_id() { return (unsigned)__builtin_amdgcn_s_getreg((3 << 11) | 20) & 0xFu; }
#define XB_SPIN(cond, bar) do { unsigned _sp = 0; while (cond) { __builtin_amdgcn_s_sleep(1); \
    if ((++_sp & 255u) == 0u) { if (xb_ld(&(bar)[XB_TMO])) break; if (_sp > XB_SPIN_CAP) { atomicAdd(&(bar)[XB_TMO], 1u); break; } } } } while (0)
struct XcdBarrier { unsigned* bar; unsigned x; volatile LAS unsigned* st; };
__device__ __forceinline__ XcdBarrier xcd_barrier_post(unsigned* bar, volatile LAS unsigned* st) {
  XcdBarrier b; b.bar = bar; b.x = xb_xcc_id(); b.st = st;
  if (threadIdx.x == 0) (void)xb_add(&bar[XB_XCNT(b.x)], 1u);
  return b;
}
__device__ __forceinline__ void xcd_barrier_complete(unsigned* bar, unsigned x, unsigned& nloc, unsigned& nx) {
  const unsigned G = gridDim.x * gridDim.y * gridDim.z;
  unsigned sum, cnt, mine, sp = 0u;
  for (;;) {
    sum = 0u; cnt = 0u; mine = 0u;
#pragma unroll
    for (unsigned j = 0; j < 16; ++j) { const unsigned c = xb_ld(&bar[XB_XCNT(j)]); sum += c; cnt += (c > 0u) ? 1u : 0u; mine = (j == x) ? c : mine; }
    if (sum == G) break;
    __builtin_amdgcn_s_sleep(1);
    if ((++sp & 255u) == 0u) { if (xb_ld(&bar[XB_TMO])) break; if (sp > XB_SPIN_CAP) { atomicAdd(&bar[XB_TMO], 1u); break; } }
  }
  nloc = mine > 0u ? mine : 1u; nx = cnt > 0u ? cnt : 1u;
}
__device__ __forceinline__ void xcd_barrier(const XcdBarrier& b) {
  asm volatile("s_waitcnt vmcnt(0)" ::: "memory");
  __syncthreads();
  if (threadIdx.x == 0) {
    unsigned* bar = b.bar;
    __builtin_amdgcn_s_waitcnt(0);
    unsigned nloc = b.st[0], nx = b.st[1];
    if (nloc == 0u) { xcd_barrier_complete(bar, b.x, nloc, nx); b.st[0] = nloc; b.st[1] = nx; }
    const unsigned old = xb_add(&bar[XB_XSUB(b.x)], 1u);
    const unsigned gen = old / nloc;
    if (old + 1u == (gen + 1u) * nloc) {
      __builtin_amdgcn_fence(__ATOMIC_RELEASE, "agent");
      asm volatile("s_waitcnt vmcnt(0)" ::: "memory");
      const unsigned og = xb_add(&bar[XB_TOP], 1u);
      const unsigned tg = og / nx;
      if (og + 1u == (tg + 1u) * nx) xb_add(&bar[XB_TOPGEN], 1u);
      else XB_SPIN(xb_ld(&bar[XB_TOPGEN]) == tg, bar);
      __builtin_amdgcn_fence(__ATOMIC_ACQUIRE, "agent");
      xb_add(&bar[XB_XGEN(b.x)], 1u);
      asm volatile("s_waitcnt vmcnt(0)" ::: "memory");
    } else {
      XB_SPIN(xb_ld(&bar[XB_XGEN(b.x)]) == gen, bar);
      __builtin_amdgcn_fence(__ATOMIC_ACQUIRE, "agent");
      asm volatile("s_waitcnt vmcnt(0)" ::: "memory");
    }
  }
  __syncthreads();
}

__device__ void mod_unit(const Params& p, int u, char* lds) {
  const int tid = opaque_tid();
  const int layer = u / 96, n0 = (u % 96) * 32, col = tid & 31, ks = tid >> 5;
  const float* W = p.mod_w + (size_t)layer * 1024 * 3072 + n0 + col;
  float a0 = 0, a1 = 0, a2 = 0;
  for (int k = ks * 64; k < ks * 64 + 64; ++k) {
    float w = W[(size_t)k * 3072];
    a0 += silu_f(p.c[k]) * w; a1 += silu_f(p.c[1024 + k]) * w; a2 += silu_f(p.c_ctx[k]) * w;
  }
  float* red = (float*)lds;
  red[(0 * 16 + ks) * 32 + col] = a0; red[(1 * 16 + ks) * 32 + col] = a1; red[(2 * 16 + ks) * 32 + col] = a2;
  __syncthreads();
  if (tid < 96) {
    int w = tid >> 5, cc = tid & 31; float s = 0;
    for (int i = 0; i < 16; ++i) s += red[(w * 16 + i) * 32 + cc];
    float* modv = (float*)(p.ws + OFF_MODV);
    modv[(layer * 3 + w) * 3072 + n0 + cc] = s + p.mod_b[layer * 3072 + n0 + cc];
  }
  __syncthreads();
}

__device__ void transpose_unit(const Params& p, int u, char* lds) {
  const float* src; const float* gain = nullptr; int K, N; u16* dst; int ul;
  if (u < 608)       { ul = u;        src = p.ab_w_in;  K = 1024; N = 2336; dst = (u16*)(p.ws + OFF_WT_IN_AB); }
  else if (u < 864)  { ul = u - 608;  src = p.ab_w_out; K = 1024; N = 1024; dst = (u16*)(p.ws + OFF_WT_OUT_AB); }
  else if (u < 912)  { ul = u - 864;  src = p.w_uq;     K = 256;  N = 768;  dst = (u16*)(p.ws + OFF_WT_UQ); gain = p.cq_gain; }
  else if (u < 976)  { ul = u - 912;  src = p.w_ukv;    K = 256;  N = 1024; dst = (u16*)(p.ws + OFF_WT_UKV); gain = p.ckv_gain; }
  else if (u < 1808) { ul = u - 976;  src = p.cd_w_in;  K = 1024; N = 3328; dst = (u16*)(p.ws + OFF_WT_IN_CD); }
  else               { ul = u - 1808; src = p.cd_w_out; K = 1024; N = 1024; dst = (u16*)(p.ws + OFF_WT_OUT_CD); }
  const int nkt = K / 64, kt = ul % nkt, nt = ul / nkt, k0 = kt * 64, n0 = nt * 64, tid = opaque_tid();
  float* tile = (float*)lds;
#pragma unroll
  for (int e = 0; e < 8; ++e) {
    int i = (tid >> 6) + 8 * e, j = tid & 63, n = n0 + j;
    float v = (n < N) ? src[(size_t)(k0 + i) * N + n] : 0.f;
    if (gain) v *= gain[k0 + i];
    tile[i * 65 + j] = v;
  }
  __syncthreads();
#pragma unroll
  for (int e = 0; e < 8; ++e) {
    int i2 = (tid >> 6) + 8 * e, j2 = tid & 63;
    dst[(size_t)(n0 + i2) * K + k0 + j2] = f2bf(tile[j2 * 65 + i2]);
  }
  __syncthreads();
}

template <bool BF>
__device__ __forceinline__ void adaln_latent(const void* __restrict__ xsrc, const float* __restrict__ modl, u16* __restrict__ H, int gw, int nw, int lane) {
  constexpr int NV = BF ? 2 : 4;
  constexpr int CW = BF ? 8 : 4;
  u32x4 cur[NV], nxt[NV];
  float sh[NV][CW], sc[NV][CW];
  auto ld = [&](u32x4 (&d)[NV], int r) {
#pragma unroll
    for (int i = 0; i < NV; ++i)
      d[i] = BF ? *(const u32x4*)((const u16*)xsrc + (size_t)r * 1024 + 8 * (lane + 64 * i)) : *(const u32x4*)((const float*)xsrc + (size_t)r * 1024 + 4 * (lane + 64 * i));
  };
  int r = gw; if (r < NLAT) ld(cur, r);
  int lastb = -1;
  for (; r < NLAT; r += nw) {
    const int rn = r + nw;
    if (rn < NLAT) ld(nxt, rn);
    const int b = r >> 14;
    if (b != lastb) { lastb = b; const float* m = modl + b * 3072;
#pragma unroll
      for (int i = 0; i < NV; ++i)
#pragma unroll
        for (int e = 0; e < CW; ++e) { sh[i][e] = m[CW * (lane + 64 * i) + e]; sc[i][e] = 1.f + m[1024 + CW * (lane + 64 * i) + e]; } }
    float f[NV][CW]; float ss = 0;
#pragma unroll
    for (int i = 0; i < NV; ++i)
#pragma unroll
      for (int e = 0; e < CW; ++e) {
        f[i][e] = BF ? ((e & 1) ? bfhi(cur[i][e >> 1]) : bflo(cur[i][e >> 1])) : __uint_as_float(cur[i][e]);
        ss += f[i][e] * f[i][e]; }
    ss = wave_sum(ss);
    const float rstd = rsqrtf(ss * (1.f / 1024) + EPS);
#pragma unroll
    for (int i = 0; i < NV; ++i) {
      float y[CW];
#pragma unroll
      for (int e = 0; e < CW; ++e) y[e] = f[i][e] * rstd * sc[i][e] + sh[i][e];
      if (BF) { const u32x4 o = {cvtpk(y[0], y[1]), cvtpk(y[2], y[3]), cvtpk(y[4 % CW], y[5 % CW]), cvtpk(y[6 % CW], y[7 % CW])}; *(u32x4*)(H + (size_t)r * 1024 + 8 * (lane + 64 * i)) = o; }
      else { const u32x2 o = {cvtpk(y[0], y[1]), cvtpk(y[2], y[3])}; *(u32x2*)(H + (size_t)r * 1024 + 4 * (lane + 64 * i)) = o; }
    }
#pragma unroll
    for (int i = 0; i < NV; ++i) cur[i] = nxt[i];
  }
}
__device__ void adaln_phase(const float* xlat, const u16* xlat_bf, const float* xctx, const float* modl, u16* H) {
  const int tid = opaque_tid(), lane = tid & 63, gw = blockIdx.x * 8 + (tid >> 6), nw = gridDim.x * 8;
  if (xlat_bf != nullptr) adaln_latent<true>(xlat_bf, modl, H, gw, nw, lane); else adaln_latent<false>(xlat, modl, H, gw, nw, lane);
  for (int r = NLAT + gw; r < NROW; r += nw) {
    const float* src = xctx + (size_t)(r - NLAT) * 1024;
    const float* m = modl + 2 * 3072;
    float4 v[4]; float ss = 0;
#pragma unroll
    for (int i = 0; i < 4; ++i) { v[i] = ((const float4*)src)[lane + 64 * i]; ss += v[i].x * v[i].x + v[i].y * v[i].y + v[i].z * v[i].z + v[i].w * v[i].w; }
    ss = wave_sum(ss);
    const float rstd = rsqrtf(ss * (1.f / 1024) + EPS);
#pragma unroll
    for (int i = 0; i < 4; ++i) {
      int c = 4 * (lane + 64 * i);
      float4 sh = *(const float4*)(m + c), sc = *(const float4*)(m + 1024 + c);
      float y0 = v[i].x * rstd * (1.f + sc.x) + sh.x, y1 = v[i].y * rstd * (1.f + sc.y) + sh.y;
      float y2 = v[i].z * rstd * (1.f + sc.z) + sh.z, y3 = v[i].w * rstd * (1.f + sc.w) + sh.w;
      u32x2 o = {cvtpk(y0, y1), cvtpk(y2, y3)};
      *(u32x2*)(H + (size_t)r * 1024 + c) = o;
    }
  }
}

#define GSWZ(row, colB) ((row) * 128 + ((colB) ^ ((((row) >> 1) & 7) << 4)))
struct ResPre { float4 v[16]; u32x2 w[16]; };
struct GPre { bf16x8 ra[4], rb[2]; };
__device__ __forceinline__ void gemm_preload(const u16* __restrict__ A, int lda, const u16* __restrict__ Bt, int ldb, int m0, int n0, GPre& g) {
  const int tid = opaque_tid(), srow = tid >> 3, sch = tid & 7;
  const u16* ap = A + (size_t)(m0 + srow) * lda + sch * 8;
  const u16* bp = Bt + (size_t)(n0 + srow) * ldb + sch * 8;
#pragma unroll
  for (int i = 0; i < 4; ++i) g.ra[i] = *(const bf16x8*)(ap + (size_t)(64 * i) * lda);
#pragma unroll
  for (int i = 0; i < 2; ++i) g.rb[i] = *(const bf16x8*)(bp + (size_t)(64 * i) * ldb);
}
template <int PRE>
__device__ __forceinline__ void gemm_tile(const u16* __restrict__ A, int lda, const u16* __restrict__ Bt, int ldb, int K,
                                          int m0, int n0, f32x16 (&acc)[2][2], char* lds, GPre& g, const void* resp = nullptr, ResPre* rp = nullptr) {
  const int tid = opaque_tid(), wid = tid >> 6, lane = tid & 63, r32 = lane & 31, hi = lane >> 5;
  const int wm = wid & 3, wn = wid >> 2;
  char* As = lds;
  char* Bs = lds + 98304;
  const int srow = tid >> 3, sch = tid & 7;
  const u16* ap = A + (size_t)(m0 + srow) * lda + sch * 8;
  const u16* bp = Bt + (size_t)(n0 + srow) * ldb + sch * 8;
  const int sw = GSWZ(srow, sch * 16);
  bf16x8 (&ra)[4] = g.ra; bf16x8 (&rb)[2] = g.rb;
#pragma unroll
  for (int i = 0; i < 2; ++i) for (int j = 0; j < 2; ++j) acc[i][j] = f32x16{};
  const int nk = K / 64;
  __syncthreads();
#pragma unroll
  for (int i = 0; i < 4; ++i) *(bf16x8*)(As + sw + i * 8192) = ra[i];
#pragma unroll
  for (int i = 0; i < 2; ++i) *(bf16x8*)(Bs + sw + i * 8192) = rb[i];
  if (1 < nk) {
#pragma unroll
    for (int i = 0; i < 4; ++i) ra[i] = *(const bf16x8*)(ap + (size_t)(64 * i) * lda + 64);
#pragma unroll
    for (int i = 0; i < 2; ++i) rb[i] = *(const bf16x8*)(bp + (size_t)(64 * i) * ldb + 64);
  }
  __syncthreads();
  const int arow0 = wm * 64 + r32, brow0 = wn * 64 + r32;
  int st = 0;
  for (int kt = 0; kt < nk; ++kt) {
    const int stn = (st == 2) ? 0 : st + 1;
    if (kt + 1 < nk) {
      char* An = As + stn * 32768; char* Bn = Bs + stn * 16384;
#pragma unroll
      for (int i = 0; i < 4; ++i) *(bf16x8*)(An + sw + i * 8192) = ra[i];
#pragma unroll
      for (int i = 0; i < 2; ++i) *(bf16x8*)(Bn + sw + i * 8192) = rb[i];
    }
    if (kt + 2 < nk) {
#pragma unroll
      for (int i = 0; i < 4; ++i) ra[i] = *(const bf16x8*)(ap + (size_t)(64 * i) * lda + (kt + 2) * 64);
#pragma unroll
      for (int i = 0; i < 2; ++i) rb[i] = *(const bf16x8*)(bp + (size_t)(64 * i) * ldb + (kt + 2) * 64);
    }
    if (PRE == 1 && kt == 0) {
#pragma unroll
      for (int q = 0; q < 16; ++q) rp->v[q] = *(const float4*)((const float*)resp + (size_t)((q >> 3) * 32 + 4 * (q & 7)) * 1024);
    }
    if (PRE == 2 && kt == 0) {
#pragma unroll
      for (int q = 0; q < 16; ++q) rp->w[q] = *(const u32x2*)((const u16*)resp + (size_t)((q >> 3) * 32 + 4 * (q & 7)) * 1024);
    }
    SBAR();
    const char* Ac = As + st * 32768; const char* Bc = Bs + st * 16384;
#pragma unroll
    for (int kk = 0; kk < 4; ++kk) {
      const int cb = kk * 32 + hi * 16;
      bf16x8 a0 = *(const bf16x8*)(Ac + GSWZ(arow0, cb));
      bf16x8 a1 = *(const bf16x8*)(Ac + GSWZ(arow0 + 32, cb));
      bf16x8 b0 = *(const bf16x8*)(Bc + GSWZ(brow0, cb));
      bf16x8 b1 = *(const bf16x8*)(Bc + GSWZ(brow0 + 32, cb));
      acc[0][0] = __builtin_amdgcn_mfma_f32_32x32x16_bf16(a0, b0, acc[0][0], 0, 0, 0);
      acc[0][1] = __builtin_amdgcn_mfma_f32_32x32x16_bf16(a0, b1, acc[0][1], 0, 0, 0);
      acc[1][0] = __builtin_amdgcn_mfma_f32_32x32x16_bf16(a1, b0, acc[1][0], 0, 0, 0);
      acc[1][1] = __builtin_amdgcn_mfma_f32_32x32x16_bf16(a1, b1, acc[1][1], 0, 0, 0);
    }
    __syncthreads();
    st = stn;
  }
}

struct TileIter {
  int f, fend, step, MT, NT;
  __device__ __forceinline__ TileIter(int MT_, int NT_) : MT(MT_), NT(NT_) {
    const int T = MT_ * NT_, bid = blockIdx.x, nblk = gridDim.x;
    if (nblk == 256) { const int x = bid & 7, cl = bid >> 3; f = (int)(((long)T * x) >> 3) + cl; fend = (int)(((long)T * (x + 1)) >> 3); step = 32; }
    else { f = bid; fend = T; step = nblk; }
  }
  __device__ __forceinline__ bool valid() const { return f < fend; }
  __device__ __forceinline__ void next() { f += step; }
  __device__ __forceinline__ void get(int& mt, int& nt) const {
    const int full = (MT >> 2) * 4 * NT;
    if (f < full) { const int g = f / (4 * NT), rem = f - g * 4 * NT; nt = rem >> 2; mt = g * 4 + (rem & 3); }
    else { const int rem = f - full, gs = MT - (MT >> 2) * 4; nt = rem / gs; mt = (MT >> 2) * 4 + (rem - nt * gs); }
  }
};

__device__ __forceinline__ void epi_bf16(f32x16 (&acc)[2][2], u16* C, int ldc, int m0, int n0, char* lds) {
  const int tid = opaque_tid(), wid = tid >> 6, lane = tid & 63, r32 = lane & 31, hi = lane >> 5;
  const int wm = wid & 3, wn = wid >> 2;
  char* wl = lds + wid * 9216;
#pragma unroll
  for (int i = 0; i < 2; ++i)
#pragma unroll
    for (int j = 0; j < 2; ++j)
#pragma unroll
      for (int r = 0; r < 16; ++r) *(u16*)(wl + (i * 32 + crow(r, hi)) * 144 + (j * 32 + r32) * 2) = f2bf(acc[i][j][r]);
  asm volatile("s_waitcnt lgkmcnt(0)" ::: "memory");
  const int rr = lane >> 3, ch = lane & 7;
  u16* cbase = C + (size_t)(m0 + wm * 64 + rr) * ldc + n0 + wn * 64 + ch * 8;
#pragma unroll
  for (int k = 0; k < 8; ++k) {
    const u32x4 v = *(const u32x4*)(wl + (rr + 8 * k) * 144 + ch * 16);
    *(u32x4*)(cbase + (size_t)(8 * k) * ldc) = v;
  }
}
template <bool IN_BF, bool OUT_BF>
__device__ __forceinline__ void epi_res(f32x16 (&acc)[2][2], const ResPre& rp, void* outp, const float* gsrc, int n0, char* lds) {
  const int tid = opaque_tid(), wid = tid >> 6, lane = tid & 63, r32 = lane & 31, hi = lane >> 5;
  const int wn = wid >> 2;
  char* wl = lds + wid * 8704;
  const int rl = lane >> 4, c4 = lane & 15;
  const float4 g = *(const float4*)(gsrc + n0 + wn * 64 + 4 * c4);
#pragma unroll
  for (int i = 0; i < 2; ++i) {
#pragma unroll
    for (int j = 0; j < 2; ++j)
#pragma unroll
      for (int r = 0; r < 16; ++r) *(float*)(wl + crow(r, hi) * 272 + (j * 32 + r32) * 4) = acc[i][j][r];
    asm volatile("s_waitcnt lgkmcnt(0)" ::: "memory");
#pragma unroll
    for (int k = 0; k < 8; ++k) {
      const float4 a = *(const float4*)(wl + (rl + 4 * k) * 272 + c4 * 16);
      float4 x;
      if (IN_BF) { const u32x2 xw = rp.w[i * 8 + k]; x.x = bflo(xw[0]); x.y = bfhi(xw[0]); x.z = bflo(xw[1]); x.w = bfhi(xw[1]); } else x = rp.v[i * 8 + k];
      float4 o; o.x = x.x + g.x * a.x; o.y = x.y + g.y * a.y; o.z = x.z + g.z * a.z; o.w = x.w + g.w * a.w;
      if (OUT_BF) { const u32x2 ow = {cvtpk(o.x, o.y), cvtpk(o.z, o.w)}; *(u32x2*)((u16*)outp + (size_t)(i * 32 + 4 * k) * 1024) = ow; }
      else *(float4*)((float*)outp + (size_t)(i * 32 + 4 * k) * 1024) = o;
    }
    asm volatile("s_waitcnt lgkmcnt(0)" ::: "memory");
  }
}

__device__ __forceinline__ float red8(float v) { v += __shfl_xor(v, 1); v += __shfl_xor(v, 2); v += __shfl_xor(v, 4); return v; }
__device__ __forceinline__ void rope_cs(float pos, float inv, bool on, float& c, float& s) {
  if (on) { float a = pos * inv * 0.15915494309189535f; a -= floorf(a); c = __builtin_amdgcn_cosf(a); s = __builtin_amdgcn_sinf(a); } else { c = 1.f; s = 0.f; }
}
__device__ __forceinline__ void head64(const u16* src, u16* dst, int gb, const float* g, const float* cG, const float* sG, float qs) {
  const u32x2 lo = *(const u32x2*)(src + gb), hi2 = *(const u32x2*)(src + gb + 16);
  float x[8] = {bflo(lo[0]), bfhi(lo[0]), bflo(lo[1]), bfhi(lo[1]), bflo(hi2[0]), bfhi(hi2[0]), bflo(hi2[1]), bfhi(hi2[1])};
  float ss = 0;
#pragma unroll
  for (int e = 0; e < 8; ++e) ss += x[e] * x[e];
  const float rn = rsqrtf(red8(ss) * (1.f / 64) + EPS) ;
#pragma unroll
  for (int e = 0; e < 8; ++e) x[e] *= rn * g[e];
  float y[8];
#pragma unroll
  for (int e = 0; e < 4; ++e) { y[e] = (x[e] * cG[e] - x[e + 4] * sG[e]) * qs; y[e + 4] = (x[e + 4] * cG[e] + x[e] * sG[e]) * qs; }
  const u32x2 o0 = {cvtpk(y[0], y[1]), cvtpk(y[2], y[3])}, o1 = {cvtpk(y[4], y[5]), cvtpk(y[6], y[7])};
  *(u32x2*)(dst + gb) = o0; *(u32x2*)(dst + gb + 16) = o1;
}
__device__ __forceinline__ void head96(float* n, float r1a, float r1b, float r2a, float r2b, u16* dst, int t, int rb,
                                       const float* gn, const float* gr, const float* cM, const float* sM, float qs) {
  float ss = r1a * r1a + r1b * r1b + r2a * r2a + r2b * r2b;
#pragma unroll
  for (int e = 0; e < 8; ++e) ss += n[e] * n[e];
  const float rn = rsqrtf(red8(ss) * (1.f / 96) + EPS);
#pragma unroll
  for (int e = 0; e < 8; ++e) n[e] *= rn * gn[e] * qs;
  r1a *= rn * gr[0]; r1b *= rn * gr[1]; r2a *= rn * gr[2]; r2b *= rn * gr[3];
  const float y1a = (r1a * cM[0] - r2a * sM[0]) * qs, y2a = (r2a * cM[0] + r1a * sM[0]) * qs;
  const float y1b = (r1b * cM[1] - r2b * sM[1]) * qs, y2b = (r2b * cM[1] + r1b * sM[1]) * qs;
  const u32x4 o = {cvtpk(n[0], n[1]), cvtpk(n[2], n[3]), cvtpk(n[4], n[5]), cvtpk(n[6], n[7])};
  *(u32x4*)(dst + 8 * t) = o;
  *(unsigned*)(dst + 64 + rb) = cvtpk(y1a, y1b); *(unsigned*)(dst + 64 + rb + 8) = cvtpk(y2a, y2b);
}
__device__ void finalize0(const Params& p) {
  const int tid = opaque_tid(), lane = tid & 63, gw = blockIdx.x * 8 + (tid >> 6), nw = gridDim.x * 8;
  const int h = lane >> 3, t = lane & 7;
  char* ws = p.ws;
  const u16* PP = (const u16*)(ws + OFF_PP);
  const u16* QAR = (const u16*)(ws + OFF_H);
  const u16* KVR = (const u16*)p.out;
  u16* QA = (u16*)(ws + OFF_QA); u16* QCA = (u16*)(ws + OFF_QCA); u16* KA = (u16*)(ws + OFF_KA); u16* VA = (u16*)(ws + OFF_VA);
  u16* QB = (u16*)(ws + OFF_QB); u16* QCB = (u16*)(ws + OFF_QCB); u16* KB = (u16*)(ws + OFF_KB); u16* VB = (u16*)(ws + OFF_VB);
  const int gb = t < 4 ? 4 * t : 32 + 4 * (t - 4), rb = t < 4 ? 2 * t : 16 + 2 * (t - 4);
  float qgn[8], kgn[8], qgr[4], kgr[4], gqg[8], gkg[8], invG[4], invM[2];
#pragma unroll
  for (int e = 0; e < 8; ++e) { qgn[e] = p.q_gain[8 * t + e]; kgn[e] = p.k_gain[8 * t + e];
    const int d = gb + (e & 3) + (e >> 2) * 16; gqg[e] = p.gq_gain[d]; gkg[e] = p.gk_gain[d]; }
#pragma unroll
  for (int k = 0; k < 4; ++k) { const int d = 64 + rb + (k & 1) + (k >> 1) * 8; qgr[k] = p.q_gain[d]; kgr[k] = p.k_gain[d]; }
#pragma unroll
  for (int e = 0; e < 4; ++e) invG[e] = exp2f(-(float)(4 * (t & 3) + e) * (13.287712379549449f / 16.f));
#pragma unroll
  for (int k = 0; k < 2; ++k) invM[k] = exp2f(-(float)(2 * (t & 3) + k) * (13.287712379549449f / 8.f));
  for (int r = gw; r < NROW; r += nw) {
    const bool isctx = r >= NLAT;
    int b, s, kpos; float pos = 0.f;
    if (!isctx) { b = r >> 14; s = r & 16383; kpos = CL + s; pos = t < 4 ? (float)(s >> 6) : (float)(s & 63); }
    else { int rc = r - NLAT; b = rc >> 8; s = rc & 255; kpos = s; }
    float cG[4], sG[4], cM[2], sM[2];
#pragma unroll
    for (int e = 0; e < 4; ++e) rope_cs(pos, invG[e], !isctx, cG[e], sG[e]);
#pragma unroll
    for (int k = 0; k < 2; ++k) rope_cs(pos, invM[k], !isctx, cM[k], sM[k]);
    const u16* pp = PP + (size_t)r * LD_AB;
    const u32x2 wq = *(const u32x2*)(pp + lane * 4), wk = *(const u32x2*)(pp + 256 + lane * 4);
    float s1 = bflo(wq[0]) * bflo(wq[0]) + bfhi(wq[0]) * bfhi(wq[0]) + bflo(wq[1]) * bflo(wq[1]) + bfhi(wq[1]) * bfhi(wq[1]);
    float s2 = bflo(wk[0]) * bflo(wk[0]) + bfhi(wk[0]) * bfhi(wk[0]) + bflo(wk[1]) * bflo(wk[1]) + bfhi(wk[1]) * bfhi(wk[1]);
    s1 = wave_sum(s1); s2 = wave_sum(s2);
    const float rstd_cq = rsqrtf(s1 * (1.f / 256) + EPS), rstd_ckv = rsqrtf(s2 * (1.f / 256) + EPS);
    { const u16* qa = QAR + (size_t)r * 768 + h * 96;
      const u32x4 nv = *(const u32x4*)(qa + 8 * t); const unsigned w1 = *(const unsigned*)(qa + 64 + rb), w2 = *(const unsigned*)(qa + 64 + rb + 8);
      float n[8] = {bflo(nv[0]) * rstd_cq, bfhi(nv[0]) * rstd_cq, bflo(nv[1]) * rstd_cq, bfhi(nv[1]) * rstd_cq, bflo(nv[2]) * rstd_cq, bfhi(nv[2]) * rstd_cq, bflo(nv[3]) * rstd_cq, bfhi(nv[3]) * rstd_cq};
      u16* dq = isctx ? QCA + ((size_t)(b * 8 + h) * CL + s) * 96 : QA + ((size_t)(b * 8 + h) * SEQ + s) * 96;
      head96(n, bflo(w1) * rstd_cq, bfhi(w1) * rstd_cq, bflo(w2) * rstd_cq, bfhi(w2) * rstd_cq, dq, t, rb, qgn, qgr, cM, sM, QS_A); }
    { const u16* kv = KVR + (size_t)r * 1024 + h * 128;
      const u32x4 nv = *(const u32x4*)(kv + 8 * t), vv = *(const u32x4*)(kv + 64 + 8 * t);
      const unsigned w1 = *(const unsigned*)(pp + 512 + rb), w2 = *(const unsigned*)(pp + 512 + rb + 8);
      float n[8] = {bflo(nv[0]) * rstd_ckv, bfhi(nv[0]) * rstd_ckv, bflo(nv[1]) * rstd_ckv, bfhi(nv[1]) * rstd_ckv, bflo(nv[2]) * rstd_ckv, bfhi(nv[2]) * rstd_ckv, bflo(nv[3]) * rstd_ckv, bfhi(nv[3]) * rstd_ckv};
      const size_t kr = (size_t)(b * 8 + h) * KVLEN + kpos;
      head96(n, bflo(w1), bfhi(w1), bflo(w2), bfhi(w2), KA + kr * 96, t, rb, kgn, kgr, cM, sM, 1.f);
      const u32x4 vo = {cvtpk(bflo(vv[0]) * rstd_ckv, bfhi(vv[0]) * rstd_ckv), cvtpk(bflo(vv[1]) * rstd_ckv, bfhi(vv[1]) * rstd_ckv),
                        cvtpk(bflo(vv[2]) * rstd_ckv, bfhi(vv[2]) * rstd_ckv), cvtpk(bflo(vv[3]) * rstd_ckv, bfhi(vv[3]) * rstd_ckv)};
      *(u32x4*)(VA + kr * 64 + 8 * t) = vo; }
    { u16* dg = isctx ? QCB + ((size_t)(b * 8 + h) * CL + s) * 64 : QB + ((size_t)(b * 8 + h) * SEQ + s) * 64;
      head64(pp + 544 + h * 64, dg, gb, gqg, cG, sG, QS_B); }
    if (h < 2) {
      const size_t kr = (size_t)(b * 2 + h) * KVLEN + kpos;
      head64(pp + 1056 + h * 64, KB + kr * 64, gb, gkg, cG, sG, 1.f);
      *(u32x4*)(VB + kr * 64 + 8 * t) = *(const u32x4*)(pp + 1184 + h * 64 + 8 * t);
    }
  }
}

__device__ void finalize1(const Params& p) {
  const int tid = opaque_tid(), lane = tid & 63, gw = blockIdx.x * 8 + (tid >> 6), nw = gridDim.x * 8;
  const int h = lane >> 3, t = lane & 7;
  char* ws = p.ws;
  const u16* PP = (const u16*)(ws + OFF_PP);
  u16* Q2 = (u16*)(ws + OFF_Q2); u16* K2 = (u16*)(ws + OFF_K2); u16* V2 = (u16*)(ws + OFF_V2);
  u16* MIX = (u16*)(ws + OFF_H);
  const int gb = t < 4 ? 4 * t : 32 + 4 * (t - 4);
  float qg[8], kg[8], invG[4];
#pragma unroll
  for (int e = 0; e < 8; ++e) { const int d = gb + (e & 3) + (e >> 2) * 16; qg[e] = p.win_q_gain[d]; kg[e] = p.win_k_gain[d]; }
#pragma unroll
  for (int e = 0; e < 4; ++e) invG[e] = exp2f(-(float)(4 * (t & 3) + e) * (13.287712379549449f / 16.f));
  float cw[3][8];
#pragma unroll
  for (int j = 0; j < 3; ++j)
#pragma unroll
    for (int e = 0; e < 8; ++e) cw[j][e] = p.conv_w[j * 512 + lane * 8 + e];
  for (int r = gw; r < NROW + 512; r += nw) {
    if (r >= NROW) {
      int slab = (r - NROW) >> 7, pr = (r - NROW) & 127;
      size_t kr = (size_t)slab * KV2LEN + KVLEN + pr;
      K2[kr * 64 + lane] = 0; V2[kr * 64 + lane] = 0;
      continue;
    }
    const bool isctx = r >= NLAT;
    int b, s, kpos; float pos = 0.f;
    if (!isctx) { b = r >> 14; s = r & 16383; kpos = CL + s; pos = t < 4 ? (float)(s >> 6) : (float)(s & 63); }
    else { int rc = r - NLAT; b = rc >> 8; s = rc & 255; kpos = s; }
    float cG[4], sG[4];
#pragma unroll
    for (int e = 0; e < 4; ++e) rope_cs(pos, invG[e], !isctx, cG[e], sG[e]);
    const u16* pp = PP + (size_t)r * LD_CD;
    if (!isctx) head64(pp + h * 64, Q2 + ((size_t)(b * 8 + h) * SEQ + s) * 64, gb, qg, cG, sG, QS_B);
    if (h < 2) {
      const size_t kr = (size_t)(b * 2 + h) * KV2LEN + kpos;
      head64(pp + 512 + h * 64, K2 + kr * 64, gb, kg, cG, sG, 1.f);
      *(u32x4*)(V2 + kr * 64 + 8 * t) = *(const u32x4*)(pp + 640 + h * 64 + 8 * t);
    }
    if (!isctx) {
      const int c0 = lane * 8;
      float y[8];
#pragma unroll
      for (int e = 0; e < 8; ++e) y[e] = 0.f;
#pragma unroll
      for (int j = 0; j < 3; ++j) {
        const int sj = s + j - 1;
        if (sj >= 0 && sj < SEQ) {
          const u16* pj = pp + (ptrdiff_t)(j - 1) * LD_CD;
          u32x4 a = *(const u32x4*)(pj + 1280 + c0), bb = *(const u32x4*)(pj + 1792 + c0);
#pragma unroll
          for (int e = 0; e < 4; ++e) {
            y[2 * e]     += bflo(a[e]) * bflo(bb[e]) * cw[j][2 * e];
            y[2 * e + 1] += bfhi(a[e]) * bfhi(bb[e]) * cw[j][2 * e + 1];
          }
        }
      }
      u32x4 gbv = *(const u32x4*)(pp + 768 + c0), gt = *(const u32x4*)(pp + 2304 + 512 + c0);
      u32x4 o;
#pragma unroll
      for (int e = 0; e < 4; ++e) {
        float v0 = bflo(gbv[e]) * y[2 * e] * silu_f(bflo(gt[e]));
        float v1 = bfhi(gbv[e]) * y[2 * e + 1] * silu_f(bfhi(gt[e]));
        o[e] = cvtpk(v0, v1);
      }
      *(u32x4*)(MIX + (size_t)r * 1024 + 512 + c0) = o;
    }
  }
}

#define KSWZ(row, colB) ((row) * 272 + (colB))
__device__ __forceinline__ int v_st2(int k, int c) { const int kk = k; return ((kk >> 3) * 2 + (c >> 5)) * 512 + ((kk & 7) * 32 + (c & 31)) * 2; }
__device__ __forceinline__ int v_rd_base(int lane) { return ((lane & 3) << 3) | (((lane >> 2) & 3) << 6) | (((lane >> 4) & 1) << 5) | (((lane >> 5) & 1) << 8); }
constexpr int v_rd_off2(int d0, int ks, int half) { return d0 * 512 + ks * 2048 + half * 1024; }
template <int OFF> __device__ __forceinline__ s16x4 tr_read(int vb) {
  s16x4 r; asm volatile("ds_read_b64_tr_b16 %0, %1 offset:%2" : "=&v"(r) : "v"(vb), "i"(OFF) : "memory"); return r;
}
template <int D0> __device__ __forceinline__ void pv_one(f32x16& od, int vb, bf16x8 pa0, bf16x8 pa1, bf16x8 pa2, bf16x8 pa3) {
  const s16x4 l0 = tr_read<v_rd_off2(D0, 0, 0)>(vb), h0 = tr_read<v_rd_off2(D0, 0, 1)>(vb), l1 = tr_read<v_rd_off2(D0, 1, 0)>(vb), h1 = tr_read<v_rd_off2(D0, 1, 1)>(vb);
  const s16x4 l2 = tr_read<v_rd_off2(D0, 2, 0)>(vb), h2 = tr_read<v_rd_off2(D0, 2, 1)>(vb), l3 = tr_read<v_rd_off2(D0, 3, 0)>(vb), h3 = tr_read<v_rd_off2(D0, 3, 1)>(vb);
  asm volatile("s_waitcnt lgkmcnt(0)" ::: "memory"); SBAR();
#define PK(L, H) (bf16x8){L[0], L[1], L[2], L[3], H[0], H[1], H[2], H[3]}
  od = __builtin_amdgcn_mfma_f32_32x32x16_bf16(pa0, PK(l0, h0), od, 0, 0, 0);
  od = __builtin_amdgcn_mfma_f32_32x32x16_bf16(pa1, PK(l1, h1), od, 0, 0, 0);
  od = __builtin_amdgcn_mfma_f32_32x32x16_bf16(pa2, PK(l2, h2), od, 0, 0, 0);
  od = __builtin_amdgcn_mfma_f32_32x32x16_bf16(pa3, PK(l3, h3), od, 0, 0, 0);
#undef PK
}
__device__ __forceinline__ void pv_all(f32x16* o, int vb, bf16x8 pa0, bf16x8 pa1, bf16x8 pa2, bf16x8 pa3) {
  pv_one<0>(o[0], vb, pa0, pa1, pa2, pa3); pv_one<1>(o[1], vb, pa0, pa1, pa2, pa3);
}
__device__ __forceinline__ void pv_exp(f32x16* o, int vb, bf16x8 pa0, bf16x8 pa1, bf16x8 pa2, bf16x8 pa3, f32x16& n0, f32x16& n1) {
#define PK(L, H) (bf16x8){L[0], L[1], L[2], L[3], H[0], H[1], H[2], H[3]}
  { const s16x4 l0 = tr_read<v_rd_off2(0, 0, 0)>(vb), h0 = tr_read<v_rd_off2(0, 0, 1)>(vb), l1 = tr_read<v_rd_off2(0, 1, 0)>(vb), h1 = tr_read<v_rd_off2(0, 1, 1)>(vb);
    const s16x4 l2 = tr_read<v_rd_off2(0, 2, 0)>(vb), h2 = tr_read<v_rd_off2(0, 2, 1)>(vb), l3 = tr_read<v_rd_off2(0, 3, 0)>(vb), h3 = tr_read<v_rd_off2(0, 3, 1)>(vb);
#pragma unroll
    for (int r = 0; r < 8; ++r) n0[r] = __builtin_amdgcn_exp2f(n0[r]);
    asm volatile("s_waitcnt lgkmcnt(0)" ::: "memory"); SBAR();
    o[0] = __builtin_amdgcn_mfma_f32_32x32x16_bf16(pa0, PK(l0, h0), o[0], 0, 0, 0);
    o[0] = __builtin_amdgcn_mfma_f32_32x32x16_bf16(pa1, PK(l1, h1), o[0], 0, 0, 0);
    o[0] = __builtin_amdgcn_mfma_f32_32x32x16_bf16(pa2, PK(l2, h2), o[0], 0, 0, 0);
    o[0] = __builtin_amdgcn_mfma_f32_32x32x16_bf16(pa3, PK(l3, h3), o[0], 0, 0, 0); }
  { const s16x4 l0 = tr_read<v_rd_off2(1, 0, 0)>(vb), h0 = tr_read<v_rd_off2(1, 0, 1)>(vb), l1 = tr_read<v_rd_off2(1, 1, 0)>(vb), h1 = tr_read<v_rd_off2(1, 1, 1)>(vb);
    const s16x4 l2 = tr_read<v_rd_off2(1, 2, 0)>(vb), h2 = tr_read<v_rd_off2(1, 2, 1)>(vb), l3 = tr_read<v_rd_off2(1, 3, 0)>(vb), h3 = tr_read<v_rd_off2(1, 3, 1)>(vb);
#pragma unroll
    for (int r = 8; r < 16; ++r) n0[r] = __builtin_amdgcn_exp2f(n0[r]);
    asm volatile("s_waitcnt lgkmcnt(0)" ::: "memory"); SBAR();
    o[1] = __builtin_amdgcn_mfma_f32_32x32x16_bf16(pa0, PK(l0, h0), o[1], 0, 0, 0);
    o[1] = __builtin_amdgcn_mfma_f32_32x32x16_bf16(pa1, PK(l1, h1), o[1], 0, 0, 0);
    o[1] = __builtin_amdgcn_mfma_f32_32x32x16_bf16(pa2, PK(l2, h2), o[1], 0, 0, 0);
    o[1] = __builtin_amdgcn_mfma_f32_32x32x16_bf16(pa3, PK(l3, h3), o[1], 0, 0, 0); }
#undef PK
#pragma unroll
  for (int r = 0; r < 16; ++r) n1[r] = __builtin_amdgcn_exp2f(n1[r]);
}

__device__ __forceinline__ void expall(f32x16& p0, f32x16& p1) {
#pragma unroll
  for (int r = 0; r < 16; ++r) p0[r] = __builtin_amdgcn_exp2f(p0[r]);
#pragma unroll
  for (int r = 0; r < 16; ++r) p1[r] = __builtin_amdgcn_exp2f(p1[r]);
}
__device__ __forceinline__ void finishSM(f32x16& p0, f32x16& p1, float& lsum, bf16x8& pa0, bf16x8& pa1, bf16x8& pa2, bf16x8& pa3) {
  float ps = 0;
#pragma unroll
  for (int r = 0; r < 16; ++r) ps += p0[r];
#pragma unroll
  for (int r = 0; r < 16; ++r) ps += p1[r];
  lsum += ps;
#define PK4(P, BASE, OUT) do { u32x4 w = {cvtpk(P[BASE + 0], P[BASE + 1]), cvtpk(P[BASE + 2], P[BASE + 3]), cvtpk(P[BASE + 4], P[BASE + 5]), cvtpk(P[BASE + 6], P[BASE + 7])}; \
    OUT = *reinterpret_cast<bf16x8*>(&w); } while (0)
  PK4(p0, 0, pa0); PK4(p0, 8, pa1); PK4(p1, 0, pa2); PK4(p1, 8, pa3);
#undef PK4
}
template <int NQK>
__device__ __forceinline__ void qkt(f32x16& p0, f32x16& p1, const char* Ks, const bf16x8* qr, int r32, int hi, const float shift) {
  p0 = f32x16{}; p1 = f32x16{};
#pragma unroll
  for (int d0 = 0; d0 < NQK; ++d0) { int cb = (d0 * 16 + hi * 8) * 2;
    bf16x8 b0 = *reinterpret_cast<const bf16x8*>(Ks + KSWZ(r32, cb));
    bf16x8 b1 = *reinterpret_cast<const bf16x8*>(Ks + KSWZ(32 + r32, cb));
    p0 = __builtin_amdgcn_mfma_f32_32x32x16_bf16(b0, qr[d0], p0, 0, 0, 0);
    p1 = __builtin_amdgcn_mfma_f32_32x32x16_bf16(b1, qr[d0], p1, 0, 0, 0); }
  if (__builtin_expect(shift != 0.f, 0)) {
#pragma unroll
    for (int r = 0; r < 16; ++r) { p0[r] -= shift; p1[r] -= shift; }
  }
}

#define PK4X(P, BASE, OUT) do { u32x4 w_ = {cvtpk(P[BASE + 0], P[BASE + 1]), cvtpk(P[BASE + 2], P[BASE + 3]), cvtpk(P[BASE + 4], P[BASE + 5]), cvtpk(P[BASE + 6], P[BASE + 7])}; \
    OUT = *reinterpret_cast<bf16x8*>(&w_); } while (0)
template <int NQK>
__device__ __forceinline__ void qkt_fin(f32x16& n0, f32x16& n1, const char* Ks, const bf16x8* qr, int r32, int hi, const float shift,
                                        f32x16& o0, f32x16& o1, float& lsum, bf16x8& pa0, bf16x8& pa1, bf16x8& pa2, bf16x8& pa3) {
  n0 = f32x16{}; n1 = f32x16{};
  float ps = 0.f;
  bf16x8 kc0 = *reinterpret_cast<const bf16x8*>(Ks + KSWZ(r32, (hi * 8) * 2));
  bf16x8 kc1 = *reinterpret_cast<const bf16x8*>(Ks + KSWZ(32 + r32, (hi * 8) * 2));
#pragma unroll
  for (int d0 = 0; d0 < NQK; ++d0) {
    bf16x8 kn0 = kc0, kn1 = kc1;
    if (d0 + 1 < NQK) { const int cb = ((d0 + 1) * 16 + hi * 8) * 2;
      kn0 = *reinterpret_cast<const bf16x8*>(Ks + KSWZ(r32, cb)); kn1 = *reinterpret_cast<const bf16x8*>(Ks + KSWZ(32 + r32, cb)); }
    n0 = __builtin_amdgcn_mfma_f32_32x32x16_bf16(kc0, qr[d0], n0, 0, 0, 0);
    n1 = __builtin_amdgcn_mfma_f32_32x32x16_bf16(kc1, qr[d0], n1, 0, 0, 0);
#define PIN(X) asm volatile("" : "+v"(X))
    if (NQK == 6) {
      if (d0 == 0) { PK4X(o0, 0, pa0); }
      if (d0 == 1) { PIN(o0); PK4X(o0, 8, pa1); }
      if (d0 == 2) { _Pragma("unroll") for (int r = 0; r < 16; ++r) ps += o0[r]; }
      if (d0 == 3) { PIN(o1); PK4X(o1, 0, pa2); _Pragma("unroll") for (int r = 0; r < 8; ++r) ps += o1[r]; }
      if (d0 == 4) { PIN(o1); PK4X(o1, 8, pa3); _Pragma("unroll") for (int r = 8; r < 16; ++r) ps += o1[r]; }
    } else {
      if (d0 == 0) { PK4X(o0, 0, pa0); PK4X(o0, 8, pa1); }
      if (d0 == 1) { _Pragma("unroll") for (int r = 0; r < 16; ++r) ps += o0[r]; }
      if (d0 == 2) { PIN(o1); PK4X(o1, 0, pa2); _Pragma("unroll") for (int r = 0; r < 8; ++r) ps += o1[r]; }
      if (d0 == 3) { PIN(o1); PK4X(o1, 8, pa3); _Pragma("unroll") for (int r = 8; r < 16; ++r) ps += o1[r]; }
    }
#undef PIN
    asm volatile("" : "+v"(ps), "+v"(pa0), "+v"(pa1), "+v"(pa2), "+v"(pa3));
    kc0 = kn0; kc1 = kn1;
    SBAR();
  }
  lsum += ps;
  if (__builtin_expect(shift != 0.f, 0)) {
#pragma unroll
    for (int r = 0; r < 16; ++r) { n0[r] -= shift; n1[r] -= shift; }
  }
}

template <int NQK, int MODE, int LDG>
__device__ __forceinline__ void attn_body(const u16* __restrict__ Qb, const u16* __restrict__ Kh, const u16* __restrict__ Vh,
                                          const int NT, const int q0, const float sink2, const float mbound,
                                          u16* __restrict__ mix0, const u16* __restrict__ gate0, char* lds) {
  constexpr int DK = NQK * 16;
  constexpr int SHM_V = 8192, SHM_K = 17408;
  int tid_ = threadIdx.x; asm volatile("" : "+v"(tid_));
  const int tid = tid_, wid = __builtin_amdgcn_readfirstlane(tid >> 6), lane = tid & 63, r32 = lane & 31, hi = lane >> 5;
  char* V_lds = lds; char* K_lds = lds + 5 * SHM_V;
  float* wsf = (float*)(lds + 5 * SHM_V + 5 * SHM_K) + wid * 64; float* li_l = wsf;
  float lsum = 0; f32x16 o[2] = {}; bf16x8 qr[NQK];
  const float shift = mbound > 80.f ? mbound - 80.f : 0.f;
  const u16* Qw = Qb + (size_t)(wid * 32 + r32) * DK + hi * 8;
#pragma unroll
  for (int d0 = 0; d0 < NQK; ++d0) qr[d0] = *(const bf16x8*)(Qw + d0 * 16);
  const int srow = tid >> 3, sc8 = tid & 7;
  const int kst0 = KSWZ(srow, sc8 * 16), kst1 = KSWZ(srow, 128 + sc8 * 16), vst = v_st2(srow, sc8 * 8);
  const int vb0 = (int)(uintptr_t)V_lds + v_rd_base(lane);
  const bool k1on = (NQK == 6) && (sc8 < 4);
  const unsigned koff0 = srow * DK + sc8 * 8, voff0 = srow * 64 + sc8 * 8;
  struct { bf16x8 k0, k1, v0; } st[2];
#define TROW(j) (MODE == 0 ? (j) * 64 : ((j) < 4 ? (j) * 64 : q0 + 128 + ((j) - 4) * 64))
#define SLOAD(i, kr) do { const u16* kp_ = Kh + (unsigned)((kr) * DK); st[i].k0 = *(const bf16x8*)(kp_ + koff0);   \
    if (k1on) st[i].k1 = *(const bf16x8*)(kp_ + koff0 + 64);                                                           \
    const u16* vp_ = Vh + (unsigned)((kr) * 64); st[i].v0 = *(const bf16x8*)(vp_ + voff0); } while (0)
#define SWRITE(b, i) do { *(bf16x8*)(K_lds + (b) * SHM_K + kst0) = st[i].k0; if (k1on) *(bf16x8*)(K_lds + (b) * SHM_K + kst1) = st[i].k1; \
    *(bf16x8*)(V_lds + (b) * SHM_V + vst) = st[i].v0; } while (0)
#define MASKT(P0, P1, j) do { if (MODE == 1 && (j) >= 4) { const int kb_ = q0 - 128 + ((j) - 4) * 64, qp_ = q0 + wid * 32 + r32;    \
    _Pragma("unroll") for (int r = 0; r < 16; ++r) { int k0_ = kb_ + crow(r, hi), k1_ = k0_ + 32; int d0_ = qp_ - k0_, d1_ = qp_ - k1_; \
      bool ok0 = (d0_ <= 128) && (d0_ >= -128) && (k0_ >= 0) && (k0_ < SEQ); bool ok1 = (d1_ <= 128) && (d1_ >= -128) && (k1_ >= 0) && (k1_ < SEQ); \
      P0[r] = ok0 ? P0[r] : -1e30f; P1[r] = ok1 ? P1[r] : -1e30f; } } } while (0)
  f32x16 pA0, pA1, pB0, pB1; bf16x8 pa0, pa1, pa2, pa3;
#define NXS(x) ((x) + 1 == 5 ? 0 : (x) + 1)
  __syncthreads();
  SLOAD(0, TROW(0)); asm volatile("s_waitcnt vmcnt(0)" ::: "memory"); SWRITE(0, 0);
  SLOAD(0, TROW(1)); SWRITE(1, 0);
  SLOAD(0, TROW(2)); SWRITE(2, 0);
  if (3 < NT) SLOAD(0, TROW(3));
  if (4 < NT) SLOAD(1, TROW(4));
  __syncthreads();
  qkt<NQK>(pA0, pA1, K_lds, qr, r32, hi, shift); MASKT(pA0, pA1, 0); expall(pA0, pA1);
  int c = 0;
  for (int j = 1; j + 1 < NT; j += 2) {
    const int sj = NXS(c), sj1 = NXS(sj), sj2 = NXS(sj1), sj3 = NXS(sj2);
    SBAR(); SWRITE(sj2, 0); if (j + 3 < NT) SWRITE(sj3, 1); SBAR();
    qkt_fin<NQK>(pB0, pB1, K_lds + sj * SHM_K, qr, r32, hi, shift, pA0, pA1, lsum, pa0, pa1, pa2, pa3); MASKT(pB0, pB1, j); SBAR();
    if (j + 4 < NT) SLOAD(0, TROW(j + 4)); SBAR();
    pv_exp(o, vb0 + c * SHM_V, pa0, pa1, pa2, pa3, pB0, pB1);
    SBAR();
    qkt_fin<NQK>(pA0, pA1, K_lds + sj1 * SHM_K, qr, r32, hi, shift, pB0, pB1, lsum, pa0, pa1, pa2, pa3); MASKT(pA0, pA1, j + 1); SBAR();
    if (j + 5 < NT) SLOAD(1, TROW(j + 5)); SBAR();
    pv_exp(o, vb0 + sj * SHM_V, pa0, pa1, pa2, pa3, pA0, pA1);
    __syncthreads();
    c = sj1;
  }
  { const int sl = NXS(c);
    SBAR(); qkt_fin<NQK>(pB0, pB1, K_lds + sl * SHM_K, qr, r32, hi, shift, pA0, pA1, lsum, pa0, pa1, pa2, pa3); MASKT(pB0, pB1, NT - 1); SBAR();
    pv_all(o, vb0 + c * SHM_V, pa0, pa1, pa2, pa3); expall(pB0, pB1);
    finishSM(pB0, pB1, lsum, pa0, pa1, pa2, pa3); SBAR();
    pv_all(o, vb0 + sl * SHM_V, pa0, pa1, pa2, pa3); }
#undef NXS
  float l_reg;
  { auto rr = __builtin_amdgcn_permlane32_swap(__float_as_uint(lsum), __float_as_uint(lsum), false, false);
    l_reg = __uint_as_float(rr[0]) + __uint_as_float(rr[1]); }
  if (MODE == 1) l_reg += __builtin_amdgcn_exp2f(sink2 - shift);
  if (hi == 0) li_l[r32] = l_reg; asm volatile("s_waitcnt lgkmcnt(0)" ::: "memory");
  float rli[16];
#pragma unroll
  for (int r = 0; r < 16; ++r) rli[r] = __builtin_amdgcn_rcpf(li_l[crow(r, hi)]);
#pragma unroll
  for (int r = 0; r < 16; ++r) { const int orow = wid * 32 + crow(r, hi);
#pragma unroll
    for (int d0 = 0; d0 < 2; ++d0) {
      const float g = bf2f(gate0[(size_t)orow * LDG + d0 * 32 + r32]);
      mix0[(size_t)orow * 1024 + d0 * 32 + r32] = f2bf(o[d0][r] * rli[r] * silu_f(g));
    } }
#undef TROW
#undef SLOAD
#undef SWRITE
#undef MASKT
}

template <int NQK, int LDG, int RING>
__device__ __forceinline__ void attn_body2(const u16* __restrict__ Qb, const u16* __restrict__ Kh, const u16* __restrict__ Vh,
                                           const int NT, const float mbound, u16* __restrict__ mix0, const u16* __restrict__ gate0, char* lds) {
  constexpr int DK = NQK * 16;
  constexpr int SHM_V = 8192, SHM_K = 17408;
  int tid_ = threadIdx.x; asm volatile("" : "+v"(tid_));
  const int tid = tid_, wid = __builtin_amdgcn_readfirstlane(tid >> 6), lane = tid & 63, r32 = lane & 31, hi = lane >> 5;
  char* V_lds = lds; char* K_lds = lds + 5 * SHM_V;
  float* wsf = (float*)(lds + 5 * SHM_V + 5 * SHM_K) + wid * 64;
  float lsA = 0, lsB = 0; f32x16 oA[2] = {}, oB[2] = {}; bf16x8 qA[NQK], qB[NQK];
  const float shift = mbound > 80.f ? mbound - 80.f : 0.f;
  const u16* Qw = Qb + (size_t)(wid * 64 + r32) * DK + hi * 8;
#pragma unroll
  for (int d0 = 0; d0 < NQK; ++d0) { qA[d0] = *(const bf16x8*)(Qw + d0 * 16); qB[d0] = *(const bf16x8*)(Qw + 32 * DK + d0 * 16); }
  const int srow = tid >> 3, sc8 = tid & 7;
  const int kst0 = KSWZ(srow, sc8 * 16), kst1 = KSWZ(srow, 128 + sc8 * 16), vst = v_st2(srow, sc8 * 8);
  const int vb0 = (int)(uintptr_t)V_lds + v_rd_base(lane);
  const bool k1on = (NQK == 6) && (sc8 < 4);
  const unsigned koff0 = srow * DK + sc8 * 8, voff0 = srow * 64 + sc8 * 8;
  struct { bf16x8 k0, k1, v0; } st[RING == 1 ? 2 : 1];
#define SLOAD(i, kr) do { const u16* kp_ = Kh + (unsigned)((kr) * DK); st[i].k0 = *(const bf16x8*)(kp_ + koff0);   \
    if (k1on) st[i].k1 = *(const bf16x8*)(kp_ + koff0 + 64);                                                           \
    const u16* vp_ = Vh + (unsigned)((kr) * 64); st[i].v0 = *(const bf16x8*)(vp_ + voff0); } while (0)
#define SWRITE(b, i) do { *(bf16x8*)(K_lds + (b) * SHM_K + kst0) = st[i].k0; if (k1on) *(bf16x8*)(K_lds + (b) * SHM_K + kst1) = st[i].k1; \
    *(bf16x8*)(V_lds + (b) * SHM_V + vst) = st[i].v0; } while (0)
#define NXS(x) ((x) + 1 == 5 ? 0 : (x) + 1)
#define UNIT(PN0, PN1, QN, KS, PO0, PO1, LSO, OO, VS) do {                                                                      \
    qkt_fin<NQK>(PN0, PN1, K_lds + (KS) * SHM_K, QN, r32, hi, shift, PO0, PO1, LSO, pa0, pa1, pa2, pa3); SBAR();               \
    pv_exp(OO, vb0 + (VS) * SHM_V, pa0, pa1, pa2, pa3, PN0, PN1); SBAR(); } while (0)
  f32x16 pA0, pA1, pB0, pB1; bf16x8 pa0, pa1, pa2, pa3;
  if constexpr (RING == 1) {
  __syncthreads();
  SLOAD(0, 0); asm volatile("s_waitcnt vmcnt(0)" ::: "memory"); SWRITE(0, 0);
  SLOAD(0, 64); SWRITE(1, 0);
  SLOAD(0, 128); SWRITE(2, 0);
  if (3 < NT) SLOAD(0, 3 * 64);
  if (4 < NT) SLOAD(1, 4 * 64);
  __syncthreads();
  qkt<NQK>(pA0, pA1, K_lds, qA, r32, hi, shift); expall(pA0, pA1);
  int c = 0;
  for (int i = 0; 2 * i + 2 < NT; ++i) {
    const int s1 = NXS(c), s2 = NXS(s1), s3 = NXS(s2), s4 = NXS(s3);
    SBAR(); if (2 * i + 3 < NT) SWRITE(s3, 0); if (2 * i + 4 < NT) SWRITE(s4, 1);
    if (2 * i + 5 < NT) SLOAD(0, (2 * i + 5) * 64); if (2 * i + 6 < NT) SLOAD(1, (2 * i + 6) * 64); SBAR();
    UNIT(pB0, pB1, qB, c, pA0, pA1, lsA, oA, c);
    UNIT(pA0, pA1, qA, s1, pB0, pB1, lsB, oB, c);
    UNIT(pB0, pB1, qB, s1, pA0, pA1, lsA, oA, s1);
    UNIT(pA0, pA1, qA, s2, pB0, pB1, lsB, oB, s1);
    __syncthreads();
    c = s2;
  }
  { const int s1 = NXS(c);
    UNIT(pB0, pB1, qB, c, pA0, pA1, lsA, oA, c);
    UNIT(pA0, pA1, qA, s1, pB0, pB1, lsB, oB, c);
    UNIT(pB0, pB1, qB, s1, pA0, pA1, lsA, oA, s1);
    finishSM(pB0, pB1, lsB, pa0, pa1, pa2, pa3); SBAR();
    pv_all(oB, vb0 + s1 * SHM_V, pa0, pa1, pa2, pa3); }
  } else if constexpr (RING == 2) {
    __syncthreads();
    SLOAD(0, 0); asm volatile("s_waitcnt vmcnt(0)" ::: "memory"); SWRITE(0, 0);
    SLOAD(0, 64); SWRITE(1, 0);
    SLOAD(0, 128); SWRITE(2, 0);
    if (3 < NT) SLOAD(0, 3 * 64);
    __syncthreads();
    qkt<NQK>(pA0, pA1, K_lds, qA, r32, hi, shift); expall(pA0, pA1);
    int c = 0;
    for (int i = 0; 2 * i + 2 < NT; ++i) {
      const int s1 = NXS(c), s2 = NXS(s1), s3 = NXS(s2), s4 = NXS(s3);
      SBAR(); if (2 * i + 3 < NT) SWRITE(s3, 0); if (2 * i + 4 < NT) SLOAD(0, (2 * i + 4) * 64); SBAR();
      UNIT(pB0, pB1, qB, c, pA0, pA1, lsA, oA, c);
      UNIT(pA0, pA1, qA, s1, pB0, pB1, lsB, oB, c);
      SBAR(); if (2 * i + 4 < NT) SWRITE(s4, 0); if (2 * i + 5 < NT) SLOAD(0, (2 * i + 5) * 64); SBAR();
      UNIT(pB0, pB1, qB, s1, pA0, pA1, lsA, oA, s1);
      UNIT(pA0, pA1, qA, s2, pB0, pB1, lsB, oB, s1);
      __syncthreads();
      c = s2;
    }
    { const int s1 = NXS(c);
      UNIT(pB0, pB1, qB, c, pA0, pA1, lsA, oA, c);
      UNIT(pA0, pA1, qA, s1, pB0, pB1, lsB, oB, c);
      UNIT(pB0, pB1, qB, s1, pA0, pA1, lsA, oA, s1);
      finishSM(pB0, pB1, lsB, pa0, pa1, pa2, pa3); SBAR();
      pv_all(oB, vb0 + s1 * SHM_V, pa0, pa1, pa2, pa3); }
  } else {
#define NX3(x) ((x) + 1 == 3 ? 0 : (x) + 1)
    __syncthreads();
    SLOAD(0, 0); asm volatile("s_waitcnt vmcnt(0)" ::: "memory"); SWRITE(0, 0);
    SLOAD(0, 64); SWRITE(1, 0);
    if (2 < NT) SLOAD(0, 128);
    __syncthreads();
    qkt<NQK>(pA0, pA1, K_lds, qA, r32, hi, shift); expall(pA0, pA1);
    int c = 0;
    for (int t = 0; t + 1 < NT; ++t) {
      const int s1 = NX3(c), s2 = NX3(s1);
      SBAR(); if (t + 2 < NT) SWRITE(s2, 0);
      if (t + 3 < NT) SLOAD(0, (t + 3) * 64); SBAR();
      UNIT(pB0, pB1, qB, c, pA0, pA1, lsA, oA, c);
      UNIT(pA0, pA1, qA, s1, pB0, pB1, lsB, oB, c);
      __syncthreads();
      c = s1;
    }
    UNIT(pB0, pB1, qB, c, pA0, pA1, lsA, oA, c);
    finishSM(pB0, pB1, lsB, pa0, pa1, pa2, pa3); SBAR();
    pv_all(oB, vb0 + c * SHM_V, pa0, pa1, pa2, pa3);
#undef NX3
  }
#undef UNIT
#undef NXS
#undef SLOAD
#undef SWRITE
  float lA, lB;
  { auto rr = __builtin_amdgcn_permlane32_swap(__float_as_uint(lsA), __float_as_uint(lsA), false, false); lA = __uint_as_float(rr[0]) + __uint_as_float(rr[1]); }
  { auto rr = __builtin_amdgcn_permlane32_swap(__float_as_uint(lsB), __float_as_uint(lsB), false, false); lB = __uint_as_float(rr[0]) + __uint_as_float(rr[1]); }
  if (hi == 0) { wsf[r32] = lA; wsf[32 + r32] = lB; }
  asm volatile("s_waitcnt lgkmcnt(0)" ::: "memory");
#pragma unroll
  for (int g = 0; g < 2; ++g) {
    float rli[16];
#pragma unroll
    for (int r = 0; r < 16; ++r) rli[r] = __builtin_amdgcn_rcpf(wsf[g * 32 + crow(r, hi)]);
#pragma unroll
    for (int r = 0; r < 16; ++r) { const int orow = wid * 64 + g * 32 + crow(r, hi);
#pragma unroll
      for (int d0 = 0; d0 < 2; ++d0) {
        const float gt = bf2f(gate0[(size_t)orow * LDG + d0 * 32 + r32]);
        const float ov = g == 0 ? oA[d0][r] : oB[d0][r];
        mix0[(size_t)orow * 1024 + d0 * 32 + r32] = f2bf(ov * rli[r] * silu_f(gt));
      } }
  }
}

__global__ void __launch_bounds__(512, 1) mega(Params p) {
  extern __shared__ __attribute__((aligned(16))) char lds[];
  cg::grid_group grid = cg::this_grid();
  const int bid = blockIdx.x, nblk = gridDim.x;
  char* ws = p.ws;
  float* modv = (float*)(ws + OFF_MODV);
  u16* H = (u16*)(ws + OFF_H);
  u16* PP = (u16*)(ws + OFF_PP);
  float* XC1 = (float*)(ws + OFF_XC1);
  unsigned* xbar = (unsigned*)(ws + OFF_END);
  volatile LAS unsigned* xst = (volatile LAS unsigned*)(lds + LDS_BYTES - 256);
  if (threadIdx.x == 0) { xst[0] = 0u; xst[1] = 0u; }
  __syncthreads();
  XcdBarrier xb = xcd_barrier_post(xbar, xst);
  if (p.ph_lo > 1000) grid.sync();

  if (p.ph_lo <= 0 && 0 < p.ph_hi) {
  for (int u = bid; u < 192; u += nblk) mod_unit(p, u, lds);
  }
  if (p.ph_lo <= 0 && 0 + 1 < p.ph_hi) xcd_barrier(xb);
  if (p.ph_lo <= 1 && 1 < p.ph_hi) {
  for (int u = bid; u < 2064; u += nblk) transpose_unit(p, u, lds);
  adaln_phase(p.x, nullptr, p.ctx, modv, H);
  }
  if (p.ph_lo <= 1 && 1 + 1 < p.ph_hi) xcd_barrier(xb);
  if (p.ph_lo <= 2 && 2 < p.ph_hi) {
  { TileIter ti(130, 19); GPre g; int nt = 0, mt = 0; const u16* Wt = (const u16*)(ws + OFF_WT_IN_AB);
    if (ti.valid()) { ti.get(mt, nt); gemm_preload(H, 1024, Wt, 1024, mt * 256, nt * 128, g); }
    while (ti.valid()) {
      f32x16 acc[2][2]; const int m0 = mt * 256, n0 = nt * 128;
      gemm_tile<0>(H, 1024, Wt, 1024, 1024, m0, n0, acc, lds, g);
      ti.next(); if (ti.valid()) { ti.get(mt, nt); gemm_preload(H, 1024, Wt, 1024, mt * 256, nt * 128, g); }
      epi_bf16(acc, PP, LD_AB, m0, n0, lds);
    } }
  }
  if (p.ph_lo <= 2 && 2 + 1 < p.ph_hi) xcd_barrier(xb);
  if (p.ph_lo <= 3 && 3 < p.ph_hi) {
  { TileIter ti(130, 14); GPre g; int nt = 0, mt = 0;
    const u16* Wq = (const u16*)(ws + OFF_WT_UQ); const u16* Wkv = (const u16*)(ws + OFF_WT_UKV);
    if (ti.valid()) { ti.get(mt, nt); gemm_preload(nt < 6 ? PP : PP + 256, LD_AB, nt < 6 ? Wq : Wkv, 256, mt * 256, (nt < 6 ? nt : nt - 6) * 128, g); }
    while (ti.valid()) {
      f32x16 acc[2][2]; const int m0 = mt * 256, cn = nt, n0 = (nt < 6 ? nt : nt - 6) * 128;
      gemm_tile<0>(cn < 6 ? PP : PP + 256, LD_AB, cn < 6 ? Wq : Wkv, 256, 256, m0, n0, acc, lds, g);
      ti.next(); if (ti.valid()) { ti.get(mt, nt); gemm_preload(nt < 6 ? PP : PP + 256, LD_AB, nt < 6 ? Wq : Wkv, 256, mt * 256, (nt < 6 ? nt : nt - 6) * 128, g); }
      if (cn < 6) epi_bf16(acc, H, 768, m0, n0, lds); else epi_bf16(acc, (u16*)p.out, 1024, m0, n0, lds);
    } }
  }
  if (p.ph_lo <= 3 && 3 + 1 < p.ph_hi) xcd_barrier(xb);
  if (p.ph_lo <= 4 && 4 < p.ph_hi) {
  finalize0(p);
  }
  if (p.ph_lo <= 4 && 4 + 1 < p.ph_hi) xcd_barrier(xb);
  if (p.ph_lo <= 5 && 5 < p.ph_hi) {
  const float mbA = LOG2E * 9.7979590f * 1.02f * vmaxabs(p.q_gain, 96) * vmaxabs(p.k_gain, 96);
  const float mbB = LOG2E * 8.f * 1.02f * vmaxabs(p.gq_gain, 64) * vmaxabs(p.gk_gain, 64);
  for (int it = bid; it < 1056; it += nblk) {
    if (it < 512) {
      const int round = it >> 8, blk = it & 255, xcd = blk & 7, cl = blk >> 3;
      const int pair = xcd * 2 + round, b = pair >> 3, h = pair & 7, qoff = cl * 512;
      const size_t r0 = (size_t)b * SEQ + qoff;
      attn_body2<6, LD_AB, 2>((const u16*)(ws + OFF_QA) + ((size_t)(b * 8 + h) * SEQ + qoff) * 96,
                                  (const u16*)(ws + OFF_KA) + (size_t)(b * 8 + h) * KVLEN * 96, (const u16*)(ws + OFF_VA) + (size_t)(b * 8 + h) * KVLEN * 64,
                                  KVLEN / 64, mbA, H + r0 * 1024 + h * 64, PP + r0 * LD_AB + 1312 + h * 64, lds);
    } else if (it < 1024) {
      const int i2 = it - 512, g = i2 >> 8, blk = i2 & 255, xcd = blk & 7, cl = blk >> 3;
      const int pi = xcd >> 1, b = pi >> 1, kvh = pi & 1, idx = (xcd & 1) * 64 + g * 32 + cl;
      const int h = kvh * 4 + (idx >> 5), qoff = (idx & 31) * 512;
      const size_t r0 = (size_t)b * SEQ + qoff;
      attn_body2<4, LD_AB, 1>((const u16*)(ws + OFF_QB) + ((size_t)(b * 8 + h) * SEQ + qoff) * 64,
                           (const u16*)(ws + OFF_KB) + (size_t)(b * 2 + kvh) * KVLEN * 64, (const u16*)(ws + OFF_VB) + (size_t)(b * 2 + kvh) * KVLEN * 64,
                           KVLEN / 64, mbB, H + r0 * 1024 + 512 + h * 64, PP + r0 * LD_AB + 1312 + 512 + h * 64, lds);
    } else {
      const int ci = it - 1024, b = (ci >> 3) & 1, h = ci & 7; const bool mla = ci < 16; const int kvh = mla ? h : (h >> 2);
      const size_t r0 = (size_t)NLAT + b * CL, qrow = (size_t)(b * 8 + h) * CL;
      if (mla) attn_body<6, 0, LD_AB>((const u16*)(ws + OFF_QCA) + qrow * 96, (const u16*)(ws + OFF_KA) + (size_t)(b * 8 + kvh) * KVLEN * 96,
                                      (const u16*)(ws + OFF_VA) + (size_t)(b * 8 + kvh) * KVLEN * 64, CL / 64, 0, 0.f, mbA, H + r0 * 1024 + h * 64, PP + r0 * LD_AB + 1312 + h * 64, lds);
      else attn_body<4, 0, LD_AB>((const u16*)(ws + OFF_QCB) + qrow * 64, (const u16*)(ws + OFF_KB) + (size_t)(b * 2 + kvh) * KVLEN * 64,
                                  (const u16*)(ws + OFF_VB) + (size_t)(b * 2 + kvh) * KVLEN * 64, CL / 64, 0, 0.f, mbB, H + r0 * 1024 + 512 + h * 64, PP + r0 * LD_AB + 1312 + 512 + h * 64, lds);
    }
  }
  }
  if (p.ph_lo <= 5 && 5 + 1 < p.ph_hi) xcd_barrier(xb);
  if (p.ph_lo <= 6 && 6 < p.ph_hi) {
  { TileIter ti(130, 8); GPre g; int nt = 0, mt = 0; const u16* Wt = (const u16*)(ws + OFF_WT_OUT_AB);
    if (ti.valid()) { ti.get(mt, nt); gemm_preload(H, 1024, Wt, 1024, mt * 256, nt * 128, g); }
    while (ti.valid()) {
      f32x16 acc[2][2]; const int m0 = mt * 256, n0 = nt * 128; const bool lat = m0 < NLAT;
      const int tid_ = opaque_tid(), wid_ = tid_ >> 6, lane_ = tid_ & 63;
      const size_t eoff = (size_t)((lat ? m0 : m0 - NLAT) + (wid_ & 3) * 64 + (lane_ >> 4)) * 1024 + n0 + (wid_ >> 2) * 64 + 4 * (lane_ & 15);
      ResPre rp;
      gemm_tile<1>(H, 1024, Wt, 1024, 1024, m0, n0, acc, lds, g, (lat ? p.x : p.ctx) + eoff, &rp);
      ti.next(); if (ti.valid()) { ti.get(mt, nt); gemm_preload(H, 1024, Wt, 1024, mt * 256, nt * 128, g); }
      if (lat) epi_res<false, true>(acc, rp, (u16*)(ws + OFF_X1B) + eoff, modv + (m0 >> 14) * 3072 + 2048, n0, lds);
      else epi_res<false, false>(acc, rp, XC1 + eoff, modv + 2 * 3072 + 2048, n0, lds);
    } }
  }
  if (p.ph_lo <= 6 && 6 + 1 < p.ph_hi) xcd_barrier(xb);
  if (p.ph_lo <= 7 && 7 < p.ph_hi) {
  adaln_phase(nullptr, (const u16*)(ws + OFF_X1B), XC1, modv + 3 * 3072, H);
  }
  if (p.ph_lo <= 7 && 7 + 1 < p.ph_hi) xcd_barrier(xb);
  if (p.ph_lo <= 8 && 8 < p.ph_hi) {
  { TileIter ti(130, 26); GPre g; int nt = 0, mt = 0; const u16* Wt = (const u16*)(ws + OFF_WT_IN_CD);
    if (ti.valid()) { ti.get(mt, nt); gemm_preload(H, 1024, Wt, 1024, mt * 256, nt * 128, g); }
    while (ti.valid()) {
      f32x16 acc[2][2]; const int m0 = mt * 256, n0 = nt * 128;
      gemm_tile<0>(H, 1024, Wt, 1024, 1024, m0, n0, acc, lds, g);
      ti.next(); if (ti.valid()) { ti.get(mt, nt); gemm_preload(H, 1024, Wt, 1024, mt * 256, nt * 128, g); }
      epi_bf16(acc, PP, LD_CD, m0, n0, lds);
    } }
  }
  if (p.ph_lo <= 8 && 8 + 1 < p.ph_hi) xcd_barrier(xb);
  if (p.ph_lo <= 9 && 9 < p.ph_hi) {
  finalize1(p);
  }
  if (p.ph_lo <= 9 && 9 + 1 < p.ph_hi) xcd_barrier(xb);
  if (p.ph_lo <= 10 && 10 < p.ph_hi) {
  const float mbW = LOG2E * 8.f * 1.02f * vmaxabs(p.win_q_gain, 64) * vmaxabs(p.win_k_gain, 64);
  for (int it = bid; it < 1024; it += nblk) {
    const int g = it >> 8, blk = it & 255, xcd = blk & 7, cl = blk >> 3;
    const int pi = xcd >> 1, b = pi >> 1, kvh = pi & 1, idx = (xcd & 1) * 128 + g * 32 + cl;
    const int h = kvh * 4 + (idx >> 6), qblk = idx & 63;
    const size_t r0 = (size_t)b * SEQ + qblk * 256;
    attn_body<4, 1, LD_CD>((const u16*)(ws + OFF_Q2) + ((size_t)(b * 8 + h) * SEQ + qblk * 256) * 64,
                    (const u16*)(ws + OFF_K2) + (size_t)(b * 2 + kvh) * KV2LEN * 64, (const u16*)(ws + OFF_V2) + (size_t)(b * 2 + kvh) * KV2LEN * 64,
                    12, qblk * 256, p.win_sink[h] * LOG2E, mbW, H + r0 * 1024 + h * 64, PP + r0 * LD_CD + 2304 + h * 64, lds);
  }
  }
  if (p.ph_lo <= 10 && 10 + 1 < p.ph_hi) xcd_barrier(xb);
  if (p.ph_lo <= 11 && 11 < p.ph_hi) {
  { TileIter ti(128, 8); GPre g; int nt = 0, mt = 0; const u16* Wt = (const u16*)(ws + OFF_WT_OUT_CD);
    if (ti.valid()) { ti.get(mt, nt); gemm_preload(H, 1024, Wt, 1024, mt * 256, nt * 128, g); }
    while (ti.valid()) {
      f32x16 acc[2][2]; const int m0 = mt * 256, n0 = nt * 128;
      const int tid_ = opaque_tid(), wid_ = tid_ >> 6, lane_ = tid_ & 63;
      const size_t eoff = (size_t)(m0 + (wid_ & 3) * 64 + (lane_ >> 4)) * 1024 + n0 + (wid_ >> 2) * 64 + 4 * (lane_ & 15);
      ResPre rp;
      gemm_tile<2>(H, 1024, Wt, 1024, 1024, m0, n0, acc, lds, g, (const u16*)(ws + OFF_X1B) + eoff, &rp);
      ti.next(); if (ti.valid()) { ti.get(mt, nt); gemm_preload(H, 1024, Wt, 1024, mt * 256, nt * 128, g); }
      epi_res<true, false>(acc, rp, p.out + eoff, modv + 3 * 3072 + (m0 >> 14) * 3072 + 2048, n0, lds);
    } }
  }
}

extern "C" void kernel_launch(void* const* d_in, const int* in_sizes, int n_in, void* d_out, int out_size, void* d_ws, size_t ws_size, hipStream_t stream) {
  static int grid_blocks = 0;
  if (!grid_blocks) {
    if (n_in != 22 || out_size != NLAT * DM || ws_size < OFF_END + 16384) {
      fprintf(stderr, "kernel_launch: shape/ws mismatch n_in %d out %d ws %zu need %zu\n", n_in, out_size, ws_size, (size_t)OFF_END);
      return;
    }
    if (hipFuncSetAttribute((const void*)mega, hipFuncAttributeMaxDynamicSharedMemorySize, LDS_BYTES) != hipSuccess) {
      fprintf(stderr, "kernel_launch: hipFuncSetAttribute failed\n"); return;
    }
    int dev = 0, cus = 0, per_cu = 0;
    (void)hipGetDevice(&dev);
    (void)hipDeviceGetAttribute(&cus, hipDeviceAttributeMultiprocessorCount, dev);
    (void)hipOccupancyMaxActiveBlocksPerMultiprocessor(&per_cu, mega, 512, LDS_BYTES);
    if (per_cu < 1) { fprintf(stderr, "kernel_launch: occupancy 0\n"); return; }
    grid_blocks = cus;
  }
  Params p{};
  p.x = (const float*)d_in[0]; p.c = (const float*)d_in[1]; p.ctx = (const float*)d_in[2]; p.c_ctx = (const float*)d_in[3];
  p.mod_w = (const float*)d_in[4]; p.mod_b = (const float*)d_in[5]; p.ab_w_in = (const float*)d_in[6]; p.ab_w_out = (const float*)d_in[7];
  p.cq_gain = (const float*)d_in[8]; p.ckv_gain = (const float*)d_in[9]; p.w_uq = (const float*)d_in[10]; p.w_ukv = (const float*)d_in[11];
  p.q_gain = (const float*)d_in[12]; p.k_gain = (const float*)d_in[13]; p.gq_gain = (const float*)d_in[14]; p.gk_gain = (const float*)d_in[15];
  p.cd_w_in = (const float*)d_in[16]; p.cd_w_out = (const float*)d_in[17]; p.win_q_gain = (const float*)d_in[18]; p.win_k_gain = (const float*)d_in[19];
  p.win_sink = (const float*)d_in[20]; p.conv_w = (const float*)d_in[21];
  p.out = (float*)d_out; p.ws = (char*)d_ws;
#if MULTI_LAUNCH
  for (int ph = 0; ph < 12; ++ph) {
    p.ph_lo = ph; p.ph_hi = ph + 1;
    hipLaunchKernelGGL(mega, dim3(grid_blocks), dim3(512), LDS_BYTES, stream, p);
  }
#else
  p.ph_lo = 0; p.ph_hi = 12;
  if (hipMemsetAsync((char*)d_ws + OFF_END, 0, XCD_BAR_WORDS * 4, stream) != hipSuccess) { fprintf(stderr, "kernel_launch: hipMemsetAsync of the barrier words failed\n"); return; }
  void* args[] = {&p};
  hipError_t e = hipLaunchCooperativeKernel((void*)mega, dim3(grid_blocks), dim3(512), args, LDS_BYTES, stream);
  if (e != hipSuccess) fprintf(stderr, "cooperative launch failed: %s (grid %d)\n", hipGetErrorString(e), grid_blocks);
#endif
}
```

```cpp
#include <hip/hip_runtime.h>
#include <hip/hip_cooperative_groups.h>
#include <cstdio>
#include <cstdint>
namespace cg = cooperative_groups;

typedef unsigned short u16;
using bf16x8 = __attribute__((ext_vector_type(8))) short;
using s16x4  = __attribute__((ext_vector_type(4))) short;
using f32x16 = __attribute__((ext_vector_type(16))) float;
using u32x4  = __attribute__((ext_vector_type(4))) unsigned;
using u32x2  = __attribute__((ext_vector_type(2))) unsigned;

constexpr int NB = 2, SEQ = 16384, DM = 1024, CL = 256;
constexpr int NLAT = NB * SEQ;
constexpr int NROW = NLAT + NB * CL;
constexpr int KVLEN = CL + SEQ;
constexpr int KV2LEN = KVLEN + 128;
constexpr int LD_AB = 2432, LD_CD = 3328;
constexpr float EPS = 1e-6f;
constexpr float QS_A = 0.14724461f;
constexpr float QS_B = 0.18033688f;
constexpr float LOG2E = 1.4426950408889634f;

constexpr size_t OFF_MODV      = 0;
constexpr size_t OFF_WT_IN_AB  = 73728;
constexpr size_t OFF_WT_OUT_AB = OFF_WT_IN_AB + (size_t)LD_AB * 1024 * 2;
constexpr size_t OFF_WT_UQ     = OFF_WT_OUT_AB + (size_t)1024 * 1024 * 2;
constexpr size_t OFF_WT_UKV    = OFF_WT_UQ + (size_t)768 * 256 * 2;
constexpr size_t OFF_WT_IN_CD  = OFF_WT_UKV + (size_t)1024 * 256 * 2;
constexpr size_t OFF_WT_OUT_CD = OFF_WT_IN_CD + (size_t)3328 * 1024 * 2;
constexpr size_t OFF_XC1       = OFF_WT_OUT_CD + (size_t)1024 * 1024 * 2;
constexpr size_t OFF_H         = OFF_XC1 + (size_t)512 * 1024 * 4;
constexpr size_t OFF_PP        = OFF_H + (size_t)NROW * 1024 * 2;
constexpr size_t OFF_QA        = OFF_PP + (size_t)NROW * 3328 * 2;
constexpr size_t OFF_QCA       = OFF_QA + (size_t)NB * 8 * SEQ * 96 * 2;
constexpr size_t OFF_KA        = OFF_QCA + (size_t)NB * 8 * CL * 96 * 2;
constexpr size_t OFF_VA        = OFF_KA + (size_t)NB * 8 * KVLEN * 96 * 2;
constexpr size_t OFF_QB        = OFF_VA + (size_t)NB * 8 * KVLEN * 64 * 2;
constexpr size_t OFF_QCB       = OFF_QB + (size_t)NB * 8 * SEQ * 64 * 2;
constexpr size_t OFF_KB        = OFF_QCB + (size_t)NB * 8 * CL * 64 * 2;
constexpr size_t OFF_VB        = OFF_KB + (size_t)NB * 2 * KVLEN * 64 * 2;
constexpr size_t OFF_END       = OFF_VB + (size_t)NB * 2 * KVLEN * 64 * 2;
constexpr size_t OFF_Q2        = OFF_QA;
constexpr size_t OFF_K2        = OFF_Q2 + (size_t)NB * 8 * SEQ * 64 * 2;
constexpr size_t OFF_V2        = OFF_K2 + (size_t)NB * 2 * KV2LEN * 64 * 2;
constexpr size_t OFF_X1B       = OFF_QA + ((size_t)64 << 20);
static_assert(OFF_V2 + (size_t)NB * 2 * KV2LEN * 64 * 2 <= OFF_X1B && OFF_X1B + (size_t)NLAT * 1024 * 2 <= OFF_END, "x1 alias");
static_assert(OFF_V2 + (size_t)NB * 2 * KV2LEN * 64 * 2 <= OFF_END, "alias overflow");

constexpr int LDS_BYTES = 147456 + 256;
#ifndef MULTI_LAUNCH
#define MULTI_LAUNCH 0
#endif

struct Params {
  const float *x, *c, *ctx, *c_ctx, *mod_w, *mod_b, *ab_w_in, *ab_w_out, *cq_gain, *ckv_gain, *w_uq, *w_ukv,
      *q_gain, *k_gain, *gq_gain, *gk_gain, *cd_w_in, *cd_w_out, *win_q_gain, *win_k_gain, *win_sink, *conv_w;
  float* out;
  char* ws;
  int ph_lo, ph_hi;
};

#define SBAR() __builtin_amdgcn_sched_barrier(0)
__device__ __forceinline__ int crow(int r, int hi) { return (r & 3) + 8 * (r >> 2) + 4 * hi; }
typedef float f32x2_t __attribute__((ext_vector_type(2)));
typedef __bf16 bf16x2_t __attribute__((ext_vector_type(2)));
__device__ __forceinline__ unsigned cvtpk(float lo, float hi) { f32x2_t v = {lo, hi}; bf16x2_t b = __builtin_convertvector(v, bf16x2_t); return __builtin_bit_cast(unsigned, b); }
__device__ __forceinline__ u16 f2bf(float x) { return (u16)(cvtpk(x, 0.f) & 0xffffu); }
__device__ __forceinline__ float bf2f(u16 x) { return __uint_as_float(((unsigned)x) << 16); }
__device__ __forceinline__ float bflo(unsigned w) { return __uint_as_float(w << 16); }
__device__ __forceinline__ float bfhi(unsigned w) { return __uint_as_float(w & 0xffff0000u); }
__device__ __forceinline__ float wave_sum(float v) {
#pragma unroll
  for (int o = 32; o >= 1; o >>= 1) v += __shfl_xor(v, o);
  return v;
}
__device__ __forceinline__ int opaque_tid() { int t = threadIdx.x; asm volatile("" : "+v"(t)); return t; }
__device__ __forceinline__ float vmaxabs(const float* g, int n) { float m = 0.f; for (int i = 0; i < n; ++i) m = fmaxf(m, fabsf(g[i])); return m; }
__device__ __forceinline__ float silu_f(float g) { return g / (1.f + __expf(-g)); }


__device__ __forceinline__ void gbar(unsigned* cnt, unsigned target) {
  asm volatile("s_waitcnt vmcnt(0)" ::: "memory");
  __syncthreads();
  if (threadIdx.x == 0) {
    __builtin_amdgcn_fence(__ATOMIC_RELEASE, "agent");
    asm volatile("s_waitcnt vmcnt(0)" ::: "memory");
    __hip_atomic_fetch_add(cnt, 1u, __ATOMIC_RELAXED, __HIP_MEMORY_SCOPE_AGENT);
    unsigned sp = 0;
    while (__hip_atomic_load(cnt, __ATOMIC_RELAXED, __HIP_MEMORY_SCOPE_AGENT) < target) { __builtin_amdgcn_s_sleep(1); if (++sp > (1u << 24)) break; }
    __builtin_amdgcn_fence(__ATOMIC_ACQUIRE, "agent");
    asm volatile("s_waitcnt vmcnt(0)" ::: "memory");
  }
  __syncthreads();
}


#define XB_TMO      128
#define XB_XCNT(j)  (256  + 64 * (j))
#define XB_XSUB(j)  (1280 + 64 * (j))
#define XB_XGEN(j)  (2304 + 64 * (j))
#define XB_TOP      3328
#define XB_TOPGEN   3392
#define XCD_BAR_WORDS 3456
#define XB_SPIN_CAP (1u << 20)
#define LAS __attribute__((address_space(3)))
__device__ __forceinline__ unsigned xb_ld(unsigned* p)              { return __hip_atomic_load(p, __ATOMIC_RELAXED, __HIP_MEMORY_SCOPE_AGENT); }
__device__ __forceinline__ unsigned xb_add(unsigned* p, unsigned v) { return __hip_atomic_fetch_add(p, v, __ATOMIC_RELAXED, __HIP_MEMORY_SCOPE_AGENT); }
__device__ __forceinline__ unsigned xb_xcc_id() { return (unsigned)__builtin_amdgcn_s_getreg((3 << 11) | 20) & 0xFu; }
#define XB_SPIN(cond, bar) do { unsigned _sp = 0; while (cond) { __builtin_amdgcn_s_sleep(1); \
    if ((++_sp & 255u) == 0u) { if (xb_ld(&(bar)[XB_TMO])) break; if (_sp > XB_SPIN_CAP) { atomicAdd(&(bar)[XB_TMO], 1u); break; } } } } while (0)
struct XcdBarrier { unsigned* bar; unsigned x; volatile LAS unsigned* st; };
__device__ __forceinline__ XcdBarrier xcd_barrier_post(unsigned* bar, volatile LAS unsigned* st) {
  XcdBarrier b; b.bar = bar; b.x = xb_xcc_id(); b.st = st;
  if (threadIdx.x == 0) (void)xb_add(&bar[XB_XCNT(b.x)], 1u);
  return b;
}
__device__ __forceinline__ void xcd_barrier_complete(unsigned* bar, unsigned x, unsigned& nloc, unsigned& nx) {
  const unsigned G = gridDim.x * gridDim.y * gridDim.z;
  unsigned sum, cnt, mine, sp = 0u;
  for (;;) {
    sum = 0u; cnt = 0u; mine = 0u;
#pragma unroll
    for (unsigned j = 0; j < 16; ++j) { const unsigned c = xb_ld(&bar[XB_XCNT(j)]); sum += c; cnt += (c > 0u) ? 1u : 0u; mine = (j == x) ? c : mine; }
    if (sum == G) break;
    __builtin_amdgcn_s_sleep(1);
    if ((++sp & 255u) == 0u) { if (xb_ld(&bar[XB_TMO])) break; if (sp > XB_SPIN_CAP) { atomicAdd(&bar[XB_TMO], 1u); break; } }
  }
  nloc = mine > 0u ? mine : 1u; nx = cnt > 0u ? cnt : 1u;
}
__device__ __forceinline__ void xcd_barrier(const XcdBarrier& b) {
  asm volatile("s_waitcnt vmcnt(0)" ::: "memory");
  __syncthreads();
  if (threadIdx.x == 0) {
    unsigned* bar = b.bar;
    __builtin_amdgcn_s_waitcnt(0);
    unsigned nloc = b.st[0], nx = b.st[1];
    if (nloc == 0u) { xcd_barrier_complete(bar, b.x, nloc, nx); b.st[0] = nloc; b.st[1] = nx; }
    const unsigned old = xb_add(&bar[XB_XSUB(b.x)], 1u);
    const unsigned gen = old / nloc;
    if (old + 1u == (gen + 1u) * nloc) {
      __builtin_amdgcn_fence(__ATOMIC_RELEASE, "agent");
      asm volatile("s_waitcnt vmcnt(0)" ::: "memory");
      const unsigned og = xb_add(&bar[XB_TOP], 1u);
      const unsigned tg = og / nx;
      if (og + 1u == (tg + 1u) * nx) xb_add(&bar[XB_TOPGEN], 1u);
      else XB_SPIN(xb_ld(&bar[XB_TOPGEN]) == tg, bar);
      __builtin_amdgcn_fence(__ATOMIC_ACQUIRE, "agent");
      xb_add(&bar[XB_XGEN(b.x)], 1u);
      asm volatile("s_waitcnt vmcnt(0)" ::: "memory");
    } else {
      XB_SPIN(xb_ld(&bar[XB_XGEN(b.x)]) == gen, bar);
      __builtin_amdgcn_fence(__ATOMIC_ACQUIRE, "agent");
      asm volatile("s_waitcnt vmcnt(0)" ::: "memory");
    }
  }
  __syncthreads();
}

__device__ void mod_unit(const Params& p, int u, char* lds) {
  const int tid = opaque_tid();
  const int layer = u / 96, n0 = (u % 96) * 32, col = tid & 31, ks = tid >> 5;
  const float* W = p.mod_w + (size_t)layer * 1024 * 3072 + n0 + col;
  float a0 = 0, a1 = 0, a2 = 0;
  for (int k = ks * 64; k < ks * 64 + 64; ++k) {
    float w = W[(size_t)k * 3072];
    a0 += silu_f(p.c[k]) * w; a1 += silu_f(p.c[1024 + k]) * w; a2 += silu_f(p.c_ctx[k]) * w;
  }
  float* red = (float*)lds;
  red[(0 * 16 + ks) * 32 + col] = a0; red[(1 * 16 + ks) * 32 + col] = a1; red[(2 * 16 + ks) * 32 + col] = a2;
  __syncthreads();
  if (tid < 96) {
    int w = tid >> 5, cc = tid & 31; float s = 0;
    for (int i = 0; i < 16; ++i) s += red[(w * 16 + i) * 32 + cc];
    float* modv = (float*)(p.ws + OFF_MODV);
    modv[(layer * 3 + w) * 3072 + n0 + cc] = s + p.mod_b[layer * 3072 + n0 + cc];
  }
  __syncthreads();
}

__device__ void transpose_unit(const Params& p, int u, char* lds) {
  const float* src; const float* gain = nullptr; int K, N; u16* dst; int ul;
  if (u < 608)       { ul = u;        src = p.ab_w_in;  K = 1024; N = 2336; dst = (u16*)(p.ws + OFF_WT_IN_AB); }
  else if (u < 864)  { ul = u - 608;  src = p.ab_w_out; K = 1024; N = 1024; dst = (u16*)(p.ws + OFF_WT_OUT_AB); }
  else if (u < 912)  { ul = u - 864;  src = p.w_uq;     K = 256;  N = 768;  dst = (u16*)(p.ws + OFF_WT_UQ); gain = p.cq_gain; }
  else if (u < 976)  { ul = u - 912;  src = p.w_ukv;    K = 256;  N = 1024; dst = (u16*)(p.ws + OFF_WT_UKV); gain = p.ckv_gain; }
  else if (u < 1808) { ul = u - 976;  src = p.cd_w_in;  K = 1024; N = 3328; dst = (u16*)(p.ws + OFF_WT_IN_CD); }
  else               { ul = u - 1808; src = p.cd_w_out; K = 1024; N = 1024; dst = (u16*)(p.ws + OFF_WT_OUT_CD); }
  const int nkt = K / 64, kt = ul % nkt, nt = ul / nkt, k0 = kt * 64, n0 = nt * 64, tid = opaque_tid();
  float* tile = (float*)lds;
#pragma unroll
  for (int e = 0; e < 8; ++e) {
    int i = (tid >> 6) + 8 * e, j = tid & 63, n = n0 + j;
    float v = (n < N) ? src[(size_t)(k0 + i) * N + n] : 0.f;
    if (gain) v *= gain[k0 + i];
    tile[i * 65 + j] = v;
  }
  __syncthreads();
#pragma unroll
  for (int e = 0; e < 8; ++e) {
    int i2 = (tid >> 6) + 8 * e, j2 = tid & 63;
    dst[(size_t)(n0 + i2) * K + k0 + j2] = f2bf(tile[j2 * 65 + i2]);
  }
  __syncthreads();
}

template <bool BF>
__device__ __forceinline__ void adaln_latent(const void* __restrict__ xsrc, const float* __restrict__ modl, u16* __restrict__ H, int gw, int nw, int lane) {
  constexpr int NV = BF ? 2 : 4;
  constexpr int CW = BF ? 8 : 4;
  u32x4 cur[NV], nxt[NV];
  float sh[NV][CW], sc[NV][CW];
  auto ld = [&](u32x4 (&d)[NV], int r) {
#pragma unroll
    for (int i = 0; i < NV; ++i)
      d[i] = BF ? *(const u32x4*)((const u16*)xsrc + (size_t)r * 1024 + 8 * (lane + 64 * i)) : *(const u32x4*)((const float*)xsrc + (size_t)r * 1024 + 4 * (lane + 64 * i));
  };
  int r = gw; if (r < NLAT) ld(cur, r);
  int lastb = -1;
  for (; r < NLAT; r += nw) {
    const int rn = r + nw;
    if (rn < NLAT) ld(nxt, rn);
    const int b = r >> 14;
    if (b != lastb) { lastb = b; const float* m = modl + b * 3072;
#pragma unroll
      for (int i = 0; i < NV; ++i)
#pragma unroll
        for (int e = 0; e < CW; ++e) { sh[i][e] = m[CW * (lane + 64 * i) + e]; sc[i][e] = 1.f + m[1024 + CW * (lane + 64 * i) + e]; } }
    float f[NV][CW]; float ss = 0;
#pragma unroll
    for (int i = 0; i < NV; ++i)
#pragma unroll
      for (int e = 0; e < CW; ++e) {
        f[i][e] = BF ? ((e & 1) ? bfhi(cur[i][e >> 1]) : bflo(cur[i][e >> 1])) : __uint_as_float(cur[i][e]);
        ss += f[i][e] * f[i][e]; }
    ss = wave_sum(ss);
    const float rstd = rsqrtf(ss * (1.f / 1024) + EPS);
#pragma unroll
    for (int i = 0; i < NV; ++i) {
      float y[CW];
#pragma unroll
      for (int e = 0; e < CW; ++e) y[e] = f[i][e] * rstd * sc[i][e] + sh[i][e];
      if (BF) { const u32x4 o = {cvtpk(y[0], y[1]), cvtpk(y[2], y[3]), cvtpk(y[4 % CW], y[5 % CW]), cvtpk(y[6 % CW], y[7 % CW])}; *(u32x4*)(H + (size_t)r * 1024 + 8 * (lane + 64 * i)) = o; }
      else { const u32x2 o = {cvtpk(y[0], y[1]), cvtpk(y[2], y[3])}; *(u32x2*)(H + (size_t)r * 1024 + 4 * (lane + 64 * i)) = o; }
    }
#pragma unroll
    for (int i = 0; i < NV; ++i) cur[i] = nxt[i];
  }
}
__device__ void adaln_phase(const float* xlat, const u16* xlat_bf, const float* xctx, const float* modl, u16* H) {
  const int tid = opaque_tid(), lane = tid & 63, gw = blockIdx.x * 8 + (tid >> 6), nw = gridDim.x * 8;
  if (xlat_bf != nullptr) adaln_latent<true>(xlat_bf, modl, H, gw, nw, lane); else adaln_latent<false>(xlat, modl, H, gw, nw, lane);
  for (int r = NLAT + gw; r < NROW; r += nw) {
    const float* src = xctx + (size_t)(r - NLAT) * 1024;
    const float* m = modl + 2 * 3072;
    float4 v[4]; float ss = 0;
#pragma unroll
    for (int i = 0; i < 4; ++i) { v[i] = ((const float4*)src)[lane + 64 * i]; ss += v[i].x * v[i].x + v[i].y * v[i].y + v[i].z * v[i].z + v[i].w * v[i].w; }
    ss = wave_sum(ss);
    const float rstd = rsqrtf(ss * (1.f / 1024) + EPS);
#pragma unroll
    for (int i = 0; i < 4; ++i) {
      int c = 4 * (lane + 64 * i);
      float4 sh = *(const float4*)(m + c), sc = *(const float4*)(m + 1024 + c);
      float y0 = v[i].x * rstd * (1.f + sc.x) + sh.x, y1 = v[i].y * rstd * (1.f + sc.y) + sh.y;
      float y2 = v[i].z * rstd * (1.f + sc.z) + sh.z, y3 = v[i].w * rstd * (1.f + sc.w) + sh.w;
      u32x2 o = {cvtpk(y0, y1), cvtpk(y2, y3)};
      *(u32x2*)(H + (size_t)r * 1024 + c) = o;
    }
  }
}

#define GSWZ(row, colB) ((row) * 128 + ((colB) ^ ((((row) >> 1) & 7) << 4)))
struct ResPre { float4 v[16]; u32x2 w[16]; };
struct GPre { bf16x8 ra[4], rb[2]; };
__device__ __forceinline__ void gemm_preload(const u16* __restrict__ A, int lda, const u16* __restrict__ Bt, int ldb, int m0, int n0, GPre& g) {
  const int tid = opaque_tid(), srow = tid >> 3, sch = tid & 7;
  const u16* ap = A + (size_t)(m0 + srow) * lda + sch * 8;
  const u16* bp = Bt + (size_t)(n0 + srow) * ldb + sch * 8;
#pragma unroll
  for (int i = 0; i < 4; ++i) g.ra[i] = *(const bf16x8*)(ap + (size_t)(64 * i) * lda);
#pragma unroll
  for (int i = 0; i < 2; ++i) g.rb[i] = *(const bf16x8*)(bp + (size_t)(64 * i) * ldb);
}
template <int PRE>
__device__ __forceinline__ void gemm_tile(const u16* __restrict__ A, int lda, const u16* __restrict__ Bt, int ldb, int K,
                                          int m0, int n0, f32x16 (&acc)[2][2], char* lds, GPre& g, const void* resp = nullptr, ResPre* rp = nullptr) {
  const int tid = opaque_tid(), wid = tid >> 6, lane = tid & 63, r32 = lane & 31, hi = lane >> 5;
  const int wm = wid & 3, wn = wid >> 2;
  char* As = lds;
  char* Bs = lds + 98304;
  const int srow = tid >> 3, sch = tid & 7;
  const u16* ap = A + (size_t)(m0 + srow) * lda + sch * 8;
  const u16* bp = Bt + (size_t)(n0 + srow) * ldb + sch * 8;
  const int sw = GSWZ(srow, sch * 16);
  bf16x8 (&ra)[4] = g.ra; bf16x8 (&rb)[2] = g.rb;
#pragma unroll
  for (int i = 0; i < 2; ++i) for (int j = 0; j < 2; ++j) acc[i][j] = f32x16{};
  const int nk = K / 64;
  __syncthreads();
#pragma unroll
  for (int i = 0; i < 4; ++i) *(bf16x8*)(As + sw + i * 8192) = ra[i];
#pragma unroll
  for (int i = 0; i < 2; ++i) *(bf16x8*)(Bs + sw + i * 8192) = rb[i];
  if (1 < nk) {
#pragma unroll
    for (int i = 0; i < 4; ++i) ra[i] = *(const bf16x8*)(ap + (size_t)(64 * i) * lda + 64);
#pragma unroll
    for (int i = 0; i < 2; ++i) rb[i] = *(const bf16x8*)(bp + (size_t)(64 * i) * ldb + 64);
  }
  __syncthreads();
  const int arow0 = wm * 64 + r32, brow0 = wn * 64 + r32;
  int st = 0;
  for (int kt = 0; kt < nk; ++kt) {
    const int stn = (st == 2) ? 0 : st + 1;
    if (kt + 1 < nk) {
      char* An = As + stn * 32768; char* Bn = Bs + stn * 16384;
#pragma unroll
      for (int i = 0; i < 4; ++i) *(bf16x8*)(An + sw + i * 8192) = ra[i];
#pragma unroll
      for (int i = 0; i < 2; ++i) *(bf16x8*)(Bn + sw + i * 8192) = rb[i];
    }
    if (kt + 2 < nk) {
#pragma unroll
      for (int i = 0; i < 4; ++i) ra[i] = *(const bf16x8*)(ap + (size_t)(64 * i) * lda + (kt + 2) * 64);
#pragma unroll
      for (int i = 0; i < 2; ++i) rb[i] = *(const bf16x8*)(bp + (size_t)(64 * i) * ldb + (kt + 2) * 64);
    }
    if (PRE == 1 && kt == 0) {
#pragma unroll
      for (int q = 0; q < 16; ++q) rp->v[q] = *(const float4*)((const float*)resp + (size_t)((q >> 3) * 32 + 4 * (q & 7)) * 1024);
    }
    if (PRE == 2 && kt == 0) {
#pragma unroll
      for (int q = 0; q < 16; ++q) rp->w[q] = *(const u32x2*)((const u16*)resp + (size_t)((q >> 3) * 32 + 4 * (q & 7)) * 1024);
    }
    SBAR();
    const char* Ac = As + st * 32768; const char* Bc = Bs + st * 16384;
#pragma unroll
    for (int kk = 0; kk < 4; ++kk) {
      const int cb = kk * 32 + hi * 16;
      bf16x8 a0 = *(const bf16x8*)(Ac + GSWZ(arow0, cb));
      bf16x8 a1 = *(const bf16x8*)(Ac + GSWZ(arow0 + 32, cb));
      bf16x8 b0 = *(const bf16x8*)(Bc + GSWZ(brow0, cb));
      bf16x8 b1 = *(const bf16x8*)(Bc + GSWZ(brow0 + 32, cb));
      acc[0][0] = __builtin_amdgcn_mfma_f32_32x32x16_bf16(a0, b0, acc[0][0], 0, 0, 0);
      acc[0][1] = __builtin_amdgcn_mfma_f32_32x32x16_bf16(a0, b1, acc[0][1], 0, 0, 0);
      acc[1][0] = __builtin_amdgcn_mfma_f32_32x32x16_bf16(a1, b0, acc[1][0], 0, 0, 0);
      acc[1][1] = __builtin_amdgcn_mfma_f32_32x32x16_bf16(a1, b1, acc[1][1], 0, 0, 0);
    }
    __syncthreads();
    st = stn;
  }
}

struct TileIter {
  int f, fend, step, MT, NT;
  __device__ __forceinline__ TileIter(int MT_, int NT_) : MT(MT_), NT(NT_) {
    const int T = MT_ * NT_, bid = blockIdx.x, nblk = gridDim.x;
    if (nblk == 256) { const int x = bid & 7, cl = bid >> 3; f = (int)(((long)T * x) >> 3) + cl; fend = (int)(((long)T * (x + 1)) >> 3); step = 32; }
    else { f = bid; fend = T; step = nblk; }
  }
  __device__ __forceinline__ bool valid() const { return f < fend; }
  __device__ __forceinline__ void next() { f += step; }
  __device__ __forceinline__ void get(int& mt, int& nt) const {
    const int full = (MT >> 2) * 4 * NT;
    if (f < full) { const int g = f / (4 * NT), rem = f - g * 4 * NT; nt = rem >> 2; mt = g * 4 + (rem & 3); }
    else { const int rem = f - full, gs = MT - (MT >> 2) * 4; nt = rem / gs; mt = (MT >> 2) * 4 + (rem - nt * gs); }
  }
};

__device__ __forceinline__ void epi_bf16(f32x16 (&acc)[2][2], u16* C, int ldc, int m0, int n0, char* lds) {
  const int tid = opaque_tid(), wid = tid >> 6, lane = tid & 63, r32 = lane & 31, hi = lane >> 5;
  const int wm = wid & 3, wn = wid >> 2;
  char* wl = lds + wid * 9216;
#pragma unroll
  for (int i = 0; i < 2; ++i)
#pragma unroll
    for (int j = 0; j < 2; ++j)
#pragma unroll
      for (int r = 0; r < 16; ++r) *(u16*)(wl + (i * 32 + crow(r, hi)) * 144 + (j * 32 + r32) * 2) = f2bf(acc[i][j][r]);
  asm volatile("s_waitcnt lgkmcnt(0)" ::: "memory");
  const int rr = lane >> 3, ch = lane & 7;
  u16* cbase = C + (size_t)(m0 + wm * 64 + rr) * ldc + n0 + wn * 64 + ch * 8;
#pragma unroll
  for (int k = 0; k < 8; ++k) {
    const u32x4 v = *(const u32x4*)(wl + (rr + 8 * k) * 144 + ch * 16);
    *(u32x4*)(cbase + (size_t)(8 * k) * ldc) = v;
  }
}
template <bool IN_BF, bool OUT_BF>
__device__ __forceinline__ void epi_res(f32x16 (&acc)[2][2], const ResPre& rp, void* outp, const float* gsrc, int n0, char* lds) {
  const int tid = opaque_tid(), wid = tid >> 6, lane = tid & 63, r32 = lane & 31, hi = lane >> 5;
  const int wn = wid >> 2;
  char* wl = lds + wid * 8704;
  const int rl = lane >> 4, c4 = lane & 15;
  const float4 g = *(const float4*)(gsrc + n0 + wn * 64 + 4 * c4);
#pragma unroll
  for (int i = 0; i < 2; ++i) {
#pragma unroll
    for (int j = 0; j < 2; ++j)
#pragma unroll
      for (int r = 0; r < 16; ++r) *(float*)(wl + crow(r, hi) * 272 + (j * 32 + r32) * 4) = acc[i][j][r];
    asm volatile("s_waitcnt lgkmcnt(0)" ::: "memory");
#pragma unroll
    for (int k = 0; k < 8; ++k) {
      const float4 a = *(const float4*)(wl + (rl + 4 * k) * 272 + c4 * 16);
      float4 x;
      if (IN_BF) { const u32x2 xw = rp.w[i * 8 + k]; x.x = bflo(xw[0]); x.y = bfhi(xw[0]); x.z = bflo(xw[1]); x.w = bfhi(xw[1]); } else x = rp.v[i * 8 + k];
      float4 o; o.x = x.x + g.x * a.x; o.y = x.y + g.y * a.y; o.z = x.z + g.z * a.z; o.w = x.w + g.w * a.w;
      if (OUT_BF) { const u32x2 ow = {cvtpk(o.x, o.y), cvtpk(o.z, o.w)}; *(u32x2*)((u16*)outp + (size_t)(i * 32 + 4 * k) * 1024) = ow; }
      else *(float4*)((float*)outp + (size_t)(i * 32 + 4 * k) * 1024) = o;
    }
    asm volatile("s_waitcnt lgkmcnt(0)" ::: "memory");
  }
}

__device__ __forceinline__ float red8(float v) { v += __shfl_xor(v, 1); v += __shfl_xor(v, 2); v += __shfl_xor(v, 4); return v; }
__device__ __forceinline__ void rope_cs(float pos, float inv, bool on, float& c, float& s) {
  if (on) { float a = pos * inv * 0.15915494309189535f; a -= floorf(a); c = __builtin_amdgcn_cosf(a); s = __builtin_amdgcn_sinf(a); } else { c = 1.f; s = 0.f; }
}
__device__ __forceinline__ void head64(const u16* src, u16* dst, int gb, const float* g, const float* cG, const float* sG, float qs) {
  const u32x2 lo = *(const u32x2*)(src + gb), hi2 = *(const u32x2*)(src + gb + 16);
  float x[8] = {bflo(lo[0]), bfhi(lo[0]), bflo(lo[1]), bfhi(lo[1]), bflo(hi2[0]), bfhi(hi2[0]), bflo(hi2[1]), bfhi(hi2[1])};
  float ss = 0;
#pragma unroll
  for (int e = 0; e < 8; ++e) ss += x[e] * x[e];
  const float rn = rsqrtf(red8(ss) * (1.f / 64) + EPS) ;
#pragma unroll
  for (int e = 0; e < 8; ++e) x[e] *= rn * g[e];
  float y[8];
#pragma unroll
  for (int e = 0; e < 4; ++e) { y[e] = (x[e] * cG[e] - x[e + 4] * sG[e]) * qs; y[e + 4] = (x[e + 4] * cG[e] + x[e] * sG[e]) * qs; }
  const u32x2 o0 = {cvtpk(y[0], y[1]), cvtpk(y[2], y[3])}, o1 = {cvtpk(y[4], y[5]), cvtpk(y[6], y[7])};
  *(u32x2*)(dst + gb) = o0; *(u32x2*)(dst + gb + 16) = o1;
}
__device__ __forceinline__ void head96(float* n, float r1a, float r1b, float r2a, float r2b, u16* dst, int t, int rb,
                                       const float* gn, const float* gr, const float* cM, const float* sM, float qs) {
  float ss = r1a * r1a + r1b * r1b + r2a * r2a + r2b * r2b;
#pragma unroll
  for (int e = 0; e < 8; ++e) ss += n[e] * n[e];
  const float rn = rsqrtf(red8(ss) * (1.f / 96) + EPS);
#pragma unroll
  for (int e = 0; e < 8; ++e) n[e] *= rn * gn[e] * qs;
  r1a *= rn * gr[0]; r1b *= rn * gr[1]; r2a *= rn * gr[2]; r2b *= rn * gr[3];
  const float y1a = (r1a * cM[0] - r2a * sM[0]) * qs, y2a = (r2a * cM[0] + r1a * sM[0]) * qs;
  const float y1b = (r1b * cM[1] - r2b * sM[1]) * qs, y2b = (r2b * cM[1] + r1b * sM[1]) * qs;
  const u32x4 o = {cvtpk(n[0], n[1]), cvtpk(n[2], n[3]), cvtpk(n[4], n[5]), cvtpk(n[6], n[7])};
  *(u32x4*)(dst + 8 * t) = o;
  *(unsigned*)(dst + 64 + rb) = cvtpk(y1a, y1b); *(unsigned*)(dst + 64 + rb + 8) = cvtpk(y2a, y2b);
}
__device__ void finalize0(const Params& p) {
  const int tid = opaque_tid(), lane = tid & 63, gw = blockIdx.x * 8 + (tid >> 6), nw = gridDim.x * 8;
  const int h = lane >> 3, t = lane & 7;
  char* ws = p.ws;
  const u16* PP = (const u16*)(ws + OFF_PP);
  const u16* QAR = (const u16*)(ws + OFF_H);
  const u16* KVR = (const u16*)p.out;
  u16* QA = (u16*)(ws + OFF_QA); u16* QCA = (u16*)(ws + OFF_QCA); u16* KA = (u16*)(ws + OFF_KA); u16* VA = (u16*)(ws + OFF_VA);
  u16* QB = (u16*)(ws + OFF_QB); u16* QCB = (u16*)(ws + OFF_QCB); u16* KB = (u16*)(ws + OFF_KB); u16* VB = (u16*)(ws + OFF_VB);
  const int gb = t < 4 ? 4 * t : 32 + 4 * (t - 4), rb = t < 4 ? 2 * t : 16 + 2 * (t - 4);
  float qgn[8], kgn[8], qgr[4], kgr[4], gqg[8], gkg[8], invG[4], invM[2];
#pragma unroll
  for (int e = 0; e < 8; ++e) { qgn[e] = p.q_gain[8 * t + e]; kgn[e] = p.k_gain[8 * t + e];
    const int d = gb + (e & 3) + (e >> 2) * 16; gqg[e] = p.gq_gain[d]; gkg[e] = p.gk_gain[d]; }
#pragma unroll
  for (int k = 0; k < 4; ++k) { const int d = 64 + rb + (k & 1) + (k >> 1) * 8; qgr[k] = p.q_gain[d]; kgr[k] = p.k_gain[d]; }
#pragma unroll
  for (int e = 0; e < 4; ++e) invG[e] = exp2f(-(float)(4 * (t & 3) + e) * (13.287712379549449f / 16.f));
#pragma unroll
  for (int k = 0; k < 2; ++k) invM[k] = exp2f(-(float)(2 * (t & 3) + k) * (13.287712379549449f / 8.f));
  for (int r = gw; r < NROW; r += nw) {
    const bool isctx = r >= NLAT;
    int b, s, kpos; float pos = 0.f;
    if (!isctx) { b = r >> 14; s = r & 16383; kpos = CL + s; pos = t < 4 ? (float)(s >> 6) : (float)(s & 63); }
    else { int rc = r - NLAT; b = rc >> 8; s = rc & 255; kpos = s; }
    float cG[4], sG[4], cM[2], sM[2];
#pragma unroll
    for (int e = 0; e < 4; ++e) rope_cs(pos, invG[e], !isctx, cG[e], sG[e]);
#pragma unroll
    for (int k = 0; k < 2; ++k) rope_cs(pos, invM[k], !isctx, cM[k], sM[k]);
    const u16* pp = PP + (size_t)r * LD_AB;
    const u32x2 wq = *(const u32x2*)(pp + lane * 4), wk = *(const u32x2*)(pp + 256 + lane * 4);
    float s1 = bflo(wq[0]) * bflo(wq[0]) + bfhi(wq[0]) * bfhi(wq[0]) + bflo(wq[1]) * bflo(wq[1]) + bfhi(wq[1]) * bfhi(wq[1]);
    float s2 = bflo(wk[0]) * bflo(wk[0]) + bfhi(wk[0]) * bfhi(wk[0]) + bflo(wk[1]) * bflo(wk[1]) + bfhi(wk[1]) * bfhi(wk[1]);
    s1 = wave_sum(s1); s2 = wave_sum(s2);
    const float rstd_cq = rsqrtf(s1 * (1.f / 256) + EPS), rstd_ckv = rsqrtf(s2 * (1.f / 256) + EPS);
    { const u16* qa = QAR + (size_t)r * 768 + h * 96;
      const u32x4 nv = *(const u32x4*)(qa + 8 * t); const unsigned w1 = *(const unsigned*)(qa + 64 + rb), w2 = *(const unsigned*)(qa + 64 + rb + 8);
      float n[8] = {bflo(nv[0]) * rstd_cq, bfhi(nv[0]) * rstd_cq, bflo(nv[1]) * rstd_cq, bfhi(nv[1]) * rstd_cq, bflo(nv[2]) * rstd_cq, bfhi(nv[2]) * rstd_cq, bflo(nv[3]) * rstd_cq, bfhi(nv[3]) * rstd_cq};
      u16* dq = isctx ? QCA + ((size_t)(b * 8 + h) * CL + s) * 96 : QA + ((size_t)(b * 8 + h) * SEQ + s) * 96;
      head96(n, bflo(w1) * rstd_cq, bfhi(w1) * rstd_cq, bflo(w2) * rstd_cq, bfhi(w2) * rstd_cq, dq, t, rb, qgn, qgr, cM, sM, QS_A); }
    { const u16* kv = KVR + (size_t)r * 1024 + h * 128;
      const u32x4 nv = *(const u32x4*)(kv + 8 * t), vv = *(const u32x4*)(kv + 64 + 8 * t);
      const unsigned w1 = *(const unsigned*)(pp + 512 + rb), w2 = *(const unsigned*)(pp + 512 + rb + 8);
      float n[8] = {bflo(nv[0]) * rstd_ckv, bfhi(nv[0]) * rstd_ckv, bflo(nv[1]) * rstd_ckv, bfhi(nv[1]) * rstd_ckv, bflo(nv[2]) * rstd_ckv, bfhi(nv[2]) * rstd_ckv, bflo(nv[3]) * rstd_ckv, bfhi(nv[3]) * rstd_ckv};
      const size_t kr = (size_t)(b * 8 + h) * KVLEN + kpos;
      head96(n, bflo(w1), bfhi(w1), bflo(w2), bfhi(w2), KA + kr * 96, t, rb, kgn, kgr, cM, sM, 1.f);
      const u32x4 vo = {cvtpk(bflo(vv[0]) * rstd_ckv, bfhi(vv[0]) * rstd_ckv), cvtpk(bflo(vv[1]) * rstd_ckv, bfhi(vv[1]) * rstd_ckv),
                        cvtpk(bflo(vv[2]) * rstd_ckv, bfhi(vv[2]) * rstd_ckv), cvtpk(bflo(vv[3]) * rstd_ckv, bfhi(vv[3]) * rstd_ckv)};
      *(u32x4*)(VA + kr * 64 + 8 * t) = vo; }
    { u16* dg = isctx ? QCB + ((size_t)(b * 8 + h) * CL + s) * 64 : QB + ((size_t)(b * 8 + h) * SEQ + s) * 64;
      head64(pp + 544 + h * 64, dg, gb, gqg, cG, sG, QS_B); }
    if (h < 2) {
      const size_t kr = (size_t)(b * 2 + h) * KVLEN + kpos;
      head64(pp + 1056 + h * 64, KB + kr * 64, gb, gkg, cG, sG, 1.f);
      *(u32x4*)(VB + kr * 64 + 8 * t) = *(const u32x4*)(pp + 1184 + h * 64 + 8 * t);
    }
  }
}

__device__ void finalize1(const Params& p) {
  const int tid = opaque_tid(), lane = tid & 63, gw = blockIdx.x * 8 + (tid >> 6), nw = gridDim.x * 8;
  const int h = lane >> 3, t = lane & 7;
  char* ws = p.ws;
  const u16* PP = (const u16*)(ws + OFF_PP);
  u16* Q2 = (u16*)(ws + OFF_Q2); u16* K2 = (u16*)(ws + OFF_K2); u16* V2 = (u16*)(ws + OFF_V2);
  u16* MIX = (u16*)(ws + OFF_H);
  const int gb = t < 4 ? 4 * t : 32 + 4 * (t - 4);
  float qg[8], kg[8], invG[4];
#pragma unroll
  for (int e = 0; e < 8; ++e) { const int d = gb + (e & 3) + (e >> 2) * 16; qg[e] = p.win_q_gain[d]; kg[e] = p.win_k_gain[d]; }
#pragma unroll
  for (int e = 0; e < 4; ++e) invG[e] = exp2f(-(float)(4 * (t & 3) + e) * (13.287712379549449f / 16.f));
  float cw[3][8];
#pragma unroll
  for (int j = 0; j < 3; ++j)
#pragma unroll
    for (int e = 0; e < 8; ++e) cw[j][e] = p.conv_w[j * 512 + lane * 8 + e];
  for (int r = gw; r < NROW + 512; r += nw) {
    if (r >= NROW) {
      int slab = (r - NROW) >> 7, pr = (r - NROW) & 127;
      size_t kr = (size_t)slab * KV2LEN + KVLEN + pr;
      K2[kr * 64 + lane] = 0; V2[kr * 64 + lane] = 0;
      continue;
    }
    const bool isctx = r >= NLAT;
    int b, s, kpos; float pos = 0.f;
    if (!isctx) { b = r >> 14; s = r & 16383; kpos = CL + s; pos = t < 4 ? (float)(s >> 6) : (float)(s & 63); }
    else { int rc = r - NLAT; b = rc >> 8; s = rc & 255; kpos = s; }
    float cG[4], sG[4];
#pragma unroll
    for (int e = 0; e < 4; ++e) rope_cs(pos, invG[e], !isctx, cG[e], sG[e]);
    const u16* pp = PP + (size_t)r * LD_CD;
    if (!isctx) head64(pp + h * 64, Q2 + ((size_t)(b * 8 + h) * SEQ + s) * 64, gb, qg, cG, sG, QS_B);
    if (h < 2) {
      const size_t kr = (size_t)(b * 2 + h) * KV2LEN + kpos;
      head64(pp + 512 + h * 64, K2 + kr * 64, gb, kg, cG, sG, 1.f);
      *(u32x4*)(V2 + kr * 64 + 8 * t) = *(const u32x4*)(pp + 640 + h * 64 + 8 * t);
    }
    if (!isctx) {
      const int c0 = lane * 8;
      float y[8];
#pragma unroll
      for (int e = 0; e < 8; ++e) y[e] = 0.f;
#pragma unroll
      for (int j = 0; j < 3; ++j) {
        const int sj = s + j - 1;
        if (sj >= 0 && sj < SEQ) {
          const u16* pj = pp + (ptrdiff_t)(j - 1) * LD_CD;
          u32x4 a = *(const u32x4*)(pj + 1280 + c0), bb = *(const u32x4*)(pj + 1792 + c0);
#pragma unroll
          for (int e = 0; e < 4; ++e) {
            y[2 * e]     += bflo(a[e]) * bflo(bb[e]) * cw[j][2 * e];
            y[2 * e + 1] += bfhi(a[e]) * bfhi(bb[e]) * cw[j][2 * e + 1];
          }
        }
      }
      u32x4 gbv = *(const u32x4*)(pp + 768 + c0), gt = *(const u32x4*)(pp + 2304 + 512 + c0);
      u32x4 o;
#pragma unroll
      for (int e = 0; e < 4; ++e) {
        float v0 = bflo(gbv[e]) * y[2 * e] * silu_f(bflo(gt[e]));
        float v1 = bfhi(gbv[e]) * y[2 * e + 1] * silu_f(bfhi(gt[e]));
        o[e] = cvtpk(v0, v1);
      }
      *(u32x4*)(MIX + (size_t)r * 1024 + 512 + c0) = o;
    }
  }
}

#define KSWZ(row, colB) ((row) * 272 + (colB))
__device__ __forceinline__ int v_st2(int k, int c) { const int kk = k; return ((kk >> 3) * 2 + (c >> 5)) * 512 + ((kk & 7) * 32 + (c & 31)) * 2; }
__device__ __forceinline__ int v_rd_base(int lane) { return ((lane & 3) << 3) | (((lane >> 2) & 3) << 6) | (((lane >> 4) & 1) << 5) | (((lane >> 5) & 1) << 8); }
constexpr int v_rd_off2(int d0, int ks, int half) { return d0 * 512 + ks * 2048 + half * 1024; }
template <int OFF> __device__ __forceinline__ s16x4 tr_read(int vb) {
  s16x4 r; asm volatile("ds_read_b64_tr_b16 %0, %1 offset:%2" : "=&v"(r) : "v"(vb), "i"(OFF) : "memory"); return r;
}
template <int D0> __device__ __forceinline__ void pv_one(f32x16& od, int vb, bf16x8 pa0, bf16x8 pa1, bf16x8 pa2, bf16x8 pa3) {
  const s16x4 l0 = tr_read<v_rd_off2(D0, 0, 0)>(vb), h0 = tr_read<v_rd_off2(D0, 0, 1)>(vb), l1 = tr_read<v_rd_off2(D0, 1, 0)>(vb), h1 = tr_read<v_rd_off2(D0, 1, 1)>(vb);
  const s16x4 l2 = tr_read<v_rd_off2(D0, 2, 0)>(vb), h2 = tr_read<v_rd_off2(D0, 2, 1)>(vb), l3 = tr_read<v_rd_off2(D0, 3, 0)>(vb), h3 = tr_read<v_rd_off2(D0, 3, 1)>(vb);
  asm volatile("s_waitcnt lgkmcnt(0)" ::: "memory"); SBAR();
#define PK(L, H) (bf16x8){L[0], L[1], L[2], L[3], H[0], H[1], H[2], H[3]}
  od = __builtin_amdgcn_mfma_f32_32x32x16_bf16(pa0, PK(l0, h0), od, 0, 0, 0);
  od = __builtin_amdgcn_mfma_f32_32x32x16_bf16(pa1, PK(l1, h1), od, 0, 0, 0);
  od = __builtin_amdgcn_mfma_f32_32x32x16_bf16(pa2, PK(l2, h2), od, 0, 0, 0);
  od = __builtin_amdgcn_mfma_f32_32x32x16_bf16(pa3, PK(l3, h3), od, 0, 0, 0);
#undef PK
}
__device__ __forceinline__ void pv_all(f32x16* o, int vb, bf16x8 pa0, bf16x8 pa1, bf16x8 pa2, bf16x8 pa3) {
  pv_one<0>(o[0], vb, pa0, pa1, pa2, pa3); pv_one<1>(o[1], vb, pa0, pa1, pa2, pa3);
}
__device__ __forceinline__ void pv_exp(f32x16* o, int vb, bf16x8 pa0, bf16x8 pa1, bf16x8 pa2, bf16x8 pa3, f32x16& n0, f32x16& n1) {
#define PK(L, H) (bf16x8){L[0], L[1], L[2], L[3], H[0], H[1], H[2], H[3]}
  { const s16x4 l0 = tr_read<v_rd_off2(0, 0, 0)>(vb), h0 = tr_read<v_rd_off2(0, 0, 1)>(vb), l1 = tr_read<v_rd_off2(0, 1, 0)>(vb), h1 = tr_read<v_rd_off2(0, 1, 1)>(vb);
    const s16x4 l2 = tr_read<v_rd_off2(0, 2, 0)>(vb), h2 = tr_read<v_rd_off2(0, 2, 1)>(vb), l3 = tr_read<v_rd_off2(0, 3, 0)>(vb), h3 = tr_read<v_rd_off2(0, 3, 1)>(vb);
#pragma unroll
    for (int r = 0; r < 8; ++r) n0[r] = __builtin_amdgcn_exp2f(n0[r]);
    asm volatile("s_waitcnt lgkmcnt(0)" ::: "memory"); SBAR();
    o[0] = __builtin_amdgcn_mfma_f32_32x32x16_bf16(pa0, PK(l0, h0), o[0], 0, 0, 0);
    o[0] = __builtin_amdgcn_mfma_f32_32x32x16_bf16(pa1, PK(l1, h1), o[0], 0, 0, 0);
    o[0] = __builtin_amdgcn_mfma_f32_32x32x16_bf16(pa2, PK(l2, h2), o[0], 0, 0, 0);
    o[0] = __builtin_amdgcn_mfma_f32_32x32x16_bf16(pa3, PK(l3, h3), o[0], 0, 0, 0); }
  { const s16x4 l0 = tr_read<v_rd_off2(1, 0, 0)>(vb), h0 = tr_read<v_rd_off2(1, 0, 1)>(vb), l1 = tr_read<v_rd_off2(1, 1, 0)>(vb), h1 = tr_read<v_rd_off2(1, 1, 1)>(vb);
    const s16x4 l2 = tr_read<v_rd_off2(1, 2, 0)>(vb), h2 = tr_read<v_rd_off2(1, 2, 1)>(vb), l3 = tr_read<v_rd_off2(1, 3, 0)>(vb), h3 = tr_read<v_rd_off2(1, 3, 1)>(vb);
#pragma unroll
    for (int r = 8; r < 16; ++r) n0[r] = __builtin_amdgcn_exp2f(n0[r]);
    asm volatile("s_waitcnt lgkmcnt(0)" ::: "memory"); SBAR();
    o[1] = __builtin_amdgcn_mfma_f32_32x32x16_bf16(pa0, PK(l0, h0), o[1], 0, 0, 0);
    o[1] = __builtin_amdgcn_mfma_f32_32x32x16_bf16(pa1, PK(l1, h1), o[1], 0, 0, 0);
    o[1] = __builtin_amdgcn_mfma_f32_32x32x16_bf16(pa2, PK(l2, h2), o[1], 0, 0, 0);
    o[1] = __builtin_amdgcn_mfma_f32_32x32x16_bf16(pa3, PK(l3, h3), o[1], 0, 0, 0); }
#undef PK
#pragma unroll
  for (int r = 0; r < 16; ++r) n1[r] = __builtin_amdgcn_exp2f(n1[r]);
}

struct VSave { bf16x8 f0, f1, f2, f3; };
__device__ __forceinline__ void pv_exp_save(f32x16* o, int vb, bf16x8 pa0, bf16x8 pa1, bf16x8 pa2, bf16x8 pa3, f32x16& n0, f32x16& n1, VSave& vs) {
#define PK(L, H) (bf16x8){L[0], L[1], L[2], L[3], H[0], H[1], H[2], H[3]}
  { const s16x4 l0 = tr_read<v_rd_off2(0, 0, 0)>(vb), h0 = tr_read<v_rd_off2(0, 0, 1)>(vb), l1 = tr_read<v_rd_off2(0, 1, 0)>(vb), h1 = tr_read<v_rd_off2(0, 1, 1)>(vb);
    const s16x4 l2 = tr_read<v_rd_off2(0, 2, 0)>(vb), h2 = tr_read<v_rd_off2(0, 2, 1)>(vb), l3 = tr_read<v_rd_off2(0, 3, 0)>(vb), h3 = tr_read<v_rd_off2(0, 3, 1)>(vb);
#pragma unroll
    for (int r = 0; r < 8; ++r) n0[r] = __builtin_amdgcn_exp2f(n0[r]);
    asm volatile("s_waitcnt lgkmcnt(0)" ::: "memory"); SBAR();
    o[0] = __builtin_amdgcn_mfma_f32_32x32x16_bf16(pa0, PK(l0, h0), o[0], 0, 0, 0);
    o[0] = __builtin_amdgcn_mfma_f32_32x32x16_bf16(pa1, PK(l1, h1), o[0], 0, 0, 0);
    o[0] = __builtin_amdgcn_mfma_f32_32x32x16_bf16(pa2, PK(l2, h2), o[0], 0, 0, 0);
    o[0] = __builtin_amdgcn_mfma_f32_32x32x16_bf16(pa3, PK(l3, h3), o[0], 0, 0, 0); }
  { const s16x4 l0 = tr_read<v_rd_off2(1, 0, 0)>(vb), h0 = tr_read<v_rd_off2(1, 0, 1)>(vb), l1 = tr_read<v_rd_off2(1, 1, 0)>(vb), h1 = tr_read<v_rd_off2(1, 1, 1)>(vb);
    const s16x4 l2 = tr_read<v_rd_off2(1, 2, 0)>(vb), h2 = tr_read<v_rd_off2(1, 2, 1)>(vb), l3 = tr_read<v_rd_off2(1, 3, 0)>(vb), h3 = tr_read<v_rd_off2(1, 3, 1)>(vb);
#pragma unroll
    for (int r = 8; r < 16; ++r) n0[r] = __builtin_amdgcn_exp2f(n0[r]);
    asm volatile("s_waitcnt lgkmcnt(0)" ::: "memory"); SBAR();
    vs.f0 = PK(l0, h0); vs.f1 = PK(l1, h1); vs.f2 = PK(l2, h2); vs.f3 = PK(l3, h3);
    o[1] = __builtin_amdgcn_mfma_f32_32x32x16_bf16(pa0, vs.f0, o[1], 0, 0, 0);
    o[1] = __builtin_amdgcn_mfma_f32_32x32x16_bf16(pa1, vs.f1, o[1], 0, 0, 0);
    o[1] = __builtin_amdgcn_mfma_f32_32x32x16_bf16(pa2, vs.f2, o[1], 0, 0, 0);
    o[1] = __builtin_amdgcn_mfma_f32_32x32x16_bf16(pa3, vs.f3, o[1], 0, 0, 0); }
#pragma unroll
  for (int r = 0; r < 16; ++r) n1[r] = __builtin_amdgcn_exp2f(n1[r]);
}
__device__ __forceinline__ void pv_exp_reuse(f32x16* o, int vb, bf16x8 pa0, bf16x8 pa1, bf16x8 pa2, bf16x8 pa3, f32x16& n0, f32x16& n1, const VSave& vs) {
  { const s16x4 l0 = tr_read<v_rd_off2(0, 0, 0)>(vb), h0 = tr_read<v_rd_off2(0, 0, 1)>(vb), l1 = tr_read<v_rd_off2(0, 1, 0)>(vb), h1 = tr_read<v_rd_off2(0, 1, 1)>(vb);
    const s16x4 l2 = tr_read<v_rd_off2(0, 2, 0)>(vb), h2 = tr_read<v_rd_off2(0, 2, 1)>(vb), l3 = tr_read<v_rd_off2(0, 3, 0)>(vb), h3 = tr_read<v_rd_off2(0, 3, 1)>(vb);
    o[1] = __builtin_amdgcn_mfma_f32_32x32x16_bf16(pa0, vs.f0, o[1], 0, 0, 0);
    o[1] = __builtin_amdgcn_mfma_f32_32x32x16_bf16(pa1, vs.f1, o[1], 0, 0, 0);
    o[1] = __builtin_amdgcn_mfma_f32_32x32x16_bf16(pa2, vs.f2, o[1], 0, 0, 0);
    o[1] = __builtin_amdgcn_mfma_f32_32x32x16_bf16(pa3, vs.f3, o[1], 0, 0, 0);
#pragma unroll
    for (int r = 0; r < 16; ++r) n0[r] = __builtin_amdgcn_exp2f(n0[r]);
    asm volatile("s_waitcnt lgkmcnt(0)" ::: "memory"); SBAR();
    o[0] = __builtin_amdgcn_mfma_f32_32x32x16_bf16(pa0, PK(l0, h0), o[0], 0, 0, 0);
    o[0] = __builtin_amdgcn_mfma_f32_32x32x16_bf16(pa1, PK(l1, h1), o[0], 0, 0, 0);
    o[0] = __builtin_amdgcn_mfma_f32_32x32x16_bf16(pa2, PK(l2, h2), o[0], 0, 0, 0);
    o[0] = __builtin_amdgcn_mfma_f32_32x32x16_bf16(pa3, PK(l3, h3), o[0], 0, 0, 0); }
#undef PK
#pragma unroll
  for (int r = 0; r < 16; ++r) n1[r] = __builtin_amdgcn_exp2f(n1[r]);
}

__device__ __forceinline__ void expall(f32x16& p0, f32x16& p1) {
#pragma unroll
  for (int r = 0; r < 16; ++r) p0[r] = __builtin_amdgcn_exp2f(p0[r]);
#pragma unroll
  for (int r = 0; r < 16; ++r) p1[r] = __builtin_amdgcn_exp2f(p1[r]);
}
__device__ __forceinline__ void finishSM(f32x16& p0, f32x16& p1, float& lsum, bf16x8& pa0, bf16x8& pa1, bf16x8& pa2, bf16x8& pa3) {
  float ps = 0;
#pragma unroll
  for (int r = 0; r < 16; ++r) ps += p0[r];
#pragma unroll
  for (int r = 0; r < 16; ++r) ps += p1[r];
  lsum += ps;
#define PK4(P, BASE, OUT) do { u32x4 w = {cvtpk(P[BASE + 0], P[BASE + 1]), cvtpk(P[BASE + 2], P[BASE + 3]), cvtpk(P[BASE + 4], P[BASE + 5]), cvtpk(P[BASE + 6], P[BASE + 7])}; \
    OUT = *reinterpret_cast<bf16x8*>(&w); } while (0)
  PK4(p0, 0, pa0); PK4(p0, 8, pa1); PK4(p1, 0, pa2); PK4(p1, 8, pa3);
#undef PK4
}
template <int NQK>
__device__ __forceinline__ void qkt(f32x16& p0, f32x16& p1, const char* Ks, const bf16x8* qr, int r32, int hi, const float shift) {
  p0 = f32x16{}; p1 = f32x16{};
#pragma unroll
  for (int d0 = 0; d0 < NQK; ++d0) { int cb = (d0 * 16 + hi * 8) * 2;
    bf16x8 b0 = *reinterpret_cast<const bf16x8*>(Ks + KSWZ(r32, cb));
    bf16x8 b1 = *reinterpret_cast<const bf16x8*>(Ks + KSWZ(32 + r32, cb));
    p0 = __builtin_amdgcn_mfma_f32_32x32x16_bf16(b0, qr[d0], p0, 0, 0, 0);
    p1 = __builtin_amdgcn_mfma_f32_32x32x16_bf16(b1, qr[d0], p1, 0, 0, 0); }
  if (__builtin_expect(shift != 0.f, 0)) {
#pragma unroll
    for (int r = 0; r < 16; ++r) { p0[r] -= shift; p1[r] -= shift; }
  }
}

#define PK4X(P, BASE, OUT) do { u32x4 w_ = {cvtpk(P[BASE + 0], P[BASE + 1]), cvtpk(P[BASE + 2], P[BASE + 3]), cvtpk(P[BASE + 4], P[BASE + 5]), cvtpk(P[BASE + 6], P[BASE + 7])}; \
    OUT = *reinterpret_cast<bf16x8*>(&w_); } while (0)
template <int NQK>
__device__ __forceinline__ void qkt_fin(f32x16& n0, f32x16& n1, const char* Ks, const bf16x8* qr, int r32, int hi, const float shift,
                                        f32x16& o0, f32x16& o1, float& lsum, bf16x8& pa0, bf16x8& pa1, bf16x8& pa2, bf16x8& pa3) {
  n0 = f32x16{}; n1 = f32x16{};
  float ps = 0.f;
  bf16x8 kc0 = *reinterpret_cast<const bf16x8*>(Ks + KSWZ(r32, (hi * 8) * 2));
  bf16x8 kc1 = *reinterpret_cast<const bf16x8*>(Ks + KSWZ(32 + r32, (hi * 8) * 2));
#pragma unroll
  for (int d0 = 0; d0 < NQK; ++d0) {
    bf16x8 kn0 = kc0, kn1 = kc1;
    if (d0 + 1 < NQK) { const int cb = ((d0 + 1) * 16 + hi * 8) * 2;
      kn0 = *reinterpret_cast<const bf16x8*>(Ks + KSWZ(r32, cb)); kn1 = *reinterpret_cast<const bf16x8*>(Ks + KSWZ(32 + r32, cb)); }
    n0 = __builtin_amdgcn_mfma_f32_32x32x16_bf16(kc0, qr[d0], n0, 0, 0, 0);
    n1 = __builtin_amdgcn_mfma_f32_32x32x16_bf16(kc1, qr[d0], n1, 0, 0, 0);
#define PIN(X) asm volatile("" : "+v"(X))
    if (NQK == 6) {
      if (d0 == 0) { PK4X(o0, 0, pa0); }
      if (d0 == 1) { PIN(o0); PK4X(o0, 8, pa1); }
      if (d0 == 2) { _Pragma("unroll") for (int r = 0; r < 16; ++r) ps += o0[r]; }
      if (d0 == 3) { PIN(o1); PK4X(o1, 0, pa2); _Pragma("unroll") for (int r = 0; r < 8; ++r) ps += o1[r]; }
      if (d0 == 4) { PIN(o1); PK4X(o1, 8, pa3); _Pragma("unroll") for (int r = 8; r < 16; ++r) ps += o1[r]; }
    } else {
      if (d0 == 0) { PK4X(o0, 0, pa0); PK4X(o0, 8, pa1); }
      if (d0 == 1) { _Pragma("unroll") for (int r = 0; r < 16; ++r) ps += o0[r]; }
      if (d0 == 2) { PIN(o1); PK4X(o1, 0, pa2); _Pragma("unroll") for (int r = 0; r < 8; ++r) ps += o1[r]; }
      if (d0 == 3) { PIN(o1); PK4X(o1, 8, pa3); _Pragma("unroll") for (int r = 8; r < 16; ++r) ps += o1[r]; }
    }
#undef PIN
    asm volatile("" : "+v"(ps), "+v"(pa0), "+v"(pa1), "+v"(pa2), "+v"(pa3));
    kc0 = kn0; kc1 = kn1;
    SBAR();
  }
  lsum += ps;
  if (__builtin_expect(shift != 0.f, 0)) {
#pragma unroll
    for (int r = 0; r < 16; ++r) { n0[r] -= shift; n1[r] -= shift; }
  }
}

template <int NQK, int MODE, int LDG>
__device__ __forceinline__ void attn_body(const u16* __restrict__ Qb, const u16* __restrict__ Kh, const u16* __restrict__ Vh,
                                          const int NT, const int q0, const float sink2, const float mbound,
                                          u16* __restrict__ mix0, const u16* __restrict__ gate0, char* lds) {
  constexpr int DK = NQK * 16;
  constexpr int SHM_V = 8192, SHM_K = 17408;
  int tid_ = threadIdx.x; asm volatile("" : "+v"(tid_));
  const int tid = tid_, wid = __builtin_amdgcn_readfirstlane(tid >> 6), lane = tid & 63, r32 = lane & 31, hi = lane >> 5;
  char* V_lds = lds; char* K_lds = lds + 5 * SHM_V;
  float* wsf = (float*)(lds + 5 * SHM_V + 5 * SHM_K) + wid * 64; float* li_l = wsf;
  float lsum = 0; f32x16 o[2] = {}; bf16x8 qr[NQK];
  const float shift = mbound > 80.f ? mbound - 80.f : 0.f;
  const u16* Qw = Qb + (size_t)(wid * 32 + r32) * DK + hi * 8;
#pragma unroll
  for (int d0 = 0; d0 < NQK; ++d0) qr[d0] = *(const bf16x8*)(Qw + d0 * 16);
  const int srow = tid >> 3, sc8 = tid & 7;
  const int kst0 = KSWZ(srow, sc8 * 16), kst1 = KSWZ(srow, 128 + sc8 * 16), vst = v_st2(srow, sc8 * 8);
  const int vb0 = (int)(uintptr_t)V_lds + v_rd_base(lane);
  const bool k1on = (NQK == 6) && (sc8 < 4);
  const unsigned koff0 = srow * DK + sc8 * 8, voff0 = srow * 64 + sc8 * 8;
  struct { bf16x8 k0, k1, v0; } st[2];
#define TROW(j) (MODE == 0 ? (j) * 64 : ((j) < 4 ? (j) * 64 : q0 + 128 + ((j) - 4) * 64))
#define SLOAD(i, kr) do { const u16* kp_ = Kh + (unsigned)((kr) * DK); st[i].k0 = *(const bf16x8*)(kp_ + koff0);   \
    if (k1on) st[i].k1 = *(const bf16x8*)(kp_ + koff0 + 64);                                                           \
    const u16* vp_ = Vh + (unsigned)((kr) * 64); st[i].v0 = *(const bf16x8*)(vp_ + voff0); } while (0)
#define SWRITE(b, i) do { *(bf16x8*)(K_lds + (b) * SHM_K + kst0) = st[i].k0; if (k1on) *(bf16x8*)(K_lds + (b) * SHM_K + kst1) = st[i].k1; \
    *(bf16x8*)(V_lds + (b) * SHM_V + vst) = st[i].v0; } while (0)
#define MASKT(P0, P1, j) do { if (MODE == 1 && (j) >= 4) { const int kb_ = q0 - 128 + ((j) - 4) * 64, qp_ = q0 + wid * 32 + r32;    \
    _Pragma("unroll") for (int r = 0; r < 16; ++r) { int k0_ = kb_ + crow(r, hi), k1_ = k0_ + 32; int d0_ = qp_ - k0_, d1_ = qp_ - k1_; \
      bool ok0 = (d0_ <= 128) && (d0_ >= -128) && (k0_ >= 0) && (k0_ < SEQ); bool ok1 = (d1_ <= 128) && (d1_ >= -128) && (k1_ >= 0) && (k1_ < SEQ); \
      P0[r] = ok0 ? P0[r] : -1e30f; P1[r] = ok1 ? P1[r] : -1e30f; } } } while (0)
  f32x16 pA0, pA1, pB0, pB1; bf16x8 pa0, pa1, pa2, pa3;
#define NXS(x) ((x) + 1 == 5 ? 0 : (x) + 1)
  __syncthreads();
  SLOAD(0, TROW(0)); asm volatile("s_waitcnt vmcnt(0)" ::: "memory"); SWRITE(0, 0);
  SLOAD(0, TROW(1)); SWRITE(1, 0);
  SLOAD(0, TROW(2)); SWRITE(2, 0);
  if (3 < NT) SLOAD(0, TROW(3));
  if (4 < NT) SLOAD(1, TROW(4));
  __syncthreads();
  qkt<NQK>(pA0, pA1, K_lds, qr, r32, hi, shift); MASKT(pA0, pA1, 0); expall(pA0, pA1);
  int c = 0;
  for (int j = 1; j + 1 < NT; j += 2) {
    const int sj = NXS(c), sj1 = NXS(sj), sj2 = NXS(sj1), sj3 = NXS(sj2);
    SBAR(); SWRITE(sj2, 0); if (j + 3 < NT) SWRITE(sj3, 1); SBAR();
    qkt_fin<NQK>(pB0, pB1, K_lds + sj * SHM_K, qr, r32, hi, shift, pA0, pA1, lsum, pa0, pa1, pa2, pa3); MASKT(pB0, pB1, j); SBAR();
    if (j + 4 < NT) SLOAD(0, TROW(j + 4)); SBAR();
    pv_exp(o, vb0 + c * SHM_V, pa0, pa1, pa2, pa3, pB0, pB1);
    SBAR();
    qkt_fin<NQK>(pA0, pA1, K_lds + sj1 * SHM_K, qr, r32, hi, shift, pB0, pB1, lsum, pa0, pa1, pa2, pa3); MASKT(pA0, pA1, j + 1); SBAR();
    if (j + 5 < NT) SLOAD(1, TROW(j + 5)); SBAR();
    pv_exp(o, vb0 + sj * SHM_V, pa0, pa1, pa2, pa3, pA0, pA1);
    __syncthreads();
    c = sj1;
  }
  { const int sl = NXS(c);
    SBAR(); qkt_fin<NQK>(pB0, pB1, K_lds + sl * SHM_K, qr, r32, hi, shift, pA0, pA1, lsum, pa0, pa1, pa2, pa3); MASKT(pB0, pB1, NT - 1); SBAR();
    pv_all(o, vb0 + c * SHM_V, pa0, pa1, pa2, pa3); expall(pB0, pB1);
    finishSM(pB0, pB1, lsum, pa0, pa1, pa2, pa3); SBAR();
    pv_all(o, vb0 + sl * SHM_V, pa0, pa1, pa2, pa3); }
#undef NXS
  float l_reg;
  { auto rr = __builtin_amdgcn_permlane32_swap(__float_as_uint(lsum), __float_as_uint(lsum), false, false);
    l_reg = __uint_as_float(rr[0]) + __uint_as_float(rr[1]); }
  if (MODE == 1) l_reg += __builtin_amdgcn_exp2f(sink2 - shift);
  if (hi == 0) li_l[r32] = l_reg; asm volatile("s_waitcnt lgkmcnt(0)" ::: "memory");
  float rli[16];
#pragma unroll
  for (int r = 0; r < 16; ++r) rli[r] = __builtin_amdgcn_rcpf(li_l[crow(r, hi)]);
#pragma unroll
  for (int r = 0; r < 16; ++r) { const int orow = wid * 32 + crow(r, hi);
#pragma unroll
    for (int d0 = 0; d0 < 2; ++d0) {
      const float g = bf2f(gate0[(size_t)orow * LDG + d0 * 32 + r32]);
      mix0[(size_t)orow * 1024 + d0 * 32 + r32] = f2bf(o[d0][r] * rli[r] * silu_f(g));
    } }
#undef TROW
#undef SLOAD
#undef SWRITE
#undef MASKT
}

template <int NQK, int LDG, int RING>
__device__ __forceinline__ void attn_body2(const u16* __restrict__ Qb, const u16* __restrict__ Kh, const u16* __restrict__ Vh,
                                           const int NT, const float mbound, u16* __restrict__ mix0, const u16* __restrict__ gate0, char* lds) {
  constexpr int DK = NQK * 16;
  constexpr int SHM_V = 8192, SHM_K = 17408;
  int tid_ = threadIdx.x; asm volatile("" : "+v"(tid_));
  const int tid = tid_, wid = __builtin_amdgcn_readfirstlane(tid >> 6), lane = tid & 63, r32 = lane & 31, hi = lane >> 5;
  char* V_lds = lds; char* K_lds = lds + 5 * SHM_V;
  float* wsf = (float*)(lds + 5 * SHM_V + 5 * SHM_K) + wid * 64;
  float lsA = 0, lsB = 0; f32x16 oA[2] = {}, oB[2] = {}; bf16x8 qA[NQK], qB[NQK];
  const float shift = mbound > 80.f ? mbound - 80.f : 0.f;
  const u16* Qw = Qb + (size_t)(wid * 64 + r32) * DK + hi * 8;
#pragma unroll
  for (int d0 = 0; d0 < NQK; ++d0) { qA[d0] = *(const bf16x8*)(Qw + d0 * 16); qB[d0] = *(const bf16x8*)(Qw + 32 * DK + d0 * 16); }
  const int srow = tid >> 3, sc8 = tid & 7;
  const int kst0 = KSWZ(srow, sc8 * 16), kst1 = KSWZ(srow, 128 + sc8 * 16), vst = v_st2(srow, sc8 * 8);
  const int vb0 = (int)(uintptr_t)V_lds + v_rd_base(lane);
  const bool k1on = (NQK == 6) && (sc8 < 4);
  const unsigned koff0 = srow * DK + sc8 * 8, voff0 = srow * 64 + sc8 * 8;
  struct { bf16x8 k0, k1, v0; } st[RING == 1 ? 2 : 1];
#define SLOAD(i, kr) do { const u16* kp_ = Kh + (unsigned)((kr) * DK); st[i].k0 = *(const bf16x8*)(kp_ + koff0);   \
    if (k1on) st[i].k1 = *(const bf16x8*)(kp_ + koff0 + 64);                                                           \
    const u16* vp_ = Vh + (unsigned)((kr) * 64); st[i].v0 = *(const bf16x8*)(vp_ + voff0); } while (0)
#define SWRITE(b, i) do { *(bf16x8*)(K_lds + (b) * SHM_K + kst0) = st[i].k0; if (k1on) *(bf16x8*)(K_lds + (b) * SHM_K + kst1) = st[i].k1; \
    *(bf16x8*)(V_lds + (b) * SHM_V + vst) = st[i].v0; } while (0)
#define NXS(x) ((x) + 1 == 5 ? 0 : (x) + 1)
#define UNIT(PN0, PN1, QN, KS, PO0, PO1, LSO, OO, VS) do {                                                                      \
    qkt_fin<NQK>(PN0, PN1, K_lds + (KS) * SHM_K, QN, r32, hi, shift, PO0, PO1, LSO, pa0, pa1, pa2, pa3); SBAR();               \
    pv_exp(OO, vb0 + (VS) * SHM_V, pa0, pa1, pa2, pa3, PN0, PN1); SBAR(); } while (0)
#define UNITS(PN0, PN1, QN, KS, PO0, PO1, LSO, OO, VS) do {                 \
    qkt_fin<NQK>(PN0, PN1, K_lds + (KS) * SHM_K, QN, r32, hi, shift, PO0, PO1, LSO, pa0, pa1, pa2, pa3); SBAR();               \
    pv_exp_save(OO, vb0 + (VS) * SHM_V, pa0, pa1, pa2, pa3, PN0, PN1, vsv); SBAR(); } while (0)
#define UNITR(PN0, PN1, QN, KS, PO0, PO1, LSO, OO, VS) do {                                                    \
    qkt_fin<NQK>(PN0, PN1, K_lds + (KS) * SHM_K, QN, r32, hi, shift, PO0, PO1, LSO, pa0, pa1, pa2, pa3); SBAR();               \
    pv_exp_reuse(OO, vb0 + (VS) * SHM_V, pa0, pa1, pa2, pa3, PN0, PN1, vsv); SBAR(); } while (0)
  f32x16 pA0, pA1, pB0, pB1; bf16x8 pa0, pa1, pa2, pa3;
  if constexpr (RING == 1) {
  VSave vsv;
  __syncthreads();
  SLOAD(0, 0); asm volatile("s_waitcnt vmcnt(0)" ::: "memory"); SWRITE(0, 0);
  SLOAD(0, 64); SWRITE(1, 0);
  SLOAD(0, 128); SWRITE(2, 0);
  if (3 < NT) SLOAD(0, 3 * 64);
  if (4 < NT) SLOAD(1, 4 * 64);
  __syncthreads();
  qkt<NQK>(pA0, pA1, K_lds, qA, r32, hi, shift); expall(pA0, pA1);
  int c = 0;
  for (int i = 0; 2 * i + 2 < NT; ++i) {
    const int s1 = NXS(c), s2 = NXS(s1), s3 = NXS(s2), s4 = NXS(s3);
    SBAR(); if (2 * i + 3 < NT) SWRITE(s3, 0); if (2 * i + 4 < NT) SWRITE(s4, 1);
    if (2 * i + 5 < NT) SLOAD(0, (2 * i + 5) * 64); if (2 * i + 6 < NT) SLOAD(1, (2 * i + 6) * 64); SBAR();
    UNITS(pB0, pB1, qB, c, pA0, pA1, lsA, oA, c);
    UNITR(pA0, pA1, qA, s1, pB0, pB1, lsB, oB, c);
    UNITS(pB0, pB1, qB, s1, pA0, pA1, lsA, oA, s1);
    UNITR(pA0, pA1, qA, s2, pB0, pB1, lsB, oB, s1);
    __syncthreads();
    c = s2;
  }
  { const int s1 = NXS(c);
    UNITS(pB0, pB1, qB, c, pA0, pA1, lsA, oA, c);
    UNITR(pA0, pA1, qA, s1, pB0, pB1, lsB, oB, c);
    UNIT(pB0, pB1, qB, s1, pA0, pA1, lsA, oA, s1);
    finishSM(pB0, pB1, lsB, pa0, pa1, pa2, pa3); SBAR();
    pv_all(oB, vb0 + s1 * SHM_V, pa0, pa1, pa2, pa3); }
  } else if constexpr (RING == 2) {
    __syncthreads();
    SLOAD(0, 0); asm volatile("s_waitcnt vmcnt(0)" ::: "memory"); SWRITE(0, 0);
    SLOAD(0, 64); SWRITE(1, 0);
    SLOAD(0, 128); SWRITE(2, 0);
    if (3 < NT) SLOAD(0, 3 * 64);
    __syncthreads();
    qkt<NQK>(pA0, pA1, K_lds, qA, r32, hi, shift); expall(pA0, pA1);
    int c = 0;
    for (int i = 0; 2 * i + 2 < NT; ++i) {
      const int s1 = NXS(c), s2 = NXS(s1), s3 = NXS(s2), s4 = NXS(s3);
      SBAR(); if (2 * i + 3 < NT) SWRITE(s3, 0); if (2 * i + 4 < NT) SLOAD(0, (2 * i + 4) * 64); SBAR();
      UNIT(pB0, pB1, qB, c, pA0, pA1, lsA, oA, c);
      UNIT(pA0, pA1, qA, s1, pB0, pB1, lsB, oB, c);
      SBAR(); if (2 * i + 4 < NT) SWRITE(s4, 0); if (2 * i + 5 < NT) SLOAD(0, (2 * i + 5) * 64); SBAR();
      UNIT(pB0, pB1, qB, s1, pA0, pA1, lsA, oA, s1);
      UNIT(pA0, pA1, qA, s2, pB0, pB1, lsB, oB, s1);
      __syncthreads();
      c = s2;
    }
    { const int s1 = NXS(c);
      UNIT(pB0, pB1, qB, c, pA0, pA1, lsA, oA, c);
      UNIT(pA0, pA1, qA, s1, pB0, pB1, lsB, oB, c);
      UNIT(pB0, pB1, qB, s1, pA0, pA1, lsA, oA, s1);
      finishSM(pB0, pB1, lsB, pa0, pa1, pa2, pa3); SBAR();
      pv_all(oB, vb0 + s1 * SHM_V, pa0, pa1, pa2, pa3); }
  } else {
#define NX3(x) ((x) + 1 == 3 ? 0 : (x) + 1)
    __syncthreads();
    SLOAD(0, 0); asm volatile("s_waitcnt vmcnt(0)" ::: "memory"); SWRITE(0, 0);
    SLOAD(0, 64); SWRITE(1, 0);
    if (2 < NT) SLOAD(0, 128);
    __syncthreads();
    qkt<NQK>(pA0, pA1, K_lds, qA, r32, hi, shift); expall(pA0, pA1);
    int c = 0;
    for (int t = 0; t + 1 < NT; ++t) {
      const int s1 = NX3(c), s2 = NX3(s1);
      SBAR(); if (t + 2 < NT) SWRITE(s2, 0);
      if (t + 3 < NT) SLOAD(0, (t + 3) * 64); SBAR();
      UNIT(pB0, pB1, qB, c, pA0, pA1, lsA, oA, c);
      UNIT(pA0, pA1, qA, s1, pB0, pB1, lsB, oB, c);
      __syncthreads();
      c = s1;
    }
    UNIT(pB0, pB1, qB, c, pA0, pA1, lsA, oA, c);
    finishSM(pB0, pB1, lsB, pa0, pa1, pa2, pa3); SBAR();
    pv_all(oB, vb0 + c * SHM_V, pa0, pa1, pa2, pa3);
#undef NX3
  }
#undef UNIT
#undef UNITS
#undef UNITR
#undef NXS
#undef SLOAD
#undef SWRITE
  float lA, lB;
  { auto rr = __builtin_amdgcn_permlane32_swap(__float_as_uint(lsA), __float_as_uint(lsA), false, false); lA = __uint_as_float(rr[0]) + __uint_as_float(rr[1]); }
  { auto rr = __builtin_amdgcn_permlane32_swap(__float_as_uint(lsB), __float_as_uint(lsB), false, false); lB = __uint_as_float(rr[0]) + __uint_as_float(rr[1]); }
  if (hi == 0) { wsf[r32] = lA; wsf[32 + r32] = lB; }
  asm volatile("s_waitcnt lgkmcnt(0)" ::: "memory");
#pragma unroll
  for (int g = 0; g < 2; ++g) {
    float rli[16];
#pragma unroll
    for (int r = 0; r < 16; ++r) rli[r] = __builtin_amdgcn_rcpf(wsf[g * 32 + crow(r, hi)]);
#pragma unroll
    for (int r = 0; r < 16; ++r) { const int orow = wid * 64 + g * 32 + crow(r, hi);
#pragma unroll
      for (int d0 = 0; d0 < 2; ++d0) {
        const float gt = bf2f(gate0[(size_t)orow * LDG + d0 * 32 + r32]);
        const float ov = g == 0 ? oA[d0][r] : oB[d0][r];
        mix0[(size_t)orow * 1024 + d0 * 32 + r32] = f2bf(ov * rli[r] * silu_f(gt));
      } }
  }
}

__global__ void __launch_bounds__(512, 1) mega(Params p) {
  extern __shared__ __attribute__((aligned(16))) char lds[];
  cg::grid_group grid = cg::this_grid();
  const int bid = blockIdx.x, nblk = gridDim.x;
  char* ws = p.ws;
  float* modv = (float*)(ws + OFF_MODV);
  u16* H = (u16*)(ws + OFF_H);
  u16* PP = (u16*)(ws + OFF_PP);
  float* XC1 = (float*)(ws + OFF_XC1);
  unsigned* xbar = (unsigned*)(ws + OFF_END);
  volatile LAS unsigned* xst = (volatile LAS unsigned*)(lds + LDS_BYTES - 256);
  if (threadIdx.x == 0) { xst[0] = 0u; xst[1] = 0u; }
  __syncthreads();
  XcdBarrier xb = xcd_barrier_post(xbar, xst);
  if (p.ph_lo > 1000) grid.sync();

  if (p.ph_lo <= 0 && 0 < p.ph_hi) {
  for (int u = bid; u < 192; u += nblk) mod_unit(p, u, lds);
  }
  if (p.ph_lo <= 0 && 0 + 1 < p.ph_hi) xcd_barrier(xb);
  if (p.ph_lo <= 1 && 1 < p.ph_hi) {
  for (int u = bid; u < 2064; u += nblk) transpose_unit(p, u, lds);
  adaln_phase(p.x, nullptr, p.ctx, modv, H);
  }
  if (p.ph_lo <= 1 && 1 + 1 < p.ph_hi) xcd_barrier(xb);
  if (p.ph_lo <= 2 && 2 < p.ph_hi) {
  { TileIter ti(130, 19); GPre g; int nt = 0, mt = 0; const u16* Wt = (const u16*)(ws + OFF_WT_IN_AB);
    if (ti.valid()) { ti.get(mt, nt); gemm_preload(H, 1024, Wt, 1024, mt * 256, nt * 128, g); }
    while (ti.valid()) {
      f32x16 acc[2][2]; const int m0 = mt * 256, n0 = nt * 128;
      gemm_tile<0>(H, 1024, Wt, 1024, 1024, m0, n0, acc, lds, g);
      ti.next(); if (ti.valid()) { ti.get(mt, nt); gemm_preload(H, 1024, Wt, 1024, mt * 256, nt * 128, g); }
      epi_bf16(acc, PP, LD_AB, m0, n0, lds);
    } }
  }
  if (p.ph_lo <= 2 && 2 + 1 < p.ph_hi) xcd_barrier(xb);
  if (p.ph_lo <= 3 && 3 < p.ph_hi) {
  { TileIter ti(130, 14); GPre g; int nt = 0, mt = 0;
    const u16* Wq = (const u16*)(ws + OFF_WT_UQ); const u16* Wkv = (const u16*)(ws + OFF_WT_UKV);
    if (ti.valid()) { ti.get(mt, nt); gemm_preload(nt < 6 ? PP : PP + 256, LD_AB, nt < 6 ? Wq : Wkv, 256, mt * 256, (nt < 6 ? nt : nt - 6) * 128, g); }
    while (ti.valid()) {
      f32x16 acc[2][2]; const int m0 = mt * 256, cn = nt, n0 = (nt < 6 ? nt : nt - 6) * 128;
      gemm_tile<0>(cn < 6 ? PP : PP + 256, LD_AB, cn < 6 ? Wq : Wkv, 256, 256, m0, n0, acc, lds, g);
      ti.next(); if (ti.valid()) { ti.get(mt, nt); gemm_preload(nt < 6 ? PP : PP + 256, LD_AB, nt < 6 ? Wq : Wkv, 256, mt * 256, (nt < 6 ? nt : nt - 6) * 128, g); }
      if (cn < 6) epi_bf16(acc, H, 768, m0, n0, lds); else epi_bf16(acc, (u16*)p.out, 1024, m0, n0, lds);
    } }
  }
  if (p.ph_lo <= 3 && 3 + 1 < p.ph_hi) xcd_barrier(xb);
  if (p.ph_lo <= 4 && 4 < p.ph_hi) {
  finalize0(p);
  }
  if (p.ph_lo <= 4 && 4 + 1 < p.ph_hi) xcd_barrier(xb);
  if (p.ph_lo <= 5 && 5 < p.ph_hi) {
  const float mbA = LOG2E * 9.7979590f * 1.02f * vmaxabs(p.q_gain, 96) * vmaxabs(p.k_gain, 96);
  const float mbB = LOG2E * 8.f * 1.02f * vmaxabs(p.gq_gain, 64) * vmaxabs(p.gk_gain, 64);
  for (int it = bid; it < 1056; it += nblk) {
    if (it < 512) {
      const int round = it >> 8, blk = it & 255, xcd = blk & 7, cl = blk >> 3;
      const int pair = xcd * 2 + round, b = pair >> 3, h = pair & 7, qoff = cl * 512;
      const size_t r0 = (size_t)b * SEQ + qoff;
      attn_body2<6, LD_AB, 2>((const u16*)(ws + OFF_QA) + ((size_t)(b * 8 + h) * SEQ + qoff) * 96,
                                  (const u16*)(ws + OFF_KA) + (size_t)(b * 8 + h) * KVLEN * 96, (const u16*)(ws + OFF_VA) + (size_t)(b * 8 + h) * KVLEN * 64,
                                  KVLEN / 64, mbA, H + r0 * 1024 + h * 64, PP + r0 * LD_AB + 1312 + h * 64, lds);
    } else if (it < 1024) {
      const int i2 = it - 512, g = i2 >> 8, blk = i2 & 255, xcd = blk & 7, cl = blk >> 3;
      const int pi = xcd >> 1, b = pi >> 1, kvh = pi & 1, idx = (xcd & 1) * 64 + g * 32 + cl;
      const int h = kvh * 4 + (idx >> 5), qoff = (idx & 31) * 512;
      const size_t r0 = (size_t)b * SEQ + qoff;
      attn_body2<4, LD_AB, 1>((const u16*)(ws + OFF_QB) + ((size_t)(b * 8 + h) * SEQ + qoff) * 64,
                           (const u16*)(ws + OFF_KB) + (size_t)(b * 2 + kvh) * KVLEN * 64, (const u16*)(ws + OFF_VB) + (size_t)(b * 2 + kvh) * KVLEN * 64,
                           KVLEN / 64, mbB, H + r0 * 1024 + 512 + h * 64, PP + r0 * LD_AB + 1312 + 512 + h * 64, lds);
    } else {
      const int ci = it - 1024, b = (ci >> 3) & 1, h = ci & 7; const bool mla = ci < 16; const int kvh = mla ? h : (h >> 2);
      const size_t r0 = (size_t)NLAT + b * CL, qrow = (size_t)(b * 8 + h) * CL;
      if (mla) attn_body<6, 0, LD_AB>((const u16*)(ws + OFF_QCA) + qrow * 96, (const u16*)(ws + OFF_KA) + (size_t)(b * 8 + kvh) * KVLEN * 96,
                                      (const u16*)(ws + OFF_VA) + (size_t)(b * 8 + kvh) * KVLEN * 64, CL / 64, 0, 0.f, mbA, H + r0 * 1024 + h * 64, PP + r0 * LD_AB + 1312 + h * 64, lds);
      else attn_body<4, 0, LD_AB>((const u16*)(ws + OFF_QCB) + qrow * 64, (const u16*)(ws + OFF_KB) + (size_t)(b * 2 + kvh) * KVLEN * 64,
                                  (const u16*)(ws + OFF_VB) + (size_t)(b * 2 + kvh) * KVLEN * 64, CL / 64, 0, 0.f, mbB, H + r0 * 1024 + 512 + h * 64, PP + r0 * LD_AB + 1312 + 512 + h * 64, lds);
    }
  }
  }
  if (p.ph_lo <= 5 && 5 + 1 < p.ph_hi) xcd_barrier(xb);
  if (p.ph_lo <= 6 && 6 < p.ph_hi) {
  { TileIter ti(130, 8); GPre g; int nt = 0, mt = 0; const u16* Wt = (const u16*)(ws + OFF_WT_OUT_AB);
    if (ti.valid()) { ti.get(mt, nt); gemm_preload(H, 1024, Wt, 1024, mt * 256, nt * 128, g); }
    while (ti.valid()) {
      f32x16 acc[2][2]; const int m0 = mt * 256, n0 = nt * 128; const bool lat = m0 < NLAT;
      const int tid_ = opaque_tid(), wid_ = tid_ >> 6, lane_ = tid_ & 63;
      const size_t eoff = (size_t)((lat ? m0 : m0 - NLAT) + (wid_ & 3) * 64 + (lane_ >> 4)) * 1024 + n0 + (wid_ >> 2) * 64 + 4 * (lane_ & 15);
      ResPre rp;
      gemm_tile<1>(H, 1024, Wt, 1024, 1024, m0, n0, acc, lds, g, (lat ? p.x : p.ctx) + eoff, &rp);
      ti.next(); if (ti.valid()) { ti.get(mt, nt); gemm_preload(H, 1024, Wt, 1024, mt * 256, nt * 128, g); }
      if (lat) epi_res<false, true>(acc, rp, (u16*)(ws + OFF_X1B) + eoff, modv + (m0 >> 14) * 3072 + 2048, n0, lds);
      else epi_res<false, false>(acc, rp, XC1 + eoff, modv + 2 * 3072 + 2048, n0, lds);
    } }
  }
  if (p.ph_lo <= 6 && 6 + 1 < p.ph_hi) xcd_barrier(xb);
  if (p.ph_lo <= 7 && 7 < p.ph_hi) {
  adaln_phase(nullptr, (const u16*)(ws + OFF_X1B), XC1, modv + 3 * 3072, H);
  }
  if (p.ph_lo <= 7 && 7 + 1 < p.ph_hi) xcd_barrier(xb);
  if (p.ph_lo <= 8 && 8 < p.ph_hi) {
  { TileIter ti(130, 26); GPre g; int nt = 0, mt = 0; const u16* Wt = (const u16*)(ws + OFF_WT_IN_CD);
    if (ti.valid()) { ti.get(mt, nt); gemm_preload(H, 1024, Wt, 1024, mt * 256, nt * 128, g); }
    while (ti.valid()) {
      f32x16 acc[2][2]; const int m0 = mt * 256, n0 = nt * 128;
      gemm_tile<0>(H, 1024, Wt, 1024, 1024, m0, n0, acc, lds, g);
      ti.next(); if (ti.valid()) { ti.get(mt, nt); gemm_preload(H, 1024, Wt, 1024, mt * 256, nt * 128, g); }
      epi_bf16(acc, PP, LD_CD, m0, n0, lds);
    } }
  }
  if (p.ph_lo <= 8 && 8 + 1 < p.ph_hi) xcd_barrier(xb);
  if (p.ph_lo <= 9 && 9 < p.ph_hi) {
  finalize1(p);
  }
  if (p.ph_lo <= 9 && 9 + 1 < p.ph_hi) xcd_barrier(xb);
  if (p.ph_lo <= 10 && 10 < p.ph_hi) {
  const float mbW = LOG2E * 8.f * 1.02f * vmaxabs(p.win_q_gain, 64) * vmaxabs(p.win_k_gain, 64);
  for (int it = bid; it < 1024; it += nblk) {
    const int g = it >> 8, blk = it & 255, xcd = blk & 7, cl = blk >> 3;
    const int pi = xcd >> 1, b = pi >> 1, kvh = pi & 1, idx = (xcd & 1) * 128 + g * 32 + cl;
    const int h = kvh * 4 + (idx >> 6), qblk = idx & 63;
    const size_t r0 = (size_t)b * SEQ + qblk * 256;
    attn_body<4, 1, LD_CD>((const u16*)(ws + OFF_Q2) + ((size_t)(b * 8 + h) * SEQ + qblk * 256) * 64,
                    (const u16*)(ws + OFF_K2) + (size_t)(b * 2 + kvh) * KV2LEN * 64, (const u16*)(ws + OFF_V2) + (size_t)(b * 2 + kvh) * KV2LEN * 64,
                    12, qblk * 256, p.win_sink[h] * LOG2E, mbW, H + r0 * 1024 + h * 64, PP + r0 * LD_CD + 2304 + h * 64, lds);
  }
  }
  if (p.ph_lo <= 10 && 10 + 1 < p.ph_hi) xcd_barrier(xb);
  if (p.ph_lo <= 11 && 11 < p.ph_hi) {
  { TileIter ti(128, 8); GPre g; int nt = 0, mt = 0; const u16* Wt = (const u16*)(ws + OFF_WT_OUT_CD);
    if (ti.valid()) { ti.get(mt, nt); gemm_preload(H, 1024, Wt, 1024, mt * 256, nt * 128, g); }
    while (ti.valid()) {
      f32x16 acc[2][2]; const int m0 = mt * 256, n0 = nt * 128;
      const int tid_ = opaque_tid(), wid_ = tid_ >> 6, lane_ = tid_ & 63;
      const size_t eoff = (size_t)(m0 + (wid_ & 3) * 64 + (lane_ >> 4)) * 1024 + n0 + (wid_ >> 2) * 64 + 4 * (lane_ & 15);
      ResPre rp;
      gemm_tile<2>(H, 1024, Wt, 1024, 1024, m0, n0, acc, lds, g, (const u16*)(ws + OFF_X1B) + eoff, &rp);
      ti.next(); if (ti.valid()) { ti.get(mt, nt); gemm_preload(H, 1024, Wt, 1024, mt * 256, nt * 128, g); }
      epi_res<true, false>(acc, rp, p.out + eoff, modv + 3 * 3072 + (m0 >> 14) * 3072 + 2048, n0, lds);
    } }
  }
}

extern "C" void kernel_launch(void* const* d_in, const int* in_sizes, int n_in, void* d_out, int out_size, void* d_ws, size_t ws_size, hipStream_t stream) {
  static int grid_blocks = 0;
  if (!grid_blocks) {
    if (n_in != 22 || out_size != NLAT * DM || ws_size < OFF_END + 16384) {
      fprintf(stderr, "kernel_launch: shape/ws mismatch n_in %d out %d ws %zu need %zu\n", n_in, out_size, ws_size, (size_t)OFF_END);
      return;
    }
    if (hipFuncSetAttribute((const void*)mega, hipFuncAttributeMaxDynamicSharedMemorySize, LDS_BYTES) != hipSuccess) {
      fprintf(stderr, "kernel_launch: hipFuncSetAttribute failed\n"); return;
    }
    int dev = 0, cus = 0, per_cu = 0;
    (void)hipGetDevice(&dev);
    (void)hipDeviceGetAttribute(&cus, hipDeviceAttributeMultiprocessorCount, dev);
    (void)hipOccupancyMaxActiveBlocksPerMultiprocessor(&per_cu, mega, 512, LDS_BYTES);
    if (per_cu < 1) { fprintf(stderr, "kernel_launch: occupancy 0\n"); return; }
    grid_blocks = cus;
  }
  Params p{};
  p.x = (const float*)d_in[0]; p.c = (const float*)d_in[1]; p.ctx = (const float*)d_in[2]; p.c_ctx = (const float*)d_in[3];
  p.mod_w = (const float*)d_in[4]; p.mod_b = (const float*)d_in[5]; p.ab_w_in = (const float*)d_in[6]; p.ab_w_out = (const float*)d_in[7];
  p.cq_gain = (const float*)d_in[8]; p.ckv_gain = (const float*)d_in[9]; p.w_uq = (const float*)d_in[10]; p.w_ukv = (const float*)d_in[11];
  p.q_gain = (const float*)d_in[12]; p.k_gain = (const float*)d_in[13]; p.gq_gain = (const float*)d_in[14]; p.gk_gain = (const float*)d_in[15];
  p.cd_w_in = (const float*)d_in[16]; p.cd_w_out = (const float*)d_in[17]; p.win_q_gain = (const float*)d_in[18]; p.win_k_gain = (const float*)d_in[19];
  p.win_sink = (const float*)d_in[20]; p.conv_w = (const float*)d_in[21];
  p.out = (float*)d_out; p.ws = (char*)d_ws;
#if MULTI_LAUNCH
  for (int ph = 0; ph < 12; ++ph) {
    p.ph_lo = ph; p.ph_hi = ph + 1;
    hipLaunchKernelGGL(mega, dim3(grid_blocks), dim3(512), LDS_BYTES, stream, p);
  }
#else
  p.ph_lo = 0; p.ph_hi = 12;
  if (hipMemsetAsync((char*)d_ws + OFF_END, 0, XCD_BAR_WORDS * 4, stream) != hipSuccess) { fprintf(stderr, "kernel_launch: hipMemsetAsync of the barrier words failed\n"); return; }
  void* args[] = {&p};
  hipError_t e = hipLaunchCooperativeKernel((void*)mega, dim3(grid_blocks), dim3(512), args, LDS_BYTES, stream);
  if (e != hipSuccess) fprintf(stderr, "cooperative launch failed: %s (grid %d)\n", hipGetErrorString(e), grid_blocks);
#endif
}
```

```cpp
#include <hip/hip_runtime.h>
#include <hip/hip_cooperative_groups.h>
#include <cstdio>
#include <cstdint>
namespace cg = cooperative_groups;

typedef unsigned short u16;
using bf16x8 = __attribute__((ext_vector_type(8))) short;
using s16x4  = __attribute__((ext_vector_type(4))) short;
using f32x16 = __attribute__((ext_vector_type(16))) float;
using u32x4  = __attribute__((ext_vector_type(4))) unsigned;
using u32x2  = __attribute__((ext_vector_type(2))) unsigned;

constexpr int NB = 2, SEQ = 16384, DM = 1024, CL = 256;
constexpr int NLAT = NB * SEQ;
constexpr int NROW = NLAT + NB * CL;
constexpr int KVLEN = CL + SEQ;
constexpr int KV2LEN = KVLEN + 128;
constexpr int LD_AB = 2432, LD_CD = 3328;
constexpr float EPS = 1e-6f;
constexpr float QS_A = 0.14724461f;
constexpr float QS_B = 0.18033688f;
constexpr float LOG2E = 1.4426950408889634f;

constexpr size_t OFF_MODV      = 0;
constexpr size_t OFF_WT_IN_AB  = 73728;
constexpr size_t OFF_WT_OUT_AB = OFF_WT_IN_AB + (size_t)LD_AB * 1024 * 2;
constexpr size_t OFF_WT_UQ     = OFF_WT_OUT_AB + (size_t)1024 * 1024 * 2;
constexpr size_t OFF_WT_UKV    = OFF_WT_UQ + (size_t)768 * 256 * 2;
constexpr size_t OFF_WT_IN_CD  = OFF_WT_UKV + (size_t)1024 * 256 * 2;
constexpr size_t OFF_WT_OUT_CD = OFF_WT_IN_CD + (size_t)3328 * 1024 * 2;
constexpr size_t OFF_XC1       = OFF_WT_OUT_CD + (size_t)1024 * 1024 * 2;
constexpr size_t OFF_H         = OFF_XC1 + (size_t)512 * 1024 * 4;
constexpr size_t OFF_PP        = OFF_H + (size_t)NROW * 1024 * 2;
constexpr size_t OFF_QA        = OFF_PP + (size_t)NROW * 3328 * 2;
constexpr size_t OFF_QCA       = OFF_QA + (size_t)NB * 8 * SEQ * 96 * 2;
constexpr size_t OFF_KA        = OFF_QCA + (size_t)NB * 8 * CL * 96 * 2;
constexpr size_t OFF_VA        = OFF_KA + (size_t)NB * 8 * KVLEN * 96 * 2;
constexpr size_t OFF_QB        = OFF_VA + (size_t)NB * 8 * KVLEN * 64 * 2;
constexpr size_t OFF_QCB       = OFF_QB + (size_t)NB * 8 * SEQ * 64 * 2;
constexpr size_t OFF_KB        = OFF_QCB + (size_t)NB * 8 * CL * 64 * 2;
constexpr size_t OFF_VB        = OFF_KB + (size_t)NB * 2 * KVLEN * 64 * 2;
constexpr size_t OFF_END       = OFF_VB + (size_t)NB * 2 * KVLEN * 64 * 2;
constexpr size_t OFF_Q2        = OFF_QA;
constexpr size_t OFF_K2        = OFF_Q2 + (size_t)NB * 8 * SEQ * 64 * 2;
constexpr size_t OFF_V2        = OFF_K2 + (size_t)NB * 2 * KV2LEN * 64 * 2;
constexpr size_t OFF_X1B       = OFF_QA + ((size_t)64 << 20);
static_assert(OFF_V2 + (size_t)NB * 2 * KV2LEN * 64 * 2 <= OFF_X1B && OFF_X1B + (size_t)NLAT * 1024 * 2 <= OFF_END, "x1 alias");
static_assert(OFF_V2 + (size_t)NB * 2 * KV2LEN * 64 * 2 <= OFF_END, "alias overflow");

constexpr int LDS_BYTES = 147456 + 256;
#ifndef MULTI_LAUNCH
#define MULTI_LAUNCH 0
#endif

struct Params {
  const float *x, *c, *ctx, *c_ctx, *mod_w, *mod_b, *ab_w_in, *ab_w_out, *cq_gain, *ckv_gain, *w_uq, *w_ukv,
      *q_gain, *k_gain, *gq_gain, *gk_gain, *cd_w_in, *cd_w_out, *win_q_gain, *win_k_gain, *win_sink, *conv_w;
  float* out;
  char* ws;
  int ph_lo, ph_hi;
};

#define SBAR() __builtin_amdgcn_sched_barrier(0)
__device__ __forceinline__ int crow(int r, int hi) { return (r & 3) + 8 * (r >> 2) + 4 * hi; }
typedef float f32x2_t __attribute__((ext_vector_type(2)));
typedef __bf16 bf16x2_t __attribute__((ext_vector_type(2)));
__device__ __forceinline__ unsigned cvtpk(float lo, float hi) { f32x2_t v = {lo, hi}; bf16x2_t b = __builtin_convertvector(v, bf16x2_t); return __builtin_bit_cast(unsigned, b); }
__device__ __forceinline__ u16 f2bf(float x) { return (u16)(cvtpk(x, 0.f) & 0xffffu); }
__device__ __forceinline__ float bf2f(u16 x) { return __uint_as_float(((unsigned)x) << 16); }
__device__ __forceinline__ float bflo(unsigned w) { return __uint_as_float(w << 16); }
__device__ __forceinline__ float bfhi(unsigned w) { return __uint_as_float(w & 0xffff0000u); }
__device__ __forceinline__ float wave_sum(float v) {
#pragma unroll
  for (int o = 32; o >= 1; o >>= 1) v += __shfl_xor(v, o);
  return v;
}
__device__ __forceinline__ int opaque_tid() { int t = threadIdx.x; asm volatile("" : "+v"(t)); return t; }
__device__ __forceinline__ float vmaxabs(const float* g, int n) { float m = 0.f; for (int i = 0; i < n; ++i) m = fmaxf(m, fabsf(g[i])); return m; }
__device__ __forceinline__ float silu_f(float g) { return g / (1.f + __expf(-g)); }


__device__ __forceinline__ void gbar(unsigned* cnt, unsigned target) {
  asm volatile("s_waitcnt vmcnt(0)" ::: "memory");
  __syncthreads();
  if (threadIdx.x == 0) {
    __builtin_amdgcn_fence(__ATOMIC_RELEASE, "agent");
    asm volatile("s_waitcnt vmcnt(0)" ::: "memory");
    __hip_atomic_fetch_add(cnt, 1u, __ATOMIC_RELAXED, __HIP_MEMORY_SCOPE_AGENT);
    unsigned sp = 0;
    while (__hip_atomic_load(cnt, __ATOMIC_RELAXED, __HIP_MEMORY_SCOPE_AGENT) < target) { __builtin_amdgcn_s_sleep(1); if (++sp > (1u << 24)) break; }
    __builtin_amdgcn_fence(__ATOMIC_ACQUIRE, "agent");
    asm volatile("s_waitcnt vmcnt(0)" ::: "memory");
  }
  __syncthreads();
}


#define XB_TMO      128
#define XB_XCNT(j)  (256  + 64 * (j))
#define XB_XSUB(j)  (1280 + 64 * (j))
#define XB_XGEN(j)  (2304 + 64 * (j))
#define XB_TOP      3328
#define XB_TOPGEN   3392
#define XCD_BAR_WORDS 3456
#define XB_SPIN_CAP (1u << 20)
#define LAS __attribute__((address_space(3)))
__device__ __forceinline__ unsigned xb_ld(unsigned* p)              { return __hip_atomic_load(p, __ATOMIC_RELAXED, __HIP_MEMORY_SCOPE_AGENT); }
__device__ __forceinline__ unsigned xb_add(unsigned* p, unsigned v) { return __hip_atomic_fetch_add(p, v, __ATOMIC_RELAXED, __HIP_MEMORY_SCOPE_AGENT); }
__device__ __forceinline__ unsigned xb_xcc_id() { return (unsigned)__builtin_amdgcn_s_getreg((3 << 11) | 20) & 0xFu; }
#define XB_SPIN(cond, bar) do { unsigned _sp = 0; while (cond) { __builtin_amdgcn_s_sleep(1); \
    if ((++_sp & 255u) == 0u) { if (xb_ld(&(bar)[XB_TMO])) break; if (_sp > XB_SPIN_CAP) { atomicAdd(&(bar)[XB_TMO], 1u); break; } } } } while (0)
struct XcdBarrier { unsigned* bar; unsigned x; volatile LAS unsigned* st; };
__device__ __forceinline__ XcdBarrier xcd_barrier_post(unsigned* bar, volatile LAS unsigned* st) {
  XcdBarrier b; b.bar = bar; b.x = xb_xcc_id(); b.st = st;
  if (threadIdx.x == 0) (void)xb_add(&bar[XB_XCNT(b.x)], 1u);
  return b;
}
__device__ __forceinline__ void xcd_barrier_complete(unsigned* bar, unsigned x, unsigned& nloc, unsigned& nx) {
  const unsigned G = gridDim.x * gridDim.y * gridDim.z;
  unsigned sum, cnt, mine, sp = 0u;
  for (;;) {
    sum = 0u; cnt = 0u; mine = 0u;
#pragma unroll
    for (unsigned j = 0; j < 16; ++j) { const unsigned c = xb_ld(&bar[XB_XCNT(j)]); sum += c; cnt += (c > 0u) ? 1u : 0u; mine = (j == x) ? c : mine; }
    if (sum == G) break;
    __builtin_amdgcn_s_sleep(1);
    if ((++sp & 255u) == 0u) { if (xb_ld(&bar[XB_TMO])) break; if (sp > XB_SPIN_CAP) { atomicAdd(&bar[XB_TMO], 1u); break; } }
  }
  nloc = mine > 0u ? mine : 1u; nx = cnt > 0u ? cnt : 1u;
}
__device__ __forceinline__ void xcd_barrier(const XcdBarrier& b) {
  asm volatile("s_waitcnt vmcnt(0)" ::: "memory");
  __syncthreads();
  if (threadIdx.x == 0) {
    unsigned* bar = b.bar;
    __builtin_amdgcn_s_waitcnt(0);
    unsigned nloc = b.st[0], nx = b.st[1];
    if (nloc == 0u) { xcd_barrier_complete(bar, b.x, nloc, nx); b.st[0] = nloc; b.st[1] = nx; }
    const unsigned old = xb_add(&bar[XB_XSUB(b.x)], 1u);
    const unsigned gen = old / nloc;
    if (old + 1u == (gen + 1u) * nloc) {
      __builtin_amdgcn_fence(__ATOMIC_RELEASE, "agent");
      asm volatile("s_waitcnt vmcnt(0)" ::: "memory");
      const unsigned og = xb_add(&bar[XB_TOP], 1u);
      const unsigned tg = og / nx;
      if (og + 1u == (tg + 1u) * nx) xb_add(&bar[XB_TOPGEN], 1u);
      else XB_SPIN(xb_ld(&bar[XB_TOPGEN]) == tg, bar);
      __builtin_amdgcn_fence(__ATOMIC_ACQUIRE, "agent");
      xb_add(&bar[XB_XGEN(b.x)], 1u);
      asm volatile("s_waitcnt vmcnt(0)" ::: "memory");
    } else {
      XB_SPIN(xb_ld(&bar[XB_XGEN(b.x)]) == gen, bar);
      __builtin_amdgcn_fence(__ATOMIC_ACQUIRE, "agent");
      asm volatile("s_waitcnt vmcnt(0)" ::: "memory");
    }
  }
  __syncthreads();
}

__device__ void mod_unit(const Params& p, int u, char* lds) {
  const int tid = opaque_tid();
  const int layer = u / 96, n0 = (u % 96) * 32, col = tid & 31, ks = tid >> 5;
  const float* W = p.mod_w + (size_t)layer * 1024 * 3072 + n0 + col;
  float a0 = 0, a1 = 0, a2 = 0;
  for (int k = ks * 64; k < ks * 64 + 64; ++k) {
    float w = W[(size_t)k * 3072];
    a0 += silu_f(p.c[k]) * w; a1 += silu_f(p.c[1024 + k]) * w; a2 += silu_f(p.c_ctx[k]) * w;
  }
  float* red = (float*)lds;
  red[(0 * 16 + ks) * 32 + col] = a0; red[(1 * 16 + ks) * 32 + col] = a1; red[(2 * 16 + ks) * 32 + col] = a2;
  __syncthreads();
  if (tid < 96) {
    int w = tid >> 5, cc = tid & 31; float s = 0;
    for (int i = 0; i < 16; ++i) s += red[(w * 16 + i) * 32 + cc];
    float* modv = (float*)(p.ws + OFF_MODV);
    modv[(layer * 3 + w) * 3072 + n0 + cc] = s + p.mod_b[layer * 3072 + n0 + cc];
  }
  __syncthreads();
}

__device__ void transpose_unit(const Params& p, int u, char* lds) {
  const float* src; const float* gain = nullptr; int K, N; u16* dst; int ul;
  if (u < 608)       { ul = u;        src = p.ab_w_in;  K = 1024; N = 2336; dst = (u16*)(p.ws + OFF_WT_IN_AB); }
  else if (u < 864)  { ul = u - 608;  src = p.ab_w_out; K = 1024; N = 1024; dst = (u16*)(p.ws + OFF_WT_OUT_AB); }
  else if (u < 912)  { ul = u - 864;  src = p.w_uq;     K = 256;  N = 768;  dst = (u16*)(p.ws + OFF_WT_UQ); gain = p.cq_gain; }
  else if (u < 976)  { ul = u - 912;  src = p.w_ukv;    K = 256;  N = 1024; dst = (u16*)(p.ws + OFF_WT_UKV); gain = p.ckv_gain; }
  else if (u < 1808) { ul = u - 976;  src = p.cd_w_in;  K = 1024; N = 3328; dst = (u16*)(p.ws + OFF_WT_IN_CD); }
  else               { ul = u - 1808; src = p.cd_w_out; K = 1024; N = 1024; dst = (u16*)(p.ws + OFF_WT_OUT_CD); }
  const int nkt = K / 64, kt = ul % nkt, nt = ul / nkt, k0 = kt * 64, n0 = nt * 64, tid = opaque_tid();
  float* tile = (float*)lds;
#pragma unroll
  for (int e = 0; e < 8; ++e) {
    int i = (tid >> 6) + 8 * e, j = tid & 63, n = n0 + j;
    float v = (n < N) ? src[(size_t)(k0 + i) * N + n] : 0.f;
    if (gain) v *= gain[k0 + i];
    tile[i * 65 + j] = v;
  }
  __syncthreads();
#pragma unroll
  for (int e = 0; e < 8; ++e) {
    int i2 = (tid >> 6) + 8 * e, j2 = tid & 63;
    dst[(size_t)(n0 + i2) * K + k0 + j2] = f2bf(tile[j2 * 65 + i2]);
  }
  __syncthreads();
}

template <bool BF>
__device__ __forceinline__ void adaln_latent(const void* __restrict__ xsrc, const float* __restrict__ modl, u16* __restrict__ H, int gw, int nw, int lane) {
  constexpr int NV = BF ? 2 : 4;
  constexpr int CW = BF ? 8 : 4;
  u32x4 cur[NV], nxt[NV];
  float sh[NV][CW], sc[NV][CW];
  auto ld = [&](u32x4 (&d)[NV], int r) {
#pragma unroll
    for (int i = 0; i < NV; ++i)
      d[i] = BF ? __builtin_nontemporal_load((const u32x4*)((const u16*)xsrc + (size_t)r * 1024 + 8 * (lane + 64 * i))) : __builtin_nontemporal_load((const u32x4*)((const float*)xsrc + (size_t)r * 1024 + 4 * (lane + 64 * i)));
  };
  int r = gw; if (r < NLAT) ld(cur, r);
  int lastb = -1;
  for (; r < NLAT; r += nw) {
    const int rn = r + nw;
    if (rn < NLAT) ld(nxt, rn);
    const int b = r >> 14;
    if (b != lastb) { lastb = b; const float* m = modl + b * 3072;
#pragma unroll
      for (int i = 0; i < NV; ++i)
#pragma unroll
        for (int e = 0; e < CW; ++e) { sh[i][e] = m[CW * (lane + 64 * i) + e]; sc[i][e] = 1.f + m[1024 + CW * (lane + 64 * i) + e]; } }
    float f[NV][CW]; float ss = 0;
#pragma unroll
    for (int i = 0; i < NV; ++i)
#pragma unroll
      for (int e = 0; e < CW; ++e) {
        f[i][e] = BF ? ((e & 1) ? bfhi(cur[i][e >> 1]) : bflo(cur[i][e >> 1])) : __uint_as_float(cur[i][e]);
        ss += f[i][e] * f[i][e]; }
    ss = wave_sum(ss);
    const float rstd = rsqrtf(ss * (1.f / 1024) + EPS);
#pragma unroll
    for (int i = 0; i < NV; ++i) {
      float y[CW];
#pragma unroll
      for (int e = 0; e < CW; ++e) y[e] = f[i][e] * rstd * sc[i][e] + sh[i][e];
      if (BF) { const u32x4 o = {cvtpk(y[0], y[1]), cvtpk(y[2], y[3]), cvtpk(y[4 % CW], y[5 % CW]), cvtpk(y[6 % CW], y[7 % CW])}; *(u32x4*)(H + (size_t)r * 1024 + 8 * (lane + 64 * i)) = o; }
      else { const u32x2 o = {cvtpk(y[0], y[1]), cvtpk(y[2], y[3])}; *(u32x2*)(H + (size_t)r * 1024 + 4 * (lane + 64 * i)) = o; }
    }
#pragma unroll
    for (int i = 0; i < NV; ++i) cur[i] = nxt[i];
  }
}
__device__ void adaln_phase(const float* xlat, const u16* xlat_bf, const float* xctx, const float* modl, u16* H) {
  const int tid = opaque_tid(), lane = tid & 63, gw = blockIdx.x * 8 + (tid >> 6), nw = gridDim.x * 8;
  if (xlat_bf != nullptr) adaln_latent<true>(xlat_bf, modl, H, gw, nw, lane); else adaln_latent<false>(xlat, modl, H, gw, nw, lane);
  for (int r = NLAT + gw; r < NROW; r += nw) {
    const float* src = xctx + (size_t)(r - NLAT) * 1024;
    const float* m = modl + 2 * 3072;
    float4 v[4]; float ss = 0;
#pragma unroll
    for (int i = 0; i < 4; ++i) { v[i] = ((const float4*)src)[lane + 64 * i]; ss += v[i].x * v[i].x + v[i].y * v[i].y + v[i].z * v[i].z + v[i].w * v[i].w; }
    ss = wave_sum(ss);
    const float rstd = rsqrtf(ss * (1.f / 1024) + EPS);
#pragma unroll
    for (int i = 0; i < 4; ++i) {
      int c = 4 * (lane + 64 * i);
      float4 sh = *(const float4*)(m + c), sc = *(const float4*)(m + 1024 + c);
      float y0 = v[i].x * rstd * (1.f + sc.x) + sh.x, y1 = v[i].y * rstd * (1.f + sc.y) + sh.y;
      float y2 = v[i].z * rstd * (1.f + sc.z) + sh.z, y3 = v[i].w * rstd * (1.f + sc.w) + sh.w;
      u32x2 o = {cvtpk(y0, y1), cvtpk(y2, y3)};
      *(u32x2*)(H + (size_t)r * 1024 + c) = o;
    }
  }
}

#define GSWZ(row, colB) ((row) * 128 + ((colB) ^ ((((row) >> 1) & 7) << 4)))
struct ResPre { float4 v[16]; u32x2 w[16]; };
struct GPre { bf16x8 ra[4], rb[2]; };
__device__ __forceinline__ void gemm_preload(const u16* __restrict__ A, int lda, const u16* __restrict__ Bt, int ldb, int m0, int n0, GPre& g) {
  const int tid = opaque_tid(), srow = tid >> 3, sch = tid & 7;
  const u16* ap = A + (size_t)(m0 + srow) * lda + sch * 8;
  const u16* bp = Bt + (size_t)(n0 + srow) * ldb + sch * 8;
#pragma unroll
  for (int i = 0; i < 4; ++i) g.ra[i] = *(const bf16x8*)(ap + (size_t)(64 * i) * lda);
#pragma unroll
  for (int i = 0; i < 2; ++i) g.rb[i] = *(const bf16x8*)(bp + (size_t)(64 * i) * ldb);
}
template <int PRE>
__device__ __forceinline__ void gemm_tile(const u16* __restrict__ A, int lda, const u16* __restrict__ Bt, int ldb, int K,
                                          int m0, int n0, f32x16 (&acc)[2][2], char* lds, GPre& g, const void* resp = nullptr, ResPre* rp = nullptr) {
  const int tid = opaque_tid(), wid = tid >> 6, lane = tid & 63, r32 = lane & 31, hi = lane >> 5;
  const int wm = wid & 3, wn = wid >> 2;
  char* As = lds;
  char* Bs = lds + 98304;
  const int srow = tid >> 3, sch = tid & 7;
  const u16* ap = A + (size_t)(m0 + srow) * lda + sch * 8;
  const u16* bp = Bt + (size_t)(n0 + srow) * ldb + sch * 8;
  const int sw = GSWZ(srow, sch * 16);
  bf16x8 (&ra)[4] = g.ra; bf16x8 (&rb)[2] = g.rb;
#pragma unroll
  for (int i = 0; i < 2; ++i) for (int j = 0; j < 2; ++j) acc[i][j] = f32x16{};
  const int nk = K / 64;
  __syncthreads();
#pragma unroll
  for (int i = 0; i < 4; ++i) *(bf16x8*)(As + sw + i * 8192) = ra[i];
#pragma unroll
  for (int i = 0; i < 2; ++i) *(bf16x8*)(Bs + sw + i * 8192) = rb[i];
  if (1 < nk) {
#pragma unroll
    for (int i = 0; i < 4; ++i) ra[i] = *(const bf16x8*)(ap + (size_t)(64 * i) * lda + 64);
#pragma unroll
    for (int i = 0; i < 2; ++i) rb[i] = *(const bf16x8*)(bp + (size_t)(64 * i) * ldb + 64);
  }
  __syncthreads();
  const int arow0 = wm * 64 + r32, brow0 = wn * 64 + r32;
  int st = 0;
  for (int kt = 0; kt < nk; ++kt) {
    const int stn = (st == 2) ? 0 : st + 1;
    if (kt + 1 < nk) {
      char* An = As + stn * 32768; char* Bn = Bs + stn * 16384;
#pragma unroll
      for (int i = 0; i < 4; ++i) *(bf16x8*)(An + sw + i * 8192) = ra[i];
#pragma unroll
      for (int i = 0; i < 2; ++i) *(bf16x8*)(Bn + sw + i * 8192) = rb[i];
    }
    if (kt + 2 < nk) {
#pragma unroll
      for (int i = 0; i < 4; ++i) ra[i] = *(const bf16x8*)(ap + (size_t)(64 * i) * lda + (kt + 2) * 64);
#pragma unroll
      for (int i = 0; i < 2; ++i) rb[i] = *(const bf16x8*)(bp + (size_t)(64 * i) * ldb + (kt + 2) * 64);
    }
    if (PRE == 1 && kt == 0) {
#pragma unroll
      for (int q = 0; q < 16; ++q) { const u32x4 t_ = __builtin_nontemporal_load((const u32x4*)((const float*)resp + (size_t)((q >> 3) * 32 + 4 * (q & 7)) * 1024)); rp->v[q] = make_float4(__uint_as_float(t_[0]), __uint_as_float(t_[1]), __uint_as_float(t_[2]), __uint_as_float(t_[3])); }
    }
    if (PRE == 2 && kt == 0) {
#pragma unroll
      for (int q = 0; q < 16; ++q) rp->w[q] = __builtin_nontemporal_load((const u32x2*)((const u16*)resp + (size_t)((q >> 3) * 32 + 4 * (q & 7)) * 1024));
    }
    SBAR();
    const char* Ac = As + st * 32768; const char* Bc = Bs + st * 16384;
#pragma unroll
    for (int kk = 0; kk < 4; ++kk) {
      const int cb = kk * 32 + hi * 16;
      bf16x8 a0 = *(const bf16x8*)(Ac + GSWZ(arow0, cb));
      bf16x8 a1 = *(const bf16x8*)(Ac + GSWZ(arow0 + 32, cb));
      bf16x8 b0 = *(const bf16x8*)(Bc + GSWZ(brow0, cb));
      bf16x8 b1 = *(const bf16x8*)(Bc + GSWZ(brow0 + 32, cb));
      acc[0][0] = __builtin_amdgcn_mfma_f32_32x32x16_bf16(a0, b0, acc[0][0], 0, 0, 0);
      acc[0][1] = __builtin_amdgcn_mfma_f32_32x32x16_bf16(a0, b1, acc[0][1], 0, 0, 0);
      acc[1][0] = __builtin_amdgcn_mfma_f32_32x32x16_bf16(a1, b0, acc[1][0], 0, 0, 0);
      acc[1][1] = __builtin_amdgcn_mfma_f32_32x32x16_bf16(a1, b1, acc[1][1], 0, 0, 0);
    }
    __syncthreads();
    st = stn;
  }
}

struct TileIter {
  int f, fend, step, MT, NT;
  __device__ __forceinline__ TileIter(int MT_, int NT_) : MT(MT_), NT(NT_) {
    const int T = MT_ * NT_, bid = blockIdx.x, nblk = gridDim.x;
    if (nblk == 256) { const int x = bid & 7, cl = bid >> 3; f = (int)(((long)T * x) >> 3) + cl; fend = (int)(((long)T * (x + 1)) >> 3); step = 32; }
    else { f = bid; fend = T; step = nblk; }
  }
  __device__ __forceinline__ bool valid() const { return f < fend; }
  __device__ __forceinline__ void next() { f += step; }
  __device__ __forceinline__ void get(int& mt, int& nt) const {
    const int full = (MT >> 2) * 4 * NT;
    if (f < full) { const int g = f / (4 * NT), rem = f - g * 4 * NT; nt = rem >> 2; mt = g * 4 + (rem & 3); }
    else { const int rem = f - full, gs = MT - (MT >> 2) * 4; nt = rem / gs; mt = (MT >> 2) * 4 + (rem - nt * gs); }
  }
};

__device__ __forceinline__ void epi_bf16(f32x16 (&acc)[2][2], u16* C, int ldc, int m0, int n0, char* lds) {
  const int tid = opaque_tid(), wid = tid >> 6, lane = tid & 63, r32 = lane & 31, hi = lane >> 5;
  const int wm = wid & 3, wn = wid >> 2;
  char* wl = lds + wid * 9216;
#pragma unroll
  for (int i = 0; i < 2; ++i)
#pragma unroll
    for (int j = 0; j < 2; ++j)
#pragma unroll
      for (int r = 0; r < 16; ++r) *(u16*)(wl + (i * 32 + crow(r, hi)) * 144 + (j * 32 + r32) * 2) = f2bf(acc[i][j][r]);
  asm volatile("s_waitcnt lgkmcnt(0)" ::: "memory");
  const int rr = lane >> 3, ch = lane & 7;
  u16* cbase = C + (size_t)(m0 + wm * 64 + rr) * ldc + n0 + wn * 64 + ch * 8;
#pragma unroll
  for (int k = 0; k < 8; ++k) {
    const u32x4 v = *(const u32x4*)(wl + (rr + 8 * k) * 144 + ch * 16);
    *(u32x4*)(cbase + (size_t)(8 * k) * ldc) = v;
  }
}
template <bool IN_BF, bool OUT_BF>
__device__ __forceinline__ void epi_res(f32x16 (&acc)[2][2], const ResPre& rp, void* outp, const float* gsrc, int n0, char* lds) {
  const int tid = opaque_tid(), wid = tid >> 6, lane = tid & 63, r32 = lane & 31, hi = lane >> 5;
  const int wn = wid >> 2;
  char* wl = lds + wid * 8704;
  const int rl = lane >> 4, c4 = lane & 15;
  const float4 g = *(const float4*)(gsrc + n0 + wn * 64 + 4 * c4);
#pragma unroll
  for (int i = 0; i < 2; ++i) {
#pragma unroll
    for (int j = 0; j < 2; ++j)
#pragma unroll
      for (int r = 0; r < 16; ++r) *(float*)(wl + crow(r, hi) * 272 + (j * 32 + r32) * 4) = acc[i][j][r];
    asm volatile("s_waitcnt lgkmcnt(0)" ::: "memory");
#pragma unroll
    for (int k = 0; k < 8; ++k) {
      const float4 a = *(const float4*)(wl + (rl + 4 * k) * 272 + c4 * 16);
      float4 x;
      if (IN_BF) { const u32x2 xw = rp.w[i * 8 + k]; x.x = bflo(xw[0]); x.y = bfhi(xw[0]); x.z = bflo(xw[1]); x.w = bfhi(xw[1]); } else x = rp.v[i * 8 + k];
      float4 o; o.x = x.x + g.x * a.x; o.y = x.y + g.y * a.y; o.z = x.z + g.z * a.z; o.w = x.w + g.w * a.w;
      if (OUT_BF) { const u32x2 ow = {cvtpk(o.x, o.y), cvtpk(o.z, o.w)}; *(u32x2*)((u16*)outp + (size_t)(i * 32 + 4 * k) * 1024) = ow; }
      else { const u32x4 t_ = {__float_as_uint(o.x), __float_as_uint(o.y), __float_as_uint(o.z), __float_as_uint(o.w)}; __builtin_nontemporal_store(t_, (u32x4*)((float*)outp + (size_t)(i * 32 + 4 * k) * 1024)); }
    }
    asm volatile("s_waitcnt lgkmcnt(0)" ::: "memory");
  }
}

__device__ __forceinline__ float red8(float v) { v += __shfl_xor(v, 1); v += __shfl_xor(v, 2); v += __shfl_xor(v, 4); return v; }
__device__ __forceinline__ void rope_cs(float pos, float inv, bool on, float& c, float& s) {
  if (on) { float a = pos * inv * 0.15915494309189535f; a -= floorf(a); c = __builtin_amdgcn_cosf(a); s = __builtin_amdgcn_sinf(a); } else { c = 1.f; s = 0.f; }
}
__device__ __forceinline__ void head64(const u16* src, u16* dst, int gb, const float* g, const float* cG, const float* sG, float qs) {
  const u32x2 lo = *(const u32x2*)(src + gb), hi2 = *(const u32x2*)(src + gb + 16);
  float x[8] = {bflo(lo[0]), bfhi(lo[0]), bflo(lo[1]), bfhi(lo[1]), bflo(hi2[0]), bfhi(hi2[0]), bflo(hi2[1]), bfhi(hi2[1])};
  float ss = 0;
#pragma unroll
  for (int e = 0; e < 8; ++e) ss += x[e] * x[e];
  const float rn = rsqrtf(red8(ss) * (1.f / 64) + EPS) ;
#pragma unroll
  for (int e = 0; e < 8; ++e) x[e] *= rn * g[e];
  float y[8];
#pragma unroll
  for (int e = 0; e < 4; ++e) { y[e] = (x[e] * cG[e] - x[e + 4] * sG[e]) * qs; y[e + 4] = (x[e + 4] * cG[e] + x[e] * sG[e]) * qs; }
  const u32x2 o0 = {cvtpk(y[0], y[1]), cvtpk(y[2], y[3])}, o1 = {cvtpk(y[4], y[5]), cvtpk(y[6], y[7])};
  *(u32x2*)(dst + gb) = o0; *(u32x2*)(dst + gb + 16) = o1;
}
__device__ __forceinline__ void head96(float* n, float r1a, float r1b, float r2a, float r2b, u16* dst, int t, int rb,
                                       const float* gn, const float* gr, const float* cM, const float* sM, float qs) {
  float ss = r1a * r1a + r1b * r1b + r2a * r2a + r2b * r2b;
#pragma unroll
  for (int e = 0; e < 8; ++e) ss += n[e] * n[e];
  const float rn = rsqrtf(red8(ss) * (1.f / 96) + EPS);
#pragma unroll
  for (int e = 0; e < 8; ++e) n[e] *= rn * gn[e] * qs;
  r1a *= rn * gr[0]; r1b *= rn * gr[1]; r2a *= rn * gr[2]; r2b *= rn * gr[3];
  const float y1a = (r1a * cM[0] - r2a * sM[0]) * qs, y2a = (r2a * cM[0] + r1a * sM[0]) * qs;
  const float y1b = (r1b * cM[1] - r2b * sM[1]) * qs, y2b = (r2b * cM[1] + r1b * sM[1]) * qs;
  const u32x4 o = {cvtpk(n[0], n[1]), cvtpk(n[2], n[3]), cvtpk(n[4], n[5]), cvtpk(n[6], n[7])};
  *(u32x4*)(dst + 8 * t) = o;
  *(unsigned*)(dst + 64 + rb) = cvtpk(y1a, y1b); *(unsigned*)(dst + 64 + rb + 8) = cvtpk(y2a, y2b);
}
__device__ void finalize0(const Params& p) {
  const int tid = opaque_tid(), lane = tid & 63, gw = blockIdx.x * 8 + (tid >> 6), nw = gridDim.x * 8;
  const int h = lane >> 3, t = lane & 7;
  char* ws = p.ws;
  const u16* PP = (const u16*)(ws + OFF_PP);
  const u16* QAR = (const u16*)(ws + OFF_H);
  const u16* KVR = (const u16*)p.out;
  u16* QA = (u16*)(ws + OFF_QA); u16* QCA = (u16*)(ws + OFF_QCA); u16* KA = (u16*)(ws + OFF_KA); u16* VA = (u16*)(ws + OFF_VA);
  u16* QB = (u16*)(ws + OFF_QB); u16* QCB = (u16*)(ws + OFF_QCB); u16* KB = (u16*)(ws + OFF_KB); u16* VB = (u16*)(ws + OFF_VB);
  const int gb = t < 4 ? 4 * t : 32 + 4 * (t - 4), rb = t < 4 ? 2 * t : 16 + 2 * (t - 4);
  float qgn[8], kgn[8], qgr[4], kgr[4], gqg[8], gkg[8], invG[4], invM[2];
#pragma unroll
  for (int e = 0; e < 8; ++e) { qgn[e] = p.q_gain[8 * t + e]; kgn[e] = p.k_gain[8 * t + e];
    const int d = gb + (e & 3) + (e >> 2) * 16; gqg[e] = p.gq_gain[d]; gkg[e] = p.gk_gain[d]; }
#pragma unroll
  for (int k = 0; k < 4; ++k) { const int d = 64 + rb + (k & 1) + (k >> 1) * 8; qgr[k] = p.q_gain[d]; kgr[k] = p.k_gain[d]; }
#pragma unroll
  for (int e = 0; e < 4; ++e) invG[e] = exp2f(-(float)(4 * (t & 3) + e) * (13.287712379549449f / 16.f));
#pragma unroll
  for (int k = 0; k < 2; ++k) invM[k] = exp2f(-(float)(2 * (t & 3) + k) * (13.287712379549449f / 8.f));
  for (int r = gw; r < NROW; r += nw) {
    const bool isctx = r >= NLAT;
    int b, s, kpos; float pos = 0.f;
    if (!isctx) { b = r >> 14; s = r & 16383; kpos = CL + s; pos = t < 4 ? (float)(s >> 6) : (float)(s & 63); }
    else { int rc = r - NLAT; b = rc >> 8; s = rc & 255; kpos = s; }
    float cG[4], sG[4], cM[2], sM[2];
#pragma unroll
    for (int e = 0; e < 4; ++e) rope_cs(pos, invG[e], !isctx, cG[e], sG[e]);
#pragma unroll
    for (int k = 0; k < 2; ++k) rope_cs(pos, invM[k], !isctx, cM[k], sM[k]);
    const u16* pp = PP + (size_t)r * LD_AB;
    const u32x2 wq = *(const u32x2*)(pp + lane * 4), wk = *(const u32x2*)(pp + 256 + lane * 4);
    float s1 = bflo(wq[0]) * bflo(wq[0]) + bfhi(wq[0]) * bfhi(wq[0]) + bflo(wq[1]) * bflo(wq[1]) + bfhi(wq[1]) * bfhi(wq[1]);
    float s2 = bflo(wk[0]) * bflo(wk[0]) + bfhi(wk[0]) * bfhi(wk[0]) + bflo(wk[1]) * bflo(wk[1]) + bfhi(wk[1]) * bfhi(wk[1]);
    s1 = wave_sum(s1); s2 = wave_sum(s2);
    const float rstd_cq = rsqrtf(s1 * (1.f / 256) + EPS), rstd_ckv = rsqrtf(s2 * (1.f / 256) + EPS);
    { const u16* qa = QAR + (size_t)r * 768 + h * 96;
      const u32x4 nv = *(const u32x4*)(qa + 8 * t); const unsigned w1 = *(const unsigned*)(qa + 64 + rb), w2 = *(const unsigned*)(qa + 64 + rb + 8);
      float n[8] = {bflo(nv[0]) * rstd_cq, bfhi(nv[0]) * rstd_cq, bflo(nv[1]) * rstd_cq, bfhi(nv[1]) * rstd_cq, bflo(nv[2]) * rstd_cq, bfhi(nv[2]) * rstd_cq, bflo(nv[3]) * rstd_cq, bfhi(nv[3]) * rstd_cq};
      u16* dq = isctx ? QCA + ((size_t)(b * 8 + h) * CL + s) * 96 : QA + ((size_t)(b * 8 + h) * SEQ + s) * 96;
      head96(n, bflo(w1) * rstd_cq, bfhi(w1) * rstd_cq, bflo(w2) * rstd_cq, bfhi(w2) * rstd_cq, dq, t, rb, qgn, qgr, cM, sM, QS_A); }
    { const u16* kv = KVR + (size_t)r * 1024 + h * 128;
      const u32x4 nv = *(const u32x4*)(kv + 8 * t), vv = *(const u32x4*)(kv + 64 + 8 * t);
      const unsigned w1 = *(const unsigned*)(pp + 512 + rb), w2 = *(const unsigned*)(pp + 512 + rb + 8);
      float n[8] = {bflo(nv[0]) * rstd_ckv, bfhi(nv[0]) * rstd_ckv, bflo(nv[1]) * rstd_ckv, bfhi(nv[1]) * rstd_ckv, bflo(nv[2]) * rstd_ckv, bfhi(nv[2]) * rstd_ckv, bflo(nv[3]) * rstd_ckv, bfhi(nv[3]) * rstd_ckv};
      const size_t kr = (size_t)(b * 8 + h) * KVLEN + kpos;
      head96(n, bflo(w1), bfhi(w1), bflo(w2), bfhi(w2), KA + kr * 96, t, rb, kgn, kgr, cM, sM, 1.f);
      const u32x4 vo = {cvtpk(bflo(vv[0]) * rstd_ckv, bfhi(vv[0]) * rstd_ckv), cvtpk(bflo(vv[1]) * rstd_ckv, bfhi(vv[1]) * rstd_ckv),
                        cvtpk(bflo(vv[2]) * rstd_ckv, bfhi(vv[2]) * rstd_ckv), cvtpk(bflo(vv[3]) * rstd_ckv, bfhi(vv[3]) * rstd_ckv)};
      *(u32x4*)(VA + kr * 64 + 8 * t) = vo; }
    { u16* dg = isctx ? QCB + ((size_t)(b * 8 + h) * CL + s) * 64 : QB + ((size_t)(b * 8 + h) * SEQ + s) * 64;
      head64(pp + 544 + h * 64, dg, gb, gqg, cG, sG, QS_B); }
    if (h < 2) {
      const size_t kr = (size_t)(b * 2 + h) * KVLEN + kpos;
      head64(pp + 1056 + h * 64, KB + kr * 64, gb, gkg, cG, sG, 1.f);
      *(u32x4*)(VB + kr * 64 + 8 * t) = *(const u32x4*)(pp + 1184 + h * 64 + 8 * t);
    }
  }
}

__device__ void finalize1(const Params& p) {
  const int tid = opaque_tid(), lane = tid & 63, gw = blockIdx.x * 8 + (tid >> 6), nw = gridDim.x * 8;
  const int h = lane >> 3, t = lane & 7;
  char* ws = p.ws;
  const u16* PP = (const u16*)(ws + OFF_PP);
  u16* Q2 = (u16*)(ws + OFF_Q2); u16* K2 = (u16*)(ws + OFF_K2); u16* V2 = (u16*)(ws + OFF_V2);
  u16* MIX = (u16*)(ws + OFF_H);
  const int gb = t < 4 ? 4 * t : 32 + 4 * (t - 4);
  float qg[8], kg[8], invG[4];
#pragma unroll
  for (int e = 0; e < 8; ++e) { const int d = gb + (e & 3) + (e >> 2) * 16; qg[e] = p.win_q_gain[d]; kg[e] = p.win_k_gain[d]; }
#pragma unroll
  for (int e = 0; e < 4; ++e) invG[e] = exp2f(-(float)(4 * (t & 3) + e) * (13.287712379549449f / 16.f));
  float cw[3][8];
#pragma unroll
  for (int j = 0; j < 3; ++j)
#pragma unroll
    for (int e = 0; e < 8; ++e) cw[j][e] = p.conv_w[j * 512 + lane * 8 + e];
  for (int r = gw; r < NROW + 512; r += nw) {
    if (r >= NROW) {
      int slab = (r - NROW) >> 7, pr = (r - NROW) & 127;
      size_t kr = (size_t)slab * KV2LEN + KVLEN + pr;
      K2[kr * 64 + lane] = 0; V2[kr * 64 + lane] = 0;
      continue;
    }
    const bool isctx = r >= NLAT;
    int b, s, kpos; float pos = 0.f;
    if (!isctx) { b = r >> 14; s = r & 16383; kpos = CL + s; pos = t < 4 ? (float)(s >> 6) : (float)(s & 63); }
    else { int rc = r - NLAT; b = rc >> 8; s = rc & 255; kpos = s; }
    float cG[4], sG[4];
#pragma unroll
    for (int e = 0; e < 4; ++e) rope_cs(pos, invG[e], !isctx, cG[e], sG[e]);
    const u16* pp = PP + (size_t)r * LD_CD;
    if (!isctx) head64(pp + h * 64, Q2 + ((size_t)(b * 8 + h) * SEQ + s) * 64, gb, qg, cG, sG, QS_B);
    if (h < 2) {
      const size_t kr = (size_t)(b * 2 + h) * KV2LEN + kpos;
      head64(pp + 512 + h * 64, K2 + kr * 64, gb, kg, cG, sG, 1.f);
      *(u32x4*)(V2 + kr * 64 + 8 * t) = *(const u32x4*)(pp + 640 + h * 64 + 8 * t);
    }
    if (!isctx) {
      const int c0 = lane * 8;
      float y[8];
#pragma unroll
      for (int e = 0; e < 8; ++e) y[e] = 0.f;
#pragma unroll
      for (int j = 0; j < 3; ++j) {
        const int sj = s + j - 1;
        if (sj >= 0 && sj < SEQ) {
          const u16* pj = pp + (ptrdiff_t)(j - 1) * LD_CD;
          u32x4 a = *(const u32x4*)(pj + 1280 + c0), bb = *(const u32x4*)(pj + 1792 + c0);
#pragma unroll
          for (int e = 0; e < 4; ++e) {
            y[2 * e]     += bflo(a[e]) * bflo(bb[e]) * cw[j][2 * e];
            y[2 * e + 1] += bfhi(a[e]) * bfhi(bb[e]) * cw[j][2 * e + 1];
          }
        }
      }
      u32x4 gbv = *(const u32x4*)(pp + 768 + c0), gt = *(const u32x4*)(pp + 2304 + 512 + c0);
      u32x4 o;
#pragma unroll
      for (int e = 0; e < 4; ++e) {
        float v0 = bflo(gbv[e]) * y[2 * e] * silu_f(bflo(gt[e]));
        float v1 = bfhi(gbv[e]) * y[2 * e + 1] * silu_f(bfhi(gt[e]));
        o[e] = cvtpk(v0, v1);
      }
      *(u32x4*)(MIX + (size_t)r * 1024 + 512 + c0) = o;
    }
  }
}

#define KSWZ(row, colB) ((row) * 272 + (colB))
__device__ __forceinline__ int v_st2(int k, int c) { const int kk = k; return ((kk >> 3) * 2 + (c >> 5)) * 512 + ((kk & 7) * 32 + (c & 31)) * 2; }
__device__ __forceinline__ int v_rd_base(int lane) { return ((lane & 3) << 3) | (((lane >> 2) & 3) << 6) | (((lane >> 4) & 1) << 5) | (((lane >> 5) & 1) << 8); }
constexpr int v_rd_off2(int d0, int ks, int half) { return d0 * 512 + ks * 2048 + half * 1024; }
template <int OFF> __device__ __forceinline__ s16x4 tr_read(int vb) {
  s16x4 r; asm volatile("ds_read_b64_tr_b16 %0, %1 offset:%2" : "=&v"(r) : "v"(vb), "i"(OFF) : "memory"); return r;
}
template <int D0> __device__ __forceinline__ void pv_one(f32x16& od, int vb, bf16x8 pa0, bf16x8 pa1, bf16x8 pa2, bf16x8 pa3) {
  const s16x4 l0 = tr_read<v_rd_off2(D0, 0, 0)>(vb), h0 = tr_read<v_rd_off2(D0, 0, 1)>(vb), l1 = tr_read<v_rd_off2(D0, 1, 0)>(vb), h1 = tr_read<v_rd_off2(D0, 1, 1)>(vb);
  const s16x4 l2 = tr_read<v_rd_off2(D0, 2, 0)>(vb), h2 = tr_read<v_rd_off2(D0, 2, 1)>(vb), l3 = tr_read<v_rd_off2(D0, 3, 0)>(vb), h3 = tr_read<v_rd_off2(D0, 3, 1)>(vb);
  asm volatile("s_waitcnt lgkmcnt(0)" ::: "memory"); SBAR();
#define PK(L, H) (bf16x8){L[0], L[1], L[2], L[3], H[0], H[1], H[2], H[3]}
  od = __builtin_amdgcn_mfma_f32_32x32x16_bf16(pa0, PK(l0, h0), od, 0, 0, 0);
  od = __builtin_amdgcn_mfma_f32_32x32x16_bf16(pa1, PK(l1, h1), od, 0, 0, 0);
  od = __builtin_amdgcn_mfma_f32_32x32x16_bf16(pa2, PK(l2, h2), od, 0, 0, 0);
  od = __builtin_amdgcn_mfma_f32_32x32x16_bf16(pa3, PK(l3, h3), od, 0, 0, 0);
#undef PK
}
__device__ __forceinline__ void pv_all(f32x16* o, int vb, bf16x8 pa0, bf16x8 pa1, bf16x8 pa2, bf16x8 pa3) {
  pv_one<0>(o[0], vb, pa0, pa1, pa2, pa3); pv_one<1>(o[1], vb, pa0, pa1, pa2, pa3);
}
__device__ __forceinline__ void pv_exp(f32x16* o, int vb, bf16x8 pa0, bf16x8 pa1, bf16x8 pa2, bf16x8 pa3, f32x16& n0, f32x16& n1) {
#define PK(L, H) (bf16x8){L[0], L[1], L[2], L[3], H[0], H[1], H[2], H[3]}
  { const s16x4 l0 = tr_read<v_rd_off2(0, 0, 0)>(vb), h0 = tr_read<v_rd_off2(0, 0, 1)>(vb), l1 = tr_read<v_rd_off2(0, 1, 0)>(vb), h1 = tr_read<v_rd_off2(0, 1, 1)>(vb);
    const s16x4 l2 = tr_read<v_rd_off2(0, 2, 0)>(vb), h2 = tr_read<v_rd_off2(0, 2, 1)>(vb), l3 = tr_read<v_rd_off2(0, 3, 0)>(vb), h3 = tr_read<v_rd_off2(0, 3, 1)>(vb);
#pragma unroll
    for (int r = 0; r < 8; ++r) n0[r] = __builtin_amdgcn_exp2f(n0[r]);
    asm volatile("s_waitcnt lgkmcnt(0)" ::: "memory"); SBAR();
    o[0] = __builtin_amdgcn_mfma_f32_32x32x16_bf16(pa0, PK(l0, h0), o[0], 0, 0, 0);
    o[0] = __builtin_amdgcn_mfma_f32_32x32x16_bf16(pa1, PK(l1, h1), o[0], 0, 0, 0);
    o[0] = __builtin_amdgcn_mfma_f32_32x32x16_bf16(pa2, PK(l2, h2), o[0], 0, 0, 0);
    o[0] = __builtin_amdgcn_mfma_f32_32x32x16_bf16(pa3, PK(l3, h3), o[0], 0, 0, 0); }
  { const s16x4 l0 = tr_read<v_rd_off2(1, 0, 0)>(vb), h0 = tr_read<v_rd_off2(1, 0, 1)>(vb), l1 = tr_read<v_rd_off2(1, 1, 0)>(vb), h1 = tr_read<v_rd_off2(1, 1, 1)>(vb);
    const s16x4 l2 = tr_read<v_rd_off2(1, 2, 0)>(vb), h2 = tr_read<v_rd_off2(1, 2, 1)>(vb), l3 = tr_read<v_rd_off2(1, 3, 0)>(vb), h3 = tr_read<v_rd_off2(1, 3, 1)>(vb);
#pragma unroll
    for (int r = 8; r < 16; ++r) n0[r] = __builtin_amdgcn_exp2f(n0[r]);
    asm volatile("s_waitcnt lgkmcnt(0)" ::: "memory"); SBAR();
    o[1] = __builtin_amdgcn_mfma_f32_32x32x16_bf16(pa0, PK(l0, h0), o[1], 0, 0, 0);
    o[1] = __builtin_amdgcn_mfma_f32_32x32x16_bf16(pa1, PK(l1, h1), o[1], 0, 0, 0);
    o[1] = __builtin_amdgcn_mfma_f32_32x32x16_bf16(pa2, PK(l2, h2), o[1], 0, 0, 0);
    o[1] = __builtin_amdgcn_mfma_f32_32x32x16_bf16(pa3, PK(l3, h3), o[1], 0, 0, 0); }
#undef PK
#pragma unroll
  for (int r = 0; r < 16; ++r) n1[r] = __builtin_amdgcn_exp2f(n1[r]);
}

struct VSave { bf16x8 f0, f1, f2, f3; };
__device__ __forceinline__ void pv_exp_save(f32x16* o, int vb, bf16x8 pa0, bf16x8 pa1, bf16x8 pa2, bf16x8 pa3, f32x16& n0, f32x16& n1, VSave& vs) {
#define PK(L, H) (bf16x8){L[0], L[1], L[2], L[3], H[0], H[1], H[2], H[3]}
  { const s16x4 l0 = tr_read<v_rd_off2(0, 0, 0)>(vb), h0 = tr_read<v_rd_off2(0, 0, 1)>(vb), l1 = tr_read<v_rd_off2(0, 1, 0)>(vb), h1 = tr_read<v_rd_off2(0, 1, 1)>(vb);
    const s16x4 l2 = tr_read<v_rd_off2(0, 2, 0)>(vb), h2 = tr_read<v_rd_off2(0, 2, 1)>(vb), l3 = tr_read<v_rd_off2(0, 3, 0)>(vb), h3 = tr_read<v_rd_off2(0, 3, 1)>(vb);
#pragma unroll
    for (int r = 0; r < 8; ++r) n0[r] = __builtin_amdgcn_exp2f(n0[r]);
    asm volatile("s_waitcnt lgkmcnt(0)" ::: "memory"); SBAR();
    o[0] = __builtin_amdgcn_mfma_f32_32x32x16_bf16(pa0, PK(l0, h0), o[0], 0, 0, 0);
    o[0] = __builtin_amdgcn_mfma_f32_32x32x16_bf16(pa1, PK(l1, h1), o[0], 0, 0, 0);
    o[0] = __builtin_amdgcn_mfma_f32_32x32x16_bf16(pa2, PK(l2, h2), o[0], 0, 0, 0);
    o[0] = __builtin_amdgcn_mfma_f32_32x32x16_bf16(pa3, PK(l3, h3), o[0], 0, 0, 0); }
  { const s16x4 l0 = tr_read<v_rd_off2(1, 0, 0)>(vb), h0 = tr_read<v_rd_off2(1, 0, 1)>(vb), l1 = tr_read<v_rd_off2(1, 1, 0)>(vb), h1 = tr_read<v_rd_off2(1, 1, 1)>(vb);
    const s16x4 l2 = tr_read<v_rd_off2(1, 2, 0)>(vb), h2 = tr_read<v_rd_off2(1, 2, 1)>(vb), l3 = tr_read<v_rd_off2(1, 3, 0)>(vb), h3 = tr_read<v_rd_off2(1, 3, 1)>(vb);
#pragma unroll
    for (int r = 8; r < 16; ++r) n0[r] = __builtin_amdgcn_exp2f(n0[r]);
    asm volatile("s_waitcnt lgkmcnt(0)" ::: "memory"); SBAR();
    vs.f0 = PK(l0, h0); vs.f1 = PK(l1, h1); vs.f2 = PK(l2, h2); vs.f3 = PK(l3, h3);
    o[1] = __builtin_amdgcn_mfma_f32_32x32x16_bf16(pa0, vs.f0, o[1], 0, 0, 0);
    o[1] = __builtin_amdgcn_mfma_f32_32x32x16_bf16(pa1, vs.f1, o[1], 0, 0, 0);
    o[1] = __builtin_amdgcn_mfma_f32_32x32x16_bf16(pa2, vs.f2, o[1], 0, 0, 0);
    o[1] = __builtin_amdgcn_mfma_f32_32x32x16_bf16(pa3, vs.f3, o[1], 0, 0, 0); }
#pragma unroll
  for (int r = 0; r < 16; ++r) n1[r] = __builtin_amdgcn_exp2f(n1[r]);
}
__device__ __forceinline__ void pv_exp_reuse(f32x16* o, int vb, bf16x8 pa0, bf16x8 pa1, bf16x8 pa2, bf16x8 pa3, f32x16& n0, f32x16& n1, const VSave& vs) {
  { const s16x4 l0 = tr_read<v_rd_off2(0, 0, 0)>(vb), h0 = tr_read<v_rd_off2(0, 0, 1)>(vb), l1 = tr_read<v_rd_off2(0, 1, 0)>(vb), h1 = tr_read<v_rd_off2(0, 1, 1)>(vb);
    const s16x4 l2 = tr_read<v_rd_off2(0, 2, 0)>(vb), h2 = tr_read<v_rd_off2(0, 2, 1)>(vb), l3 = tr_read<v_rd_off2(0, 3, 0)>(vb), h3 = tr_read<v_rd_off2(0, 3, 1)>(vb);
    o[1] = __builtin_amdgcn_mfma_f32_32x32x16_bf16(pa0, vs.f0, o[1], 0, 0, 0);
    o[1] = __builtin_amdgcn_mfma_f32_32x32x16_bf16(pa1, vs.f1, o[1], 0, 0, 0);
    o[1] = __builtin_amdgcn_mfma_f32_32x32x16_bf16(pa2, vs.f2, o[1], 0, 0, 0);
    o[1] = __builtin_amdgcn_mfma_f32_32x32x16_bf16(pa3, vs.f3, o[1], 0, 0, 0);
#pragma unroll
    for (int r = 0; r < 16; ++r) n0[r] = __builtin_amdgcn_exp2f(n0[r]);
    asm volatile("s_waitcnt lgkmcnt(0)" ::: "memory"); SBAR();
    o[0] = __builtin_amdgcn_mfma_f32_32x32x16_bf16(pa0, PK(l0, h0), o[0], 0, 0, 0);
    o[0] = __builtin_amdgcn_mfma_f32_32x32x16_bf16(pa1, PK(l1, h1), o[0], 0, 0, 0);
    o[0] = __builtin_amdgcn_mfma_f32_32x32x16_bf16(pa2, PK(l2, h2), o[0], 0, 0, 0);
    o[0] = __builtin_amdgcn_mfma_f32_32x32x16_bf16(pa3, PK(l3, h3), o[0], 0, 0, 0); }
#undef PK
#pragma unroll
  for (int r = 0; r < 16; ++r) n1[r] = __builtin_amdgcn_exp2f(n1[r]);
}

__device__ __forceinline__ void expall(f32x16& p0, f32x16& p1) {
#pragma unroll
  for (int r = 0; r < 16; ++r) p0[r] = __builtin_amdgcn_exp2f(p0[r]);
#pragma unroll
  for (int r = 0; r < 16; ++r) p1[r] = __builtin_amdgcn_exp2f(p1[r]);
}
__device__ __forceinline__ void finishSM(f32x16& p0, f32x16& p1, float& lsum, bf16x8& pa0, bf16x8& pa1, bf16x8& pa2, bf16x8& pa3) {
  float ps = 0;
#pragma unroll
  for (int r = 0; r < 16; ++r) ps += p0[r];
#pragma unroll
  for (int r = 0; r < 16; ++r) ps += p1[r];
  lsum += ps;
#define PK4(P, BASE, OUT) do { u32x4 w = {cvtpk(P[BASE + 0], P[BASE + 1]), cvtpk(P[BASE + 2], P[BASE + 3]), cvtpk(P[BASE + 4], P[BASE + 5]), cvtpk(P[BASE + 6], P[BASE + 7])}; \
    OUT = *reinterpret_cast<bf16x8*>(&w); } while (0)
  PK4(p0, 0, pa0); PK4(p0, 8, pa1); PK4(p1, 0, pa2); PK4(p1, 8, pa3);
#undef PK4
}
template <int NQK>
__device__ __forceinline__ void qkt(f32x16& p0, f32x16& p1, const char* Ks, const bf16x8* qr, int r32, int hi, const float shift) {
  p0 = f32x16{}; p1 = f32x16{};
#pragma unroll
  for (int d0 = 0; d0 < NQK; ++d0) { int cb = (d0 * 16 + hi * 8) * 2;
    bf16x8 b0 = *reinterpret_cast<const bf16x8*>(Ks + KSWZ(r32, cb));
    bf16x8 b1 = *reinterpret_cast<const bf16x8*>(Ks + KSWZ(32 + r32, cb));
    p0 = __builtin_amdgcn_mfma_f32_32x32x16_bf16(b0, qr[d0], p0, 0, 0, 0);
    p1 = __builtin_amdgcn_mfma_f32_32x32x16_bf16(b1, qr[d0], p1, 0, 0, 0); }
  if (__builtin_expect(shift != 0.f, 0)) {
#pragma unroll
    for (int r = 0; r < 16; ++r) { p0[r] -= shift; p1[r] -= shift; }
  }
}

#define PK4X(P, BASE, OUT) do { u32x4 w_ = {cvtpk(P[BASE + 0], P[BASE + 1]), cvtpk(P[BASE + 2], P[BASE + 3]), cvtpk(P[BASE + 4], P[BASE + 5]), cvtpk(P[BASE + 6], P[BASE + 7])}; \
    OUT = *reinterpret_cast<bf16x8*>(&w_); } while (0)
template <int NQK>
__device__ __forceinline__ void qkt_fin(f32x16& n0, f32x16& n1, const char* Ks, const bf16x8* qr, int r32, int hi, const float shift,
                                        f32x16& o0, f32x16& o1, float& lsum, bf16x8& pa0, bf16x8& pa1, bf16x8& pa2, bf16x8& pa3) {
  n0 = f32x16{}; n1 = f32x16{};
  float ps = 0.f;
  bf16x8 kc0 = *reinterpret_cast<const bf16x8*>(Ks + KSWZ(r32, (hi * 8) * 2));
  bf16x8 kc1 = *reinterpret_cast<const bf16x8*>(Ks + KSWZ(32 + r32, (hi * 8) * 2));
#pragma unroll
  for (int d0 = 0; d0 < NQK; ++d0) {
    bf16x8 kn0 = kc0, kn1 = kc1;
    if (d0 + 1 < NQK) { const int cb = ((d0 + 1) * 16 + hi * 8) * 2;
      kn0 = *reinterpret_cast<const bf16x8*>(Ks + KSWZ(r32, cb)); kn1 = *reinterpret_cast<const bf16x8*>(Ks + KSWZ(32 + r32, cb)); }
    n0 = __builtin_amdgcn_mfma_f32_32x32x16_bf16(kc0, qr[d0], n0, 0, 0, 0);
    n1 = __builtin_amdgcn_mfma_f32_32x32x16_bf16(kc1, qr[d0], n1, 0, 0, 0);
#define PIN(X) asm volatile("" : "+v"(X))
    if (NQK == 6) {
      if (d0 == 0) { PK4X(o0, 0, pa0); }
      if (d0 == 1) { PIN(o0); PK4X(o0, 8, pa1); }
      if (d0 == 2) { _Pragma("unroll") for (int r = 0; r < 16; ++r) ps += o0[r]; }
      if (d0 == 3) { PIN(o1); PK4X(o1, 0, pa2); _Pragma("unroll") for (int r = 0; r < 8; ++r) ps += o1[r]; }
      if (d0 == 4) { PIN(o1); PK4X(o1, 8, pa3); _Pragma("unroll") for (int r = 8; r < 16; ++r) ps += o1[r]; }
    } else {
      if (d0 == 0) { PK4X(o0, 0, pa0); PK4X(o0, 8, pa1); }
      if (d0 == 1) { _Pragma("unroll") for (int r = 0; r < 16; ++r) ps += o0[r]; }
      if (d0 == 2) { PIN(o1); PK4X(o1, 0, pa2); _Pragma("unroll") for (int r = 0; r < 8; ++r) ps += o1[r]; }
      if (d0 == 3) { PIN(o1); PK4X(o1, 8, pa3); _Pragma("unroll") for (int r = 8; r < 16; ++r) ps += o1[r]; }
    }
#undef PIN
    asm volatile("" : "+v"(ps), "+v"(pa0), "+v"(pa1), "+v"(pa2), "+v"(pa3));
    kc0 = kn0; kc1 = kn1;
    SBAR();
  }
  lsum += ps;
  if (__builtin_expect(shift != 0.f, 0)) {
#pragma unroll
    for (int r = 0; r < 16; ++r) { n0[r] -= shift; n1[r] -= shift; }
  }
}

template <int NQK, int MODE, int LDG>
__device__ __forceinline__ void attn_body(const u16* __restrict__ Qb, const u16* __restrict__ Kh, const u16* __restrict__ Vh,
                                          const int NT, const int q0, const float sink2, const float mbound,
                                          u16* __restrict__ mix0, const u16* __restrict__ gate0, char* lds) {
  constexpr int DK = NQK * 16;
  constexpr int SHM_V = 8192, SHM_K = 17408;
  int tid_ = threadIdx.x; asm volatile("" : "+v"(tid_));
  const int tid = tid_, wid = __builtin_amdgcn_readfirstlane(tid >> 6), lane = tid & 63, r32 = lane & 31, hi = lane >> 5;
  char* V_lds = lds; char* K_lds = lds + 5 * SHM_V;
  float* wsf = (float*)(lds + 5 * SHM_V + 5 * SHM_K) + wid * 64; float* li_l = wsf;
  float lsum = 0; f32x16 o[2] = {}; bf16x8 qr[NQK];
  const float shift = mbound > 80.f ? mbound - 80.f : 0.f;
  const u16* Qw = Qb + (size_t)(wid * 32 + r32) * DK + hi * 8;
#pragma unroll
  for (int d0 = 0; d0 < NQK; ++d0) qr[d0] = *(const bf16x8*)(Qw + d0 * 16);
  const int srow = tid >> 3, sc8 = tid & 7;
  const int kst0 = KSWZ(srow, sc8 * 16), kst1 = KSWZ(srow, 128 + sc8 * 16), vst = v_st2(srow, sc8 * 8);
  const int vb0 = (int)(uintptr_t)V_lds + v_rd_base(lane);
  const bool k1on = (NQK == 6) && (sc8 < 4);
  const unsigned koff0 = srow * DK + sc8 * 8, voff0 = srow * 64 + sc8 * 8;
  struct { bf16x8 k0, k1, v0; } st[2];
#define TROW(j) (MODE == 0 ? (j) * 64 : ((j) < 4 ? (j) * 64 : q0 + 128 + ((j) - 4) * 64))
#define SLOAD(i, kr) do { const u16* kp_ = Kh + (unsigned)((kr) * DK); st[i].k0 = *(const bf16x8*)(kp_ + koff0);   \
    if (k1on) st[i].k1 = *(const bf16x8*)(kp_ + koff0 + 64);                                                           \
    const u16* vp_ = Vh + (unsigned)((kr) * 64); st[i].v0 = *(const bf16x8*)(vp_ + voff0); } while (0)
#define SWRITE(b, i) do { *(bf16x8*)(K_lds + (b) * SHM_K + kst0) = st[i].k0; if (k1on) *(bf16x8*)(K_lds + (b) * SHM_K + kst1) = st[i].k1; \
    *(bf16x8*)(V_lds + (b) * SHM_V + vst) = st[i].v0; } while (0)
#define MASKT(P0, P1, j) do { if (MODE == 1 && (j) >= 4) { const int kb_ = q0 - 128 + ((j) - 4) * 64, qp_ = q0 + wid * 32 + r32;    \
    _Pragma("unroll") for (int r = 0; r < 16; ++r) { int k0_ = kb_ + crow(r, hi), k1_ = k0_ + 32; int d0_ = qp_ - k0_, d1_ = qp_ - k1_; \
      bool ok0 = (d0_ <= 128) && (d0_ >= -128) && (k0_ >= 0) && (k0_ < SEQ); bool ok1 = (d1_ <= 128) && (d1_ >= -128) && (k1_ >= 0) && (k1_ < SEQ); \
      P0[r] = ok0 ? P0[r] : -1e30f; P1[r] = ok1 ? P1[r] : -1e30f; } } } while (0)
  f32x16 pA0, pA1, pB0, pB1; bf16x8 pa0, pa1, pa2, pa3;
#define NXS(x) ((x) + 1 == 5 ? 0 : (x) + 1)
  __syncthreads();
  SLOAD(0, TROW(0)); asm volatile("s_waitcnt vmcnt(0)" ::: "memory"); SWRITE(0, 0);
  SLOAD(0, TROW(1)); SWRITE(1, 0);
  SLOAD(0, TROW(2)); SWRITE(2, 0);
  if (3 < NT) SLOAD(0, TROW(3));
  if (4 < NT) SLOAD(1, TROW(4));
  __syncthreads();
  qkt<NQK>(pA0, pA1, K_lds, qr, r32, hi, shift); MASKT(pA0, pA1, 0); expall(pA0, pA1);
  int c = 0;
  for (int j = 1; j + 1 < NT; j += 2) {
    const int sj = NXS(c), sj1 = NXS(sj), sj2 = NXS(sj1), sj3 = NXS(sj2);
    SBAR(); SWRITE(sj2, 0); if (j + 3 < NT) SWRITE(sj3, 1); SBAR();
    qkt_fin<NQK>(pB0, pB1, K_lds + sj * SHM_K, qr, r32, hi, shift, pA0, pA1, lsum, pa0, pa1, pa2, pa3); MASKT(pB0, pB1, j); SBAR();
    if (j + 4 < NT) SLOAD(0, TROW(j + 4)); SBAR();
    pv_exp(o, vb0 + c * SHM_V, pa0, pa1, pa2, pa3, pB0, pB1);
    SBAR();
    qkt_fin<NQK>(pA0, pA1, K_lds + sj1 * SHM_K, qr, r32, hi, shift, pB0, pB1, lsum, pa0, pa1, pa2, pa3); MASKT(pA0, pA1, j + 1); SBAR();
    if (j + 5 < NT) SLOAD(1, TROW(j + 5)); SBAR();
    pv_exp(o, vb0 + sj * SHM_V, pa0, pa1, pa2, pa3, pA0, pA1);
    __syncthreads();
    c = sj1;
  }
  { const int sl = NXS(c);
    SBAR(); qkt_fin<NQK>(pB0, pB1, K_lds + sl * SHM_K, qr, r32, hi, shift, pA0, pA1, lsum, pa0, pa1, pa2, pa3); MASKT(pB0, pB1, NT - 1); SBAR();
    pv_all(o, vb0 + c * SHM_V, pa0, pa1, pa2, pa3); expall(pB0, pB1);
    finishSM(pB0, pB1, lsum, pa0, pa1, pa2, pa3); SBAR();
    pv_all(o, vb0 + sl * SHM_V, pa0, pa1, pa2, pa3); }
#undef NXS
  float l_reg;
  { auto rr = __builtin_amdgcn_permlane32_swap(__float_as_uint(lsum), __float_as_uint(lsum), false, false);
    l_reg = __uint_as_float(rr[0]) + __uint_as_float(rr[1]); }
  if (MODE == 1) l_reg += __builtin_amdgcn_exp2f(sink2 - shift);
  if (hi == 0) li_l[r32] = l_reg; asm volatile("s_waitcnt lgkmcnt(0)" ::: "memory");
  float rli[16];
#pragma unroll
  for (int r = 0; r < 16; ++r) rli[r] = __builtin_amdgcn_rcpf(li_l[crow(r, hi)]);
#pragma unroll
  for (int r = 0; r < 16; ++r) { const int orow = wid * 32 + crow(r, hi);
#pragma unroll
    for (int d0 = 0; d0 < 2; ++d0) {
      const float g = bf2f(gate0[(size_t)orow * LDG + d0 * 32 + r32]);
      mix0[(size_t)orow * 1024 + d0 * 32 + r32] = f2bf(o[d0][r] * rli[r] * silu_f(g));
    } }
#undef TROW
#undef SLOAD
#undef SWRITE
#undef MASKT
}

template <int NQK, int LDG, int RING>
__device__ __forceinline__ void attn_body2(const u16* __restrict__ Qb, const u16* __restrict__ Kh, const u16* __restrict__ Vh,
                                           const int NT, const float mbound, u16* __restrict__ mix0, const u16* __restrict__ gate0, char* lds) {
  constexpr int DK = NQK * 16;
  constexpr int SHM_V = 8192, SHM_K = 17408;
  int tid_ = threadIdx.x; asm volatile("" : "+v"(tid_));
  const int tid = tid_, wid = __builtin_amdgcn_readfirstlane(tid >> 6), lane = tid & 63, r32 = lane & 31, hi = lane >> 5;
  char* V_lds = lds; char* K_lds = lds + 5 * SHM_V;
  float* wsf = (float*)(lds + 5 * SHM_V + 5 * SHM_K) + wid * 64;
  float lsA = 0, lsB = 0; f32x16 oA[2] = {}, oB[2] = {}; bf16x8 qA[NQK], qB[NQK];
  const float shift = mbound > 80.f ? mbound - 80.f : 0.f;
  const u16* Qw = Qb + (size_t)(wid * 64 + r32) * DK + hi * 8;
#pragma unroll
  for (int d0 = 0; d0 < NQK; ++d0) { qA[d0] = *(const bf16x8*)(Qw + d0 * 16); qB[d0] = *(const bf16x8*)(Qw + 32 * DK + d0 * 16); }
  const int srow = tid >> 3, sc8 = tid & 7;
  const int kst0 = KSWZ(srow, sc8 * 16), kst1 = KSWZ(srow, 128 + sc8 * 16), vst = v_st2(srow, sc8 * 8);
  const int vb0 = (int)(uintptr_t)V_lds + v_rd_base(lane);
  const bool k1on = (NQK == 6) && (sc8 < 4);
  const unsigned koff0 = srow * DK + sc8 * 8, voff0 = srow * 64 + sc8 * 8;
  struct { bf16x8 k0, k1, v0; } st[RING == 1 ? 2 : 1];
#define SLOAD(i, kr) do { const u16* kp_ = Kh + (unsigned)((kr) * DK); st[i].k0 = *(const bf16x8*)(kp_ + koff0);   \
    if (k1on) st[i].k1 = *(const bf16x8*)(kp_ + koff0 + 64);                                                           \
    const u16* vp_ = Vh + (unsigned)((kr) * 64); st[i].v0 = *(const bf16x8*)(vp_ + voff0); } while (0)
#define SWRITE(b, i) do { *(bf16x8*)(K_lds + (b) * SHM_K + kst0) = st[i].k0; if (k1on) *(bf16x8*)(K_lds + (b) * SHM_K + kst1) = st[i].k1; \
    *(bf16x8*)(V_lds + (b) * SHM_V + vst) = st[i].v0; } while (0)
#define NXS(x) ((x) + 1 == 5 ? 0 : (x) + 1)
#define UNIT(PN0, PN1, QN, KS, PO0, PO1, LSO, OO, VS) do {                                                                      \
    qkt_fin<NQK>(PN0, PN1, K_lds + (KS) * SHM_K, QN, r32, hi, shift, PO0, PO1, LSO, pa0, pa1, pa2, pa3); SBAR();               \
    pv_exp(OO, vb0 + (VS) * SHM_V, pa0, pa1, pa2, pa3, PN0, PN1); SBAR(); } while (0)
#define UNITS(PN0, PN1, QN, KS, PO0, PO1, LSO, OO, VS) do {                 \
    qkt_fin<NQK>(PN0, PN1, K_lds + (KS) * SHM_K, QN, r32, hi, shift, PO0, PO1, LSO, pa0, pa1, pa2, pa3); SBAR();               \
    pv_exp_save(OO, vb0 + (VS) * SHM_V, pa0, pa1, pa2, pa3, PN0, PN1, vsv); SBAR(); } while (0)
#define UNITR(PN0, PN1, QN, KS, PO0, PO1, LSO, OO, VS) do {                                                    \
    qkt_fin<NQK>(PN0, PN1, K_lds + (KS) * SHM_K, QN, r32, hi, shift, PO0, PO1, LSO, pa0, pa1, pa2, pa3); SBAR();               \
    pv_exp_reuse(OO, vb0 + (VS) * SHM_V, pa0, pa1, pa2, pa3, PN0, PN1, vsv); SBAR(); } while (0)
  f32x16 pA0, pA1, pB0, pB1; bf16x8 pa0, pa1, pa2, pa3;
  if constexpr (RING == 1) {
  VSave vsv;
  __syncthreads();
  SLOAD(0, 0); asm volatile("s_waitcnt vmcnt(0)" ::: "memory"); SWRITE(0, 0);
  SLOAD(0, 64); SWRITE(1, 0);
  SLOAD(0, 128); SWRITE(2, 0);
  if (3 < NT) SLOAD(0, 3 * 64);
  if (4 < NT) SLOAD(1, 4 * 64);
  __syncthreads();
  qkt<NQK>(pA0, pA1, K_lds, qA, r32, hi, shift); expall(pA0, pA1);
  int c = 0;
  for (int i = 0; 2 * i + 2 < NT; ++i) {
    const int s1 = NXS(c), s2 = NXS(s1), s3 = NXS(s2), s4 = NXS(s3);
    SBAR(); if (2 * i + 3 < NT) SWRITE(s3, 0); if (2 * i + 4 < NT) SWRITE(s4, 1);
    if (2 * i + 5 < NT) SLOAD(0, (2 * i + 5) * 64); if (2 * i + 6 < NT) SLOAD(1, (2 * i + 6) * 64); SBAR();
    UNITS(pB0, pB1, qB, c, pA0, pA1, lsA, oA, c);
    UNITR(pA0, pA1, qA, s1, pB0, pB1, lsB, oB, c);
    UNITS(pB0, pB1, qB, s1, pA0, pA1, lsA, oA, s1);
    UNITR(pA0, pA1, qA, s2, pB0, pB1, lsB, oB, s1);
    __syncthreads();
    c = s2;
  }
  { const int s1 = NXS(c);
    UNITS(pB0, pB1, qB, c, pA0, pA1, lsA, oA, c);
    UNITR(pA0, pA1, qA, s1, pB0, pB1, lsB, oB, c);
    UNIT(pB0, pB1, qB, s1, pA0, pA1, lsA, oA, s1);
    finishSM(pB0, pB1, lsB, pa0, pa1, pa2, pa3); SBAR();
    pv_all(oB, vb0 + s1 * SHM_V, pa0, pa1, pa2, pa3); }
  } else if constexpr (RING == 2) {
    __syncthreads();
    SLOAD(0, 0); asm volatile("s_waitcnt vmcnt(0)" ::: "memory"); SWRITE(0, 0);
    SLOAD(0, 64); SWRITE(1, 0);
    SLOAD(0, 128); SWRITE(2, 0);
    if (3 < NT) SLOAD(0, 3 * 64);
    __syncthreads();
    qkt<NQK>(pA0, pA1, K_lds, qA, r32, hi, shift); expall(pA0, pA1);
    int c = 0;
    for (int i = 0; 2 * i + 2 < NT; ++i) {
      const int s1 = NXS(c), s2 = NXS(s1), s3 = NXS(s2), s4 = NXS(s3);
      SBAR(); if (2 * i + 3 < NT) SWRITE(s3, 0); if (2 * i + 4 < NT) SLOAD(0, (2 * i + 4) * 64); SBAR();
      UNIT(pB0, pB1, qB, c, pA0, pA1, lsA, oA, c);
      UNIT(pA0, pA1, qA, s1, pB0, pB1, lsB, oB, c);
      SBAR(); if (2 * i + 4 < NT) SWRITE(s4, 0); if (2 * i + 5 < NT) SLOAD(0, (2 * i + 5) * 64); SBAR();
      UNIT(pB0, pB1, qB, s1, pA0, pA1, lsA, oA, s1);
      UNIT(pA0, pA1, qA, s2, pB0, pB1, lsB, oB, s1);
      __syncthreads();
      c = s2;
    }
    { const int s1 = NXS(c);
      UNIT(pB0, pB1, qB, c, pA0, pA1, lsA, oA, c);
      UNIT(pA0, pA1, qA, s1, pB0, pB1, lsB, oB, c);
      UNIT(pB0, pB1, qB, s1, pA0, pA1, lsA, oA, s1);
      finishSM(pB0, pB1, lsB, pa0, pa1, pa2, pa3); SBAR();
      pv_all(oB, vb0 + s1 * SHM_V, pa0, pa1, pa2, pa3); }
  } else {
#define NX3(x) ((x) + 1 == 3 ? 0 : (x) + 1)
    __syncthreads();
    SLOAD(0, 0); asm volatile("s_waitcnt vmcnt(0)" ::: "memory"); SWRITE(0, 0);
    SLOAD(0, 64); SWRITE(1, 0);
    if (2 < NT) SLOAD(0, 128);
    __syncthreads();
    qkt<NQK>(pA0, pA1, K_lds, qA, r32, hi, shift); expall(pA0, pA1);
    int c = 0;
    for (int t = 0; t + 1 < NT; ++t) {
      const int s1 = NX3(c), s2 = NX3(s1);
      SBAR(); if (t + 2 < NT) SWRITE(s2, 0);
      if (t + 3 < NT) SLOAD(0, (t + 3) * 64); SBAR();
      UNIT(pB0, pB1, qB, c, pA0, pA1, lsA, oA, c);
      UNIT(pA0, pA1, qA, s1, pB0, pB1, lsB, oB, c);
      __syncthreads();
      c = s1;
    }
    UNIT(pB0, pB1, qB, c, pA0, pA1, lsA, oA, c);
    finishSM(pB0, pB1, lsB, pa0, pa1, pa2, pa3); SBAR();
    pv_all(oB, vb0 + c * SHM_V, pa0, pa1, pa2, pa3);
#undef NX3
  }
#undef UNIT
#undef UNITS
#undef UNITR
#undef NXS
#undef SLOAD
#undef SWRITE
  float lA, lB;
  { auto rr = __builtin_amdgcn_permlane32_swap(__float_as_uint(lsA), __float_as_uint(lsA), false, false); lA = __uint_as_float(rr[0]) + __uint_as_float(rr[1]); }
  { auto rr = __builtin_amdgcn_permlane32_swap(__float_as_uint(lsB), __float_as_uint(lsB), false, false); lB = __uint_as_float(rr[0]) + __uint_as_float(rr[1]); }
  if (hi == 0) { wsf[r32] = lA; wsf[32 + r32] = lB; }
  asm volatile("s_waitcnt lgkmcnt(0)" ::: "memory");
#pragma unroll
  for (int g = 0; g < 2; ++g) {
    float rli[16];
#pragma unroll
    for (int r = 0; r < 16; ++r) rli[r] = __builtin_amdgcn_rcpf(wsf[g * 32 + crow(r, hi)]);
#pragma unroll
    for (int r = 0; r < 16; ++r) { const int orow = wid * 64 + g * 32 + crow(r, hi);
#pragma unroll
      for (int d0 = 0; d0 < 2; ++d0) {
        const float gt = bf2f(gate0[(size_t)orow * LDG + d0 * 32 + r32]);
        const float ov = g == 0 ? oA[d0][r] : oB[d0][r];
        mix0[(size_t)orow * 1024 + d0 * 32 + r32] = f2bf(ov * rli[r] * silu_f(gt));
      } }
  }
}

__global__ void __launch_bounds__(512, 1) mega(Params p) {
  extern __shared__ __attribute__((aligned(16))) char lds[];
  cg::grid_group grid = cg::this_grid();
  const int bid = blockIdx.x, nblk = gridDim.x;
  char* ws = p.ws;
  float* modv = (float*)(ws + OFF_MODV);
  u16* H = (u16*)(ws + OFF_H);
  u16* PP = (u16*)(ws + OFF_PP);
  float* XC1 = (float*)(ws + OFF_XC1);
  unsigned* xbar = (unsigned*)(ws + OFF_END);
  volatile LAS unsigned* xst = (volatile LAS unsigned*)(lds + LDS_BYTES - 256);
  if (threadIdx.x == 0) { xst[0] = 0u; xst[1] = 0u; }
  __syncthreads();
  XcdBarrier xb = xcd_barrier_post(xbar, xst);
  if (p.ph_lo > 1000) grid.sync();

  if (p.ph_lo <= 0 && 0 < p.ph_hi) {
  for (int u = bid; u < 192; u += nblk) mod_unit(p, u, lds);
  }
  if (p.ph_lo <= 0 && 0 + 1 < p.ph_hi) xcd_barrier(xb);
  if (p.ph_lo <= 1 && 1 < p.ph_hi) {
  for (int u = bid; u < 2064; u += nblk) transpose_unit(p, u, lds);
  adaln_phase(p.x, nullptr, p.ctx, modv, H);
  }
  if (p.ph_lo <= 1 && 1 + 1 < p.ph_hi) xcd_barrier(xb);
  if (p.ph_lo <= 2 && 2 < p.ph_hi) {
  { TileIter ti(130, 19); GPre g; int nt = 0, mt = 0; const u16* Wt = (const u16*)(ws + OFF_WT_IN_AB);
    if (ti.valid()) { ti.get(mt, nt); gemm_preload(H, 1024, Wt, 1024, mt * 256, nt * 128, g); }
    while (ti.valid()) {
      f32x16 acc[2][2]; const int m0 = mt * 256, n0 = nt * 128;
      gemm_tile<0>(H, 1024, Wt, 1024, 1024, m0, n0, acc, lds, g);
      ti.next(); if (ti.valid()) { ti.get(mt, nt); gemm_preload(H, 1024, Wt, 1024, mt * 256, nt * 128, g); }
      epi_bf16(acc, PP, LD_AB, m0, n0, lds);
    } }
  }
  if (p.ph_lo <= 2 && 2 + 1 < p.ph_hi) xcd_barrier(xb);
  if (p.ph_lo <= 3 && 3 < p.ph_hi) {
  { TileIter ti(130, 14); GPre g; int nt = 0, mt = 0;
    const u16* Wq = (const u16*)(ws + OFF_WT_UQ); const u16* Wkv = (const u16*)(ws + OFF_WT_UKV);
    if (ti.valid()) { ti.get(mt, nt); gemm_preload(nt < 6 ? PP : PP + 256, LD_AB, nt < 6 ? Wq : Wkv, 256, mt * 256, (nt < 6 ? nt : nt - 6) * 128, g); }
    while (ti.valid()) {
      f32x16 acc[2][2]; const int m0 = mt * 256, cn = nt, n0 = (nt < 6 ? nt : nt - 6) * 128;
      gemm_tile<0>(cn < 6 ? PP : PP + 256, LD_AB, cn < 6 ? Wq : Wkv, 256, 256, m0, n0, acc, lds, g);
      ti.next(); if (ti.valid()) { ti.get(mt, nt); gemm_preload(nt < 6 ? PP : PP + 256, LD_AB, nt < 6 ? Wq : Wkv, 256, mt * 256, (nt < 6 ? nt : nt - 6) * 128, g); }
      if (cn < 6) epi_bf16(acc, H, 768, m0, n0, lds); else epi_bf16(acc, (u16*)p.out, 1024, m0, n0, lds);
    } }
  }
  if (p.ph_lo <= 3 && 3 + 1 < p.ph_hi) xcd_barrier(xb);
  if (p.ph_lo <= 4 && 4 < p.ph_hi) {
  finalize0(p);
  }
  if (p.ph_lo <= 4 && 4 + 1 < p.ph_hi) xcd_barrier(xb);
  if (p.ph_lo <= 5 && 5 < p.ph_hi) {
  const float mbA = LOG2E * 9.7979590f * 1.02f * vmaxabs(p.q_gain, 96) * vmaxabs(p.k_gain, 96);
  const float mbB = LOG2E * 8.f * 1.02f * vmaxabs(p.gq_gain, 64) * vmaxabs(p.gk_gain, 64);
  for (int it = bid; it < 1056; it += nblk) {
    if (it < 512) {
      const int round = it >> 8, blk = it & 255, xcd = blk & 7, cl = blk >> 3;
      const int pair = xcd * 2 + round, b = pair >> 3, h = pair & 7, qoff = cl * 512;
      const size_t r0 = (size_t)b * SEQ + qoff;
      attn_body2<6, LD_AB, 2>((const u16*)(ws + OFF_QA) + ((size_t)(b * 8 + h) * SEQ + qoff) * 96,
                                  (const u16*)(ws + OFF_KA) + (size_t)(b * 8 + h) * KVLEN * 96, (const u16*)(ws + OFF_VA) + (size_t)(b * 8 + h) * KVLEN * 64,
                                  KVLEN / 64, mbA, H + r0 * 1024 + h * 64, PP + r0 * LD_AB + 1312 + h * 64, lds);
    } else if (it < 1024) {
      const int i2 = it - 512, g = i2 >> 8, blk = i2 & 255, xcd = blk & 7, cl = blk >> 3;
      const int pi = xcd >> 1, b = pi >> 1, kvh = pi & 1, idx = (xcd & 1) * 64 + g * 32 + cl;
      const int h = kvh * 4 + (idx >> 5), qoff = (idx & 31) * 512;
      const size_t r0 = (size_t)b * SEQ + qoff;
      attn_body2<4, LD_AB, 1>((const u16*)(ws + OFF_QB) + ((size_t)(b * 8 + h) * SEQ + qoff) * 64,
                           (const u16*)(ws + OFF_KB) + (size_t)(b * 2 + kvh) * KVLEN * 64, (const u16*)(ws + OFF_VB) + (size_t)(b * 2 + kvh) * KVLEN * 64,
                           KVLEN / 64, mbB, H + r0 * 1024 + 512 + h * 64, PP + r0 * LD_AB + 1312 + 512 + h * 64, lds);
    } else {
      const int ci = it - 1024, b = (ci >> 3) & 1, h = ci & 7; const bool mla = ci < 16; const int kvh = mla ? h : (h >> 2);
      const size_t r0 = (size_t)NLAT + b * CL, qrow = (size_t)(b * 8 + h) * CL;
      if (mla) attn_body<6, 0, LD_AB>((const u16*)(ws + OFF_QCA) + qrow * 96, (const u16*)(ws + OFF_KA) + (size_t)(b * 8 + kvh) * KVLEN * 96,
                                      (const u16*)(ws + OFF_VA) + (size_t)(b * 8 + kvh) * KVLEN * 64, CL / 64, 0, 0.f, mbA, H + r0 * 1024 + h * 64, PP + r0 * LD_AB + 1312 + h * 64, lds);
      else attn_body<4, 0, LD_AB>((const u16*)(ws + OFF_QCB) + qrow * 64, (const u16*)(ws + OFF_KB) + (size_t)(b * 2 + kvh) * KVLEN * 64,
                                  (const u16*)(ws + OFF_VB) + (size_t)(b * 2 + kvh) * KVLEN * 64, CL / 64, 0, 0.f, mbB, H + r0 * 1024 + 512 + h * 64, PP + r0 * LD_AB + 1312 + 512 + h * 64, lds);
    }
  }
  }
  if (p.ph_lo <= 5 && 5 + 1 < p.ph_hi) xcd_barrier(xb);
  if (p.ph_lo <= 6 && 6 < p.ph_hi) {
  { TileIter ti(130, 8); GPre g; int nt = 0, mt = 0; const u16* Wt = (const u16*)(ws + OFF_WT_OUT_AB);
    if (ti.valid()) { ti.get(mt, nt); gemm_preload(H, 1024, Wt, 1024, mt * 256, nt * 128, g); }
    while (ti.valid()) {
      f32x16 acc[2][2]; const int m0 = mt * 256, n0 = nt * 128; const bool lat = m0 < NLAT;
      const int tid_ = opaque_tid(), wid_ = tid_ >> 6, lane_ = tid_ & 63;
      const size_t eoff = (size_t)((lat ? m0 : m0 - NLAT) + (wid_ & 3) * 64 + (lane_ >> 4)) * 1024 + n0 + (wid_ >> 2) * 64 + 4 * (lane_ & 15);
      ResPre rp;
      gemm_tile<1>(H, 1024, Wt, 1024, 1024, m0, n0, acc, lds, g, (lat ? p.x : p.ctx) + eoff, &rp);
      ti.next(); if (ti.valid()) { ti.get(mt, nt); gemm_preload(H, 1024, Wt, 1024, mt * 256, nt * 128, g); }
      if (lat) epi_res<false, true>(acc, rp, (u16*)(ws + OFF_X1B) + eoff, modv + (m0 >> 14) * 3072 + 2048, n0, lds);
      else epi_res<false, false>(acc, rp, XC1 + eoff, modv + 2 * 3072 + 2048, n0, lds);
    } }
  }
  if (p.ph_lo <= 6 && 6 + 1 < p.ph_hi) xcd_barrier(xb);
  if (p.ph_lo <= 7 && 7 < p.ph_hi) {
  adaln_phase(nullptr, (const u16*)(ws + OFF_X1B), XC1, modv + 3 * 3072, H);
  }
  if (p.ph_lo <= 7 && 7 + 1 < p.ph_hi) xcd_barrier(xb);
  if (p.ph_lo <= 8 && 8 < p.ph_hi) {
  { TileIter ti(130, 26); GPre g; int nt = 0, mt = 0; const u16* Wt = (const u16*)(ws + OFF_WT_IN_CD);
    if (ti.valid()) { ti.get(mt, nt); gemm_preload(H, 1024, Wt, 1024, mt * 256, nt * 128, g); }
    while (ti.valid()) {
      f32x16 acc[2][2]; const int m0 = mt * 256, n0 = nt * 128;
      gemm_tile<0>(H, 1024, Wt, 1024, 1024, m0, n0, acc, lds, g);
      ti.next(); if (ti.valid()) { ti.get(mt, nt); gemm_preload(H, 1024, Wt, 1024, mt * 256, nt * 128, g); }
      epi_bf16(acc, PP, LD_CD, m0, n0, lds);
    } }
  }
  if (p.ph_lo <= 8 && 8 + 1 < p.ph_hi) xcd_barrier(xb);
  if (p.ph_lo <= 9 && 9 < p.ph_hi) {
  finalize1(p);
  }
  if (p.ph_lo <= 9 && 9 + 1 < p.ph_hi) xcd_barrier(xb);
  if (p.ph_lo <= 10 && 10 < p.ph_hi) {
  const float mbW = LOG2E * 8.f * 1.02f * vmaxabs(p.win_q_gain, 64) * vmaxabs(p.win_k_gain, 64);
  for (int it = bid; it < 1024; it += nblk) {
    const int g = it >> 8, blk = it & 255, xcd = blk & 7, cl = blk >> 3;
    const int pi = xcd >> 1, b = pi >> 1, kvh = pi & 1, idx = (xcd & 1) * 128 + g * 32 + cl;
    const int h = kvh * 4 + (idx >> 6), qblk = idx & 63;
    const size_t r0 = (size_t)b * SEQ + qblk * 256;
    attn_body<4, 1, LD_CD>((const u16*)(ws + OFF_Q2) + ((size_t)(b * 8 + h) * SEQ + qblk * 256) * 64,
                    (const u16*)(ws + OFF_K2) + (size_t)(b * 2 + kvh) * KV2LEN * 64, (const u16*)(ws + OFF_V2) + (size_t)(b * 2 + kvh) * KV2LEN * 64,
                    12, qblk * 256, p.win_sink[h] * LOG2E, mbW, H + r0 * 1024 + h * 64, PP + r0 * LD_CD + 2304 + h * 64, lds);
  }
  }
  if (p.ph_lo <= 10 && 10 + 1 < p.ph_hi) xcd_barrier(xb);
  if (p.ph_lo <= 11 && 11 < p.ph_hi) {
  { TileIter ti(128, 8); GPre g; int nt = 0, mt = 0; const u16* Wt = (const u16*)(ws + OFF_WT_OUT_CD);
    if (ti.valid()) { ti.get(mt, nt); gemm_preload(H, 1024, Wt, 1024, mt * 256, nt * 128, g); }
    while (ti.valid()) {
      f32x16 acc[2][2]; const int m0 = mt * 256, n0 = nt * 128;
      const int tid_ = opaque_tid(), wid_ = tid_ >> 6, lane_ = tid_ & 63;
      const size_t eoff = (size_t)(m0 + (wid_ & 3) * 64 + (lane_ >> 4)) * 1024 + n0 + (wid_ >> 2) * 64 + 4 * (lane_ & 15);
      ResPre rp;
      gemm_tile<2>(H, 1024, Wt, 1024, 1024, m0, n0, acc, lds, g, (const u16*)(ws + OFF_X1B) + eoff, &rp);
      ti.next(); if (ti.valid()) { ti.get(mt, nt); gemm_preload(H, 1024, Wt, 1024, mt * 256, nt * 128, g); }
      epi_res<true, false>(acc, rp, p.out + eoff, modv + 3 * 3072 + (m0 >> 14) * 3072 + 2048, n0, lds);
    } }
  }
}

extern "C" void kernel_launch(void* const* d_in, const int* in_sizes, int n_in, void* d_out, int out_size, void* d_ws, size_t ws_size, hipStream_t stream) {
  static int grid_blocks = 0;
  if (!grid_blocks) {
    if (n_in != 22 || out_size != NLAT * DM || ws_size < OFF_END + 16384) {
      fprintf(stderr, "kernel_launch: shape/ws mismatch n_in %d out %d ws %zu need %zu\n", n_in, out_size, ws_size, (size_t)OFF_END);
      return;
    }
    if (hipFuncSetAttribute((const void*)mega, hipFuncAttributeMaxDynamicSharedMemorySize, LDS_BYTES) != hipSuccess) {
      fprintf(stderr, "kernel_launch: hipFuncSetAttribute failed\n"); return;
    }
    int dev = 0, cus = 0, per_cu = 0;
    (void)hipGetDevice(&dev);
    (void)hipDeviceGetAttribute(&cus, hipDeviceAttributeMultiprocessorCount, dev);
    (void)hipOccupancyMaxActiveBlocksPerMultiprocessor(&per_cu, mega, 512, LDS_BYTES);
    if (per_cu < 1) { fprintf(stderr, "kernel_launch: occupancy 0\n"); return; }
    grid_blocks = cus;
  }
  Params p{};
  p.x = (const float*)d_in[0]; p.c = (const float*)d_in[1]; p.ctx = (const float*)d_in[2]; p.c_ctx = (const float*)d_in[3];
  p.mod_w = (const float*)d_in[4]; p.mod_b = (const float*)d_in[5]; p.ab_w_in = (const float*)d_in[6]; p.ab_w_out = (const float*)d_in[7];
  p.cq_gain = (const float*)d_in[8]; p.ckv_gain = (const float*)d_in[9]; p.w_uq = (const float*)d_in[10]; p.w_ukv = (const float*)d_in[11];
  p.q_gain = (const float*)d_in[12]; p.k_gain = (const float*)d_in[13]; p.gq_gain = (const float*)d_in[14]; p.gk_gain = (const float*)d_in[15];
  p.cd_w_in = (const float*)d_in[16]; p.cd_w_out = (const float*)d_in[17]; p.win_q_gain = (const float*)d_in[18]; p.win_k_gain = (const float*)d_in[19];
  p.win_sink = (const float*)d_in[20]; p.conv_w = (const float*)d_in[21];
  p.out = (float*)d_out; p.ws = (char*)d_ws;
#if MULTI_LAUNCH
  for (int ph = 0; ph < 12; ++ph) {
    p.ph_lo = ph; p.ph_hi = ph + 1;
    hipLaunchKernelGGL(mega, dim3(grid_blocks), dim3(512), LDS_BYTES, stream, p);
  }
#else
  p.ph_lo = 0; p.ph_hi = 12;
  if (hipMemsetAsync((char*)d_ws + OFF_END, 0, XCD_BAR_WORDS * 4, stream) != hipSuccess) { fprintf(stderr, "kernel_launch: hipMemsetAsync of the barrier words failed\n"); return; }
  void* args[] = {&p};
  hipError_t e = hipLaunchCooperativeKernel((void*)mega, dim3(grid_blocks), dim3(512), args, LDS_BYTES, stream);
  if (e != hipSuccess) fprintf(stderr, "cooperative launch failed: %s (grid %d)\n", hipGetErrorString(e), grid_blocks);
#endif
}
```

```cpp
#include <hip/hip_runtime.h>
#include <hip/hip_cooperative_groups.h>
#include <cstdio>
#include <cstdint>
namespace cg = cooperative_groups;

typedef unsigned short u16;
using bf16x8 = __attribute__((ext_vector_type(8))) short;
using s16x4  = __attribute__((ext_vector_type(4))) short;
using f32x16 = __attribute__((ext_vector_type(16))) float;
using u32x4  = __attribute__((ext_vector_type(4))) unsigned;
using u32x2  = __attribute__((ext_vector_type(2))) unsigned;

constexpr int NB = 2, SEQ = 16384, DM = 1024, CL = 256;
constexpr int NLAT = NB * SEQ;
constexpr int NROW = NLAT + NB * CL;
constexpr int KVLEN = CL + SEQ;
constexpr int KV2LEN = KVLEN + 128;
constexpr int LD_AB = 2432, LD_CD = 3328;
constexpr float EPS = 1e-6f;
constexpr float QS_A = 0.14724461f;
constexpr float QS_B = 0.18033688f;
constexpr float LOG2E = 1.4426950408889634f;

constexpr size_t OFF_MODV      = 0;
constexpr size_t OFF_WT_IN_AB  = 73728;
constexpr size_t OFF_WT_OUT_AB = OFF_WT_IN_AB + (size_t)LD_AB * 1024 * 2;
constexpr size_t OFF_WT_UQ     = OFF_WT_OUT_AB + (size_t)1024 * 1024 * 2;
constexpr size_t OFF_WT_UKV    = OFF_WT_UQ + (size_t)768 * 256 * 2;
constexpr size_t OFF_WT_IN_CD  = OFF_WT_UKV + (size_t)1024 * 256 * 2;
constexpr size_t OFF_WT_OUT_CD = OFF_WT_IN_CD + (size_t)3328 * 1024 * 2;
constexpr size_t OFF_XC1       = OFF_WT_OUT_CD + (size_t)1024 * 1024 * 2;
constexpr size_t OFF_H         = OFF_XC1 + (size_t)512 * 1024 * 4;
constexpr size_t OFF_PP        = OFF_H + (size_t)NROW * 1024 * 2;
constexpr size_t OFF_QA        = OFF_PP + (size_t)NROW * 3328 * 2;
constexpr size_t OFF_QCA       = OFF_QA + (size_t)NB * 8 * SEQ * 96 * 2;
constexpr size_t OFF_KA        = OFF_QCA + (size_t)NB * 8 * CL * 96 * 2;
constexpr size_t OFF_VA        = OFF_KA + (size_t)NB * 8 * KVLEN * 96 * 2;
constexpr size_t OFF_QB        = OFF_VA + (size_t)NB * 8 * KVLEN * 64 * 2;
constexpr size_t OFF_QCB       = OFF_QB + (size_t)NB * 8 * SEQ * 64 * 2;
constexpr size_t OFF_KB        = OFF_QCB + (size_t)NB * 8 * CL * 64 * 2;
constexpr size_t OFF_VB        = OFF_KB + (size_t)NB * 2 * KVLEN * 64 * 2;
constexpr size_t OFF_END       = OFF_VB + (size_t)NB * 2 * KVLEN * 64 * 2;
constexpr size_t OFF_Q2        = OFF_QA;
constexpr size_t OFF_K2        = OFF_Q2 + (size_t)NB * 8 * SEQ * 64 * 2;
constexpr size_t OFF_V2        = OFF_K2 + (size_t)NB * 2 * KV2LEN * 64 * 2;
constexpr size_t OFF_X1B       = OFF_QA + ((size_t)64 << 20);
static_assert(OFF_V2 + (size_t)NB * 2 * KV2LEN * 64 * 2 <= OFF_X1B && OFF_X1B + (size_t)NLAT * 1024 * 2 <= OFF_END, "x1 alias");
static_assert(OFF_V2 + (size_t)NB * 2 * KV2LEN * 64 * 2 <= OFF_END, "alias overflow");

constexpr int LDS_BYTES = 147456 + 256;
#ifndef MULTI_LAUNCH
#define MULTI_LAUNCH 0
#endif

struct Params {
  const float *x, *c, *ctx, *c_ctx, *mod_w, *mod_b, *ab_w_in, *ab_w_out, *cq_gain, *ckv_gain, *w_uq, *w_ukv,
      *q_gain, *k_gain, *gq_gain, *gk_gain, *cd_w_in, *cd_w_out, *win_q_gain, *win_k_gain, *win_sink, *conv_w;
  float* out;
  char* ws;
  int ph_lo, ph_hi;
};

#define SBAR() __builtin_amdgcn_sched_barrier(0)
__device__ __forceinline__ int crow(int r, int hi) { return (r & 3) + 8 * (r >> 2) + 4 * hi; }
typedef float f32x2_t __attribute__((ext_vector_type(2)));
typedef __bf16 bf16x2_t __attribute__((ext_vector_type(2)));
__device__ __forceinline__ unsigned cvtpk(float lo, float hi) { f32x2_t v = {lo, hi}; bf16x2_t b = __builtin_convertvector(v, bf16x2_t); return __builtin_bit_cast(unsigned, b); }
__device__ __forceinline__ u16 f2bf(float x) { return (u16)(cvtpk(x, 0.f) & 0xffffu); }
__device__ __forceinline__ float bf2f(u16 x) { return __uint_as_float(((unsigned)x) << 16); }
__device__ __forceinline__ float bflo(unsigned w) { return __uint_as_float(w << 16); }
__device__ __forceinline__ float bfhi(unsigned w) { return __uint_as_float(w & 0xffff0000u); }
__device__ __forceinline__ float wave_sum(float v) {
#pragma unroll
  for (int o = 32; o >= 1; o >>= 1) v += __shfl_xor(v, o);
  return v;
}
__device__ __forceinline__ int opaque_tid() { int t = threadIdx.x; asm volatile("" : "+v"(t)); return t; }
__device__ __forceinline__ float vmaxabs(const float* g, int n) { float m = 0.f; for (int i = 0; i < n; ++i) m = fmaxf(m, fabsf(g[i])); return m; }
__device__ __forceinline__ float silu_f(float g) { return g / (1.f + __expf(-g)); }


__device__ __forceinline__ void gbar(unsigned* cnt, unsigned target) {
  asm volatile("s_waitcnt vmcnt(0)" ::: "memory");
  __syncthreads();
  if (threadIdx.x == 0) {
    __builtin_amdgcn_fence(__ATOMIC_RELEASE, "agent");
    asm volatile("s_waitcnt vmcnt(0)" ::: "memory");
    __hip_atomic_fetch_add(cnt, 1u, __ATOMIC_RELAXED, __HIP_MEMORY_SCOPE_AGENT);
    unsigned sp = 0;
    while (__hip_atomic_load(cnt, __ATOMIC_RELAXED, __HIP_MEMORY_SCOPE_AGENT) < target) { __builtin_amdgcn_s_sleep(1); if (++sp > (1u << 24)) break; }
    __builtin_amdgcn_fence(__ATOMIC_ACQUIRE, "agent");
    asm volatile("s_waitcnt vmcnt(0)" ::: "memory");
  }
  __syncthreads();
}


#define XB_TMO      128
#define XB_XCNT(j)  (256  + 64 * (j))
#define XB_XSUB(j)  (1280 + 64 * (j))
#define XB_XGEN(j)  (2304 + 64 * (j))
#define XB_TOP      3328
#define XB_TOPGEN   3392
#define XCD_BAR_WORDS 3456
#define XB_SPIN_CAP (1u << 20)
#define LAS __attribute__((address_space(3)))
__device__ __forceinline__ unsigned xb_ld(unsigned* p)              { return __hip_atomic_load(p, __ATOMIC_RELAXED, __HIP_MEMORY_SCOPE_AGENT); }
__device__ __forceinline__ unsigned xb_add(unsigned* p, unsigned v) { return __hip_atomic_fetch_add(p, v, __ATOMIC_RELAXED, __HIP_MEMORY_SCOPE_AGENT); }
__device__ __forceinline__ unsigned xb_xcc_id() { return (unsigned)__builtin_amdgcn_s_getreg((3 << 11) | 20) & 0xFu; }
#define XB_SPIN(cond, bar) do { unsigned _sp = 0; while (cond) { __builtin_amdgcn_s_sleep(1); \
    if ((++_sp & 255u) == 0u) { if (xb_ld(&(bar)[XB_TMO])) break; if (_sp > XB_SPIN_CAP) { atomicAdd(&(bar)[XB_TMO], 1u); break; } } } } while (0)
struct XcdBarrier { unsigned* bar; unsigned x; volatile LAS unsigned* st; };
__device__ __forceinline__ XcdBarrier xcd_barrier_post(unsigned* bar, volatile LAS unsigned* st) {
  XcdBarrier b; b.bar = bar; b.x = xb_xcc_id(); b.st = st;
  if (threadIdx.x == 0) (void)xb_add(&bar[XB_XCNT(b.x)], 1u);
  return b;
}
__device__ __forceinline__ void xcd_barrier_complete(unsigned* bar, unsigned x, unsigned& nloc, unsigned& nx) {
  const unsigned G = gridDim.x * gridDim.y * gridDim.z;
  unsigned sum, cnt, mine, sp = 0u;
  for (;;) {
    sum = 0u; cnt = 0u; mine = 0u;
#pragma unroll
    for (unsigned j = 0; j < 16; ++j) { const unsigned c = xb_ld(&bar[XB_XCNT(j)]); sum += c; cnt += (c > 0u) ? 1u : 0u; mine = (j == x) ? c : mine; }
    if (sum == G) break;
    __builtin_amdgcn_s_sleep(1);
    if ((++sp & 255u) == 0u) { if (xb_ld(&bar[XB_TMO])) break; if (sp > XB_SPIN_CAP) { atomicAdd(&bar[XB_TMO], 1u); break; } }
  }
  nloc = mine > 0u ? mine : 1u; nx = cnt > 0u ? cnt : 1u;
}
__device__ __forceinline__ void xcd_barrier(const XcdBarrier& b) {
  asm volatile("s_waitcnt vmcnt(0)" ::: "memory");
  __syncthreads();
  if (threadIdx.x == 0) {
    unsigned* bar = b.bar;
    __builtin_amdgcn_s_waitcnt(0);
    unsigned nloc = b.st[0], nx = b.st[1];
    if (nloc == 0u) { xcd_barrier_complete(bar, b.x, nloc, nx); b.st[0] = nloc; b.st[1] = nx; }
    const unsigned old = xb_add(&bar[XB_XSUB(b.x)], 1u);
    const unsigned gen = old / nloc;
    if (old + 1u == (gen + 1u) * nloc) {
      __builtin_amdgcn_fence(__ATOMIC_RELEASE, "agent");
      asm volatile("s_waitcnt vmcnt(0)" ::: "memory");
      const unsigned og = xb_add(&bar[XB_TOP], 1u);
      const unsigned tg = og / nx;
      if (og + 1u == (tg + 1u) * nx) xb_add(&bar[XB_TOPGEN], 1u);
      else XB_SPIN(xb_ld(&bar[XB_TOPGEN]) == tg, bar);
      __builtin_amdgcn_fence(__ATOMIC_ACQUIRE, "agent");
      xb_add(&bar[XB_XGEN(b.x)], 1u);
      asm volatile("s_waitcnt vmcnt(0)" ::: "memory");
    } else {
      XB_SPIN(xb_ld(&bar[XB_XGEN(b.x)]) == gen, bar);
      __builtin_amdgcn_fence(__ATOMIC_ACQUIRE, "agent");
      asm volatile("s_waitcnt vmcnt(0)" ::: "memory");
    }
  }
  __syncthreads();
}

__device__ void mod_unit(const Params& p, int u, char* lds) {
  const int tid = opaque_tid();
  const int layer = u / 96, n0 = (u % 96) * 32, col = tid & 31, ks = tid >> 5;
  const float* W = p.mod_w + (size_t)layer * 1024 * 3072 + n0 + col;
  float a0 = 0, a1 = 0, a2 = 0;
  for (int k = ks * 64; k < ks * 64 + 64; ++k) {
    float w = W[(size_t)k * 3072];
    a0 += silu_f(p.c[k]) * w; a1 += silu_f(p.c[1024 + k]) * w; a2 += silu_f(p.c_ctx[k]) * w;
  }
  float* red = (float*)lds;
  red[(0 * 16 + ks) * 32 + col] = a0; red[(1 * 16 + ks) * 32 + col] = a1; red[(2 * 16 + ks) * 32 + col] = a2;
  __syncthreads();
  if (tid < 96) {
    int w = tid >> 5, cc = tid & 31; float s = 0;
    for (int i = 0; i < 16; ++i) s += red[(w * 16 + i) * 32 + cc];
    float* modv = (float*)(p.ws + OFF_MODV);
    modv[(layer * 3 + w) * 3072 + n0 + cc] = s + p.mod_b[layer * 3072 + n0 + cc];
  }
  __syncthreads();
}

__device__ void transpose_unit(const Params& p, int u, char* lds) {
  const float* src; const float* gain = nullptr; int K, N; u16* dst; int ul;
  if (u < 608)       { ul = u;        src = p.ab_w_in;  K = 1024; N = 2336; dst = (u16*)(p.ws + OFF_WT_IN_AB); }
  else if (u < 864)  { ul = u - 608;  src = p.ab_w_out; K = 1024; N = 1024; dst = (u16*)(p.ws + OFF_WT_OUT_AB); }
  else if (u < 912)  { ul = u - 864;  src = p.w_uq;     K = 256;  N = 768;  dst = (u16*)(p.ws + OFF_WT_UQ); gain = p.cq_gain; }
  else if (u < 976)  { ul = u - 912;  src = p.w_ukv;    K = 256;  N = 1024; dst = (u16*)(p.ws + OFF_WT_UKV); gain = p.ckv_gain; }
  else if (u < 1808) { ul = u - 976;  src = p.cd_w_in;  K = 1024; N = 3328; dst = (u16*)(p.ws + OFF_WT_IN_CD); }
  else               { ul = u - 1808; src = p.cd_w_out; K = 1024; N = 1024; dst = (u16*)(p.ws + OFF_WT_OUT_CD); }
  const int nkt = K / 64, kt = ul % nkt, nt = ul / nkt, k0 = kt * 64, n0 = nt * 64, tid = opaque_tid();
  float* tile = (float*)lds;
#pragma unroll
  for (int e = 0; e < 8; ++e) {
    int i = (tid >> 6) + 8 * e, j = tid & 63, n = n0 + j;
    float v = (n < N) ? src[(size_t)(k0 + i) * N + n] : 0.f;
    if (gain) v *= gain[k0 + i];
    tile[i * 65 + j] = v;
  }
  __syncthreads();
#pragma unroll
  for (int e = 0; e < 8; ++e) {
    int i2 = (tid >> 6) + 8 * e, j2 = tid & 63;
    dst[(size_t)(n0 + i2) * K + k0 + j2] = f2bf(tile[j2 * 65 + i2]);
  }
  __syncthreads();
}

template <bool BF>
__device__ __forceinline__ void adaln_latent(const void* __restrict__ xsrc, const float* __restrict__ modl, u16* __restrict__ H, int gw, int nw, int lane) {
  constexpr int NV = BF ? 2 : 4;
  constexpr int CW = BF ? 8 : 4;
  u32x4 cur[NV], nxt[NV];
  float sh[NV][CW], sc[NV][CW];
  auto ld = [&](u32x4 (&d)[NV], int r) {
#pragma unroll
    for (int i = 0; i < NV; ++i)
      d[i] = BF ? __builtin_nontemporal_load((const u32x4*)((const u16*)xsrc + (size_t)r * 1024 + 8 * (lane + 64 * i))) : __builtin_nontemporal_load((const u32x4*)((const float*)xsrc + (size_t)r * 1024 + 4 * (lane + 64 * i)));
  };
  int r = gw; if (r < NLAT) ld(cur, r);
  int lastb = -1;
  for (; r < NLAT; r += nw) {
    const int rn = r + nw;
    if (rn < NLAT) ld(nxt, rn);
    const int b = r >> 14;
    if (b != lastb) { lastb = b; const float* m = modl + b * 3072;
#pragma unroll
      for (int i = 0; i < NV; ++i)
#pragma unroll
        for (int e = 0; e < CW; ++e) { sh[i][e] = m[CW * (lane + 64 * i) + e]; sc[i][e] = 1.f + m[1024 + CW * (lane + 64 * i) + e]; } }
    float f[NV][CW]; float ss = 0;
#pragma unroll
    for (int i = 0; i < NV; ++i)
#pragma unroll
      for (int e = 0; e < CW; ++e) {
        f[i][e] = BF ? ((e & 1) ? bfhi(cur[i][e >> 1]) : bflo(cur[i][e >> 1])) : __uint_as_float(cur[i][e]);
        ss += f[i][e] * f[i][e]; }
    ss = wave_sum(ss);
    const float rstd = rsqrtf(ss * (1.f / 1024) + EPS);
#pragma unroll
    for (int i = 0; i < NV; ++i) {
      float y[CW];
#pragma unroll
      for (int e = 0; e < CW; ++e) y[e] = f[i][e] * rstd * sc[i][e] + sh[i][e];
      if (BF) { const u32x4 o = {cvtpk(y[0], y[1]), cvtpk(y[2], y[3]), cvtpk(y[4 % CW], y[5 % CW]), cvtpk(y[6 % CW], y[7 % CW])}; *(u32x4*)(H + (size_t)r * 1024 + 8 * (lane + 64 * i)) = o; }
      else { const u32x2 o = {cvtpk(y[0], y[1]), cvtpk(y[2], y[3])}; *(u32x2*)(H + (size_t)r * 1024 + 4 * (lane + 64 * i)) = o; }
    }
#pragma unroll
    for (int i = 0; i < NV; ++i) cur[i] = nxt[i];
  }
}
__device__ void adaln_phase(const float* xlat, const u16* xlat_bf, const float* xctx, const float* modl, u16* H) {
  const int tid = opaque_tid(), lane = tid & 63, gw = blockIdx.x * 8 + (tid >> 6), nw = gridDim.x * 8;
  if (xlat_bf != nullptr) adaln_latent<true>(xlat_bf, modl, H, gw, nw, lane); else adaln_latent<false>(xlat, modl, H, gw, nw, lane);
  for (int r = NLAT + gw; r < NROW; r += nw) {
    const float* src = xctx + (size_t)(r - NLAT) * 1024;
    const float* m = modl + 2 * 3072;
    float4 v[4]; float ss = 0;
#pragma unroll
    for (int i = 0; i < 4; ++i) { v[i] = ((const float4*)src)[lane + 64 * i]; ss += v[i].x * v[i].x + v[i].y * v[i].y + v[i].z * v[i].z + v[i].w * v[i].w; }
    ss = wave_sum(ss);
    const float rstd = rsqrtf(ss * (1.f / 1024) + EPS);
#pragma unroll
    for (int i = 0; i < 4; ++i) {
      int c = 4 * (lane + 64 * i);
      float4 sh = *(const float4*)(m + c), sc = *(const float4*)(m + 1024 + c);
      float y0 = v[i].x * rstd * (1.f + sc.x) + sh.x, y1 = v[i].y * rstd * (1.f + sc.y) + sh.y;
      float y2 = v[i].z * rstd * (1.f + sc.z) + sh.z, y3 = v[i].w * rstd * (1.f + sc.w) + sh.w;
      u32x2 o = {cvtpk(y0, y1), cvtpk(y2, y3)};
      *(u32x2*)(H + (size_t)r * 1024 + c) = o;
    }
  }
}

#define GSWZ(row, colB) ((row) * 128 + ((colB) ^ ((((row) >> 1) & 7) << 4)))
struct ResPre { float4 v[16]; u32x2 w[16]; };
struct GPre { bf16x8 ra[4], rb[2]; };
__device__ __forceinline__ void gemm_preload(const u16* __restrict__ A, int lda, const u16* __restrict__ Bt, int ldb, int m0, int n0, GPre& g) {
  const int tid = opaque_tid(), srow = tid >> 3, sch = tid & 7;
  const u16* ap = A + (size_t)(m0 + srow) * lda + sch * 8;
  const u16* bp = Bt + (size_t)(n0 + srow) * ldb + sch * 8;
#pragma unroll
  for (int i = 0; i < 4; ++i) g.ra[i] = *(const bf16x8*)(ap + (size_t)(64 * i) * lda);
#pragma unroll
  for (int i = 0; i < 2; ++i) g.rb[i] = *(const bf16x8*)(bp + (size_t)(64 * i) * ldb);
}
template <int PRE>
__device__ __forceinline__ void gemm_tile(const u16* __restrict__ A, int lda, const u16* __restrict__ Bt, int ldb, int K,
                                          int m0, int n0, f32x16 (&acc)[2][2], char* lds, GPre& g, const void* resp = nullptr, ResPre* rp = nullptr) {
  const int tid = opaque_tid(), wid = tid >> 6, lane = tid & 63, r32 = lane & 31, hi = lane >> 5;
  const int wm = wid & 3, wn = wid >> 2;
  char* As = lds;
  char* Bs = lds + 98304;
  const int srow = tid >> 3, sch = tid & 7;
  const u16* ap = A + (size_t)(m0 + srow) * lda + sch * 8;
  const u16* bp = Bt + (size_t)(n0 + srow) * ldb + sch * 8;
  const int sw = GSWZ(srow, sch * 16);
  bf16x8 (&ra)[4] = g.ra; bf16x8 (&rb)[2] = g.rb;
#pragma unroll
  for (int i = 0; i < 2; ++i) for (int j = 0; j < 2; ++j) acc[i][j] = f32x16{};
  const int nk = K / 64;
  __syncthreads();
#pragma unroll
  for (int i = 0; i < 4; ++i) *(bf16x8*)(As + sw + i * 8192) = ra[i];
#pragma unroll
  for (int i = 0; i < 2; ++i) *(bf16x8*)(Bs + sw + i * 8192) = rb[i];
  if (1 < nk) {
#pragma unroll
    for (int i = 0; i < 4; ++i) ra[i] = *(const bf16x8*)(ap + (size_t)(64 * i) * lda + 64);
#pragma unroll
    for (int i = 0; i < 2; ++i) rb[i] = *(const bf16x8*)(bp + (size_t)(64 * i) * ldb + 64);
  }
  __syncthreads();
  const int arow0 = wm * 64 + r32, brow0 = wn * 64 + r32;
  int st = 0;
  for (int kt = 0; kt < nk; ++kt) {
    const int stn = (st == 2) ? 0 : st + 1;
    if (kt + 1 < nk) {
      char* An = As + stn * 32768; char* Bn = Bs + stn * 16384;
#pragma unroll
      for (int i = 0; i < 4; ++i) *(bf16x8*)(An + sw + i * 8192) = ra[i];
#pragma unroll
      for (int i = 0; i < 2; ++i) *(bf16x8*)(Bn + sw + i * 8192) = rb[i];
    }
    if (kt + 2 < nk) {
#pragma unroll
      for (int i = 0; i < 4; ++i) ra[i] = *(const bf16x8*)(ap + (size_t)(64 * i) * lda + (kt + 2) * 64);
#pragma unroll
      for (int i = 0; i < 2; ++i) rb[i] = *(const bf16x8*)(bp + (size_t)(64 * i) * ldb + (kt + 2) * 64);
    }
    if (PRE == 1 && kt == 0) {
#pragma unroll
      for (int q = 0; q < 16; ++q) { const u32x4 t_ = __builtin_nontemporal_load((const u32x4*)((const float*)resp + (size_t)((q >> 3) * 32 + 4 * (q & 7)) * 1024)); rp->v[q] = make_float4(__uint_as_float(t_[0]), __uint_as_float(t_[1]), __uint_as_float(t_[2]), __uint_as_float(t_[3])); }
    }
    if (PRE == 2 && kt == 0) {
#pragma unroll
      for (int q = 0; q < 16; ++q) rp->w[q] = __builtin_nontemporal_load((const u32x2*)((const u16*)resp + (size_t)((q >> 3) * 32 + 4 * (q & 7)) * 1024));
    }
    SBAR();
    const char* Ac = As + st * 32768; const char* Bc = Bs + st * 16384;
#pragma unroll
    for (int kk = 0; kk < 4; ++kk) {
      const int cb = kk * 32 + hi * 16;
      bf16x8 a0 = *(const bf16x8*)(Ac + GSWZ(arow0, cb));
      bf16x8 a1 = *(const bf16x8*)(Ac + GSWZ(arow0 + 32, cb));
      bf16x8 b0 = *(const bf16x8*)(Bc + GSWZ(brow0, cb));
      bf16x8 b1 = *(const bf16x8*)(Bc + GSWZ(brow0 + 32, cb));
      acc[0][0] = __builtin_amdgcn_mfma_f32_32x32x16_bf16(a0, b0, acc[0][0], 0, 0, 0);
      acc[0][1] = __builtin_amdgcn_mfma_f32_32x32x16_bf16(a0, b1, acc[0][1], 0, 0, 0);
      acc[1][0] = __builtin_amdgcn_mfma_f32_32x32x16_bf16(a1, b0, acc[1][0], 0, 0, 0);
      acc[1][1] = __builtin_amdgcn_mfma_f32_32x32x16_bf16(a1, b1, acc[1][1], 0, 0, 0);
    }
    __syncthreads();
    st = stn;
  }
}

struct TileIter {
  int f, fend, step, MT, NT;
  __device__ __forceinline__ TileIter(int MT_, int NT_) : MT(MT_), NT(NT_) {
    const int T = MT_ * NT_, bid = blockIdx.x, nblk = gridDim.x;
    if (nblk == 256) { const int x = bid & 7, cl = bid >> 3; f = (int)(((long)T * x) >> 3) + cl; fend = (int)(((long)T * (x + 1)) >> 3); step = 32; }
    else { f = bid; fend = T; step = nblk; }
  }
  __device__ __forceinline__ bool valid() const { return f < fend; }
  __device__ __forceinline__ void next() { f += step; }
  __device__ __forceinline__ void get(int& mt, int& nt) const {
    const int full = (MT >> 2) * 4 * NT;
    if (f < full) { const int g = f / (4 * NT), rem = f - g * 4 * NT; nt = rem >> 2; mt = g * 4 + (rem & 3); }
    else { const int rem = f - full, gs = MT - (MT >> 2) * 4; nt = rem / gs; mt = (MT >> 2) * 4 + (rem - nt * gs); }
  }
};

__device__ __forceinline__ void epi_bf16(f32x16 (&acc)[2][2], u16* C, int ldc, int m0, int n0, char* lds) {
  const int tid = opaque_tid(), wid = tid >> 6, lane = tid & 63, r32 = lane & 31, hi = lane >> 5;
  const int wm = wid & 3, wn = wid >> 2;
  char* wl = lds + wid * 9216;
#pragma unroll
  for (int i = 0; i < 2; ++i)
#pragma unroll
    for (int j = 0; j < 2; ++j)
#pragma unroll
      for (int r = 0; r < 16; ++r) *(u16*)(wl + (i * 32 + crow(r, hi)) * 144 + (j * 32 + r32) * 2) = f2bf(acc[i][j][r]);
  asm volatile("s_waitcnt lgkmcnt(0)" ::: "memory");
  const int rr = lane >> 3, ch = lane & 7;
  u16* cbase = C + (size_t)(m0 + wm * 64 + rr) * ldc + n0 + wn * 64 + ch * 8;
#pragma unroll
  for (int k = 0; k < 8; ++k) {
    const u32x4 v = *(const u32x4*)(wl + (rr + 8 * k) * 144 + ch * 16);
    *(u32x4*)(cbase + (size_t)(8 * k) * ldc) = v;
  }
}
template <bool IN_BF, bool OUT_BF>
__device__ __forceinline__ void epi_res(f32x16 (&acc)[2][2], const ResPre& rp, void* outp, const float* gsrc, int n0, char* lds) {
  const int tid = opaque_tid(), wid = tid >> 6, lane = tid & 63, r32 = lane & 31, hi = lane >> 5;
  const int wn = wid >> 2;
  char* wl = lds + wid * 8704;
  const int rl = lane >> 4, c4 = lane & 15;
  const float4 g = *(const float4*)(gsrc + n0 + wn * 64 + 4 * c4);
#pragma unroll
  for (int i = 0; i < 2; ++i) {
#pragma unroll
    for (int j = 0; j < 2; ++j)
#pragma unroll
      for (int r = 0; r < 16; ++r) *(float*)(wl + crow(r, hi) * 272 + (j * 32 + r32) * 4) = acc[i][j][r];
    asm volatile("s_waitcnt lgkmcnt(0)" ::: "memory");
#pragma unroll
    for (int k = 0; k < 8; ++k) {
      const float4 a = *(const float4*)(wl + (rl + 4 * k) * 272 + c4 * 16);
      float4 x;
      if (IN_BF) { const u32x2 xw = rp.w[i * 8 + k]; x.x = bflo(xw[0]); x.y = bfhi(xw[0]); x.z = bflo(xw[1]); x.w = bfhi(xw[1]); } else x = rp.v[i * 8 + k];
      float4 o; o.x = x.x + g.x * a.x; o.y = x.y + g.y * a.y; o.z = x.z + g.z * a.z; o.w = x.w + g.w * a.w;
      if (OUT_BF) { const u32x2 ow = {cvtpk(o.x, o.y), cvtpk(o.z, o.w)}; *(u32x2*)((u16*)outp + (size_t)(i * 32 + 4 * k) * 1024) = ow; }
      else { const u32x4 t_ = {__float_as_uint(o.x), __float_as_uint(o.y), __float_as_uint(o.z), __float_as_uint(o.w)}; __builtin_nontemporal_store(t_, (u32x4*)((float*)outp + (size_t)(i * 32 + 4 * k) * 1024)); }
    }
    asm volatile("s_waitcnt lgkmcnt(0)" ::: "memory");
  }
}

__device__ __forceinline__ float red8(float v) { v += __shfl_xor(v, 1); v += __shfl_xor(v, 2); v += __shfl_xor(v, 4); return v; }
__device__ __forceinline__ void rope_cs(float pos, float inv, bool on, float& c, float& s) {
  if (on) { float a = pos * inv * 0.15915494309189535f; a -= floorf(a); c = __builtin_amdgcn_cosf(a); s = __builtin_amdgcn_sinf(a); } else { c = 1.f; s = 0.f; }
}
__device__ __forceinline__ void head64(const u16* src, u16* dst, int gb, const float* g, const float* cG, const float* sG, float qs) {
  const u32x2 lo = *(const u32x2*)(src + gb), hi2 = *(const u32x2*)(src + gb + 16);
  float x[8] = {bflo(lo[0]), bfhi(lo[0]), bflo(lo[1]), bfhi(lo[1]), bflo(hi2[0]), bfhi(hi2[0]), bflo(hi2[1]), bfhi(hi2[1])};
  float ss = 0;
#pragma unroll
  for (int e = 0; e < 8; ++e) ss += x[e] * x[e];
  const float rn = rsqrtf(red8(ss) * (1.f / 64) + EPS) ;
#pragma unroll
  for (int e = 0; e < 8; ++e) x[e] *= rn * g[e];
  float y[8];
#pragma unroll
  for (int e = 0; e < 4; ++e) { y[e] = (x[e] * cG[e] - x[e + 4] * sG[e]) * qs; y[e + 4] = (x[e + 4] * cG[e] + x[e] * sG[e]) * qs; }
  const u32x2 o0 = {cvtpk(y[0], y[1]), cvtpk(y[2], y[3])}, o1 = {cvtpk(y[4], y[5]), cvtpk(y[6], y[7])};
  *(u32x2*)(dst + gb) = o0; *(u32x2*)(dst + gb + 16) = o1;
}
__device__ __forceinline__ void head96(float* n, float r1a, float r1b, float r2a, float r2b, u16* dst, int t, int rb,
                                       const float* gn, const float* gr, const float* cM, const float* sM, float qs) {
  float ss = r1a * r1a + r1b * r1b + r2a * r2a + r2b * r2b;
#pragma unroll
  for (int e = 0; e < 8; ++e) ss += n[e] * n[e];
  const float rn = rsqrtf(red8(ss) * (1.f / 96) + EPS);
#pragma unroll
  for (int e = 0; e < 8; ++e) n[e] *= rn * gn[e] * qs;
  r1a *= rn * gr[0]; r1b *= rn * gr[1]; r2a *= rn * gr[2]; r2b *= rn * gr[3];
  const float y1a = (r1a * cM[0] - r2a * sM[0]) * qs, y2a = (r2a * cM[0] + r1a * sM[0]) * qs;
  const float y1b = (r1b * cM[1] - r2b * sM[1]) * qs, y2b = (r2b * cM[1] + r1b * sM[1]) * qs;
  const u32x4 o = {cvtpk(n[0], n[1]), cvtpk(n[2], n[3]), cvtpk(n[4], n[5]), cvtpk(n[6], n[7])};
  *(u32x4*)(dst + 8 * t) = o;
  *(unsigned*)(dst + 64 + rb) = cvtpk(y1a, y1b); *(unsigned*)(dst + 64 + rb + 8) = cvtpk(y2a, y2b);
}
__device__ void finalize0(const Params& p) {
  const int tid = opaque_tid(), lane = tid & 63, gw = blockIdx.x * 8 + (tid >> 6), nw = gridDim.x * 8;
  const int h = lane >> 3, t = lane & 7;
  char* ws = p.ws;
  const u16* PP = (const u16*)(ws + OFF_PP);
  const u16* QAR = (const u16*)(ws + OFF_H);
  const u16* KVR = (const u16*)p.out;
  u16* QA = (u16*)(ws + OFF_QA); u16* QCA = (u16*)(ws + OFF_QCA); u16* KA = (u16*)(ws + OFF_KA); u16* VA = (u16*)(ws + OFF_VA);
  u16* QB = (u16*)(ws + OFF_QB); u16* QCB = (u16*)(ws + OFF_QCB); u16* KB = (u16*)(ws + OFF_KB); u16* VB = (u16*)(ws + OFF_VB);
  const int gb = t < 4 ? 4 * t : 32 + 4 * (t - 4), rb = t < 4 ? 2 * t : 16 + 2 * (t - 4);
  float qgn[8], kgn[8], qgr[4], kgr[4], gqg[8], gkg[8], invG[4], invM[2];
#pragma unroll
  for (int e = 0; e < 8; ++e) { qgn[e] = p.q_gain[8 * t + e]; kgn[e] = p.k_gain[8 * t + e];
    const int d = gb + (e & 3) + (e >> 2) * 16; gqg[e] = p.gq_gain[d]; gkg[e] = p.gk_gain[d]; }
#pragma unroll
  for (int k = 0; k < 4; ++k) { const int d = 64 + rb + (k & 1) + (k >> 1) * 8; qgr[k] = p.q_gain[d]; kgr[k] = p.k_gain[d]; }
#pragma unroll
  for (int e = 0; e < 4; ++e) invG[e] = exp2f(-(float)(4 * (t & 3) + e) * (13.287712379549449f / 16.f));
#pragma unroll
  for (int k = 0; k < 2; ++k) invM[k] = exp2f(-(float)(2 * (t & 3) + k) * (13.287712379549449f / 8.f));
  for (int r = gw; r < NROW; r += nw) {
    const bool isctx = r >= NLAT;
    int b, s, kpos; float pos = 0.f;
    if (!isctx) { b = r >> 14; s = r & 16383; kpos = CL + s; pos = t < 4 ? (float)(s >> 6) : (float)(s & 63); }
    else { int rc = r - NLAT; b = rc >> 8; s = rc & 255; kpos = s; }
    float cG[4], sG[4], cM[2], sM[2];
#pragma unroll
    for (int e = 0; e < 4; ++e) rope_cs(pos, invG[e], !isctx, cG[e], sG[e]);
#pragma unroll
    for (int k = 0; k < 2; ++k) rope_cs(pos, invM[k], !isctx, cM[k], sM[k]);
    const u16* pp = PP + (size_t)r * LD_AB;
    const u32x2 wq = *(const u32x2*)(pp + lane * 4), wk = *(const u32x2*)(pp + 256 + lane * 4);
    float s1 = bflo(wq[0]) * bflo(wq[0]) + bfhi(wq[0]) * bfhi(wq[0]) + bflo(wq[1]) * bflo(wq[1]) + bfhi(wq[1]) * bfhi(wq[1]);
    float s2 = bflo(wk[0]) * bflo(wk[0]) + bfhi(wk[0]) * bfhi(wk[0]) + bflo(wk[1]) * bflo(wk[1]) + bfhi(wk[1]) * bfhi(wk[1]);
    s1 = wave_sum(s1); s2 = wave_sum(s2);
    const float rstd_cq = rsqrtf(s1 * (1.f / 256) + EPS), rstd_ckv = rsqrtf(s2 * (1.f / 256) + EPS);
    { const u16* qa = QAR + (size_t)r * 768 + h * 96;
      const u32x4 nv = *(const u32x4*)(qa + 8 * t); const unsigned w1 = *(const unsigned*)(qa + 64 + rb), w2 = *(const unsigned*)(qa + 64 + rb + 8);
      float n[8] = {bflo(nv[0]) * rstd_cq, bfhi(nv[0]) * rstd_cq, bflo(nv[1]) * rstd_cq, bfhi(nv[1]) * rstd_cq, bflo(nv[2]) * rstd_cq, bfhi(nv[2]) * rstd_cq, bflo(nv[3]) * rstd_cq, bfhi(nv[3]) * rstd_cq};
      u16* dq = isctx ? QCA + ((size_t)(b * 8 + h) * CL + s) * 96 : QA + ((size_t)(b * 8 + h) * SEQ + s) * 96;
      head96(n, bflo(w1) * rstd_cq, bfhi(w1) * rstd_cq, bflo(w2) * rstd_cq, bfhi(w2) * rstd_cq, dq, t, rb, qgn, qgr, cM, sM, QS_A); }
    { const u16* kv = KVR + (size_t)r * 1024 + h * 128;
      const u32x4 nv = *(const u32x4*)(kv + 8 * t), vv = *(const u32x4*)(kv + 64 + 8 * t);
      const unsigned w1 = *(const unsigned*)(pp + 512 + rb), w2 = *(const unsigned*)(pp + 512 + rb + 8);
      float n[8] = {bflo(nv[0]) * rstd_ckv, bfhi(nv[0]) * rstd_ckv, bflo(nv[1]) * rstd_ckv, bfhi(nv[1]) * rstd_ckv, bflo(nv[2]) * rstd_ckv, bfhi(nv[2]) * rstd_ckv, bflo(nv[3]) * rstd_ckv, bfhi(nv[3]) * rstd_ckv};
      const size_t kr = (size_t)(b * 8 + h) * KVLEN + kpos;
      head96(n, bflo(w1), bfhi(w1), bflo(w2), bfhi(w2), KA + kr * 96, t, rb, kgn, kgr, cM, sM, 1.f);
      const u32x4 vo = {cvtpk(bflo(vv[0]) * rstd_ckv, bfhi(vv[0]) * rstd_ckv), cvtpk(bflo(vv[1]) * rstd_ckv, bfhi(vv[1]) * rstd_ckv),
                        cvtpk(bflo(vv[2]) * rstd_ckv, bfhi(vv[2]) * rstd_ckv), cvtpk(bflo(vv[3]) * rstd_ckv, bfhi(vv[3]) * rstd_ckv)};
      *(u32x4*)(VA + kr * 64 + 8 * t) = vo; }
    { u16* dg = isctx ? QCB + ((size_t)(b * 8 + h) * CL + s) * 64 : QB + ((size_t)(b * 8 + h) * SEQ + s) * 64;
      head64(pp + 544 + h * 64, dg, gb, gqg, cG, sG, QS_B); }
    if (h < 2) {
      const size_t kr = (size_t)(b * 2 + h) * KVLEN + kpos;
      head64(pp + 1056 + h * 64, KB + kr * 64, gb, gkg, cG, sG, 1.f);
      *(u32x4*)(VB + kr * 64 + 8 * t) = *(const u32x4*)(pp + 1184 + h * 64 + 8 * t);
    }
  }
}

__device__ void finalize1(const Params& p) {
  const int tid = opaque_tid(), lane = tid & 63, gw = blockIdx.x * 8 + (tid >> 6), nw = gridDim.x * 8;
  const int h = lane >> 3, t = lane & 7;
  char* ws = p.ws;
  const u16* PP = (const u16*)(ws + OFF_PP);
  u16* Q2 = (u16*)(ws + OFF_Q2); u16* K2 = (u16*)(ws + OFF_K2); u16* V2 = (u16*)(ws + OFF_V2);
  u16* MIX = (u16*)(ws + OFF_H);
  const int gb = t < 4 ? 4 * t : 32 + 4 * (t - 4);
  float qg[8], kg[8], invG[4];
#pragma unroll
  for (int e = 0; e < 8; ++e) { const int d = gb + (e & 3) + (e >> 2) * 16; qg[e] = p.win_q_gain[d]; kg[e] = p.win_k_gain[d]; }
#pragma unroll
  for (int e = 0; e < 4; ++e) invG[e] = exp2f(-(float)(4 * (t & 3) + e) * (13.287712379549449f / 16.f));
  float cw[3][8];
#pragma unroll
  for (int j = 0; j < 3; ++j)
#pragma unroll
    for (int e = 0; e < 8; ++e) cw[j][e] = p.conv_w[j * 512 + lane * 8 + e];
  for (int r = gw; r < NROW + 512; r += nw) {
    if (r >= NROW) {
      int slab = (r - NROW) >> 7, pr = (r - NROW) & 127;
      size_t kr = (size_t)slab * KV2LEN + KVLEN + pr;
      K2[kr * 64 + lane] = 0; V2[kr * 64 + lane] = 0;
      continue;
    }
    const bool isctx = r >= NLAT;
    int b, s, kpos; float pos = 0.f;
    if (!isctx) { b = r >> 14; s = r & 16383; kpos = CL + s; pos = t < 4 ? (float)(s >> 6) : (float)(s & 63); }
    else { int rc = r - NLAT; b = rc >> 8; s = rc & 255; kpos = s; }
    float cG[4], sG[4];
#pragma unroll
    for (int e = 0; e < 4; ++e) rope_cs(pos, invG[e], !isctx, cG[e], sG[e]);
    const u16* pp = PP + (size_t)r * LD_CD;
    if (!isctx) head64(pp + h * 64, Q2 + ((size_t)(b * 8 + h) * SEQ + s) * 64, gb, qg, cG, sG, QS_B);
    if (h < 2) {
      const size_t kr = (size_t)(b * 2 + h) * KV2LEN + kpos;
      head64(pp + 512 + h * 64, K2 + kr * 64, gb, kg, cG, sG, 1.f);
      *(u32x4*)(V2 + kr * 64 + 8 * t) = *(const u32x4*)(pp + 640 + h * 64 + 8 * t);
    }
    if (!isctx) {
      const int c0 = lane * 8;
      float y[8];
#pragma unroll
      for (int e = 0; e < 8; ++e) y[e] = 0.f;
#pragma unroll
      for (int j = 0; j < 3; ++j) {
        const int sj = s + j - 1;
        if (sj >= 0 && sj < SEQ) {
          const u16* pj = pp + (ptrdiff_t)(j - 1) * LD_CD;
          u32x4 a = *(const u32x4*)(pj + 1280 + c0), bb = *(const u32x4*)(pj + 1792 + c0);
#pragma unroll
          for (int e = 0; e < 4; ++e) {
            y[2 * e]     += bflo(a[e]) * bflo(bb[e]) * cw[j][2 * e];
            y[2 * e + 1] += bfhi(a[e]) * bfhi(bb[e]) * cw[j][2 * e + 1];
          }
        }
      }
      u32x4 gbv = *(const u32x4*)(pp + 768 + c0), gt = *(const u32x4*)(pp + 2304 + 512 + c0);
      u32x4 o;
#pragma unroll
      for (int e = 0; e < 4; ++e) {
        float v0 = bflo(gbv[e]) * y[2 * e] * silu_f(bflo(gt[e]));
        float v1 = bfhi(gbv[e]) * y[2 * e + 1] * silu_f(bfhi(gt[e]));
        o[e] = cvtpk(v0, v1);
      }
      *(u32x4*)(MIX + (size_t)r * 1024 + 512 + c0) = o;
    }
  }
}

#define KSWZ(row, colB) ((row) * 272 + (colB))
__device__ __forceinline__ int v_st2(int k, int c) { const int kk = k; return ((kk >> 3) * 2 + (c >> 5)) * 512 + ((kk & 7) * 32 + (c & 31)) * 2; }
__device__ __forceinline__ int v_rd_base(int lane) { return ((lane & 3) << 3) | (((lane >> 2) & 3) << 6) | (((lane >> 4) & 1) << 5) | (((lane >> 5) & 1) << 8); }
constexpr int v_rd_off2(int d0, int ks, int half) { return d0 * 512 + ks * 2048 + half * 1024; }
template <int OFF> __device__ __forceinline__ s16x4 tr_read(int vb) {
  s16x4 r; asm volatile("ds_read_b64_tr_b16 %0, %1 offset:%2" : "=&v"(r) : "v"(vb), "i"(OFF) : "memory"); return r;
}
template <int D0> __device__ __forceinline__ void pv_one(f32x16& od, int vb, bf16x8 pa0, bf16x8 pa1, bf16x8 pa2, bf16x8 pa3) {
  const s16x4 l0 = tr_read<v_rd_off2(D0, 0, 0)>(vb), h0 = tr_read<v_rd_off2(D0, 0, 1)>(vb), l1 = tr_read<v_rd_off2(D0, 1, 0)>(vb), h1 = tr_read<v_rd_off2(D0, 1, 1)>(vb);
  const s16x4 l2 = tr_read<v_rd_off2(D0, 2, 0)>(vb), h2 = tr_read<v_rd_off2(D0, 2, 1)>(vb), l3 = tr_read<v_rd_off2(D0, 3, 0)>(vb), h3 = tr_read<v_rd_off2(D0, 3, 1)>(vb);
  asm volatile("s_waitcnt lgkmcnt(0)" ::: "memory"); SBAR();
#define PK(L, H) (bf16x8){L[0], L[1], L[2], L[3], H[0], H[1], H[2], H[3]}
  od = __builtin_amdgcn_mfma_f32_32x32x16_bf16(pa0, PK(l0, h0), od, 0, 0, 0);
  od = __builtin_amdgcn_mfma_f32_32x32x16_bf16(pa1, PK(l1, h1), od, 0, 0, 0);
  od = __builtin_amdgcn_mfma_f32_32x32x16_bf16(pa2, PK(l2, h2), od, 0, 0, 0);
  od = __builtin_amdgcn_mfma_f32_32x32x16_bf16(pa3, PK(l3, h3), od, 0, 0, 0);
#undef PK
}
__device__ __forceinline__ void pv_all(f32x16* o, int vb, bf16x8 pa0, bf16x8 pa1, bf16x8 pa2, bf16x8 pa3) {
  pv_one<0>(o[0], vb, pa0, pa1, pa2, pa3); pv_one<1>(o[1], vb, pa0, pa1, pa2, pa3);
}
__device__ __forceinline__ void pv_exp(f32x16* o, int vb, bf16x8 pa0, bf16x8 pa1, bf16x8 pa2, bf16x8 pa3, f32x16& n0, f32x16& n1) {
#define PK(L, H) (bf16x8){L[0], L[1], L[2], L[3], H[0], H[1], H[2], H[3]}
  { const s16x4 l0 = tr_read<v_rd_off2(0, 0, 0)>(vb), h0 = tr_read<v_rd_off2(0, 0, 1)>(vb), l1 = tr_read<v_rd_off2(0, 1, 0)>(vb), h1 = tr_read<v_rd_off2(0, 1, 1)>(vb);
    const s16x4 l2 = tr_read<v_rd_off2(0, 2, 0)>(vb), h2 = tr_read<v_rd_off2(0, 2, 1)>(vb), l3 = tr_read<v_rd_off2(0, 3, 0)>(vb), h3 = tr_read<v_rd_off2(0, 3, 1)>(vb);
#pragma unroll
    for (int r = 0; r < 8; ++r) n0[r] = __builtin_amdgcn_exp2f(n0[r]);
    asm volatile("s_waitcnt lgkmcnt(0)" ::: "memory"); SBAR();
    o[0] = __builtin_amdgcn_mfma_f32_32x32x16_bf16(pa0, PK(l0, h0), o[0], 0, 0, 0);
    o[0] = __builtin_amdgcn_mfma_f32_32x32x16_bf16(pa1, PK(l1, h1), o[0], 0, 0, 0);
    o[0] = __builtin_amdgcn_mfma_f32_32x32x16_bf16(pa2, PK(l2, h2), o[0], 0, 0, 0);
    o[0] = __builtin_amdgcn_mfma_f32_32x32x16_bf16(pa3, PK(l3, h3), o[0], 0, 0, 0); }
  { const s16x4 l0 = tr_read<v_rd_off2(1, 0, 0)>(vb), h0 = tr_read<v_rd_off2(1, 0, 1)>(vb), l1 = tr_read<v_rd_off2(1, 1, 0)>(vb), h1 = tr_read<v_rd_off2(1, 1, 1)>(vb);
    const s16x4 l2 = tr_read<v_rd_off2(1, 2, 0)>(vb), h2 = tr_read<v_rd_off2(1, 2, 1)>(vb), l3 = tr_read<v_rd_off2(1, 3, 0)>(vb), h3 = tr_read<v_rd_off2(1, 3, 1)>(vb);
#pragma unroll
    for (int r = 8; r < 16; ++r) n0[r] = __builtin_amdgcn_exp2f(n0[r]);
    asm volatile("s_waitcnt lgkmcnt(0)" ::: "memory"); SBAR();
    o[1] = __builtin_amdgcn_mfma_f32_32x32x16_bf16(pa0, PK(l0, h0), o[1], 0, 0, 0);
    o[1] = __builtin_amdgcn_mfma_f32_32x32x16_bf16(pa1, PK(l1, h1), o[1], 0, 0, 0);
    o[1] = __builtin_amdgcn_mfma_f32_32x32x16_bf16(pa2, PK(l2, h2), o[1], 0, 0, 0);
    o[1] = __builtin_amdgcn_mfma_f32_32x32x16_bf16(pa3, PK(l3, h3), o[1], 0, 0, 0); }
#undef PK
#pragma unroll
  for (int r = 0; r < 16; ++r) n1[r] = __builtin_amdgcn_exp2f(n1[r]);
}

struct VSave { bf16x8 f0, f1, f2, f3; };
__device__ __forceinline__ void pv_exp_save(f32x16* o, int vb, bf16x8 pa0, bf16x8 pa1, bf16x8 pa2, bf16x8 pa3, f32x16& n0, f32x16& n1, VSave& vs) {
#define PK(L, H) (bf16x8){L[0], L[1], L[2], L[3], H[0], H[1], H[2], H[3]}
  { const s16x4 l0 = tr_read<v_rd_off2(0, 0, 0)>(vb), h0 = tr_read<v_rd_off2(0, 0, 1)>(vb), l1 = tr_read<v_rd_off2(0, 1, 0)>(vb), h1 = tr_read<v_rd_off2(0, 1, 1)>(vb);
    const s16x4 l2 = tr_read<v_rd_off2(0, 2, 0)>(vb), h2 = tr_read<v_rd_off2(0, 2, 1)>(vb), l3 = tr_read<v_rd_off2(0, 3, 0)>(vb), h3 = tr_read<v_rd_off2(0, 3, 1)>(vb);
#pragma unroll
    for (int r = 0; r < 8; ++r) n0[r] = __builtin_amdgcn_exp2f(n0[r]);
    asm volatile("s_waitcnt lgkmcnt(0)" ::: "memory"); SBAR();
    o[0] = __builtin_amdgcn_mfma_f32_32x32x16_bf16(pa0, PK(l0, h0), o[0], 0, 0, 0);
    o[0] = __builtin_amdgcn_mfma_f32_32x32x16_bf16(pa1, PK(l1, h1), o[0], 0, 0, 0);
    o[0] = __builtin_amdgcn_mfma_f32_32x32x16_bf16(pa2, PK(l2, h2), o[0], 0, 0, 0);
    o[0] = __builtin_amdgcn_mfma_f32_32x32x16_bf16(pa3, PK(l3, h3), o[0], 0, 0, 0); }
  { const s16x4 l0 = tr_read<v_rd_off2(1, 0, 0)>(vb), h0 = tr_read<v_rd_off2(1, 0, 1)>(vb), l1 = tr_read<v_rd_off2(1, 1, 0)>(vb), h1 = tr_read<v_rd_off2(1, 1, 1)>(vb);
    const s16x4 l2 = tr_read<v_rd_off2(1, 2, 0)>(vb), h2 = tr_read<v_rd_off2(1, 2, 1)>(vb), l3 = tr_read<v_rd_off2(1, 3, 0)>(vb), h3 = tr_read<v_rd_off2(1, 3, 1)>(vb);
#pragma unroll
    for (int r = 8; r < 16; ++r) n0[r] = __builtin_amdgcn_exp2f(n0[r]);
    asm volatile("s_waitcnt lgkmcnt(0)" ::: "memory"); SBAR();
    vs.f0 = PK(l0, h0); vs.f1 = PK(l1, h1); vs.f2 = PK(l2, h2); vs.f3 = PK(l3, h3);
    o[1] = __builtin_amdgcn_mfma_f32_32x32x16_bf16(pa0, vs.f0, o[1], 0, 0, 0);
    o[1] = __builtin_amdgcn_mfma_f32_32x32x16_bf16(pa1, vs.f1, o[1], 0, 0, 0);
    o[1] = __builtin_amdgcn_mfma_f32_32x32x16_bf16(pa2, vs.f2, o[1], 0, 0, 0);
    o[1] = __builtin_amdgcn_mfma_f32_32x32x16_bf16(pa3, vs.f3, o[1], 0, 0, 0); }
#pragma unroll
  for (int r = 0; r < 16; ++r) n1[r] = __builtin_amdgcn_exp2f(n1[r]);
}
__device__ __forceinline__ void pv_exp_reuse(f32x16* o, int vb, bf16x8 pa0, bf16x8 pa1, bf16x8 pa2, bf16x8 pa3, f32x16& n0, f32x16& n1, const VSave& vs) {
  { const s16x4 l0 = tr_read<v_rd_off2(0, 0, 0)>(vb), h0 = tr_read<v_rd_off2(0, 0, 1)>(vb), l1 = tr_read<v_rd_off2(0, 1, 0)>(vb), h1 = tr_read<v_rd_off2(0, 1, 1)>(vb);
    const s16x4 l2 = tr_read<v_rd_off2(0, 2, 0)>(vb), h2 = tr_read<v_rd_off2(0, 2, 1)>(vb), l3 = tr_read<v_rd_off2(0, 3, 0)>(vb), h3 = tr_read<v_rd_off2(0, 3, 1)>(vb);
    o[1] = __builtin_amdgcn_mfma_f32_32x32x16_bf16(pa0, vs.f0, o[1], 0, 0, 0);
    o[1] = __builtin_amdgcn_mfma_f32_32x32x16_bf16(pa1, vs.f1, o[1], 0, 0, 0);
    o[1] = __builtin_amdgcn_mfma_f32_32x32x16_bf16(pa2, vs.f2, o[1], 0, 0, 0);
    o[1] = __builtin_amdgcn_mfma_f32_32x32x16_bf16(pa3, vs.f3, o[1], 0, 0, 0);
#pragma unroll
    for (int r = 0; r < 16; ++r) n0[r] = __builtin_amdgcn_exp2f(n0[r]);
    asm volatile("s_waitcnt lgkmcnt(0)" ::: "memory"); SBAR();
    o[0] = __builtin_amdgcn_mfma_f32_32x32x16_bf16(pa0, PK(l0, h0), o[0], 0, 0, 0);
    o[0] = __builtin_amdgcn_mfma_f32_32x32x16_bf16(pa1, PK(l1, h1), o[0], 0, 0, 0);
    o[0] = __builtin_amdgcn_mfma_f32_32x32x16_bf16(pa2, PK(l2, h2), o[0], 0, 0, 0);
    o[0] = __builtin_amdgcn_mfma_f32_32x32x16_bf16(pa3, PK(l3, h3), o[0], 0, 0, 0); }
#undef PK
#pragma unroll
  for (int r = 0; r < 16; ++r) n1[r] = __builtin_amdgcn_exp2f(n1[r]);
}

__device__ __forceinline__ void expall(f32x16& p0, f32x16& p1) {
#pragma unroll
  for (int r = 0; r < 16; ++r) p0[r] = __builtin_amdgcn_exp2f(p0[r]);
#pragma unroll
  for (int r = 0; r < 16; ++r) p1[r] = __builtin_amdgcn_exp2f(p1[r]);
}
__device__ __forceinline__ void finishSM(f32x16& p0, f32x16& p1, float& lsum, bf16x8& pa0, bf16x8& pa1, bf16x8& pa2, bf16x8& pa3) {
  float ps = 0;
#pragma unroll
  for (int r = 0; r < 16; ++r) ps += p0[r];
#pragma unroll
  for (int r = 0; r < 16; ++r) ps += p1[r];
  lsum += ps;
#define PK4(P, BASE, OUT) do { u32x4 w = {cvtpk(P[BASE + 0], P[BASE + 1]), cvtpk(P[BASE + 2], P[BASE + 3]), cvtpk(P[BASE + 4], P[BASE + 5]), cvtpk(P[BASE + 6], P[BASE + 7])}; \
    OUT = *reinterpret_cast<bf16x8*>(&w); } while (0)
  PK4(p0, 0, pa0); PK4(p0, 8, pa1); PK4(p1, 0, pa2); PK4(p1, 8, pa3);
#undef PK4
}
template <int NQK>
__device__ __forceinline__ void qkt(f32x16& p0, f32x16& p1, const char* Ks, const bf16x8* qr, int r32, int hi, const float shift) {
  p0 = f32x16{}; p1 = f32x16{};
#pragma unroll
  for (int d0 = 0; d0 < NQK; ++d0) { int cb = (d0 * 16 + hi * 8) * 2;
    bf16x8 b0 = *reinterpret_cast<const bf16x8*>(Ks + KSWZ(r32, cb));
    bf16x8 b1 = *reinterpret_cast<const bf16x8*>(Ks + KSWZ(32 + r32, cb));
    p0 = __builtin_amdgcn_mfma_f32_32x32x16_bf16(b0, qr[d0], p0, 0, 0, 0);
    p1 = __builtin_amdgcn_mfma_f32_32x32x16_bf16(b1, qr[d0], p1, 0, 0, 0); }
  if (__builtin_expect(shift != 0.f, 0)) {
#pragma unroll
    for (int r = 0; r < 16; ++r) { p0[r] -= shift; p1[r] -= shift; }
  }
}

#define PK4X(P, BASE, OUT) do { u32x4 w_ = {cvtpk(P[BASE + 0], P[BASE + 1]), cvtpk(P[BASE + 2], P[BASE + 3]), cvtpk(P[BASE + 4], P[BASE + 5]), cvtpk(P[BASE + 6], P[BASE + 7])}; \
    OUT = *reinterpret_cast<bf16x8*>(&w_); } while (0)
template <int NQK>
__device__ __forceinline__ void qkt_fin(f32x16& n0, f32x16& n1, const char* Ks, const bf16x8* qr, int r32, int hi, const float shift,
                                        f32x16& o0, f32x16& o1, float& lsum, bf16x8& pa0, bf16x8& pa1, bf16x8& pa2, bf16x8& pa3) {
  n0 = f32x16{}; n1 = f32x16{};
  float ps = 0.f;
  bf16x8 kc0 = *reinterpret_cast<const bf16x8*>(Ks + KSWZ(r32, (hi * 8) * 2));
  bf16x8 kc1 = *reinterpret_cast<const bf16x8*>(Ks + KSWZ(32 + r32, (hi * 8) * 2));
#pragma unroll
  for (int d0 = 0; d0 < NQK; ++d0) {
    bf16x8 kn0 = kc0, kn1 = kc1;
    if (d0 + 1 < NQK) { const int cb = ((d0 + 1) * 16 + hi * 8) * 2;
      kn0 = *reinterpret_cast<const bf16x8*>(Ks + KSWZ(r32, cb)); kn1 = *reinterpret_cast<const bf16x8*>(Ks + KSWZ(32 + r32, cb)); }
    n0 = __builtin_amdgcn_mfma_f32_32x32x16_bf16(kc0, qr[d0], n0, 0, 0, 0);
    n1 = __builtin_amdgcn_mfma_f32_32x32x16_bf16(kc1, qr[d0], n1, 0, 0, 0);
#define PIN(X) asm volatile("" : "+v"(X))
    if (NQK == 6) {
      if (d0 == 0) { PK4X(o0, 0, pa0); }
      if (d0 == 1) { PIN(o0); PK4X(o0, 8, pa1); }
      if (d0 == 2) { _Pragma("unroll") for (int r = 0; r < 16; ++r) ps += o0[r]; }
      if (d0 == 3) { PIN(o1); PK4X(o1, 0, pa2); _Pragma("unroll") for (int r = 0; r < 8; ++r) ps += o1[r]; }
      if (d0 == 4) { PIN(o1); PK4X(o1, 8, pa3); _Pragma("unroll") for (int r = 8; r < 16; ++r) ps += o1[r]; }
    } else {
      if (d0 == 0) { PK4X(o0, 0, pa0); PK4X(o0, 8, pa1); }
      if (d0 == 1) { _Pragma("unroll") for (int r = 0; r < 16; ++r) ps += o0[r]; }
      if (d0 == 2) { PIN(o1); PK4X(o1, 0, pa2); _Pragma("unroll") for (int r = 0; r < 8; ++r) ps += o1[r]; }
      if (d0 == 3) { PIN(o1); PK4X(o1, 8, pa3); _Pragma("unroll") for (int r = 8; r < 16; ++r) ps += o1[r]; }
    }
#undef PIN
    asm volatile("" : "+v"(ps), "+v"(pa0), "+v"(pa1), "+v"(pa2), "+v"(pa3));
    kc0 = kn0; kc1 = kn1;
    SBAR();
  }
  lsum += ps;
  if (__builtin_expect(shift != 0.f, 0)) {
#pragma unroll
    for (int r = 0; r < 16; ++r) { n0[r] -= shift; n1[r] -= shift; }
  }
}

template <int NQK, int MODE, int LDG>
__device__ __forceinline__ void attn_body(const u16* __restrict__ Qb, const u16* __restrict__ Kh, const u16* __restrict__ Vh,
                                          const int NT, const int q0, const float sink2, const float mbound,
                                          u16* __restrict__ mix0, const u16* __restrict__ gate0, char* lds) {
  constexpr int DK = NQK * 16;
  constexpr int SHM_V = 8192, SHM_K = 17408;
  int tid_ = threadIdx.x; asm volatile("" : "+v"(tid_));
  const int tid = tid_, wid = __builtin_amdgcn_readfirstlane(tid >> 6), lane = tid & 63, r32 = lane & 31, hi = lane >> 5;
  char* V_lds = lds; char* K_lds = lds + 5 * SHM_V;
  float* wsf = (float*)(lds + 5 * SHM_V + 5 * SHM_K) + wid * 64; float* li_l = wsf;
  float lsum = 0; f32x16 o[2] = {}; bf16x8 qr[NQK];
  const float shift = mbound > 80.f ? mbound - 80.f : 0.f;
  const u16* Qw = Qb + (size_t)(wid * 32 + r32) * DK + hi * 8;
#pragma unroll
  for (int d0 = 0; d0 < NQK; ++d0) qr[d0] = *(const bf16x8*)(Qw + d0 * 16);
  const int srow = tid >> 3, sc8 = tid & 7;
  const int kst0 = KSWZ(srow, sc8 * 16), kst1 = KSWZ(srow, 128 + sc8 * 16), vst = v_st2(srow, sc8 * 8);
  const int vb0 = (int)(uintptr_t)V_lds + v_rd_base(lane);
  const bool k1on = (NQK == 6) && (sc8 < 4);
  const unsigned koff0 = srow * DK + sc8 * 8, voff0 = srow * 64 + sc8 * 8;
  struct { bf16x8 k0, k1, v0; } st[2];
#define TROW(j) (MODE == 0 ? (j) * 64 : ((j) < 4 ? (j) * 64 : q0 + 128 + ((j) - 4) * 64))
#define SLOAD(i, kr) do { const u16* kp_ = Kh + (unsigned)((kr) * DK); st[i].k0 = *(const bf16x8*)(kp_ + koff0);   \
    if (k1on) st[i].k1 = *(const bf16x8*)(kp_ + koff0 + 64);                                                           \
    const u16* vp_ = Vh + (unsigned)((kr) * 64); st[i].v0 = *(const bf16x8*)(vp_ + voff0); } while (0)
#define SWRITE(b, i) do { *(bf16x8*)(K_lds + (b) * SHM_K + kst0) = st[i].k0; if (k1on) *(bf16x8*)(K_lds + (b) * SHM_K + kst1) = st[i].k1; \
    *(bf16x8*)(V_lds + (b) * SHM_V + vst) = st[i].v0; } while (0)
#define MASKT(P0, P1, j) do { if (MODE == 1 && (j) >= 4) { const int kb_ = q0 - 128 + ((j) - 4) * 64, qp_ = q0 + wid * 32 + r32;    \
    _Pragma("unroll") for (int r = 0; r < 16; ++r) { int k0_ = kb_ + crow(r, hi), k1_ = k0_ + 32; int d0_ = qp_ - k0_, d1_ = qp_ - k1_; \
      bool ok0 = (d0_ <= 128) && (d0_ >= -128) && (k0_ >= 0) && (k0_ < SEQ); bool ok1 = (d1_ <= 128) && (d1_ >= -128) && (k1_ >= 0) && (k1_ < SEQ); \
      P0[r] = ok0 ? P0[r] : -1e30f; P1[r] = ok1 ? P1[r] : -1e30f; } } } while (0)
  f32x16 pA0, pA1, pB0, pB1; bf16x8 pa0, pa1, pa2, pa3;
#define NXS(x) ((x) + 1 == 5 ? 0 : (x) + 1)
  __syncthreads();
  SLOAD(0, TROW(0)); asm volatile("s_waitcnt vmcnt(0)" ::: "memory"); SWRITE(0, 0);
  SLOAD(0, TROW(1)); SWRITE(1, 0);
  SLOAD(0, TROW(2)); SWRITE(2, 0);
  if (3 < NT) SLOAD(0, TROW(3));
  if (4 < NT) SLOAD(1, TROW(4));
  __syncthreads();
  qkt<NQK>(pA0, pA1, K_lds, qr, r32, hi, shift); MASKT(pA0, pA1, 0); expall(pA0, pA1);
  int c = 0;
  for (int j = 1; j + 1 < NT; j += 2) {
    const int sj = NXS(c), sj1 = NXS(sj), sj2 = NXS(sj1), sj3 = NXS(sj2);
    SBAR(); SWRITE(sj2, 0); if (j + 3 < NT) SWRITE(sj3, 1); SBAR();
    qkt_fin<NQK>(pB0, pB1, K_lds + sj * SHM_K, qr, r32, hi, shift, pA0, pA1, lsum, pa0, pa1, pa2, pa3); MASKT(pB0, pB1, j); SBAR();
    if (j + 4 < NT) SLOAD(0, TROW(j + 4)); SBAR();
    pv_exp(o, vb0 + c * SHM_V, pa0, pa1, pa2, pa3, pB0, pB1);
    SBAR();
    qkt_fin<NQK>(pA0, pA1, K_lds + sj1 * SHM_K, qr, r32, hi, shift, pB0, pB1, lsum, pa0, pa1, pa2, pa3); MASKT(pA0, pA1, j + 1); SBAR();
    if (j + 5 < NT) SLOAD(1, TROW(j + 5)); SBAR();
    pv_exp(o, vb0 + sj * SHM_V, pa0, pa1, pa2, pa3, pA0, pA1);
    __syncthreads();
    c = sj1;
  }
  { const int sl = NXS(c);
    SBAR(); qkt_fin<NQK>(pB0, pB1, K_lds + sl * SHM_K, qr, r32, hi, shift, pA0, pA1, lsum, pa0, pa1, pa2, pa3); MASKT(pB0, pB1, NT - 1); SBAR();
    pv_all(o, vb0 + c * SHM_V, pa0, pa1, pa2, pa3); expall(pB0, pB1);
    finishSM(pB0, pB1, lsum, pa0, pa1, pa2, pa3); SBAR();
    pv_all(o, vb0 + sl * SHM_V, pa0, pa1, pa2, pa3); }
#undef NXS
  float l_reg;
  { auto rr = __builtin_amdgcn_permlane32_swap(__float_as_uint(lsum), __float_as_uint(lsum), false, false);
    l_reg = __uint_as_float(rr[0]) + __uint_as_float(rr[1]); }
  if (MODE == 1) l_reg += __builtin_amdgcn_exp2f(sink2 - shift);
  if (hi == 0) li_l[r32] = l_reg; asm volatile("s_waitcnt lgkmcnt(0)" ::: "memory");
  float rli[16];
#pragma unroll
  for (int r = 0; r < 16; ++r) rli[r] = __builtin_amdgcn_rcpf(li_l[crow(r, hi)]);
#pragma unroll
  for (int r = 0; r < 16; ++r) { const int orow = wid * 32 + crow(r, hi);
#pragma unroll
    for (int d0 = 0; d0 < 2; ++d0) {
      const float g = bf2f(gate0[(size_t)orow * LDG + d0 * 32 + r32]);
      mix0[(size_t)orow * 1024 + d0 * 32 + r32] = f2bf(o[d0][r] * rli[r] * silu_f(g));
    } }
#undef TROW
#undef SLOAD
#undef SWRITE
#undef MASKT
}

template <int NQK, int LDG, int RING>
__device__ __forceinline__ void attn_body2(const u16* __restrict__ Qb, const u16* __restrict__ Kh, const u16* __restrict__ Vh,
                                           const int NT, const float mbound, u16* __restrict__ mix0, const u16* __restrict__ gate0, char* lds) {
  constexpr int DK = NQK * 16;
  constexpr int SHM_V = 8192, SHM_K = 17408;
  int tid_ = threadIdx.x; asm volatile("" : "+v"(tid_));
  const int tid = tid_, wid = __builtin_amdgcn_readfirstlane(tid >> 6), lane = tid & 63, r32 = lane & 31, hi = lane >> 5;
  char* V_lds = lds; char* K_lds = lds + 5 * SHM_V;
  float* wsf = (float*)(lds + 5 * SHM_V + 5 * SHM_K) + wid * 64;
  float lsA = 0, lsB = 0; f32x16 oA[2] = {}, oB[2] = {}; bf16x8 qA[NQK], qB[NQK];
  const float shift = mbound > 80.f ? mbound - 80.f : 0.f;
  const u16* Qw = Qb + (size_t)(wid * 64 + r32) * DK + hi * 8;
#pragma unroll
  for (int d0 = 0; d0 < NQK; ++d0) { qA[d0] = *(const bf16x8*)(Qw + d0 * 16); qB[d0] = *(const bf16x8*)(Qw + 32 * DK + d0 * 16); }
  const int srow = tid >> 3, sc8 = tid & 7;
  const int kst0 = KSWZ(srow, sc8 * 16), kst1 = KSWZ(srow, 128 + sc8 * 16), vst = v_st2(srow, sc8 * 8);
  const int vb0 = (int)(uintptr_t)V_lds + v_rd_base(lane);
  const bool k1on = (NQK == 6) && (sc8 < 4);
  const unsigned koff0 = srow * DK + sc8 * 8, voff0 = srow * 64 + sc8 * 8;
  struct { bf16x8 k0, k1, v0; } st[RING == 1 ? 2 : 1];
  const auto rsK = __builtin_amdgcn_make_buffer_rsrc((void*)Kh, 0, KVLEN * DK * 2, 0x00020000);
  const auto rsV = __builtin_amdgcn_make_buffer_rsrc((void*)Vh, 0, KVLEN * 64 * 2, 0x00020000);
  const int kob = (int)koff0 * 2, vob = (int)voff0 * 2;
#define SLOAD(i, kr) do { st[i].k0 = __builtin_bit_cast(bf16x8, __builtin_amdgcn_raw_buffer_load_b128(rsK, kob, (kr) * (DK * 2), 0));   \
    if (k1on) st[i].k1 = __builtin_bit_cast(bf16x8, __builtin_amdgcn_raw_buffer_load_b128(rsK, kob + 128, (kr) * (DK * 2), 0));          \
    st[i].v0 = __builtin_bit_cast(bf16x8, __builtin_amdgcn_raw_buffer_load_b128(rsV, vob, (kr) * 128, 0)); } while (0)
#define SWRITE(b, i) do { *(bf16x8*)(K_lds + (b) * SHM_K + kst0) = st[i].k0; if (k1on) *(bf16x8*)(K_lds + (b) * SHM_K + kst1) = st[i].k1; \
    *(bf16x8*)(V_lds + (b) * SHM_V + vst) = st[i].v0; } while (0)
#define NXS(x) ((x) + 1 == 5 ? 0 : (x) + 1)
#define UNIT(PN0, PN1, QN, KS, PO0, PO1, LSO, OO, VS) do {                                                                      \
    qkt_fin<NQK>(PN0, PN1, K_lds + (KS) * SHM_K, QN, r32, hi, shift, PO0, PO1, LSO, pa0, pa1, pa2, pa3); SBAR();               \
    pv_exp(OO, vb0 + (VS) * SHM_V, pa0, pa1, pa2, pa3, PN0, PN1); SBAR(); } while (0)
#define UNITS(PN0, PN1, QN, KS, PO0, PO1, LSO, OO, VS) do {                 \
    qkt_fin<NQK>(PN0, PN1, K_lds + (KS) * SHM_K, QN, r32, hi, shift, PO0, PO1, LSO, pa0, pa1, pa2, pa3); SBAR();               \
    pv_exp_save(OO, vb0 + (VS) * SHM_V, pa0, pa1, pa2, pa3, PN0, PN1, vsv); SBAR(); } while (0)
#define UNITR(PN0, PN1, QN, KS, PO0, PO1, LSO, OO, VS) do {                                                    \
    qkt_fin<NQK>(PN0, PN1, K_lds + (KS) * SHM_K, QN, r32, hi, shift, PO0, PO1, LSO, pa0, pa1, pa2, pa3); SBAR();               \
    pv_exp_reuse(OO, vb0 + (VS) * SHM_V, pa0, pa1, pa2, pa3, PN0, PN1, vsv); SBAR(); } while (0)
  f32x16 pA0, pA1, pB0, pB1; bf16x8 pa0, pa1, pa2, pa3;
  if constexpr (RING == 1) {
  VSave vsv;
  __syncthreads();
  SLOAD(0, 0); asm volatile("s_waitcnt vmcnt(0)" ::: "memory"); SWRITE(0, 0);
  SLOAD(0, 64); SWRITE(1, 0);
  SLOAD(0, 128); SWRITE(2, 0);
  if (3 < NT) SLOAD(0, 3 * 64);
  if (4 < NT) SLOAD(1, 4 * 64);
  __syncthreads();
  qkt<NQK>(pA0, pA1, K_lds, qA, r32, hi, shift); expall(pA0, pA1);
  int c = 0;
  for (int i = 0; 2 * i + 2 < NT; ++i) {
    const int s1 = NXS(c), s2 = NXS(s1), s3 = NXS(s2), s4 = NXS(s3);
    SBAR(); if (2 * i + 3 < NT) SWRITE(s3, 0); if (2 * i + 4 < NT) SWRITE(s4, 1);
    if (2 * i + 5 < NT) SLOAD(0, (2 * i + 5) * 64); if (2 * i + 6 < NT) SLOAD(1, (2 * i + 6) * 64); SBAR();
    UNITS(pB0, pB1, qB, c, pA0, pA1, lsA, oA, c);
    UNITR(pA0, pA1, qA, s1, pB0, pB1, lsB, oB, c);
    UNITS(pB0, pB1, qB, s1, pA0, pA1, lsA, oA, s1);
    UNITR(pA0, pA1, qA, s2, pB0, pB1, lsB, oB, s1);
    __syncthreads();
    c = s2;
  }
  { const int s1 = NXS(c);
    UNITS(pB0, pB1, qB, c, pA0, pA1, lsA, oA, c);
    UNITR(pA0, pA1, qA, s1, pB0, pB1, lsB, oB, c);
    UNIT(pB0, pB1, qB, s1, pA0, pA1, lsA, oA, s1);
    finishSM(pB0, pB1, lsB, pa0, pa1, pa2, pa3); SBAR();
    pv_all(oB, vb0 + s1 * SHM_V, pa0, pa1, pa2, pa3); }
  } else if constexpr (RING == 2) {
    __syncthreads();
    SLOAD(0, 0); asm volatile("s_waitcnt vmcnt(0)" ::: "memory"); SWRITE(0, 0);
    SLOAD(0, 64); SWRITE(1, 0);
    SLOAD(0, 128); SWRITE(2, 0);
    if (3 < NT) SLOAD(0, 3 * 64);
    __syncthreads();
    qkt<NQK>(pA0, pA1, K_lds, qA, r32, hi, shift); expall(pA0, pA1);
    int c = 0;
    for (int i = 0; 2 * i + 2 < NT; ++i) {
      const int s1 = NXS(c), s2 = NXS(s1), s3 = NXS(s2), s4 = NXS(s3);
      SBAR(); if (2 * i + 3 < NT) SWRITE(s3, 0); if (2 * i + 4 < NT) SLOAD(0, (2 * i + 4) * 64); SBAR();
      UNIT(pB0, pB1, qB, c, pA0, pA1, lsA, oA, c);
      UNIT(pA0, pA1, qA, s1, pB0, pB1, lsB, oB, c);
      SBAR(); if (2 * i + 4 < NT) SWRITE(s4, 0); if (2 * i + 5 < NT) SLOAD(0, (2 * i + 5) * 64); SBAR();
      UNIT(pB0, pB1, qB, s1, pA0, pA1, lsA, oA, s1);
      UNIT(pA0, pA1, qA, s2, pB0, pB1, lsB, oB, s1);
      __syncthreads();
      c = s2;
    }
    { const int s1 = NXS(c);
      UNIT(pB0, pB1, qB, c, pA0, pA1, lsA, oA, c);
      UNIT(pA0, pA1, qA, s1, pB0, pB1, lsB, oB, c);
      UNIT(pB0, pB1, qB, s1, pA0, pA1, lsA, oA, s1);
      finishSM(pB0, pB1, lsB, pa0, pa1, pa2, pa3); SBAR();
      pv_all(oB, vb0 + s1 * SHM_V, pa0, pa1, pa2, pa3); }
  } else {
#define NX3(x) ((x) + 1 == 3 ? 0 : (x) + 1)
    __syncthreads();
    SLOAD(0, 0); asm volatile("s_waitcnt vmcnt(0)" ::: "memory"); SWRITE(0, 0);
    SLOAD(0, 64); SWRITE(1, 0);
    if (2 < NT) SLOAD(0, 128);
    __syncthreads();
    qkt<NQK>(pA0, pA1, K_lds, qA, r32, hi, shift); expall(pA0, pA1);
    int c = 0;
    for (int t = 0; t + 1 < NT; ++t) {
      const int s1 = NX3(c), s2 = NX3(s1);
      SBAR(); if (t + 2 < NT) SWRITE(s2, 0);
      if (t + 3 < NT) SLOAD(0, (t + 3) * 64); SBAR();
      UNIT(pB0, pB1, qB, c, pA0, pA1, lsA, oA, c);
      UNIT(pA0, pA1, qA, s1, pB0, pB1, lsB, oB, c);
      __syncthreads();
      c = s1;
    }
    UNIT(pB0, pB1, qB, c, pA0, pA1, lsA, oA, c);
    finishSM(pB0, pB1, lsB, pa0, pa1, pa2, pa3); SBAR();
    pv_all(oB, vb0 + c * SHM_V, pa0, pa1, pa2, pa3);
#undef NX3
  }
#undef UNIT
#undef UNITS
#undef UNITR
#undef NXS
#undef SLOAD
#undef SWRITE
  float lA, lB;
  { auto rr = __builtin_amdgcn_permlane32_swap(__float_as_uint(lsA), __float_as_uint(lsA), false, false); lA = __uint_as_float(rr[0]) + __uint_as_float(rr[1]); }
  { auto rr = __builtin_amdgcn_permlane32_swap(__float_as_uint(lsB), __float_as_uint(lsB), false, false); lB = __uint_as_float(rr[0]) + __uint_as_float(rr[1]); }
  if (hi == 0) { wsf[r32] = lA; wsf[32 + r32] = lB; }
  asm volatile("s_waitcnt lgkmcnt(0)" ::: "memory");
#pragma unroll
  for (int g = 0; g < 2; ++g) {
    float rli[16];
#pragma unroll
    for (int r = 0; r < 16; ++r) rli[r] = __builtin_amdgcn_rcpf(wsf[g * 32 + crow(r, hi)]);
#pragma unroll
    for (int r = 0; r < 16; ++r) { const int orow = wid * 64 + g * 32 + crow(r, hi);
#pragma unroll
      for (int d0 = 0; d0 < 2; ++d0) {
        const float gt = bf2f(gate0[(size_t)orow * LDG + d0 * 32 + r32]);
        const float ov = g == 0 ? oA[d0][r] : oB[d0][r];
        mix0[(size_t)orow * 1024 + d0 * 32 + r32] = f2bf(ov * rli[r] * silu_f(gt));
      } }
  }
}

__global__ void __launch_bounds__(512, 1) mega(Params p) {
  extern __shared__ __attribute__((aligned(16))) char lds[];
  cg::grid_group grid = cg::this_grid();
  const int bid = blockIdx.x, nblk = gridDim.x;
  char* ws = p.ws;
  float* modv = (float*)(ws + OFF_MODV);
  u16* H = (u16*)(ws + OFF_H);
  u16* PP = (u16*)(ws + OFF_PP);
  float* XC1 = (float*)(ws + OFF_XC1);
  unsigned* xbar = (unsigned*)(ws + OFF_END);
  volatile LAS unsigned* xst = (volatile LAS unsigned*)(lds + LDS_BYTES - 256);
  if (threadIdx.x == 0) { xst[0] = 0u; xst[1] = 0u; }
  __syncthreads();
  XcdBarrier xb = xcd_barrier_post(xbar, xst);
  if (p.ph_lo > 1000) grid.sync();

  if (p.ph_lo <= 0 && 0 < p.ph_hi) {
  for (int u = bid; u < 192; u += nblk) mod_unit(p, u, lds);
  }
  if (p.ph_lo <= 0 && 0 + 1 < p.ph_hi) xcd_barrier(xb);
  if (p.ph_lo <= 1 && 1 < p.ph_hi) {
  for (int u = bid; u < 2064; u += nblk) transpose_unit(p, u, lds);
  adaln_phase(p.x, nullptr, p.ctx, modv, H);
  }
  if (p.ph_lo <= 1 && 1 + 1 < p.ph_hi) xcd_barrier(xb);
  if (p.ph_lo <= 2 && 2 < p.ph_hi) {
  { TileIter ti(130, 19); GPre g; int nt = 0, mt = 0; const u16* Wt = (const u16*)(ws + OFF_WT_IN_AB);
    if (ti.valid()) { ti.get(mt, nt); gemm_preload(H, 1024, Wt, 1024, mt * 256, nt * 128, g); }
    while (ti.valid()) {
      f32x16 acc[2][2]; const int m0 = mt * 256, n0 = nt * 128;
      gemm_tile<0>(H, 1024, Wt, 1024, 1024, m0, n0, acc, lds, g);
      ti.next(); if (ti.valid()) { ti.get(mt, nt); gemm_preload(H, 1024, Wt, 1024, mt * 256, nt * 128, g); }
      epi_bf16(acc, PP, LD_AB, m0, n0, lds);
    } }
  }
  if (p.ph_lo <= 2 && 2 + 1 < p.ph_hi) xcd_barrier(xb);
  if (p.ph_lo <= 3 && 3 < p.ph_hi) {
  { TileIter ti(130, 14); GPre g; int nt = 0, mt = 0;
    const u16* Wq = (const u16*)(ws + OFF_WT_UQ); const u16* Wkv = (const u16*)(ws + OFF_WT_UKV);
    if (ti.valid()) { ti.get(mt, nt); gemm_preload(nt < 6 ? PP : PP + 256, LD_AB, nt < 6 ? Wq : Wkv, 256, mt * 256, (nt < 6 ? nt : nt - 6) * 128, g); }
    while (ti.valid()) {
      f32x16 acc[2][2]; const int m0 = mt * 256, cn = nt, n0 = (nt < 6 ? nt : nt - 6) * 128;
      gemm_tile<0>(cn < 6 ? PP : PP + 256, LD_AB, cn < 6 ? Wq : Wkv, 256, 256, m0, n0, acc, lds, g);
      ti.next(); if (ti.valid()) { ti.get(mt, nt); gemm_preload(nt < 6 ? PP : PP + 256, LD_AB, nt < 6 ? Wq : Wkv, 256, mt * 256, (nt < 6 ? nt : nt - 6) * 128, g); }
      if (cn < 6) epi_bf16(acc, H, 768, m0, n0, lds); else epi_bf16(acc, (u16*)p.out, 1024, m0, n0, lds);
    } }
  }
  if (p.ph_lo <= 3 && 3 + 1 < p.ph_hi) xcd_barrier(xb);
  if (p.ph_lo <= 4 && 4 < p.ph_hi) {
  finalize0(p);
  }
  if (p.ph_lo <= 4 && 4 + 1 < p.ph_hi) xcd_barrier(xb);
  if (p.ph_lo <= 5 && 5 < p.ph_hi) {
  const float mbA = LOG2E * 9.7979590f * 1.02f * vmaxabs(p.q_gain, 96) * vmaxabs(p.k_gain, 96);
  const float mbB = LOG2E * 8.f * 1.02f * vmaxabs(p.gq_gain, 64) * vmaxabs(p.gk_gain, 64);
  for (int it = bid; it < 1056; it += nblk) {
    if (it < 512) {
      const int round = it >> 8, blk = it & 255, xcd = blk & 7, cl = blk >> 3;
      const int pair = xcd * 2 + round, b = pair >> 3, h = pair & 7, qoff = cl * 512;
      const size_t r0 = (size_t)b * SEQ + qoff;
      attn_body2<6, LD_AB, 2>((const u16*)(ws + OFF_QA) + ((size_t)(b * 8 + h) * SEQ + qoff) * 96,
                                  (const u16*)(ws + OFF_KA) + (size_t)(b * 8 + h) * KVLEN * 96, (const u16*)(ws + OFF_VA) + (size_t)(b * 8 + h) * KVLEN * 64,
                                  KVLEN / 64, mbA, H + r0 * 1024 + h * 64, PP + r0 * LD_AB + 1312 + h * 64, lds);
    } else if (it < 1024) {
      const int i2 = it - 512, g = i2 >> 8, blk = i2 & 255, xcd = blk & 7, cl = blk >> 3;
      const int pi = xcd >> 1, b = pi >> 1, kvh = pi & 1, idx = (xcd & 1) * 64 + g * 32 + cl;
      const int h = kvh * 4 + (idx >> 5), qoff = (idx & 31) * 512;
      const size_t r0 = (size_t)b * SEQ + qoff;
      attn_body2<4, LD_AB, 1>((const u16*)(ws + OFF_QB) + ((size_t)(b * 8 + h) * SEQ + qoff) * 64,
                           (const u16*)(ws + OFF_KB) + (size_t)(b * 2 + kvh) * KVLEN * 64, (const u16*)(ws + OFF_VB) + (size_t)(b * 2 + kvh) * KVLEN * 64,
                           KVLEN / 64, mbB, H + r0 * 1024 + 512 + h * 64, PP + r0 * LD_AB + 1312 + 512 + h * 64, lds);
    } else {
      const int ci = it - 1024, b = (ci >> 3) & 1, h = ci & 7; const bool mla = ci < 16; const int kvh = mla ? h : (h >> 2);
      const size_t r0 = (size_t)NLAT + b * CL, qrow = (size_t)(b * 8 + h) * CL;
      if (mla) attn_body<6, 0, LD_AB>((const u16*)(ws + OFF_QCA) + qrow * 96, (const u16*)(ws + OFF_KA) + (size_t)(b * 8 + kvh) * KVLEN * 96,
                                      (const u16*)(ws + OFF_VA) + (size_t)(b * 8 + kvh) * KVLEN * 64, CL / 64, 0, 0.f, mbA, H + r0 * 1024 + h * 64, PP + r0 * LD_AB + 1312 + h * 64, lds);
      else attn_body<4, 0, LD_AB>((const u16*)(ws + OFF_QCB) + qrow * 64, (const u16*)(ws + OFF_KB) + (size_t)(b * 2 + kvh) * KVLEN * 64,
                                  (const u16*)(ws + OFF_VB) + (size_t)(b * 2 + kvh) * KVLEN * 64, CL / 64, 0, 0.f, mbB, H + r0 * 1024 + 512 + h * 64, PP + r0 * LD_AB + 1312 + 512 + h * 64, lds);
    }
  }
  }
  if (p.ph_lo <= 5 && 5 + 1 < p.ph_hi) xcd_barrier(xb);
  if (p.ph_lo <= 6 && 6 < p.ph_hi) {
  { TileIter ti(130, 8); GPre g; int nt = 0, mt = 0; const u16* Wt = (const u16*)(ws + OFF_WT_OUT_AB);
    if (ti.valid()) { ti.get(mt, nt); gemm_preload(H, 1024, Wt, 1024, mt * 256, nt * 128, g); }
    while (ti.valid()) {
      f32x16 acc[2][2]; const int m0 = mt * 256, n0 = nt * 128; const bool lat = m0 < NLAT;
      const int tid_ = opaque_tid(), wid_ = tid_ >> 6, lane_ = tid_ & 63;
      const size_t eoff = (size_t)((lat ? m0 : m0 - NLAT) + (wid_ & 3) * 64 + (lane_ >> 4)) * 1024 + n0 + (wid_ >> 2) * 64 + 4 * (lane_ & 15);
      ResPre rp;
      gemm_tile<1>(H, 1024, Wt, 1024, 1024, m0, n0, acc, lds, g, (lat ? p.x : p.ctx) + eoff, &rp);
      ti.next(); if (ti.valid()) { ti.get(mt, nt); gemm_preload(H, 1024, Wt, 1024, mt * 256, nt * 128, g); }
      if (lat) epi_res<false, true>(acc, rp, (u16*)(ws + OFF_X1B) + eoff, modv + (m0 >> 14) * 3072 + 2048, n0, lds);
      else epi_res<false, false>(acc, rp, XC1 + eoff, modv + 2 * 3072 + 2048, n0, lds);
    } }
  }
  if (p.ph_lo <= 6 && 6 + 1 < p.ph_hi) xcd_barrier(xb);
  if (p.ph_lo <= 7 && 7 < p.ph_hi) {
  adaln_phase(nullptr, (const u16*)(ws + OFF_X1B), XC1, modv + 3 * 3072, H);
  }
  if (p.ph_lo <= 7 && 7 + 1 < p.ph_hi) xcd_barrier(xb);
  if (p.ph_lo <= 8 && 8 < p.ph_hi) {
  { TileIter ti(130, 26); GPre g; int nt = 0, mt = 0; const u16* Wt = (const u16*)(ws + OFF_WT_IN_CD);
    if (ti.valid()) { ti.get(mt, nt); gemm_preload(H, 1024, Wt, 1024, mt * 256, nt * 128, g); }
    while (ti.valid()) {
      f32x16 acc[2][2]; const int m0 = mt * 256, n0 = nt * 128;
      gemm_tile<0>(H, 1024, Wt, 1024, 1024, m0, n0, acc, lds, g);
      ti.next(); if (ti.valid()) { ti.get(mt, nt); gemm_preload(H, 1024, Wt, 1024, mt * 256, nt * 128, g); }
      epi_bf16(acc, PP, LD_CD, m0, n0, lds);
    } }
  }
  if (p.ph_lo <= 8 && 8 + 1 < p.ph_hi) xcd_barrier(xb);
  if (p.ph_lo <= 9 && 9 < p.ph_hi) {
  finalize1(p);
  }
  if (p.ph_lo <= 9 && 9 + 1 < p.ph_hi) xcd_barrier(xb);
  if (p.ph_lo <= 10 && 10 < p.ph_hi) {
  const float mbW = LOG2E * 8.f * 1.02f * vmaxabs(p.win_q_gain, 64) * vmaxabs(p.win_k_gain, 64);
  for (int it = bid; it < 1024; it += nblk) {
    const int g = it >> 8, blk = it & 255, xcd = blk & 7, cl = blk >> 3;
    const int pi = xcd >> 1, b = pi >> 1, kvh = pi & 1, idx = (xcd & 1) * 128 + g * 32 + cl;
    const int h = kvh * 4 + (idx >> 6), qblk = idx & 63;
    const size_t r0 = (size_t)b * SEQ + qblk * 256;
    attn_body<4, 1, LD_CD>((const u16*)(ws + OFF_Q2) + ((size_t)(b * 8 + h) * SEQ + qblk * 256) * 64,
                    (const u16*)(ws + OFF_K2) + (size_t)(b * 2 + kvh) * KV2LEN * 64, (const u16*)(ws + OFF_V2) + (size_t)(b * 2 + kvh) * KV2LEN * 64,
                    12, qblk * 256, p.win_sink[h] * LOG2E, mbW, H + r0 * 1024 + h * 64, PP + r0 * LD_CD + 2304 + h * 64, lds);
  }
  }
  if (p.ph_lo <= 10 && 10 + 1 < p.ph_hi) xcd_barrier(xb);
  if (p.ph_lo <= 11 && 11 < p.ph_hi) {
  { TileIter ti(128, 8); GPre g; int nt = 0, mt = 0; const u16* Wt = (const u16*)(ws + OFF_WT_OUT_CD);
    if (ti.valid()) { ti.get(mt, nt); gemm_preload(H, 1024, Wt, 1024, mt * 256, nt * 128, g); }
    while (ti.valid()) {
      f32x16 acc[2][2]; const int m0 = mt * 256, n0 = nt * 128;
      const int tid_ = opaque_tid(), wid_ = tid_ >> 6, lane_ = tid_ & 63;
      const size_t eoff = (size_t)(m0 + (wid_ & 3) * 64 + (lane_ >> 4)) * 1024 + n0 + (wid_ >> 2) * 64 + 4 * (lane_ & 15);
      ResPre rp;
      gemm_tile<2>(H, 1024, Wt, 1024, 1024, m0, n0, acc, lds, g, (const u16*)(ws + OFF_X1B) + eoff, &rp);
      ti.next(); if (ti.valid()) { ti.get(mt, nt); gemm_preload(H, 1024, Wt, 1024, mt * 256, nt * 128, g); }
      epi_res<true, false>(acc, rp, p.out + eoff, modv + 3 * 3072 + (m0 >> 14) * 3072 + 2048, n0, lds);
    } }
  }
}

extern "C" void kernel_launch(void* const* d_in, const int* in_sizes, int n_in, void* d_out, int out_size, void* d_ws, size_t ws_size, hipStream_t stream) {
  static int grid_blocks = 0;
  if (!grid_blocks) {
    if (n_in != 22 || out_size != NLAT * DM || ws_size < OFF_END + 16384) {
      fprintf(stderr, "kernel_launch: shape/ws mismatch n_in %d out %d ws %zu need %zu\n", n_in, out_size, ws_size, (size_t)OFF_END);
      return;
    }
    if (hipFuncSetAttribute((const void*)mega, hipFuncAttributeMaxDynamicSharedMemorySize, LDS_BYTES) != hipSuccess) {
      fprintf(stderr, "kernel_launch: hipFuncSetAttribute failed\n"); return;
    }
    int dev = 0, cus = 0, per_cu = 0;
    (void)hipGetDevice(&dev);
    (void)hipDeviceGetAttribute(&cus, hipDeviceAttributeMultiprocessorCount, dev);
    (void)hipOccupancyMaxActiveBlocksPerMultiprocessor(&per_cu, mega, 512, LDS_BYTES);
    if (per_cu < 1) { fprintf(stderr, "kernel_launch: occupancy 0\n"); return; }
    grid_blocks = cus;
  }
  Params p{};
  p.x = (const float*)d_in[0]; p.c = (const float*)d_in[1]; p.ctx = (const float*)d_in[2]; p.c_ctx = (const float*)d_in[3];
  p.mod_w = (const float*)d_in[4]; p.mod_b = (const float*)d_in[5]; p.ab_w_in = (const float*)d_in[6]; p.ab_w_out = (const float*)d_in[7];
  p.cq_gain = (const float*)d_in[8]; p.ckv_gain = (const float*)d_in[9]; p.w_uq = (const float*)d_in[10]; p.w_ukv = (const float*)d_in[11];
  p.q_gain = (const float*)d_in[12]; p.k_gain = (const float*)d_in[13]; p.gq_gain = (const float*)d_in[14]; p.gk_gain = (const float*)d_in[15];
  p.cd_w_in = (const float*)d_in[16]; p.cd_w_out = (const float*)d_in[17]; p.win_q_gain = (const float*)d_in[18]; p.win_k_gain = (const float*)d_in[19];
  p.win_sink = (const float*)d_in[20]; p.conv_w = (const float*)d_in[21];
  p.out = (float*)d_out; p.ws = (char*)d_ws;
#if MULTI_LAUNCH
  for (int ph = 0; ph < 12; ++ph) {
    p.ph_lo = ph; p.ph_hi = ph + 1;
    hipLaunchKernelGGL(mega, dim3(grid_blocks), dim3(512), LDS_BYTES, stream, p);
  }
#else
  p.ph_lo = 0; p.ph_hi = 12;
  if (hipMemsetAsync((char*)d_ws + OFF_END, 0, XCD_BAR_WORDS * 4, stream) != hipSuccess) { fprintf(stderr, "kernel_launch: hipMemsetAsync of the barrier words failed\n"); return; }
  void* args[] = {&p};
  hipError_t e = hipLaunchCooperativeKernel((void*)mega, dim3(grid_blocks), dim3(512), args, LDS_BYTES, stream);
  if (e != hipSuccess) fprintf(stderr, "cooperative launch failed: %s (grid %d)\n", hipGetErrorString(e), grid_blocks);
#endif
}
```
